# Optimizing an MI355X kernel written in HIP

```python
import math
import functools
import jax
import jax.numpy as jnp
from jax import lax
import numpy as np

D_MODEL = 1024
BATCH = 8
SEQ = 2048
DEPTH = 2

GRID_W = 64
CTX_LEN = 256
HEAD_DIM = 64
ROPE_BASE = 10000.0
EPS = 1e-6

NA_HEADS = 8
NA_WIN_ROWS = 8
NA_WIN_COLS = 16
NA_QCOLS = 16
NA_KCOLS = 32
NA_WIDTH = NA_HEADS * HEAD_DIM

SSM_HEADS = 16
SSM_HEADDIM = 64
SSM_D_INNER = SSM_HEADS * SSM_HEADDIM
SSM_STATE = 128
SSM_GROUPS = 2
SSM_CONV = 5
SSM_CONV_CH = SSM_D_INNER + 2 * SSM_GROUPS * SSM_STATE
SCAN_CHUNK = 128

SWA_HEADS = 8
SWA_KV_HEADS = 2
SWA_WINDOW = 128
SWA_BLOCK = 128
SWA_Q = SWA_HEADS * HEAD_DIM
SWA_KV = SWA_KV_HEADS * HEAD_DIM

RET_HEADS = 8
RET_QK_DIM = 64
RET_V_DIM = 128
RET_QK = RET_HEADS * RET_QK_DIM
RET_V = RET_HEADS * RET_V_DIM

EVEN_IN = 3 * NA_WIDTH + SSM_D_INNER + SSM_CONV_CH + 2 * SSM_HEADS
EVEN_OUT = NA_WIDTH + SSM_D_INNER
ODD_IN = SWA_Q + 2 * SWA_KV + 2 * RET_QK + 2 * RET_V
ODD_OUT = SWA_Q + RET_V

D_FF = 2816
N_EXPERTS = 8
TOP_K = 2
D_FF_EXPERT = 3584

kernel_name = "hybrid_diffusion_prefix_backbone"


def split_cols(t, sizes):
    return jnp.split(t, np.cumsum(sizes)[:-1].tolist(), axis=-1)


def to_heads(t, n_heads):
    return t.reshape(t.shape[:-1] + (n_heads, t.shape[-1] // n_heads))


def rmsnorm(x, g):
    xf = x.astype(jnp.float32)
    y = xf * lax.rsqrt(jnp.mean(jnp.square(xf), axis=-1, keepdims=True) + EPS)
    return (y * g.astype(jnp.float32)).astype(x.dtype)


def modulate(h, shift, scale):
    return h * (1 + scale) + shift


def axial_rope(n_tokens, dim):
    t = jnp.arange(n_tokens)
    row = (t // GRID_W).astype(jnp.float32)
    col = (t % GRID_W).astype(jnp.float32)
    n_freq = dim // 4
    inv = ROPE_BASE ** (-jnp.arange(n_freq, dtype=jnp.float32) / n_freq)
    ang = jnp.concatenate([row[:, None] * inv, col[:, None] * inv], axis=-1)
    return jnp.cos(ang)[:, None, :], jnp.sin(ang)[:, None, :]


def apply_rope(x, cos, sin):
    x1, x2 = jnp.split(x.astype(jnp.float32), 2, axis=-1)
    return jnp.concatenate([x1 * cos - x2 * sin, x2 * cos + x1 * sin], axis=-1).astype(x.dtype)


def centred_depthwise_conv(x, w, bias):
    pad = (w.shape[0] - 1) // 2
    y = lax.conv_general_dilated(x, w, window_strides=(1,), padding=[(pad, pad)],
                                 dimension_numbers=('NWC', 'WIO', 'NWC'),
                                 feature_group_count=x.shape[-1])
    return y + bias


def chunked_scan(x, a, Bm, Cm, h0, need_y):
    b, L, H, P = x.shape
    G, N = Bm.shape[2], Bm.shape[3]
    hg = H // G
    Q = SCAN_CHUNK
    nc = L // Q
    xr = x.reshape(b, nc, Q, G, hg, P)
    Br = Bm.reshape(b, nc, Q, G, N)
    Cr = Cm.reshape(b, nc, Q, G, N)
    a_cum = jnp.cumsum(a.astype(jnp.float32).reshape(b, nc, Q, G, hg), axis=2)
    a_tot = a_cum[:, :, -1]
    w_state = jnp.exp(a_tot[:, :, None] - a_cum).astype(x.dtype)
    states = jnp.einsum('bcjgn,bcjgh,bcjghp->bcghpn', Br, w_state, xr)

    def step(h, inp):
        decay, s = inp
        return jnp.exp(decay)[..., None, None].astype(h.dtype) * h + s, h

    h_final, h_prev = lax.scan(step, h0.reshape(b, G, hg, P, N),
                               (jnp.moveaxis(a_tot, 1, 0), jnp.moveaxis(states, 1, 0)))
    h_final = h_final.reshape(b, H, P, N)
    if not need_y:
        return None, h_final
    h_prev = jnp.moveaxis(h_prev, 0, 1)
    diff = a_cum[:, :, :, None] - a_cum[:, :, None, :]
    causal = np.tril(np.ones((Q, Q), dtype=bool))[:, :, None, None]
    decay_mat = jnp.exp(jnp.where(causal, diff, -jnp.inf)).astype(x.dtype)
    cb = jnp.einsum('bcign,bcjgn->bcijg', Cr, Br)
    y_diag = jnp.einsum('bcijg,bcijgh,bcjghp->bcighp', cb, decay_mat, xr)
    y_off = jnp.einsum('bcign,bcghpn,bcigh->bcighp', Cr, h_prev, jnp.exp(a_cum).astype(x.dtype))
    return (y_diag + y_off).reshape(b, L, H, P), h_final


def scan_from_context(xc, ac, Bc, Cc, xl, al, Bl, Cl, reverse, need_ctx):
    if reverse:
        xc, ac, Bc, Cc, xl, al, Bl, Cl = [jnp.flip(t, axis=1) for t in (xc, ac, Bc, Cc, xl, al, Bl, Cl)]
    b, _, H, P = xc.shape
    h0 = jnp.zeros((b, H, P, Bc.shape[-1]), xc.dtype)
    yc, hc = chunked_scan(xc, ac, Bc, Cc, h0, need_ctx)
    yl, _ = chunked_scan(xl, al, Bl, Cl, hc, True)
    if reverse:
        yl = jnp.flip(yl, axis=1)
        yc = jnp.flip(yc, axis=1) if need_ctx else None
    return yc, yl


def context_attention(q, k, v, sink):
    b, lc, H, D = q.shape
    kvh = k.shape[2]
    g = H // kvh
    s = jnp.einsum('bqkgd,bskd->bkgqs', q.reshape(b, lc, kvh, g, D), k) * D ** -0.5
    if sink is not None:
        s_sink = jnp.broadcast_to(sink.reshape(1, kvh, g, 1, 1).astype(s.dtype), (b, kvh, g, lc, 1))
        s = jnp.concatenate([s, s_sink], axis=-1)
    p = jax.nn.softmax(s.astype(jnp.float32), axis=-1).astype(v.dtype)
    o = jnp.einsum('bkgqs,bskd->bqkgd', p[..., :lc], v)
    return o.reshape(b, lc, H * D)


def neighbourhood_attention(q, k, v, k_ctx, v_ctx, rpb):
    b, L, H, D = q.shape
    rows = L // GRID_W
    kr = min(NA_WIN_ROWS, rows)
    ncb = GRID_W // NA_QCOLS
    scale = D ** -0.5
    qcol = np.arange(GRID_W).reshape(ncb, NA_QCOLS)
    kstart = np.clip(np.arange(ncb) * NA_QCOLS - NA_WIN_COLS // 2, 0, GRID_W - NA_KCOLS)
    kcol = kstart[:, None] + np.arange(NA_KCOLS)[None, :]
    c0 = np.clip(qcol - NA_WIN_COLS // 2, 0, GRID_W - NA_WIN_COLS)
    col_ok = (kcol[:, None, :] >= c0[:, :, None]) & (kcol[:, None, :] < c0[:, :, None] + NA_WIN_COLS)
    col_idx = np.clip(kcol[:, None, :] - qcol[:, :, None] + NA_WIN_COLS - 1, 0, 2 * NA_WIN_COLS - 2)
    qg = q.reshape(b, rows, ncb, NA_QCOLS, H, D)
    kg = k.reshape(b, rows, GRID_W, H, D)
    vg = v.reshape(b, rows, GRID_W, H, D)
    n_nb = kr * NA_KCOLS

    def one_row(r):
        r0 = jnp.clip(r - kr // 2, 0, rows - kr)
        q_r = lax.dynamic_index_in_dim(qg, r, axis=1, keepdims=False)
        k_blk = lax.dynamic_slice_in_dim(kg, r0, kr, axis=1)[:, :, kcol]
        v_blk = lax.dynamic_slice_in_dim(vg, r0, kr, axis=1)[:, :, kcol]
        drow = r0 + jnp.arange(kr) - r + NA_WIN_ROWS - 1
        bias = jnp.moveaxis(rpb[:, drow[:, None, None, None], col_idx[None]], 1, 3)
        s_nb = jnp.einsum('bjqhd,brjkhd->bhjqrk', q_r, k_blk) * scale + bias[None]
        s_nb = jnp.where(col_ok[:, :, None, :], s_nb, -jnp.inf)
        s_ctx = jnp.einsum('bjqhd,bkhd->bhjqk', q_r, k_ctx) * scale
        s = jnp.concatenate([s_nb.reshape(b, H, ncb, NA_QCOLS, n_nb), s_ctx.astype(s_nb.dtype)], axis=-1)
        p = jax.nn.softmax(s.astype(jnp.float32), axis=-1).astype(v.dtype)
        p_nb = p[..., :n_nb].reshape(b, H, ncb, NA_QCOLS, kr, NA_KCOLS)
        o = (jnp.einsum('bhjqrk,brjkhd->bjqhd', p_nb, v_blk)
             + jnp.einsum('bhjqk,bkhd->bjqhd', p[..., n_nb:], v_ctx))
        return o.reshape(b, GRID_W, H * D)

    out = lax.map(one_row, jnp.arange(rows))
    return jnp.moveaxis(out, 0, 1).reshape(b, L, H * D)


def sliding_window_attention(q, k, v, k_ctx, v_ctx, sink):
    b, L, H, D = q.shape
    kvh = k.shape[2]
    g = H // kvh
    blk = SWA_BLOCK
    nb = L // blk
    lc = k_ctx.shape[1]
    nw = 3 * blk
    scale = D ** -0.5
    qb = q.reshape(b, nb, blk, kvh, g, D)
    pad = ((0, 0), (blk, blk), (0, 0), (0, 0))
    kp = jnp.pad(k, pad).reshape(b, nb + 2, blk, kvh, D)
    vp = jnp.pad(v, pad).reshape(b, nb + 2, blk, kvh, D)
    k_win = jnp.concatenate([kp[:, :-2], kp[:, 1:-1], kp[:, 2:]], axis=2)
    v_win = jnp.concatenate([vp[:, :-2], vp[:, 1:-1], vp[:, 2:]], axis=2)
    qpos = np.arange(L).reshape(nb, blk)
    kpos = np.arange(nb)[:, None] * blk - blk + np.arange(nw)[None, :]
    ok = ((kpos[:, None, :] >= 0) & (kpos[:, None, :] < L)
          & (np.abs(kpos[:, None, :] - qpos[:, :, None]) <= SWA_WINDOW))
    s_loc = jnp.where(ok, jnp.einsum('bnqkgd,bnskd->bkgnqs', qb, k_win) * scale, -jnp.inf)
    s_ctx = jnp.einsum('bnqkgd,bskd->bkgnqs', qb, k_ctx) * scale
    s_sink = jnp.broadcast_to(sink.reshape(1, kvh, g, 1, 1, 1).astype(s_ctx.dtype), (b, kvh, g, nb, blk, 1))
    s = jnp.concatenate([s_loc, s_ctx, s_sink], axis=-1)
    p = jax.nn.softmax(s.astype(jnp.float32), axis=-1).astype(v.dtype)
    o = (jnp.einsum('bkgnqs,bnskd->bnqkgd', p[..., :nw], v_win)
         + jnp.einsum('bkgnqs,bskd->bnqkgd', p[..., nw:nw + lc], v_ctx))
    return o.reshape(b, L, H * D)


def ssm_inputs(xbc, dt_raw, conv_w, conv_b, dt_bias, a_log):
    b, L, _ = xbc.shape
    xbc = jax.nn.silu(centred_depthwise_conv(xbc, conv_w, conv_b))
    xs, Bm, Cm = split_cols(xbc, [SSM_D_INNER, SSM_GROUPS * SSM_STATE, SSM_GROUPS * SSM_STATE])
    xs = xs.reshape(b, L, SSM_HEADS, SSM_HEADDIM)
    Bm = Bm.reshape(b, L, SSM_GROUPS, SSM_STATE)
    Cm = Cm.reshape(b, L, SSM_GROUPS, SSM_STATE)
    dt = jax.nn.softplus(dt_raw.reshape(b, L, 2, SSM_HEADS) + dt_bias)
    a = dt * (-jnp.exp(a_log))
    xdt = xs[:, :, None] * dt[..., None]
    return xs, Bm, Cm, xdt, a


def ssm_output(y, xs, z, d_skip, g):
    b, L = y.shape[:2]
    y = (y + xs * d_skip[:, None]).reshape(b, L, SSM_D_INNER)
    yz = (y * jax.nn.silu(z)).reshape(b, L, SSM_GROUPS, SSM_D_INNER // SSM_GROUPS).astype(jnp.float32)
    yz = yz * lax.rsqrt(jnp.mean(jnp.square(yz), axis=-1, keepdims=True) + EPS)
    return (yz.reshape(b, L, SSM_D_INNER) * g.astype(jnp.float32)).astype(y.dtype)


def head_layernorm(y, g, bias):
    b, L, H, P = y.shape
    yf = y.astype(jnp.float32)
    mu = jnp.mean(yf, axis=-1, keepdims=True)
    var = jnp.mean(jnp.square(yf - mu), axis=-1, keepdims=True)
    yn = ((yf - mu) * lax.rsqrt(var + EPS)).reshape(b, L, H * P)
    return (yn * g.astype(jnp.float32) + bias.astype(jnp.float32)).astype(y.dtype)


def even_mixer(hc, hl, w_in, w_out, rpb, conv_w, conv_b, dt_bias, a_log, d_skip, gn_g, need_ctx):
    sizes = [NA_WIDTH, NA_WIDTH, NA_WIDTH, SSM_D_INNER, SSM_CONV_CH, 2 * SSM_HEADS]
    qc, kc, vc, zc, xbcc, dtc = split_cols(hc @ w_in, sizes)
    ql, kl, vl, zl, xbcl, dtl = split_cols(hl @ w_in, sizes)
    kc = to_heads(kc, NA_HEADS)
    vc = to_heads(vc, NA_HEADS)
    ya_l = neighbourhood_attention(to_heads(ql, NA_HEADS), to_heads(kl, NA_HEADS), to_heads(vl, NA_HEADS), kc, vc, rpb)
    xs_c, Bc, Cc, xdt_c, a_c = ssm_inputs(xbcc, dtc, conv_w, conv_b, dt_bias, a_log)
    xs_l, Bl, Cl, xdt_l, a_l = ssm_inputs(xbcl, dtl, conv_w, conv_b, dt_bias, a_log)
    yf_c, yf_l = scan_from_context(xdt_c[:, :, 0], a_c[:, :, 0], Bc, Cc,
                                   xdt_l[:, :, 0], a_l[:, :, 0], Bl, Cl, False, need_ctx)
    yb_c, yb_l = scan_from_context(xdt_c[:, :, 1], a_c[:, :, 1], Bc, Cc,
                                   xdt_l[:, :, 1], a_l[:, :, 1], Bl, Cl, True, need_ctx)
    ys_l = ssm_output(yf_l + yb_l, xs_l, zl, d_skip, gn_g)
    y_l = jnp.concatenate([ya_l, ys_l], axis=-1) @ w_out
    if not need_ctx:
        return None, y_l
    ya_c = context_attention(to_heads(qc, NA_HEADS), kc, vc, None)
    ys_c = ssm_output(yf_c + yb_c, xs_c, zc, d_skip, gn_g)
    y_c = jnp.concatenate([ya_c, ys_c], axis=-1) @ w_out
    return y_c, y_l


def odd_mixer(hc, hl, w_in, w_out, sink, log_decay, gn_g, gn_b, need_ctx):
    sizes = [SWA_Q, SWA_KV, SWA_KV, RET_QK, RET_QK, RET_V, RET_V]
    qc, kc, vc, rqc, rkc, rvc, rgc = split_cols(hc @ w_in, sizes)
    ql, kl, vl, rql, rkl, rvl, rgl = split_cols(hl @ w_in, sizes)
    b, L, _ = hl.shape
    lc = hc.shape[1]
    cos, sin = axial_rope(L, HEAD_DIM)
    kc = to_heads(kc, SWA_KV_HEADS)
    vc = to_heads(vc, SWA_KV_HEADS)
    yw_l = sliding_window_attention(apply_rope(to_heads(ql, SWA_HEADS), cos, sin),
                                    apply_rope(to_heads(kl, SWA_KV_HEADS), cos, sin),
                                    to_heads(vl, SWA_KV_HEADS), kc, vc, sink)
    kscale = RET_QK_DIM ** -0.5
    rq_l = apply_rope(to_heads(rql, RET_HEADS), cos, sin)
    rk_l = apply_rope(to_heads(rkl, RET_HEADS), cos, sin) * kscale
    rv_l = to_heads(rvl, RET_HEADS)
    rq_c = to_heads(rqc, RET_HEADS)
    rk_c = to_heads(rkc, RET_HEADS) * kscale
    rv_c = to_heads(rvc, RET_HEADS)
    log_gamma = jnp.log1p(-jnp.exp(log_decay.astype(jnp.float32)))
    ga_c = [jnp.broadcast_to(log_gamma[d], (b, lc, RET_HEADS)) for d in (0, 1)]
    ga_l = [jnp.broadcast_to(log_gamma[d], (b, L, RET_HEADS)) for d in (0, 1)]
    rf_c, rf_l = scan_from_context(rv_c, ga_c[0], rk_c, rq_c, rv_l, ga_l[0], rk_l, rq_l, False, need_ctx)
    rb_c, rb_l = scan_from_context(rv_c, ga_c[1], rk_c, rq_c, rv_l, ga_l[1], rk_l, rq_l, True, need_ctx)
    yr_l = jax.nn.silu(rgl) * head_layernorm(rf_l + rb_l, gn_g, gn_b)
    y_l = jnp.concatenate([yw_l, yr_l], axis=-1) @ w_out
    if not need_ctx:
        return None, y_l
    yw_c = context_attention(to_heads(qc, SWA_HEADS), kc, vc, sink)
    yr_c = jax.nn.silu(rgc) * head_layernorm(rf_c + rb_c, gn_g, gn_b)
    y_c = jnp.concatenate([yw_c, yr_c], axis=-1) @ w_out
    return y_c, y_l


def swiglu(h, w1, w3, w2):
    return (jax.nn.silu(h @ w1) * (h @ w3)) @ w2


def moe_swiglu(h, router, w1, w3, w2):
    logits = (h @ router).astype(jnp.float32)
    top_v, top_i = lax.top_k(logits, TOP_K)
    gates = jax.nn.softmax(top_v, axis=-1)
    dense_gate = jnp.sum(jax.nn.one_hot(top_i, N_EXPERTS, dtype=jnp.float32) * gates[..., None], axis=-2).astype(h.dtype)
    out = jnp.zeros_like(h)
    for e in range(N_EXPERTS):
        out = out + dense_gate[..., e:e + 1] * swiglu(h, w1[e], w3[e], w2[e])
    return out


def setup_inputs(seed: int = 0) -> dict:
    key = jax.random.key(seed)
    keys = iter(jax.random.split(key, 48))
    f32 = jnp.float32
    n_even = (DEPTH + 1) // 2
    n_odd = DEPTH // 2
    D = D_MODEL

    def normal(shape, scale):
        return jax.random.normal(next(keys), shape, f32) * scale

    def gain(shape):
        return 1.0 + normal(shape, 0.05)

    a_log = jnp.log(jax.random.uniform(next(keys), (n_even, 2, SSM_HEADS), f32, 1.0, 16.0))
    dt0 = jnp.exp(jax.random.uniform(next(keys), (n_even, 2, SSM_HEADS), f32, math.log(1e-3), math.log(1e-1)))
    dt_bias = dt0 + jnp.log(-jnp.expm1(-dt0))
    base_decay = (-5.0 - jnp.arange(RET_HEADS, dtype=f32)) * math.log(2.0)
    return {
        'x': normal((BATCH, SEQ, D), 1.0),
        'c': normal((BATCH, D), 1.0),
        'ctx': normal((BATCH, CTX_LEN, D), 1.0),
        'c_ctx': normal((D,), 1.0),
        'ada_w': normal((DEPTH, D, 6 * D), D ** -0.5),
        'ada_b': normal((DEPTH, 6 * D), 0.02),
        'norm_attn_g': gain((DEPTH, D)),
        'norm_ffn_g': gain((DEPTH, D)),
        'ev_w_in': normal((n_even, D, EVEN_IN), D ** -0.5),
        'ev_w_out': normal((n_even, EVEN_OUT, D), EVEN_OUT ** -0.5),
        'na_rpb': normal((n_even, NA_HEADS, 2 * NA_WIN_ROWS - 1, 2 * NA_WIN_COLS - 1), 0.02),
        'ssm_conv_w': normal((n_even, SSM_CONV, 1, SSM_CONV_CH), SSM_CONV ** -0.5),
        'ssm_conv_b': normal((n_even, SSM_CONV_CH), 0.02),
        'ssm_dt_bias': dt_bias,
        'ssm_a_log': a_log,
        'ssm_d': gain((n_even, SSM_HEADS)),
        'ssm_norm_g': gain((n_even, SSM_D_INNER)),
        'ffn_w1': normal((n_even, D, D_FF), D ** -0.5),
        'ffn_w3': normal((n_even, D, D_FF), D ** -0.5),
        'ffn_w2': normal((n_even, D_FF, D), D_FF ** -0.5),
        'od_w_in': normal((n_odd, D, ODD_IN), D ** -0.5),
        'od_w_out': normal((n_odd, ODD_OUT, D), ODD_OUT ** -0.5),
        'swa_sink': normal((n_odd, SWA_HEADS), 1.0),
        'ret_log_decay': base_decay + normal((n_odd, 2, RET_HEADS), 0.05),
        'ret_gn_g': gain((n_odd, RET_V)),
        'ret_gn_b': normal((n_odd, RET_V), 0.02),
        'moe_router': normal((n_odd, D, N_EXPERTS), D ** -0.5),
        'moe_w1': normal((n_odd, N_EXPERTS, D, D_FF_EXPERT), D ** -0.5),
        'moe_w3': normal((n_odd, N_EXPERTS, D, D_FF_EXPERT), D ** -0.5),
        'moe_w2': normal((n_odd, N_EXPERTS, D_FF_EXPERT, D), D_FF_EXPERT ** -0.5),
        'final_g': gain((D,)),
    }


def reference(x, c, ctx, c_ctx, ada_w, ada_b, norm_attn_g, norm_ffn_g,
              ev_w_in, ev_w_out, na_rpb, ssm_conv_w, ssm_conv_b, ssm_dt_bias, ssm_a_log, ssm_d, ssm_norm_g,
              ffn_w1, ffn_w3, ffn_w2,
              od_w_in, od_w_out, swa_sink, ret_log_decay, ret_gn_g, ret_gn_b,
              moe_router, moe_w1, moe_w3, moe_w2, final_g):
    xl, xc = x, ctx
    for l in range(DEPTH):
        i = l // 2
        need_ctx = l < DEPTH - 1
        mod_l = (jax.nn.silu(c) @ ada_w[l] + ada_b[l])[:, None, :]
        mod_c = (jax.nn.silu(c_ctx) @ ada_w[l] + ada_b[l])[None, None, :]
        sh1_l, sc1_l, g1_l, sh2_l, sc2_l, g2_l = jnp.split(mod_l, 6, axis=-1)
        sh1_c, sc1_c, g1_c, sh2_c, sc2_c, g2_c = jnp.split(mod_c, 6, axis=-1)
        hl = modulate(rmsnorm(xl, norm_attn_g[l]), sh1_l, sc1_l)
        hc = modulate(rmsnorm(xc, norm_attn_g[l]), sh1_c, sc1_c)
        if l % 2 == 0:
            yc, yl = even_mixer(hc, hl, ev_w_in[i], ev_w_out[i], na_rpb[i], ssm_conv_w[i], ssm_conv_b[i],
                                ssm_dt_bias[i], ssm_a_log[i], ssm_d[i], ssm_norm_g[i], need_ctx)
            ffn = functools.partial(swiglu, w1=ffn_w1[i], w3=ffn_w3[i], w2=ffn_w2[i])
        else:
            yc, yl = odd_mixer(hc, hl, od_w_in[i], od_w_out[i], swa_sink[i], ret_log_decay[i],
                               ret_gn_g[i], ret_gn_b[i], need_ctx)
            ffn = functools.partial(moe_swiglu, router=moe_router[i], w1=moe_w1[i], w3=moe_w3[i], w2=moe_w2[i])
        xl = xl + g1_l * yl
        xl = xl + g2_l * ffn(modulate(rmsnorm(xl, norm_ffn_g[l]), sh2_l, sc2_l))
        if need_ctx:
            xc = xc + g1_c * yc
            xc = xc + g2_c * ffn(modulate(rmsnorm(xc, norm_ffn_g[l]), sh2_c, sc2_c))
    return rmsnorm(xl, final_g)
```

```cpp
#include <hip/hip_runtime.h>
#include <cstdio>
#include <cstdint>

#ifndef MK_ONE_LAUNCH
#define MK_ONE_LAUNCH 0
#endif

#define LAS __attribute__((address_space(3)))
typedef unsigned short bf16;
typedef short bf16x8 __attribute__((ext_vector_type(8)));
typedef float f32x4 __attribute__((ext_vector_type(4)));
typedef unsigned v4u __attribute__((ext_vector_type(4)));
typedef unsigned v2u __attribute__((ext_vector_type(2)));

constexpr int DM = 1024, NB = 8, SEQ = 2048, CTXL = 256;
constexpr int TL = NB * SEQ, TC = NB * CTXL, TT = TL + TC;
constexpr int LDP0 = 4352;
constexpr int LDP1 = 3840;
constexpr int DFF = 2816, DFE = 3584, NEXP = 8;
constexpr float EPS = 1e-6f;

constexpr size_t MiB = 1u << 20;
constexpr size_t WS_CTL = 0, CTL_ZERO_BYTES = 1 * MiB;
constexpr size_t WS_MOD = 1 * MiB;
constexpr size_t WS_GATE = 2 * MiB;
constexpr size_t WS_ROPE = 3 * MiB;
constexpr size_t WS_WIN0 = 4 * MiB;
constexpr size_t WS_WOUT0 = 13 * MiB;
constexpr size_t WS_WF13 = 16 * MiB;
constexpr size_t WS_WF2 = 27 * MiB;
constexpr size_t WS_WIN1 = 33 * MiB;
constexpr size_t WS_WOUT1 = 41 * MiB;
constexpr size_t WS_X = 44 * MiB;
constexpr size_t WS_H = 116 * MiB;
constexpr size_t WS_R = 152 * MiB;
constexpr size_t WS_P = WS_R;
constexpr size_t WS_YA = WS_R + 153 * MiB;
constexpr size_t WS_XBC = WS_R + 207 * MiB;
constexpr size_t WS_YF = WS_R + 261 * MiB;
constexpr size_t WS_YB = WS_R + 297 * MiB;
constexpr size_t WS_G = WS_R;
constexpr size_t WS_WM13 = WS_R;
constexpr size_t WS_WM2 = WS_R + 112 * MiB;
constexpr size_t WS_MG = WS_R + 168 * MiB;
constexpr size_t WS_END = WS_R + 333 * MiB;
static_assert(WS_P + (size_t)TT * LDP0 * 2 <= WS_YA && WS_YA + (size_t)TT * 1536 * 2 <= WS_XBC && WS_XBC + (size_t)TT * 1536 * 2 <= WS_YF && WS_YF + (size_t)TT * 1024 * 2 <= WS_YB && WS_YB + (size_t)TT * 1024 * 2 <= WS_END, "ws map");
static_assert(WS_WM13 + (size_t)8 * 7168 * 1024 * 2 <= WS_WM2 && WS_WM2 + (size_t)8 * 1024 * 3584 * 2 <= WS_MG && WS_MG + (size_t)TL * 3584 * 2 <= WS_END, "ws map moe");
static_assert(WS_X + (size_t)TT * 1024 * 4 <= WS_H && WS_H + (size_t)TT * 1024 * 2 <= WS_R, "ws map 2");
constexpr int CW_BAR = 4096;

constexpr int RING_BYTES = 131072, LDSCTL_OFF = RING_BYTES, MISC_OFF = LDSCTL_OFF + 320, LDS_BYTES = 147456;
constexpr int NWAVES = 8;

#define LDS_WAIT() asm volatile("s_waitcnt lgkmcnt(0)" ::: "memory")
__device__ __forceinline__ unsigned f2bf(float f) { unsigned u = __builtin_bit_cast(unsigned, f); return (u + 0x7fffu + ((u >> 16) & 1u)) >> 16; }
__device__ __forceinline__ unsigned pk2(float lo, float hi) { return f2bf(lo) | (f2bf(hi) << 16); }
__device__ __forceinline__ float bf2f(unsigned short b) { return __builtin_bit_cast(float, ((unsigned)b) << 16); }
__device__ __forceinline__ float bflo(unsigned w) { return __builtin_bit_cast(float, w << 16); }
__device__ __forceinline__ float bfhi(unsigned w) { return __builtin_bit_cast(float, w & 0xffff0000u); }
__device__ __forceinline__ float silu_f(float x) { return x / (1.f + __expf(-x)); }
__device__ __forceinline__ float wave_sum(float v) {
#pragma unroll
    for (int o = 1; o < 64; o <<= 1) v += __shfl_xor(v, o);
    return v;
}
__host__ __device__ __forceinline__ int perm32(int rho) { const int n = rho >> 4, i = rho & 15; return 8 * (i >> 2) + 4 * n + (i & 3); }

#define XB_TMO      128
#define XB_XCNT(j)  (256  + 64 * (j))
#define XB_XSUB(j)  (1280 + 64 * (j))
#define XB_XGEN(j)  (2304 + 64 * (j))
#define XB_TOP      3328
#define XB_TOPGEN   3392
#define XCD_BAR_WORDS 3456
#define XB_SPIN_CAP (1u << 18)
__device__ __forceinline__ unsigned xb_ld(unsigned* p)              { return __hip_atomic_load(p, __ATOMIC_RELAXED, __HIP_MEMORY_SCOPE_AGENT); }
__device__ __forceinline__ unsigned xb_add(unsigned* p, unsigned v) { return __hip_atomic_fetch_add(p, v, __ATOMIC_RELAXED, __HIP_MEMORY_SCOPE_AGENT); }
__device__ __forceinline__ unsigned xb_xcc_id() { return (unsigned)__builtin_amdgcn_s_getreg((3 << 11) | 20) & 0xFu; }
#define XB_SPIN(cond, bar) do { unsigned _sp = 0; while (cond) { __builtin_amdgcn_s_sleep(1); \
    if ((++_sp & 255u) == 0u) { if (xb_ld(&(bar)[XB_TMO])) break; if (_sp > XB_SPIN_CAP) { atomicAdd(&(bar)[XB_TMO], 1u); break; } } } } while (0)
struct XcdBarrier { unsigned* bar; unsigned x; volatile LAS unsigned* st; };
__device__ __forceinline__ XcdBarrier xcd_barrier_post(unsigned* bar, volatile LAS unsigned* st) {
    XcdBarrier b; b.bar = bar; b.x = xb_xcc_id(); b.st = st;
    if (threadIdx.x == 0) (void)xb_add(&bar[XB_XCNT(b.x)], 1u);
    return b;
}
__device__ __forceinline__ void xcd_barrier_complete(unsigned* bar, unsigned x, unsigned& nloc, unsigned& nx) {
    const unsigned G = gridDim.x * gridDim.y * gridDim.z;
    unsigned sum, cnt, mine, sp = 0u;
    for (;;) {
        sum = 0u; cnt = 0u; mine = 0u;
#pragma unroll
        for (unsigned j = 0; j < 16; ++j) { const unsigned c = xb_ld(&bar[XB_XCNT(j)]); sum += c; cnt += (c > 0u) ? 1u : 0u; mine = (j == x) ? c : mine; }
        if (sum == G) break;
        __builtin_amdgcn_s_sleep(1);
        if ((++sp & 255u) == 0u) { if (xb_ld(&bar[XB_TMO])) break; if (sp > XB_SPIN_CAP) { atomicAdd(&bar[XB_TMO], 1u); break; } }
    }
    nloc = mine > 0u ? mine : 1u; nx = cnt > 0u ? cnt : 1u;
}
__device__ __forceinline__ void xcd_barrier(const XcdBarrier& b) {
    asm volatile("s_waitcnt vmcnt(0)" ::: "memory");
    __syncthreads();
    if (threadIdx.x == 0) {
        unsigned* bar = b.bar;
        __builtin_amdgcn_s_waitcnt(0);
        unsigned nloc = b.st[0], nx = b.st[1];
        if (nloc == 0u) { xcd_barrier_complete(bar, b.x, nloc, nx); b.st[0] = nloc; b.st[1] = nx; }
        const unsigned old = xb_add(&bar[XB_XSUB(b.x)], 1u);
        const unsigned gen = old / nloc;
        if (old + 1u == (gen + 1u) * nloc) {
            __builtin_amdgcn_fence(__ATOMIC_RELEASE, "agent");
            asm volatile("s_waitcnt vmcnt(0)" ::: "memory");
            const unsigned og = xb_add(&bar[XB_TOP], 1u);
            const unsigned tg = og / nx;
            if (og + 1u == (tg + 1u) * nx) xb_add(&bar[XB_TOPGEN], 1u);
            else XB_SPIN(xb_ld(&bar[XB_TOPGEN]) == tg, bar);
            __builtin_amdgcn_fence(__ATOMIC_ACQUIRE, "agent");
            xb_add(&bar[XB_XGEN(b.x)], 1u);
            asm volatile("s_waitcnt vmcnt(0)" ::: "memory");
        } else {
            XB_SPIN(xb_ld(&bar[XB_XGEN(b.x)]) == gen, bar);
            __builtin_amdgcn_fence(__ATOMIC_ACQUIRE, "agent");
            asm volatile("s_waitcnt vmcnt(0)" ::: "memory");
        }
    }
    __syncthreads();
}

struct Frame {
    LAS unsigned char* lds;
    int tid, lane, wave, vcu, G;
    const float *x, *c, *ctx, *c_ctx, *ada_w, *ada_b, *norm_attn_g, *norm_ffn_g, *ev_w_in, *ev_w_out, *na_rpb, *conv_w, *conv_b, *dt_bias, *a_log, *ssm_d, *ssm_norm_g,
        *ffn_w1, *ffn_w3, *ffn_w2, *od_w_in, *od_w_out, *swa_sink, *ret_log_decay, *ret_gn_g, *ret_gn_b, *moe_router, *moe_w1, *moe_w3, *moe_w2, *final_g;
    float* out;
    float *MOD, *GATE, *ROPE, *X;
    bf16 *WIN0, *WOUT0, *WF13, *WF2, *WIN1, *WOUT1, *WM13, *WM2, *H, *P, *YA, *XBC, *YF, *YB, *Gh, *MG;
};

__device__ __forceinline__ void tr_item(const float* W, int K, int N, bf16* WT, int ilv, LAS float* scr, int item, int lane) {
    const int nblk = N / 32, kb = item / nblk, nb = item % nblk, k0 = 64 * kb, n0 = 32 * nb;
#pragma unroll 8
    for (int i = 0; i < 32; ++i) { const int kk = 2 * i + (lane >> 5); scr[kk * 33 + (lane & 31)] = W[(size_t)(k0 + kk) * N + n0 + (lane & 31)]; }
    LDS_WAIT(); asm volatile("" ::: "memory");
    const int c = lane & 7;
#pragma unroll
    for (int j = 0; j < 4; ++j) { const int n = (lane >> 3) + 8 * j; const LAS float* s = scr + (8 * c) * 33 + n;
        v4u o; o.x = pk2(s[0 * 33], s[1 * 33]); o.y = pk2(s[2 * 33], s[3 * 33]); o.z = pk2(s[4 * 33], s[5 * 33]); o.w = pk2(s[6 * 33], s[7 * 33]);
        const int nn = n0 + n; const int row = ilv ? (8 * (nn >> 2) + (nn & 3) + (ilv == 2 ? 4 : 0)) : nn;
        *(v4u*)(WT + (size_t)row * K + k0 + 8 * c) = o; }
    LDS_WAIT(); asm volatile("" ::: "memory");
}

__device__ __forceinline__ void ph_cvt(const Frame& F) {
    LAS float* scr = (LAS float*)(F.lds + F.wave * 16384);
    const int gw = F.vcu * NWAVES + F.wave, NGW = F.G * NWAVES;
    constexpr int I_IN0 = 16 * 129, I_OUT = 24 * 32, I_F1 = 16 * 88, I_F2 = 44 * 32, I_IN1 = 16 * 120;
    constexpr int NITEMS = I_IN0 + I_OUT + 2 * I_F1 + I_F2 + I_IN1 + I_OUT;
    for (int it = gw; it < NITEMS; it += NGW) {
        int r = it;
        if (r < I_IN0) { tr_item(F.ev_w_in, 1024, 4128, F.WIN0, 0, scr, r, F.lane); continue; } r -= I_IN0;
        if (r < I_OUT) { tr_item(F.ev_w_out, 1536, 1024, F.WOUT0, 0, scr, r, F.lane); continue; } r -= I_OUT;
        if (r < I_F1) { tr_item(F.ffn_w1, 1024, DFF, F.WF13, 1, scr, r, F.lane); continue; } r -= I_F1;
        if (r < I_F1) { tr_item(F.ffn_w3, 1024, DFF, F.WF13, 2, scr, r, F.lane); continue; } r -= I_F1;
        if (r < I_F2) { tr_item(F.ffn_w2, DFF, 1024, F.WF2, 0, scr, r, F.lane); continue; } r -= I_F2;
        if (r < I_IN1) { tr_item(F.od_w_in, 1024, LDP1, F.WIN1, 0, scr, r, F.lane); continue; } r -= I_IN1;
        tr_item(F.od_w_out, 1536, 1024, F.WOUT1, 0, scr, r, F.lane);
    }
    { const int gt = F.vcu * 512 + F.tid, NGT = F.G * 512; v4u* z = (v4u*)(F.WIN0 + (size_t)4128 * 1024);
      for (int i = gt; i < 224 * 1024 / 8; i += NGT) z[i] = (v4u){0u, 0u, 0u, 0u}; }
    { const int gt = F.vcu * 512 + F.tid, NGT = F.G * 512;
      for (int i = gt; i < 2048 * 32; i += NGT) { const int t = i >> 5, f = i & 31; const float inv = powf(10000.f, -(float)(f & 15) / 16.f);
          const float ang = (float)((f < 16) ? (t >> 6) : (t & 63)) * inv; float sn, cs; sincosf(ang, &sn, &cs); F.ROPE[2 * i] = cs; F.ROPE[2 * i + 1] = sn; } }
    __syncthreads();
    LAS float* sv = (LAS float*)F.lds;
    LAS float* part = (LAS float*)(F.lds + 36864);
    for (int it = F.vcu; it < 192; it += F.G) {
        const int l = it / 96, n0 = (it % 96) * 64;
        for (int i = F.tid; i < 9 * 1024; i += 512) { const int r = i >> 10, k = i & 1023; const float v = (r < 8) ? F.c[r * 1024 + k] : F.c_ctx[k]; sv[i] = silu_f(v); }
        __syncthreads();
        float acc[9];
#pragma unroll
        for (int r = 0; r < 9; ++r) acc[r] = 0.f;
        const float* wp = F.ada_w + (size_t)l * 1024 * 6144 + n0 + F.lane;
        for (int k = F.wave * 128; k < F.wave * 128 + 128; ++k) { const float w = wp[(size_t)k * 6144];
#pragma unroll
            for (int r = 0; r < 9; ++r) acc[r] += sv[r * 1024 + k] * w; }
#pragma unroll
        for (int r = 0; r < 9; ++r) part[(F.wave * 9 + r) * 64 + F.lane] = acc[r];
        __syncthreads();
        for (int i = F.tid; i < 9 * 64; i += 512) { const int r = i >> 6, n = i & 63; float s = 0.f;
#pragma unroll
            for (int w = 0; w < 8; ++w) s += part[(w * 9 + r) * 64 + n];
            F.MOD[(size_t)(l * 9 + r) * 6144 + n0 + n] = s + F.ada_b[l * 6144 + n0 + n]; }
        __syncthreads();
    }
}

__device__ __forceinline__ void ph_cvt_moe(const Frame& F) {
    LAS float* scr = (LAS float*)(F.lds + F.wave * 16384);
    const int gw = F.vcu * NWAVES + F.wave, NGW = F.G * NWAVES;
    constexpr int I_1 = 16 * 112, I_2 = 56 * 32;
    constexpr int NITEMS = NEXP * (2 * I_1 + I_2);
    for (int it = gw; it < NITEMS; it += NGW) {
        const int e = it / (2 * I_1 + I_2); int r = it % (2 * I_1 + I_2);
        if (r < I_1) { tr_item(F.moe_w1 + (size_t)e * 1024 * DFE, 1024, DFE, F.WM13 + (size_t)e * 7168 * 1024, 1, scr, r, F.lane); continue; } r -= I_1;
        if (r < I_1) { tr_item(F.moe_w3 + (size_t)e * 1024 * DFE, 1024, DFE, F.WM13 + (size_t)e * 7168 * 1024, 2, scr, r, F.lane); continue; } r -= I_1;
        tr_item(F.moe_w2 + (size_t)e * DFE * 1024, DFE, 1024, F.WM2 + (size_t)e * 1024 * DFE, 0, scr, r, F.lane);
    }
}

template <int MODE, bool ROUTER>
__device__ __forceinline__ void ph_norm(const Frame& F, int layer, int which, int nrows) {
    const int gw = F.vcu * NWAVES + F.wave, NGW = F.G * NWAVES;
    const float* g = (which ? F.norm_ffn_g : F.norm_attn_g) + layer * 1024;
    for (int row = gw; row < nrows; row += NGW) {
        const int bidx = row < TL ? (row >> 11) : 8;
        const float* src = MODE == 0 ? (row < TL ? F.x + (size_t)row * 1024 : F.ctx + (size_t)(row - TL) * 1024) : F.X + (size_t)row * 1024;
        const float* mod = F.MOD + (size_t)(layer * 9 + bidx) * 6144 + (which ? 3 : 0) * 1024;
        const f32x4* xr = (const f32x4*)src + F.lane;
        f32x4 v[4]; float s = 0.f;
#pragma unroll
        for (int j = 0; j < 4; ++j) { v[j] = xr[64 * j]; s += (v[j].x * v[j].x + v[j].y * v[j].y) + (v[j].z * v[j].z + v[j].w * v[j].w); }
        const float rstd = 1.0f / sqrtf(wave_sum(s) * (1.f / 1024.f) + EPS);
        unsigned long long* o8 = (unsigned long long*)(F.H + (size_t)row * 1024) + F.lane;
#pragma unroll
        for (int j = 0; j < 4; ++j) {
            const f32x4 gg = ((const f32x4*)g)[F.lane + 64 * j], sh = ((const f32x4*)mod)[F.lane + 64 * j], sc = ((const f32x4*)(mod + 1024))[F.lane + 64 * j];
            v[j] = (v[j] * rstd * gg) * (sc + 1.0f) + sh;
            o8[64 * j] = (unsigned long long)pk2(v[j].x, v[j].y) | ((unsigned long long)pk2(v[j].z, v[j].w) << 32);
        }
        if (ROUTER) {
            float lg[8];
#pragma unroll
            for (int e = 0; e < 8; ++e) lg[e] = 0.f;
#pragma unroll
            for (int j = 0; j < 4; ++j)
#pragma unroll
                for (int i = 0; i < 4; ++i) { const int k = 4 * (F.lane + 64 * j) + i; const f32x4 r0 = ((const f32x4*)(F.moe_router + (size_t)k * 8))[0], r1 = ((const f32x4*)(F.moe_router + (size_t)k * 8))[1];
                    const float hv = v[j][i];
                    lg[0] += hv * r0.x; lg[1] += hv * r0.y; lg[2] += hv * r0.z; lg[3] += hv * r0.w; lg[4] += hv * r1.x; lg[5] += hv * r1.y; lg[6] += hv * r1.z; lg[7] += hv * r1.w; }
#pragma unroll
            for (int e = 0; e < 8; ++e) lg[e] = wave_sum(lg[e]);
            int i0 = 0; float v0 = lg[0];
#pragma unroll
            for (int e = 1; e < 8; ++e) if (lg[e] > v0) { v0 = lg[e]; i0 = e; }
            int i1 = -1; float v1 = -3.0e38f;
#pragma unroll
            for (int e = 0; e < 8; ++e) if (e != i0 && lg[e] > v1) { v1 = lg[e]; i1 = e; }
            const float e1 = __expf(v1 - v0), g0 = 1.f / (1.f + e1), g1 = e1 / (1.f + e1);
            if (F.lane < 8) F.GATE[(size_t)row * 8 + F.lane] = (F.lane == i0) ? g0 : ((F.lane == i1) ? g1 : 0.f);
        }
    }
}

template <class Epi>
__device__ __forceinline__ void gemm_simple(const Frame& F, const bf16* A, const bf16* Bt, int M, int N, int K, const Epi& E) {
    const int nN = N / 128, nU = (M / 256) * nN;
    const int wr = F.wave >> 1, wc = F.wave & 1, fr = F.lane & 15, fq = F.lane >> 4;
    for (int u = F.vcu; u < nU; u += F.G) {
        const int pm = u / nN, pn = u % nN, row0 = pm * 256 + wr * 64, col0 = pn * 128 + wc * 64;
        f32x4 acc[4][4];
#pragma unroll
        for (int i = 0; i < 4; ++i)
#pragma unroll
            for (int j = 0; j < 4; ++j) acc[i][j] = (f32x4){0.f, 0.f, 0.f, 0.f};
        const bf16* ap = A + (size_t)(row0 + fr) * K + fq * 8;
        const bf16* bp0 = Bt + (size_t)(col0 + perm32(fr)) * K + fq * 8;
        const bf16* bp1 = Bt + (size_t)(col0 + perm32(16 + fr)) * K + fq * 8;
#pragma unroll 2
        for (int k0 = 0; k0 < K; k0 += 32) {
            bf16x8 a[4], b[4];
#pragma unroll
            for (int i = 0; i < 4; ++i) a[i] = *(const bf16x8*)(ap + (size_t)(16 * i) * K + k0);
            b[0] = *(const bf16x8*)(bp0 + k0); b[1] = *(const bf16x8*)(bp1 + k0);
            b[2] = *(const bf16x8*)(bp0 + (size_t)32 * K + k0); b[3] = *(const bf16x8*)(bp1 + (size_t)32 * K + k0);
#pragma unroll
            for (int i = 0; i < 4; ++i)
#pragma unroll
                for (int j = 0; j < 4; ++j) acc[i][j] = __builtin_amdgcn_mfma_f32_16x16x32_bf16(b[j], a[i], acc[i][j], 0, 0, 0);
        }
#pragma unroll
        for (int i = 0; i < 4; ++i)
#pragma unroll
            for (int q = 0; q < 2; ++q) E(row0 + 16 * i + fr, col0 + 32 * q + 8 * fq, acc[i][2 * q], acc[i][2 * q + 1]);
    }
}

struct EpiStore {
    bf16* O; int ldc;
    __device__ __forceinline__ void operator()(int row, int col, f32x4 lo, f32x4 hi) const {
        v4u w; w.x = pk2(lo.x, lo.y); w.y = pk2(lo.z, lo.w); w.z = pk2(hi.x, hi.y); w.w = pk2(hi.z, hi.w);
        *(v4u*)(O + (size_t)row * ldc + col) = w; }
};
struct EpiSwiglu {
    bf16* O; int ldc;
    __device__ __forceinline__ void operator()(int row, int col, f32x4 lo, f32x4 hi) const {
        v2u w; w.x = pk2(silu_f(lo.x) * hi.x, silu_f(lo.y) * hi.y); w.y = pk2(silu_f(lo.z) * hi.z, silu_f(lo.w) * hi.w);
        *(v2u*)(O + (size_t)row * ldc + (col >> 1)) = w; }
};
struct EpiResid {
    const float* bl; const float* bc; float* X; const float* gate  ; const float* rs; int rs_ld, rs_off;
    __device__ __forceinline__ void operator()(int row, int col, f32x4 lo, f32x4 hi) const {
        const int bidx = row < TL ? (row >> 11) : 8;
        const float* b = row < TL ? bl + (size_t)row * 1024 + col : bc + (size_t)(row - TL) * 1024 + col;
        const float* gp = gate + (size_t)bidx * 6144 + col;
        float sc = 1.f; if (rs) sc = rs[(size_t)row * rs_ld + rs_off];
        const f32x4 g0 = ((const f32x4*)gp)[0] * sc, g1 = ((const f32x4*)gp)[1] * sc;
        const f32x4 b0 = ((const f32x4*)b)[0], b1 = ((const f32x4*)b)[1];
        float* o = X + (size_t)row * 1024 + col;
        ((f32x4*)o)[0] = b0 + g0 * lo; ((f32x4*)o)[1] = b1 + g1 * hi; }
};

#define DOT64(s, q, kp) do { s = 0.f; _Pragma("unroll") for (int _c = 0; _c < 8; ++_c) { const v4u _w = ((const v4u*)(kp))[_c]; \
    s += q[8*_c+0] * bflo(_w.x) + q[8*_c+1] * bfhi(_w.x) + q[8*_c+2] * bflo(_w.y) + q[8*_c+3] * bfhi(_w.y) + q[8*_c+4] * bflo(_w.z) + q[8*_c+5] * bfhi(_w.z) + q[8*_c+6] * bflo(_w.w) + q[8*_c+7] * bfhi(_w.w); } } while (0)
#define ONLINE_UPD(s, m, l, o, vp) do { if (s > m) { const float _cr = __expf(m - s); l *= _cr; _Pragma("unroll") for (int _d = 0; _d < 64; ++_d) o[_d] *= _cr; m = s; } \
    const float _p = __expf(s - m); l += _p; _Pragma("unroll") for (int _c = 0; _c < 8; ++_c) { const v4u _w = ((const v4u*)(vp))[_c]; \
    o[8*_c+0] += _p * bflo(_w.x); o[8*_c+1] += _p * bfhi(_w.x); o[8*_c+2] += _p * bflo(_w.y); o[8*_c+3] += _p * bfhi(_w.y); o[8*_c+4] += _p * bflo(_w.z); o[8*_c+5] += _p * bfhi(_w.z); o[8*_c+6] += _p * bflo(_w.w); o[8*_c+7] += _p * bfhi(_w.w); } } while (0)
#define LOADQ64(q, qp, scale) do { _Pragma("unroll") for (int _c = 0; _c < 8; ++_c) { const v4u _w = ((const v4u*)(qp))[_c]; \
    q[8*_c+0] = scale * bflo(_w.x); q[8*_c+1] = scale * bfhi(_w.x); q[8*_c+2] = scale * bflo(_w.y); q[8*_c+3] = scale * bfhi(_w.y); q[8*_c+4] = scale * bflo(_w.z); q[8*_c+5] = scale * bfhi(_w.z); q[8*_c+6] = scale * bflo(_w.w); q[8*_c+7] = scale * bfhi(_w.w); } } while (0)
#define STORE_O64(op, o, inv) do { _Pragma("unroll") for (int _c = 0; _c < 8; ++_c) { v4u _w; _w.x = pk2(o[8*_c+0] * inv, o[8*_c+1] * inv); _w.y = pk2(o[8*_c+2] * inv, o[8*_c+3] * inv); \
    _w.z = pk2(o[8*_c+4] * inv, o[8*_c+5] * inv); _w.w = pk2(o[8*_c+6] * inv, o[8*_c+7] * inv); ((v4u*)(op))[_c] = _w; } } while (0)

__device__ __forceinline__ void ph_attn0(const Frame& F) {
    const int gw = F.vcu * NWAVES + F.wave, NGW = F.G * NWAVES;
    const bf16* P = F.P;
    for (int u = gw; u < 2048 + 256; u += NGW) {
        float q[64], o[64]; float m = -INFINITY, l = 0.f;
#pragma unroll
        for (int d = 0; d < 64; ++d) o[d] = 0.f;
        if (u < 2048) {
            const int h = u & 7, r = (u >> 3) & 31, b = u >> 8, qc = F.lane;
            const int r0 = min(max(r - 4, 0), 24), c0 = min(max(qc - 8, 0), 48);
            const size_t qrow = (size_t)b * 2048 + r * 64 + qc;
            LOADQ64(q, P + qrow * LDP0 + h * 64, 0.125f);
            for (int ri = 0; ri < 8; ++ri)
                for (int ci = 0; ci < 16; ++ci) {
                    const size_t krow = (size_t)b * 2048 + (r0 + ri) * 64 + c0 + ci;
                    const bf16* kp = P + krow * LDP0 + 512 + h * 64;
                    float s; DOT64(s, q, kp);
                    s += F.na_rpb[(h * 15 + (r0 + ri - r + 7)) * 31 + (c0 + ci - qc + 15)];
                    ONLINE_UPD(s, m, l, o, kp + 512);
                }
            for (int sc = 0; sc < 256; ++sc) {
                const size_t krow = (size_t)TL + b * 256 + sc;
                const bf16* kp = P + krow * LDP0 + 512 + h * 64;
                float s; DOT64(s, q, kp);
                ONLINE_UPD(s, m, l, o, kp + 512);
            }
            const float inv = 1.f / l;
            STORE_O64(F.YA + qrow * 1536 + h * 64, o, inv);
        } else {
            const int v = u - 2048, qb = v & 3, h = (v >> 2) & 7, b = v >> 5;
            const size_t qrow = (size_t)TL + b * 256 + qb * 64 + F.lane;
            LOADQ64(q, P + qrow * LDP0 + h * 64, 0.125f);
            for (int sc = 0; sc < 256; ++sc) {
                const size_t krow = (size_t)TL + b * 256 + sc;
                const bf16* kp = P + krow * LDP0 + 512 + h * 64;
                float s; DOT64(s, q, kp);
                ONLINE_UPD(s, m, l, o, kp + 512);
            }
            const float inv = 1.f / l;
            STORE_O64(F.YA + qrow * 1536 + h * 64, o, inv);
        }
    }
}

__device__ __forceinline__ void ph_conv(const Frame& F) {
    const int gt = F.vcu * 512 + F.tid, NGT = F.G * 512;
    for (int idx = gt; idx < TT * 192; idx += NGT) {
        const int row = idx / 192, ch = (idx % 192) * 8;
        int t, len; if (row < TL) { t = row & 2047; len = 2048; } else { t = (row - TL) & 255; len = 256; }
        float acc[8];
#pragma unroll
        for (int j = 0; j < 8; ++j) acc[j] = F.conv_b[ch + j];
#pragma unroll
        for (int k = 0; k < 5; ++k) { const int tt = t + k - 2;
            if (tt >= 0 && tt < len) { const v4u w = *(const v4u*)(F.P + (size_t)(row + k - 2) * LDP0 + 2560 + ch); const float* cw = F.conv_w + k * 1536 + ch;
                acc[0] += cw[0] * bflo(w.x); acc[1] += cw[1] * bfhi(w.x); acc[2] += cw[2] * bflo(w.y); acc[3] += cw[3] * bfhi(w.y);
                acc[4] += cw[4] * bflo(w.z); acc[5] += cw[5] * bfhi(w.z); acc[6] += cw[6] * bflo(w.w); acc[7] += cw[7] * bfhi(w.w); } }
        v4u o; o.x = pk2(silu_f(acc[0]), silu_f(acc[1])); o.y = pk2(silu_f(acc[2]), silu_f(acc[3])); o.z = pk2(silu_f(acc[4]), silu_f(acc[5])); o.w = pk2(silu_f(acc[6]), silu_f(acc[7]));
        *(v4u*)(F.XBC + (size_t)row * 1536 + ch) = o;
    }
}

__device__ __forceinline__ int scan_row(int b, int d, int s) {
    if (s < 256) return TL + b * 256 + (d ? 255 - s : s);
    const int t = s - 256; return b * 2048 + (d ? 2047 - t : t);
}
__device__ __forceinline__ void ph_scan0(const Frame& F) {
    LAS float* xs = (LAS float*)F.lds;
    LAS float* Bs = xs + 32 * 64;
    LAS float* Cs = Bs + 32 * 128;
    LAS float* dts = Cs + 32 * 128;
    LAS float* decs = dts + 32;
    LAS float* ybuf = decs + 32;
    const int p = F.tid >> 3, ng = F.tid & 7;
    for (int u = F.vcu; u < 256; u += F.G) {
        const int d = u & 1, h = (u >> 1) & 15, b = u >> 5, g = h >> 3;
        const float dtb = F.dt_bias[d * 16 + h], Acoef = -expf(F.a_log[d * 16 + h]);
        float hst[16];
#pragma unroll
        for (int j = 0; j < 16; ++j) hst[j] = 0.f;
        for (int ck = 0; ck < 72; ++ck) {
            __syncthreads();
            for (int idx = F.tid; idx < 32 * 320; idx += 512) { const int i = idx / 320, c = idx % 320; const int row = scan_row(b, d, ck * 32 + i);
                const int col = c < 64 ? h * 64 + c : (c < 192 ? 1024 + g * 128 + (c - 64) : 1280 + g * 128 + (c - 192));
                const float val = bf2f(F.XBC[(size_t)row * 1536 + col]);
                if (c < 64) xs[i * 64 + c] = val; else if (c < 192) Bs[i * 128 + (c - 64)] = val; else Cs[i * 128 + (c - 192)] = val; }
            if (F.tid < 32) { const int row = scan_row(b, d, ck * 32 + F.tid); const float raw = bf2f(F.P[(size_t)row * LDP0 + 4096 + d * 16 + h]) + dtb;
                const float dt = raw > 20.f ? raw : log1pf(__expf(raw)); dts[F.tid] = dt; decs[F.tid] = __expf(dt * Acoef); }
            __syncthreads();
            for (int i = 0; i < 32; ++i) {
                const float dt = dts[i], dec = decs[i], xv = xs[i * 64 + p] * dt;
                float y = 0.f;
#pragma unroll
                for (int j4 = 0; j4 < 4; ++j4) { const f32x4 bv = *(const LAS f32x4*)(Bs + i * 128 + 16 * ng + 4 * j4), cv = *(const LAS f32x4*)(Cs + i * 128 + 16 * ng + 4 * j4);
#pragma unroll
                    for (int jj = 0; jj < 4; ++jj) { hst[4 * j4 + jj] = hst[4 * j4 + jj] * dec + xv * bv[jj]; y += hst[4 * j4 + jj] * cv[jj]; } }
                y += __shfl_xor(y, 1); y += __shfl_xor(y, 2); y += __shfl_xor(y, 4);
                if (ng == 0) ybuf[i * 64 + p] = y;
            }
            __syncthreads();
            bf16* Y = d ? F.YB : F.YF;
            for (int idx = F.tid; idx < 2048; idx += 512) { const int i = idx >> 6, pp = idx & 63; const int row = scan_row(b, d, ck * 32 + i);
                Y[(size_t)row * 1024 + h * 64 + pp] = (bf16)f2bf(ybuf[i * 64 + pp]); }
        }
    }
}

__device__ __forceinline__ void ph_ssmout(const Frame& F) {
    const int gw = F.vcu * NWAVES + F.wave, NGW = F.G * NWAVES;
    for (int row = gw; row < TT; row += NGW) {
#pragma unroll
        for (int grp = 0; grp < 2; ++grp) {
            const int ch = grp * 512 + F.lane * 8;
            const v4u yf = *(const v4u*)(F.YF + (size_t)row * 1024 + ch), yb = *(const v4u*)(F.YB + (size_t)row * 1024 + ch);
            const v4u xv = *(const v4u*)(F.XBC + (size_t)row * 1536 + ch), zv = *(const v4u*)(F.P + (size_t)row * LDP0 + 1536 + ch);
            const float dsk = F.ssm_d[ch >> 6];
            float yz[8];
            const unsigned yfw[4] = {yf.x, yf.y, yf.z, yf.w}, ybw[4] = {yb.x, yb.y, yb.z, yb.w}, xw[4] = {xv.x, xv.y, xv.z, xv.w}, zw[4] = {zv.x, zv.y, zv.z, zv.w};
            float ss = 0.f;
#pragma unroll
            for (int j = 0; j < 4; ++j) {
                const float y0 = bflo(yfw[j]) + bflo(ybw[j]) + bflo(xw[j]) * dsk, y1 = bfhi(yfw[j]) + bfhi(ybw[j]) + bfhi(xw[j]) * dsk;
                yz[2 * j] = y0 * silu_f(bflo(zw[j])); yz[2 * j + 1] = y1 * silu_f(bfhi(zw[j]));
                ss += yz[2 * j] * yz[2 * j] + yz[2 * j + 1] * yz[2 * j + 1]; }
            const float rstd = 1.0f / sqrtf(wave_sum(ss) * (1.f / 512.f) + EPS);
            const f32x4 g0 = *(const f32x4*)(F.ssm_norm_g + ch), g1 = *(const f32x4*)(F.ssm_norm_g + ch + 4);
            v4u o; o.x = pk2(yz[0] * rstd * g0.x, yz[1] * rstd * g0.y); o.y = pk2(yz[2] * rstd * g0.z, yz[3] * rstd * g0.w);
            o.z = pk2(yz[4] * rstd * g1.x, yz[5] * rstd * g1.y); o.w = pk2(yz[6] * rstd * g1.z, yz[7] * rstd * g1.w);
            *(v4u*)(F.YA + (size_t)row * 1536 + 512 + ch) = o;
        }
    }
}

__device__ __forceinline__ void ph_rope(const Frame& F) {
    const int gw = F.vcu * NWAVES + F.wave, NGW = F.G * NWAVES;
    for (int row = gw; row < TL; row += NGW) {
        const int t = row & 2047; bf16* pr = F.P + (size_t)row * LDP1;
        for (int i = F.lane; i < 26 * 32; i += 64) {
            const int hb = i >> 5, f = i & 31;
            const int col = hb < 10 ? hb * 64 : 768 + (hb - 10) * 64;
            const float cs = F.ROPE[(t * 32 + f) * 2], sn = F.ROPE[(t * 32 + f) * 2 + 1];
            const float x1 = bf2f(pr[col + f]), x2 = bf2f(pr[col + 32 + f]);
            pr[col + f] = (bf16)f2bf(x1 * cs - x2 * sn); pr[col + 32 + f] = (bf16)f2bf(x2 * cs + x1 * sn);
        }
    }
}

__device__ __forceinline__ void ph_swa(const Frame& F) {
    const int gw = F.vcu * NWAVES + F.wave, NGW = F.G * NWAVES;
    const bf16* P = F.P;
    for (int u = gw; u < 2048; u += NGW) {
        const int qb = u & 31, h = (u >> 5) & 7, b = u >> 8, kvh = h >> 2;
        const int t = qb * 64 + F.lane; const size_t qrow = (size_t)b * 2048 + t;
        float q[64], o[64]; float m = -INFINITY, l = 0.f;
#pragma unroll
        for (int d = 0; d < 64; ++d) o[d] = 0.f;
        LOADQ64(q, P + qrow * LDP1 + h * 64, 0.125f);
        const int jlo = max(qb * 64 - 128, 0), jhi = min(qb * 64 + 63 + 128, 2047);
        for (int j = jlo; j <= jhi; ++j) {
            const int dj = t - j;
            if (dj <= 128 && dj >= -128) {
                const bf16* kp = P + ((size_t)b * 2048 + j) * LDP1 + 512 + kvh * 64;
                float s; DOT64(s, q, kp);
                ONLINE_UPD(s, m, l, o, kp + 128);
            }
        }
        for (int sc = 0; sc < 256; ++sc) {
            const bf16* kp = P + ((size_t)TL + b * 256 + sc) * LDP1 + 512 + kvh * 64;
            float s; DOT64(s, q, kp);
            ONLINE_UPD(s, m, l, o, kp + 128);
        }
        { const float sk = F.swa_sink[h]; if (sk > m) { const float cr = __expf(m - sk); l *= cr;
#pragma unroll
              for (int d = 0; d < 64; ++d) o[d] *= cr;
              m = sk; }
          l += __expf(sk - m); }
        const float inv = 1.f / l;
        STORE_O64(F.YA + qrow * 1536 + h * 64, o, inv);
    }
}

__device__ __forceinline__ void ph_retscan(const Frame& F) {
    LAS float* vs = (LAS float*)F.lds;
    LAS float* ks = vs + 32 * 64;
    LAS float* qs = ks + 32 * 64;
    LAS float* ybuf = qs + 32 * 64;
    const int p = F.tid >> 3, ng = F.tid & 7;
    for (int u = F.vcu; u < 256; u += F.G) {
        const int ph = u & 1, d = (u >> 1) & 1, h = (u >> 2) & 7, b = u >> 5;
        const float gamma = 1.f - expf(F.ret_log_decay[d * 8 + h]);
        float hst[8];
#pragma unroll
        for (int j = 0; j < 8; ++j) hst[j] = 0.f;
        for (int ck = 0; ck < 72; ++ck) {
            __syncthreads();
            for (int idx = F.tid; idx < 32 * 192; idx += 512) { const int i = idx / 192, c = idx % 192; const int row = scan_row(b, d, ck * 32 + i);
                const bf16* pr = F.P + (size_t)row * LDP1;
                if (c < 64) vs[i * 64 + c] = bf2f(pr[1792 + h * 128 + ph * 64 + c]);
                else if (c < 128) ks[i * 64 + (c - 64)] = 0.125f * bf2f(pr[1280 + h * 64 + (c - 64)]);
                else qs[i * 64 + (c - 128)] = bf2f(pr[768 + h * 64 + (c - 128)]); }
            __syncthreads();
            for (int i = 0; i < 32; ++i) {
                const float vv = vs[i * 64 + p];
                float y = 0.f;
#pragma unroll
                for (int j4 = 0; j4 < 2; ++j4) { const f32x4 kv = *(const LAS f32x4*)(ks + i * 64 + 8 * ng + 4 * j4), qv = *(const LAS f32x4*)(qs + i * 64 + 8 * ng + 4 * j4);
#pragma unroll
                    for (int jj = 0; jj < 4; ++jj) { hst[4 * j4 + jj] = hst[4 * j4 + jj] * gamma + vv * kv[jj]; y += hst[4 * j4 + jj] * qv[jj]; } }
                y += __shfl_xor(y, 1); y += __shfl_xor(y, 2); y += __shfl_xor(y, 4);
                if (ng == 0) ybuf[i * 64 + p] = y;
            }
            __syncthreads();
            if (ck >= 8) { bf16* Y = d ? F.YB : F.YF;
                for (int idx = F.tid; idx < 2048; idx += 512) { const int i = idx >> 6, pp = idx & 63; const int row = scan_row(b, d, ck * 32 + i);
                    Y[(size_t)row * 1024 + h * 128 + ph * 64 + pp] = (bf16)f2bf(ybuf[i * 64 + pp]); } }
        }
    }
}

__device__ __forceinline__ void ph_retout(const Frame& F) {
    const int gw = F.vcu * NWAVES + F.wave, NGW = F.G * NWAVES;
    for (int row = gw; row < TL; row += NGW) {
#pragma unroll
        for (int half = 0; half < 2; ++half) {
            const int ch = half * 512 + F.lane * 8;
            const v4u yf = *(const v4u*)(F.YF + (size_t)row * 1024 + ch), yb = *(const v4u*)(F.YB + (size_t)row * 1024 + ch), gv = *(const v4u*)(F.P + (size_t)row * LDP1 + 2816 + ch);
            const unsigned yfw[4] = {yf.x, yf.y, yf.z, yf.w}, ybw[4] = {yb.x, yb.y, yb.z, yb.w}, gw4[4] = {gv.x, gv.y, gv.z, gv.w};
            float y[8]; float s = 0.f;
#pragma unroll
            for (int j = 0; j < 4; ++j) { y[2 * j] = bflo(yfw[j]) + bflo(ybw[j]); y[2 * j + 1] = bfhi(yfw[j]) + bfhi(ybw[j]); s += y[2 * j] + y[2 * j + 1]; }
            s += __shfl_xor(s, 1); s += __shfl_xor(s, 2); s += __shfl_xor(s, 4); s += __shfl_xor(s, 8);
            const float mu = s * (1.f / 128.f); float q = 0.f;
#pragma unroll
            for (int j = 0; j < 8; ++j) { y[j] -= mu; q += y[j] * y[j]; }
            q += __shfl_xor(q, 1); q += __shfl_xor(q, 2); q += __shfl_xor(q, 4); q += __shfl_xor(q, 8);
            const float rstd = 1.0f / sqrtf(q * (1.f / 128.f) + EPS);
            float ov[8];
#pragma unroll
            for (int j = 0; j < 8; ++j) { const float gg = (j & 1) ? bfhi(gw4[j >> 1]) : bflo(gw4[j >> 1]); ov[j] = silu_f(gg) * (y[j] * rstd * F.ret_gn_g[ch + j] + F.ret_gn_b[ch + j]); }
            v4u o; o.x = pk2(ov[0], ov[1]); o.y = pk2(ov[2], ov[3]); o.z = pk2(ov[4], ov[5]); o.w = pk2(ov[6], ov[7]);
            *(v4u*)(F.YA + (size_t)row * 1536 + 512 + ch) = o;
        }
    }
}

__device__ __forceinline__ void ph_final(const Frame& F) {
    const int gw = F.vcu * NWAVES + F.wave, NGW = F.G * NWAVES;
    for (int row = gw; row < TL; row += NGW) {
        const f32x4* xr = (const f32x4*)(F.X + (size_t)row * 1024) + F.lane;
        f32x4 v[4]; float s = 0.f;
#pragma unroll
        for (int j = 0; j < 4; ++j) { v[j] = xr[64 * j]; s += (v[j].x * v[j].x + v[j].y * v[j].y) + (v[j].z * v[j].z + v[j].w * v[j].w); }
        const float rstd = 1.0f / sqrtf(wave_sum(s) * (1.f / 1024.f) + EPS);
        f32x4* o = (f32x4*)(F.out + (size_t)row * 1024) + F.lane;
#pragma unroll
        for (int j = 0; j < 4; ++j) o[64 * j] = v[j] * rstd * ((const f32x4*)F.final_g)[F.lane + 64 * j];
    }
}

enum { PH_CVT = 0, PH_NORM0, PH_IN0, PH_MIX0, PH_SCAN0, PH_SSMOUT, PH_OUT0, PH_NORM1, PH_F13, PH_F2, PH_NORM2, PH_IN1, PH_ROPE, PH_MIX1, PH_RETOUT, PH_OUT1, PH_NORM3, PH_MOE0,
       PH_FINAL = PH_MOE0 + 16, NPHASES };

struct Args { const float* in[31]; float* out; unsigned char* ws; int ph_lo, ph_hi; };

__global__ void __launch_bounds__(NWAVES * 64, 2) fwd(Args args) {
    extern __shared__ __attribute__((aligned(16))) unsigned char lds_raw[];
    Frame F;
    F.lds = (LAS unsigned char*)lds_raw;
    F.tid = threadIdx.x; F.lane = F.tid & 63; F.wave = __builtin_amdgcn_readfirstlane(F.tid >> 6);
    F.G = gridDim.x; { const int bx = blockIdx.x; F.vcu = (F.G % 8 == 0) ? (bx % 8) * (F.G / 8) + bx / 8 : bx; }
    F.x = args.in[0]; F.c = args.in[1]; F.ctx = args.in[2]; F.c_ctx = args.in[3]; F.ada_w = args.in[4]; F.ada_b = args.in[5]; F.norm_attn_g = args.in[6]; F.norm_ffn_g = args.in[7];
    F.ev_w_in = args.in[8]; F.ev_w_out = args.in[9]; F.na_rpb = args.in[10]; F.conv_w = args.in[11]; F.conv_b = args.in[12]; F.dt_bias = args.in[13]; F.a_log = args.in[14]; F.ssm_d = args.in[15];
    F.ssm_norm_g = args.in[16]; F.ffn_w1 = args.in[17]; F.ffn_w3 = args.in[18]; F.ffn_w2 = args.in[19]; F.od_w_in = args.in[20]; F.od_w_out = args.in[21]; F.swa_sink = args.in[22];
    F.ret_log_decay = args.in[23]; F.ret_gn_g = args.in[24]; F.ret_gn_b = args.in[25]; F.moe_router = args.in[26]; F.moe_w1 = args.in[27]; F.moe_w3 = args.in[28]; F.moe_w2 = args.in[29]; F.final_g = args.in[30];
    F.out = args.out;
    unsigned char* ws = args.ws;
    F.MOD = (float*)(ws + WS_MOD); F.GATE = (float*)(ws + WS_GATE); F.ROPE = (float*)(ws + WS_ROPE); F.X = (float*)(ws + WS_X);
    F.WIN0 = (bf16*)(ws + WS_WIN0); F.WOUT0 = (bf16*)(ws + WS_WOUT0); F.WF13 = (bf16*)(ws + WS_WF13); F.WF2 = (bf16*)(ws + WS_WF2); F.WIN1 = (bf16*)(ws + WS_WIN1); F.WOUT1 = (bf16*)(ws + WS_WOUT1);
    F.WM13 = (bf16*)(ws + WS_WM13); F.WM2 = (bf16*)(ws + WS_WM2); F.H = (bf16*)(ws + WS_H); F.P = (bf16*)(ws + WS_P); F.YA = (bf16*)(ws + WS_YA); F.XBC = (bf16*)(ws + WS_XBC);
    F.YF = (bf16*)(ws + WS_YF); F.YB = (bf16*)(ws + WS_YB); F.Gh = (bf16*)(ws + WS_G); F.MG = (bf16*)(ws + WS_MG);

    for (int u = F.tid; u < (LDS_BYTES - LDSCTL_OFF) / 4; u += NWAVES * 64) ((LAS unsigned*)(F.lds + LDSCTL_OFF))[u] = 0u;
    __syncthreads();
    volatile LAS unsigned* MISC = (volatile LAS unsigned*)(F.lds + MISC_OFF);
    XcdBarrier bar; bar.bar = (unsigned*)(ws + WS_CTL) + CW_BAR; bar.x = 0; bar.st = nullptr;
    const int lo = args.ph_lo, hi = args.ph_hi;
    if (hi - lo > 1) bar = xcd_barrier_post((unsigned*)(ws + WS_CTL) + CW_BAR, MISC + 8);
#define IN(k) (lo <= (k) && (k) < hi)
#define SEAM(k) do { if (IN(k) && IN((k) + 1)) xcd_barrier(bar); else __syncthreads(); } while (0)

    if (IN(PH_CVT)) { ph_cvt(F); SEAM(PH_CVT); }
    if (IN(PH_NORM0)) { ph_norm<0, false>(F, 0, 0, TT); SEAM(PH_NORM0); }
    if (IN(PH_IN0)) { EpiStore E{F.P, LDP0}; gemm_simple(F, F.H, F.WIN0, TT, LDP0, 1024, E); SEAM(PH_IN0); }
    if (IN(PH_MIX0)) { ph_attn0(F); ph_conv(F); SEAM(PH_MIX0); }
    if (IN(PH_SCAN0)) { ph_scan0(F); SEAM(PH_SCAN0); }
    if (IN(PH_SSMOUT)) { ph_ssmout(F); SEAM(PH_SSMOUT); }
    if (IN(PH_OUT0)) { EpiResid E{F.x, F.ctx, F.X, F.MOD + 2 * 1024, nullptr, 0, 0}; gemm_simple(F, F.YA, F.WOUT0, TT, 1024, 1536, E); SEAM(PH_OUT0); }
    if (IN(PH_NORM1)) { ph_norm<1, false>(F, 0, 1, TT); SEAM(PH_NORM1); }
    if (IN(PH_F13)) { EpiSwiglu E{F.Gh, DFF}; gemm_simple(F, F.H, F.WF13, TT, 2 * DFF, 1024, E); SEAM(PH_F13); }
    if (IN(PH_F2)) { EpiResid E{F.X, F.X + (size_t)TL * 1024, F.X, F.MOD + 5 * 1024, nullptr, 0, 0}; gemm_simple(F, F.Gh, F.WF2, TT, 1024, DFF, E); SEAM(PH_F2); }
    if (IN(PH_NORM2)) { ph_norm<1, false>(F, 1, 0, TT); SEAM(PH_NORM2); }
    if (IN(PH_IN1)) { EpiStore E{F.P, LDP1}; gemm_simple(F, F.H, F.WIN1, TT, LDP1, 1024, E); SEAM(PH_IN1); }
    if (IN(PH_ROPE)) { ph_rope(F); SEAM(PH_ROPE); }
    if (IN(PH_MIX1)) { ph_retscan(F); ph_swa(F); SEAM(PH_MIX1); }
    if (IN(PH_RETOUT)) { ph_retout(F); SEAM(PH_RETOUT); }
    if (IN(PH_OUT1)) { EpiResid E{F.X, F.X + (size_t)TL * 1024, F.X, F.MOD + 9 * 6144 + 2 * 1024, nullptr, 0, 0}; gemm_simple(F, F.YA, F.WOUT1, TL, 1024, 1536, E); SEAM(PH_OUT1); }
    if (IN(PH_NORM3)) { ph_norm<1, true>(F, 1, 1, TL); ph_cvt_moe(F); SEAM(PH_NORM3); }
    for (int e = 0; e < NEXP; ++e) {
        if (IN(PH_MOE0 + 2 * e)) { EpiSwiglu E{F.MG, DFE}; gemm_simple(F, F.H, F.WM13 + (size_t)e * 7168 * 1024, TL, 2 * DFE, 1024, E); SEAM(PH_MOE0 + 2 * e); }
        if (IN(PH_MOE0 + 2 * e + 1)) { EpiResid E{F.X, F.X + (size_t)TL * 1024, F.X, F.MOD + 9 * 6144 + 5 * 1024, F.GATE, 8, e}; gemm_simple(F, F.MG, F.WM2 + (size_t)e * 1024 * DFE, TL, 1024, DFE, E); SEAM(PH_MOE0 + 2 * e + 1); }
    }
    if (IN(PH_FINAL)) { ph_final(F); }
#undef IN
#undef SEAM
}

extern "C" void kernel_launch(void* const* d_in, const int* in_sizes, int n_in, void* d_out, int out_size, void* d_ws, size_t ws_size, hipStream_t stream) {
    static int grid = 0;
    if (grid == 0) {
        if (n_in != 31 || out_size != TL * DM || ws_size < WS_END) { fprintf(stderr, "kernel_launch: unexpected shapes (n_in %d out %d ws %zu need %zu)\n", n_in, out_size, ws_size, (size_t)WS_END); grid = -1; return; }
        int dev = 0, cus = 0, per_cu = 0;
        if (hipGetDevice(&dev) != hipSuccess || hipDeviceGetAttribute(&cus, hipDeviceAttributeMultiprocessorCount, dev) != hipSuccess) { grid = -1; return; }
        if (hipFuncSetAttribute((const void*)fwd, hipFuncAttributeMaxDynamicSharedMemorySize, LDS_BYTES) != hipSuccess) { grid = -1; return; }
        if (hipOccupancyMaxActiveBlocksPerMultiprocessor(&per_cu, (const void*)fwd, NWAVES * 64, LDS_BYTES) != hipSuccess || per_cu < 1) fprintf(stderr, "kernel_launch: occupancy query reports %d\n", per_cu);
        (void)hipGetLastError();
        grid = cus;
    }
    if (grid < 0) return;
    if (hipMemsetAsync((char*)d_ws + WS_CTL, 0, CTL_ZERO_BYTES, stream) != hipSuccess) return;
    Args a{};
    for (int i = 0; i < 31; ++i) a.in[i] = (const float*)d_in[i];
    a.out = (float*)d_out; a.ws = (unsigned char*)d_ws;
#if MK_ONE_LAUNCH
    a.ph_lo = 0; a.ph_hi = NPHASES;
    hipLaunchKernelGGL(fwd, dim3(grid), dim3(NWAVES * 64), LDS_BYTES, stream, a);
#else
    for (int ph = 0; ph < NPHASES; ++ph) { a.ph_lo = ph; a.ph_hi = ph + 1; hipLaunchKernelGGL(fwd, dim3(grid), dim3(NWAVES * 64), LDS_BYTES, stream, a); }
#endif
}
```

```cpp
#include <hip/hip_runtime.h>
#include <cstdio>
#include <cstdint>

#ifndef MK_ONE_LAUNCH
#define MK_ONE_LAUNCH 1
#endif

#define LAS __attribute__((address_space(3)))
typedef unsigned short bf16;
typedef short bf16x8 __attribute__((ext_vector_type(8)));
typedef float f32x4 __attribute__((ext_vector_type(4)));
typedef unsigned v4u __attribute__((ext_vector_type(4)));
typedef unsigned v2u __attribute__((ext_vector_type(2)));

constexpr int DM = 1024, NB = 8, SEQ = 2048, CTXL = 256;
constexpr int TL = NB * SEQ, TC = NB * CTXL, TT = TL + TC;
constexpr int LDP0 = 4352;
constexpr int LDP1 = 3840;
constexpr int DFF = 2816, DFE = 3584, NEXP = 8;
constexpr float EPS = 1e-6f;

constexpr size_t MiB = 1u << 20;
constexpr size_t WS_CTL = 0, CTL_ZERO_BYTES = 1 * MiB;
constexpr size_t WS_MOD = 1 * MiB;
constexpr size_t WS_GATE = 2 * MiB;
constexpr size_t WS_ROPE = 3 * MiB;
constexpr size_t WS_WIN0 = 4 * MiB;
constexpr size_t WS_WOUT0 = 13 * MiB;
constexpr size_t WS_WF13 = 16 * MiB;
constexpr size_t WS_WF2 = 27 * MiB;
constexpr size_t WS_WIN1 = 33 * MiB;
constexpr size_t WS_WOUT1 = 41 * MiB;
constexpr size_t WS_X = 44 * MiB;
constexpr size_t WS_H = 116 * MiB;
constexpr size_t WS_R = 152 * MiB;
constexpr size_t WS_P = WS_R;
constexpr size_t WS_YA = WS_R + 153 * MiB;
constexpr size_t WS_XBC = WS_R + 207 * MiB;
constexpr size_t WS_YF = WS_R + 261 * MiB;
constexpr size_t WS_YB = WS_R + 297 * MiB;
constexpr size_t WS_G = WS_R;
constexpr size_t WS_WM13 = WS_R;
constexpr size_t WS_WM2 = WS_R + 112 * MiB;
constexpr size_t WS_MG = WS_R + 168 * MiB;
constexpr size_t WS_END = WS_R + 333 * MiB;
static_assert(WS_P + (size_t)TT * LDP0 * 2 <= WS_YA && WS_YA + (size_t)TT * 1536 * 2 <= WS_XBC && WS_XBC + (size_t)TT * 1536 * 2 <= WS_YF && WS_YF + (size_t)TT * 1024 * 2 <= WS_YB && WS_YB + (size_t)TT * 1024 * 2 <= WS_END, "ws map");
static_assert(WS_WM13 + (size_t)8 * 7168 * 1024 * 2 <= WS_WM2 && WS_WM2 + (size_t)8 * 1024 * 3584 * 2 <= WS_MG && WS_MG + (size_t)TL * 3584 * 2 <= WS_END, "ws map moe");
static_assert(WS_X + (size_t)TT * 1024 * 4 <= WS_H && WS_H + (size_t)TT * 1024 * 2 <= WS_R, "ws map 2");
constexpr int CW_BAR = 4096;

constexpr int RING_BYTES = 131072, LDSCTL_OFF = RING_BYTES, MISC_OFF = LDSCTL_OFF + 320, LDS_BYTES = 147456;
constexpr int NWAVES = 8;

#define LDS_WAIT() asm volatile("s_waitcnt lgkmcnt(0)" ::: "memory")
__device__ __forceinline__ unsigned f2bf(float f) { unsigned u = __builtin_bit_cast(unsigned, f); return (u + 0x7fffu + ((u >> 16) & 1u)) >> 16; }
__device__ __forceinline__ unsigned pk2(float lo, float hi) { return f2bf(lo) | (f2bf(hi) << 16); }
__device__ __forceinline__ float bf2f(unsigned short b) { return __builtin_bit_cast(float, ((unsigned)b) << 16); }
__device__ __forceinline__ float bflo(unsigned w) { return __builtin_bit_cast(float, w << 16); }
__device__ __forceinline__ float bfhi(unsigned w) { return __builtin_bit_cast(float, w & 0xffff0000u); }
__device__ __forceinline__ float silu_f(float x) { return x / (1.f + __expf(-x)); }
__device__ __forceinline__ float wave_sum(float v) {
#pragma unroll
    for (int o = 1; o < 64; o <<= 1) v += __shfl_xor(v, o);
    return v;
}
__host__ __device__ __forceinline__ int perm32(int rho) { const int n = rho >> 4, i = rho & 15; return 8 * (i >> 2) + 4 * n + (i & 3); }

#define XB_TMO      128
#define XB_XCNT(j)  (256  + 64 * (j))
#define XB_XSUB(j)  (1280 + 64 * (j))
#define XB_XGEN(j)  (2304 + 64 * (j))
#define XB_TOP      3328
#define XB_TOPGEN   3392
#define XCD_BAR_WORDS 3456
#define XB_SPIN_CAP (1u << 18)
__device__ __forceinline__ unsigned xb_ld(unsigned* p)              { return __hip_atomic_load(p, __ATOMIC_RELAXED, __HIP_MEMORY_SCOPE_AGENT); }
__device__ __forceinline__ unsigned xb_add(unsigned* p, unsigned v) { return __hip_atomic_fetch_add(p, v, __ATOMIC_RELAXED, __HIP_MEMORY_SCOPE_AGENT); }
__device__ __forceinline__ unsigned xb_xcc_id() { return (unsigned)__builtin_amdgcn_s_getreg((3 << 11) | 20) & 0xFu; }
#define XB_SPIN(cond, bar) do { unsigned _sp = 0; while (cond) { __builtin_amdgcn_s_sleep(1); \
    if ((++_sp & 255u) == 0u) { if (xb_ld(&(bar)[XB_TMO])) break; if (_sp > XB_SPIN_CAP) { atomicAdd(&(bar)[XB_TMO], 1u); break; } } } } while (0)
struct XcdBarrier { unsigned* bar; unsigned x; volatile LAS unsigned* st; };
__device__ __forceinline__ XcdBarrier xcd_barrier_post(unsigned* bar, volatile LAS unsigned* st) {
    XcdBarrier b; b.bar = bar; b.x = xb_xcc_id(); b.st = st;
    if (threadIdx.x == 0) (void)xb_add(&bar[XB_XCNT(b.x)], 1u);
    return b;
}
__device__ __forceinline__ void xcd_barrier_complete(unsigned* bar, unsigned x, unsigned& nloc, unsigned& nx) {
    const unsigned G = gridDim.x * gridDim.y * gridDim.z;
    unsigned sum, cnt, mine, sp = 0u;
    for (;;) {
        sum = 0u; cnt = 0u; mine = 0u;
#pragma unroll
        for (unsigned j = 0; j < 16; ++j) { const unsigned c = xb_ld(&bar[XB_XCNT(j)]); sum += c; cnt += (c > 0u) ? 1u : 0u; mine = (j == x) ? c : mine; }
        if (sum == G) break;
        __builtin_amdgcn_s_sleep(1);
        if ((++sp & 255u) == 0u) { if (xb_ld(&bar[XB_TMO])) break; if (sp > XB_SPIN_CAP) { atomicAdd(&bar[XB_TMO], 1u); break; } }
    }
    nloc = mine > 0u ? mine : 1u; nx = cnt > 0u ? cnt : 1u;
}
__device__ __forceinline__ void xcd_barrier(const XcdBarrier& b) {
    asm volatile("s_waitcnt vmcnt(0)" ::: "memory");
    __syncthreads();
    if (threadIdx.x == 0) {
        unsigned* bar = b.bar;
        __builtin_amdgcn_s_waitcnt(0);
        unsigned nloc = b.st[0], nx = b.st[1];
        if (nloc == 0u) { xcd_barrier_complete(bar, b.x, nloc, nx); b.st[0] = nloc; b.st[1] = nx; }
        const unsigned old = xb_add(&bar[XB_XSUB(b.x)], 1u);
        const unsigned gen = old / nloc;
        if (old + 1u == (gen + 1u) * nloc) {
            __builtin_amdgcn_fence(__ATOMIC_RELEASE, "agent");
            asm volatile("s_waitcnt vmcnt(0)" ::: "memory");
            const unsigned og = xb_add(&bar[XB_TOP], 1u);
            const unsigned tg = og / nx;
            if (og + 1u == (tg + 1u) * nx) xb_add(&bar[XB_TOPGEN], 1u);
            else XB_SPIN(xb_ld(&bar[XB_TOPGEN]) == tg, bar);
            __builtin_amdgcn_fence(__ATOMIC_ACQUIRE, "agent");
            xb_add(&bar[XB_XGEN(b.x)], 1u);
            asm volatile("s_waitcnt vmcnt(0)" ::: "memory");
        } else {
            XB_SPIN(xb_ld(&bar[XB_XGEN(b.x)]) == gen, bar);
            __builtin_amdgcn_fence(__ATOMIC_ACQUIRE, "agent");
            asm volatile("s_waitcnt vmcnt(0)" ::: "memory");
        }
    }
    __syncthreads();
}

struct Frame {
    LAS unsigned char* lds;
    int tid, lane, wave, vcu, G;
    const float *x, *c, *ctx, *c_ctx, *ada_w, *ada_b, *norm_attn_g, *norm_ffn_g, *ev_w_in, *ev_w_out, *na_rpb, *conv_w, *conv_b, *dt_bias, *a_log, *ssm_d, *ssm_norm_g,
        *ffn_w1, *ffn_w3, *ffn_w2, *od_w_in, *od_w_out, *swa_sink, *ret_log_decay, *ret_gn_g, *ret_gn_b, *moe_router, *moe_w1, *moe_w3, *moe_w2, *final_g;
    float* out;
    float *MOD, *GATE, *ROPE, *X;
    bf16 *WIN0, *WOUT0, *WF13, *WF2, *WIN1, *WOUT1, *WM13, *WM2, *H, *P, *YA, *XBC, *YF, *YB, *Gh, *MG;
};

__device__ __forceinline__ void tr_item(const float* W, int K, int N, bf16* WT, int ilv, LAS float* scr, int item, int lane) {
    const int nblk = N / 32, kb = item / nblk, nb = item % nblk, k0 = 64 * kb, n0 = 32 * nb;
#pragma unroll 8
    for (int i = 0; i < 32; ++i) { const int kk = 2 * i + (lane >> 5); scr[kk * 33 + (lane & 31)] = W[(size_t)(k0 + kk) * N + n0 + (lane & 31)]; }
    LDS_WAIT(); asm volatile("" ::: "memory");
    const int c = lane & 7;
#pragma unroll
    for (int j = 0; j < 4; ++j) { const int n = (lane >> 3) + 8 * j; const LAS float* s = scr + (8 * c) * 33 + n;
        v4u o; o.x = pk2(s[0 * 33], s[1 * 33]); o.y = pk2(s[2 * 33], s[3 * 33]); o.z = pk2(s[4 * 33], s[5 * 33]); o.w = pk2(s[6 * 33], s[7 * 33]);
        const int nn = n0 + n; const int row = ilv ? (8 * (nn >> 2) + (nn & 3) + (ilv == 2 ? 4 : 0)) : nn;
        *(v4u*)(WT + (size_t)row * K + k0 + 8 * c) = o; }
    LDS_WAIT(); asm volatile("" ::: "memory");
}

__device__ __forceinline__ void ph_cvt(const Frame& F) {
    LAS float* scr = (LAS float*)(F.lds + F.wave * 16384);
    const int gw = F.vcu * NWAVES + F.wave, NGW = F.G * NWAVES;
    constexpr int I_IN0 = 16 * 129, I_OUT = 24 * 32, I_F1 = 16 * 88, I_F2 = 44 * 32, I_IN1 = 16 * 120;
    constexpr int NITEMS = I_IN0 + I_OUT + 2 * I_F1 + I_F2 + I_IN1 + I_OUT;
    for (int it = gw; it < NITEMS; it += NGW) {
        int r = it;
        if (r < I_IN0) { tr_item(F.ev_w_in, 1024, 4128, F.WIN0, 0, scr, r, F.lane); continue; } r -= I_IN0;
        if (r < I_OUT) { tr_item(F.ev_w_out, 1536, 1024, F.WOUT0, 0, scr, r, F.lane); continue; } r -= I_OUT;
        if (r < I_F1) { tr_item(F.ffn_w1, 1024, DFF, F.WF13, 1, scr, r, F.lane); continue; } r -= I_F1;
        if (r < I_F1) { tr_item(F.ffn_w3, 1024, DFF, F.WF13, 2, scr, r, F.lane); continue; } r -= I_F1;
        if (r < I_F2) { tr_item(F.ffn_w2, DFF, 1024, F.WF2, 0, scr, r, F.lane); continue; } r -= I_F2;
        if (r < I_IN1) { tr_item(F.od_w_in, 1024, LDP1, F.WIN1, 0, scr, r, F.lane); continue; } r -= I_IN1;
        tr_item(F.od_w_out, 1536, 1024, F.WOUT1, 0, scr, r, F.lane);
    }
    { const int gt = F.vcu * 512 + F.tid, NGT = F.G * 512; v4u* z = (v4u*)(F.WIN0 + (size_t)4128 * 1024);
      for (int i = gt; i < 224 * 1024 / 8; i += NGT) z[i] = (v4u){0u, 0u, 0u, 0u}; }
    { const int gt = F.vcu * 512 + F.tid, NGT = F.G * 512;
      for (int i = gt; i < 2048 * 32; i += NGT) { const int t = i >> 5, f = i & 31; const float inv = powf(10000.f, -(float)(f & 15) / 16.f);
          const float ang = (float)((f < 16) ? (t >> 6) : (t & 63)) * inv; float sn, cs; sincosf(ang, &sn, &cs); F.ROPE[2 * i] = cs; F.ROPE[2 * i + 1] = sn; } }
    __syncthreads();
    LAS float* sv = (LAS float*)F.lds;
    LAS float* part = (LAS float*)(F.lds + 36864);
    for (int it = F.vcu; it < 192; it += F.G) {
        const int l = it / 96, n0 = (it % 96) * 64;
        for (int i = F.tid; i < 9 * 1024; i += 512) { const int r = i >> 10, k = i & 1023; const float v = (r < 8) ? F.c[r * 1024 + k] : F.c_ctx[k]; sv[i] = silu_f(v); }
        __syncthreads();
        float acc[9];
#pragma unroll
        for (int r = 0; r < 9; ++r) acc[r] = 0.f;
        const float* wp = F.ada_w + (size_t)l * 1024 * 6144 + n0 + F.lane;
        for (int k = F.wave * 128; k < F.wave * 128 + 128; ++k) { const float w = wp[(size_t)k * 6144];
#pragma unroll
            for (int r = 0; r < 9; ++r) acc[r] += sv[r * 1024 + k] * w; }
#pragma unroll
        for (int r = 0; r < 9; ++r) part[(F.wave * 9 + r) * 64 + F.lane] = acc[r];
        __syncthreads();
        for (int i = F.tid; i < 9 * 64; i += 512) { const int r = i >> 6, n = i & 63; float s = 0.f;
#pragma unroll
            for (int w = 0; w < 8; ++w) s += part[(w * 9 + r) * 64 + n];
            F.MOD[(size_t)(l * 9 + r) * 6144 + n0 + n] = s + F.ada_b[l * 6144 + n0 + n]; }
        __syncthreads();
    }
}

__device__ __forceinline__ void ph_cvt_moe(const Frame& F) {
    LAS float* scr = (LAS float*)(F.lds + F.wave * 16384);
    const int gw = F.vcu * NWAVES + F.wave, NGW = F.G * NWAVES;
    constexpr int I_1 = 16 * 112, I_2 = 56 * 32;
    constexpr int NITEMS = NEXP * (2 * I_1 + I_2);
    for (int it = gw; it < NITEMS; it += NGW) {
        const int e = it / (2 * I_1 + I_2); int r = it % (2 * I_1 + I_2);
        if (r < I_1) { tr_item(F.moe_w1 + (size_t)e * 1024 * DFE, 1024, DFE, F.WM13 + (size_t)e * 7168 * 1024, 1, scr, r, F.lane); continue; } r -= I_1;
        if (r < I_1) { tr_item(F.moe_w3 + (size_t)e * 1024 * DFE, 1024, DFE, F.WM13 + (size_t)e * 7168 * 1024, 2, scr, r, F.lane); continue; } r -= I_1;
        tr_item(F.moe_w2 + (size_t)e * DFE * 1024, DFE, 1024, F.WM2 + (size_t)e * 1024 * DFE, 0, scr, r, F.lane);
    }
}

template <int MODE, bool ROUTER>
__device__ __forceinline__ void ph_norm(const Frame& F, int layer, int which, int nrows) {
    const int gw = F.vcu * NWAVES + F.wave, NGW = F.G * NWAVES;
    const float* g = (which ? F.norm_ffn_g : F.norm_attn_g) + layer * 1024;
    for (int row = gw; row < nrows; row += NGW) {
        const int bidx = row < TL ? (row >> 11) : 8;
        const float* src = MODE == 0 ? (row < TL ? F.x + (size_t)row * 1024 : F.ctx + (size_t)(row - TL) * 1024) : F.X + (size_t)row * 1024;
        const float* mod = F.MOD + (size_t)(layer * 9 + bidx) * 6144 + (which ? 3 : 0) * 1024;
        const f32x4* xr = (const f32x4*)src + F.lane;
        f32x4 v[4]; float s = 0.f;
#pragma unroll
        for (int j = 0; j < 4; ++j) { v[j] = xr[64 * j]; s += (v[j].x * v[j].x + v[j].y * v[j].y) + (v[j].z * v[j].z + v[j].w * v[j].w); }
        const float rstd = 1.0f / sqrtf(wave_sum(s) * (1.f / 1024.f) + EPS);
        unsigned long long* o8 = (unsigned long long*)(F.H + (size_t)row * 1024) + F.lane;
#pragma unroll
        for (int j = 0; j < 4; ++j) {
            const f32x4 gg = ((const f32x4*)g)[F.lane + 64 * j], sh = ((const f32x4*)mod)[F.lane + 64 * j], sc = ((const f32x4*)(mod + 1024))[F.lane + 64 * j];
            v[j] = (v[j] * rstd * gg) * (sc + 1.0f) + sh;
            o8[64 * j] = (unsigned long long)pk2(v[j].x, v[j].y) | ((unsigned long long)pk2(v[j].z, v[j].w) << 32);
        }
        if (ROUTER) {
            float lg[8];
#pragma unroll
            for (int e = 0; e < 8; ++e) lg[e] = 0.f;
#pragma unroll
            for (int j = 0; j < 4; ++j)
#pragma unroll
                for (int i = 0; i < 4; ++i) { const int k = 4 * (F.lane + 64 * j) + i; const f32x4 r0 = ((const f32x4*)(F.moe_router + (size_t)k * 8))[0], r1 = ((const f32x4*)(F.moe_router + (size_t)k * 8))[1];
                    const float hv = v[j][i];
                    lg[0] += hv * r0.x; lg[1] += hv * r0.y; lg[2] += hv * r0.z; lg[3] += hv * r0.w; lg[4] += hv * r1.x; lg[5] += hv * r1.y; lg[6] += hv * r1.z; lg[7] += hv * r1.w; }
#pragma unroll
            for (int e = 0; e < 8; ++e) lg[e] = wave_sum(lg[e]);
            int i0 = 0; float v0 = lg[0];
#pragma unroll
            for (int e = 1; e < 8; ++e) if (lg[e] > v0) { v0 = lg[e]; i0 = e; }
            int i1 = -1; float v1 = -3.0e38f;
#pragma unroll
            for (int e = 0; e < 8; ++e) if (e != i0 && lg[e] > v1) { v1 = lg[e]; i1 = e; }
            const float e1 = __expf(v1 - v0), g0 = 1.f / (1.f + e1), g1 = e1 / (1.f + e1);
            if (F.lane < 8) F.GATE[(size_t)row * 8 + F.lane] = (F.lane == i0) ? g0 : ((F.lane == i1) ? g1 : 0.f);
        }
    }
}

template <class Epi>
__device__ __forceinline__ void gemm_simple(const Frame& F, const bf16* A, const bf16* Bt, int M, int N, int K, const Epi& E) {
    const int nN = N / 128, nU = (M / 256) * nN;
    const int wr = F.wave >> 1, wc = F.wave & 1, fr = F.lane & 15, fq = F.lane >> 4;
    for (int u = F.vcu; u < nU; u += F.G) {
        const int pm = u / nN, pn = u % nN, row0 = pm * 256 + wr * 64, col0 = pn * 128 + wc * 64;
        f32x4 acc[4][4];
#pragma unroll
        for (int i = 0; i < 4; ++i)
#pragma unroll
            for (int j = 0; j < 4; ++j) acc[i][j] = (f32x4){0.f, 0.f, 0.f, 0.f};
        const bf16* ap = A + (size_t)(row0 + fr) * K + fq * 8;
        const bf16* bp0 = Bt + (size_t)(col0 + perm32(fr)) * K + fq * 8;
        const bf16* bp1 = Bt + (size_t)(col0 + perm32(16 + fr)) * K + fq * 8;
#pragma unroll 2
        for (int k0 = 0; k0 < K; k0 += 32) {
            bf16x8 a[4], b[4];
#pragma unroll
            for (int i = 0; i < 4; ++i) a[i] = *(const bf16x8*)(ap + (size_t)(16 * i) * K + k0);
            b[0] = *(const bf16x8*)(bp0 + k0); b[1] = *(const bf16x8*)(bp1 + k0);
            b[2] = *(const bf16x8*)(bp0 + (size_t)32 * K + k0); b[3] = *(const bf16x8*)(bp1 + (size_t)32 * K + k0);
#pragma unroll
            for (int i = 0; i < 4; ++i)
#pragma unroll
                for (int j = 0; j < 4; ++j) acc[i][j] = __builtin_amdgcn_mfma_f32_16x16x32_bf16(b[j], a[i], acc[i][j], 0, 0, 0);
        }
#pragma unroll
        for (int i = 0; i < 4; ++i)
#pragma unroll
            for (int q = 0; q < 2; ++q) E(row0 + 16 * i + fr, col0 + 32 * q + 8 * fq, acc[i][2 * q], acc[i][2 * q + 1]);
    }
}

struct EpiStore {
    bf16* O; int ldc;
    __device__ __forceinline__ void operator()(int row, int col, f32x4 lo, f32x4 hi) const {
        v4u w; w.x = pk2(lo.x, lo.y); w.y = pk2(lo.z, lo.w); w.z = pk2(hi.x, hi.y); w.w = pk2(hi.z, hi.w);
        *(v4u*)(O + (size_t)row * ldc + col) = w; }
};
struct EpiSwiglu {
    bf16* O; int ldc;
    __device__ __forceinline__ void operator()(int row, int col, f32x4 lo, f32x4 hi) const {
        v2u w; w.x = pk2(silu_f(lo.x) * hi.x, silu_f(lo.y) * hi.y); w.y = pk2(silu_f(lo.z) * hi.z, silu_f(lo.w) * hi.w);
        *(v2u*)(O + (size_t)row * ldc + (col >> 1)) = w; }
};
struct EpiResid {
    const float* bl; const float* bc; float* X; const float* gate  ; const float* rs; int rs_ld, rs_off;
    __device__ __forceinline__ void operator()(int row, int col, f32x4 lo, f32x4 hi) const {
        const int bidx = row < TL ? (row >> 11) : 8;
        const float* b = row < TL ? bl + (size_t)row * 1024 + col : bc + (size_t)(row - TL) * 1024 + col;
        const float* gp = gate + (size_t)bidx * 6144 + col;
        float sc = 1.f; if (rs) sc = rs[(size_t)row * rs_ld + rs_off];
        const f32x4 g0 = ((const f32x4*)gp)[0] * sc, g1 = ((const f32x4*)gp)[1] * sc;
        const f32x4 b0 = ((const f32x4*)b)[0], b1 = ((const f32x4*)b)[1];
        float* o = X + (size_t)row * 1024 + col;
        ((f32x4*)o)[0] = b0 + g0 * lo; ((f32x4*)o)[1] = b1 + g1 * hi; }
};

#define DOT64(s, q, kp) do { s = 0.f; _Pragma("unroll") for (int _c = 0; _c < 8; ++_c) { const v4u _w = ((const v4u*)(kp))[_c]; \
    s += q[8*_c+0] * bflo(_w.x) + q[8*_c+1] * bfhi(_w.x) + q[8*_c+2] * bflo(_w.y) + q[8*_c+3] * bfhi(_w.y) + q[8*_c+4] * bflo(_w.z) + q[8*_c+5] * bfhi(_w.z) + q[8*_c+6] * bflo(_w.w) + q[8*_c+7] * bfhi(_w.w); } } while (0)
#define ONLINE_UPD(s, m, l, o, vp) do { if (s > m) { const float _cr = __expf(m - s); l *= _cr; _Pragma("unroll") for (int _d = 0; _d < 64; ++_d) o[_d] *= _cr; m = s; } \
    const float _p = __expf(s - m); l += _p; _Pragma("unroll") for (int _c = 0; _c < 8; ++_c) { const v4u _w = ((const v4u*)(vp))[_c]; \
    o[8*_c+0] += _p * bflo(_w.x); o[8*_c+1] += _p * bfhi(_w.x); o[8*_c+2] += _p * bflo(_w.y); o[8*_c+3] += _p * bfhi(_w.y); o[8*_c+4] += _p * bflo(_w.z); o[8*_c+5] += _p * bfhi(_w.z); o[8*_c+6] += _p * bflo(_w.w); o[8*_c+7] += _p * bfhi(_w.w); } } while (0)
#define LOADQ64(q, qp, scale) do { _Pragma("unroll") for (int _c = 0; _c < 8; ++_c) { const v4u _w = ((const v4u*)(qp))[_c]; \
    q[8*_c+0] = scale * bflo(_w.x); q[8*_c+1] = scale * bfhi(_w.x); q[8*_c+2] = scale * bflo(_w.y); q[8*_c+3] = scale * bfhi(_w.y); q[8*_c+4] = scale * bflo(_w.z); q[8*_c+5] = scale * bfhi(_w.z); q[8*_c+6] = scale * bflo(_w.w); q[8*_c+7] = scale * bfhi(_w.w); } } while (0)
#define STORE_O64(op, o, inv) do { _Pragma("unroll") for (int _c = 0; _c < 8; ++_c) { v4u _w; _w.x = pk2(o[8*_c+0] * inv, o[8*_c+1] * inv); _w.y = pk2(o[8*_c+2] * inv, o[8*_c+3] * inv); \
    _w.z = pk2(o[8*_c+4] * inv, o[8*_c+5] * inv); _w.w = pk2(o[8*_c+6] * inv, o[8*_c+7] * inv); ((v4u*)(op))[_c] = _w; } } while (0)

__device__ __forceinline__ void ph_attn0(const Frame& F) {
    const int gw = F.vcu * NWAVES + F.wave, NGW = F.G * NWAVES;
    const bf16* P = F.P;
    for (int u = gw; u < 2048 + 256; u += NGW) {
        float q[64], o[64]; float m = -INFINITY, l = 0.f;
#pragma unroll
        for (int d = 0; d < 64; ++d) o[d] = 0.f;
        if (u < 2048) {
            const int h = u & 7, r = (u >> 3) & 31, b = u >> 8, qc = F.lane;
            const int r0 = min(max(r - 4, 0), 24), c0 = min(max(qc - 8, 0), 48);
            const size_t qrow = (size_t)b * 2048 + r * 64 + qc;
            LOADQ64(q, P + qrow * LDP0 + h * 64, 0.125f);
            for (int ri = 0; ri < 8; ++ri)
                for (int ci = 0; ci < 16; ++ci) {
                    const size_t krow = (size_t)b * 2048 + (r0 + ri) * 64 + c0 + ci;
                    const bf16* kp = P + krow * LDP0 + 512 + h * 64;
                    float s; DOT64(s, q, kp);
                    s += F.na_rpb[(h * 15 + (r0 + ri - r + 7)) * 31 + (c0 + ci - qc + 15)];
                    ONLINE_UPD(s, m, l, o, kp + 512);
                }
            for (int sc = 0; sc < 256; ++sc) {
                const size_t krow = (size_t)TL + b * 256 + sc;
                const bf16* kp = P + krow * LDP0 + 512 + h * 64;
                float s; DOT64(s, q, kp);
                ONLINE_UPD(s, m, l, o, kp + 512);
            }
            const float inv = 1.f / l;
            STORE_O64(F.YA + qrow * 1536 + h * 64, o, inv);
        } else {
            const int v = u - 2048, qb = v & 3, h = (v >> 2) & 7, b = v >> 5;
            const size_t qrow = (size_t)TL + b * 256 + qb * 64 + F.lane;
            LOADQ64(q, P + qrow * LDP0 + h * 64, 0.125f);
            for (int sc = 0; sc < 256; ++sc) {
                const size_t krow = (size_t)TL + b * 256 + sc;
                const bf16* kp = P + krow * LDP0 + 512 + h * 64;
                float s; DOT64(s, q, kp);
                ONLINE_UPD(s, m, l, o, kp + 512);
            }
            const float inv = 1.f / l;
            STORE_O64(F.YA + qrow * 1536 + h * 64, o, inv);
        }
    }
}

__device__ __forceinline__ void ph_conv(const Frame& F) {
    const int gt = F.vcu * 512 + F.tid, NGT = F.G * 512;
    for (int idx = gt; idx < TT * 192; idx += NGT) {
        const int row = idx / 192, ch = (idx % 192) * 8;
        int t, len; if (row < TL) { t = row & 2047; len = 2048; } else { t = (row - TL) & 255; len = 256; }
        float acc[8];
#pragma unroll
        for (int j = 0; j < 8; ++j) acc[j] = F.conv_b[ch + j];
#pragma unroll
        for (int k = 0; k < 5; ++k) { const int tt = t + k - 2;
            if (tt >= 0 && tt < len) { const v4u w = *(const v4u*)(F.P + (size_t)(row + k - 2) * LDP0 + 2560 + ch); const float* cw = F.conv_w + k * 1536 + ch;
                acc[0] += cw[0] * bflo(w.x); acc[1] += cw[1] * bfhi(w.x); acc[2] += cw[2] * bflo(w.y); acc[3] += cw[3] * bfhi(w.y);
                acc[4] += cw[4] * bflo(w.z); acc[5] += cw[5] * bfhi(w.z); acc[6] += cw[6] * bflo(w.w); acc[7] += cw[7] * bfhi(w.w); } }
        v4u o; o.x = pk2(silu_f(acc[0]), silu_f(acc[1])); o.y = pk2(silu_f(acc[2]), silu_f(acc[3])); o.z = pk2(silu_f(acc[4]), silu_f(acc[5])); o.w = pk2(silu_f(acc[6]), silu_f(acc[7]));
        *(v4u*)(F.XBC + (size_t)row * 1536 + ch) = o;
    }
}

__device__ __forceinline__ int scan_row(int b, int d, int s) {
    if (s < 256) return TL + b * 256 + (d ? 255 - s : s);
    const int t = s - 256; return b * 2048 + (d ? 2047 - t : t);
}
__device__ __forceinline__ void ph_scan0(const Frame& F) {
    LAS float* xs = (LAS float*)F.lds;
    LAS float* Bs = xs + 32 * 64;
    LAS float* Cs = Bs + 32 * 128;
    LAS float* dts = Cs + 32 * 128;
    LAS float* decs = dts + 32;
    LAS float* ybuf = decs + 32;
    const int p = F.tid >> 3, ng = F.tid & 7;
    for (int u = F.vcu; u < 256; u += F.G) {
        const int d = u & 1, h = (u >> 1) & 15, b = u >> 5, g = h >> 3;
        const float dtb = F.dt_bias[d * 16 + h], Acoef = -expf(F.a_log[d * 16 + h]);
        float hst[16];
#pragma unroll
        for (int j = 0; j < 16; ++j) hst[j] = 0.f;
        for (int ck = 0; ck < 72; ++ck) {
            __syncthreads();
            for (int idx = F.tid; idx < 32 * 320; idx += 512) { const int i = idx / 320, c = idx % 320; const int row = scan_row(b, d, ck * 32 + i);
                const int col = c < 64 ? h * 64 + c : (c < 192 ? 1024 + g * 128 + (c - 64) : 1280 + g * 128 + (c - 192));
                const float val = bf2f(F.XBC[(size_t)row * 1536 + col]);
                if (c < 64) xs[i * 64 + c] = val; else if (c < 192) Bs[i * 128 + (c - 64)] = val; else Cs[i * 128 + (c - 192)] = val; }
            if (F.tid < 32) { const int row = scan_row(b, d, ck * 32 + F.tid); const float raw = bf2f(F.P[(size_t)row * LDP0 + 4096 + d * 16 + h]) + dtb;
                const float dt = raw > 20.f ? raw : log1pf(__expf(raw)); dts[F.tid] = dt; decs[F.tid] = __expf(dt * Acoef); }
            __syncthreads();
            for (int i = 0; i < 32; ++i) {
                const float dt = dts[i], dec = decs[i], xv = xs[i * 64 + p] * dt;
                float y = 0.f;
#pragma unroll
                for (int j4 = 0; j4 < 4; ++j4) { const f32x4 bv = *(const LAS f32x4*)(Bs + i * 128 + 16 * ng + 4 * j4), cv = *(const LAS f32x4*)(Cs + i * 128 + 16 * ng + 4 * j4);
#pragma unroll
                    for (int jj = 0; jj < 4; ++jj) { hst[4 * j4 + jj] = hst[4 * j4 + jj] * dec + xv * bv[jj]; y += hst[4 * j4 + jj] * cv[jj]; } }
                y += __shfl_xor(y, 1); y += __shfl_xor(y, 2); y += __shfl_xor(y, 4);
                if (ng == 0) ybuf[i * 64 + p] = y;
            }
            __syncthreads();
            bf16* Y = d ? F.YB : F.YF;
            for (int idx = F.tid; idx < 2048; idx += 512) { const int i = idx >> 6, pp = idx & 63; const int row = scan_row(b, d, ck * 32 + i);
                Y[(size_t)row * 1024 + h * 64 + pp] = (bf16)f2bf(ybuf[i * 64 + pp]); }
        }
    }
}

__device__ __forceinline__ void ph_ssmout(const Frame& F) {
    const int gw = F.vcu * NWAVES + F.wave, NGW = F.G * NWAVES;
    for (int row = gw; row < TT; row += NGW) {
#pragma unroll
        for (int grp = 0; grp < 2; ++grp) {
            const int ch = grp * 512 + F.lane * 8;
            const v4u yf = *(const v4u*)(F.YF + (size_t)row * 1024 + ch), yb = *(const v4u*)(F.YB + (size_t)row * 1024 + ch);
            const v4u xv = *(const v4u*)(F.XBC + (size_t)row * 1536 + ch), zv = *(const v4u*)(F.P + (size_t)row * LDP0 + 1536 + ch);
            const float dsk = F.ssm_d[ch >> 6];
            float yz[8];
            const unsigned yfw[4] = {yf.x, yf.y, yf.z, yf.w}, ybw[4] = {yb.x, yb.y, yb.z, yb.w}, xw[4] = {xv.x, xv.y, xv.z, xv.w}, zw[4] = {zv.x, zv.y, zv.z, zv.w};
            float ss = 0.f;
#pragma unroll
            for (int j = 0; j < 4; ++j) {
                const float y0 = bflo(yfw[j]) + bflo(ybw[j]) + bflo(xw[j]) * dsk, y1 = bfhi(yfw[j]) + bfhi(ybw[j]) + bfhi(xw[j]) * dsk;
                yz[2 * j] = y0 * silu_f(bflo(zw[j])); yz[2 * j + 1] = y1 * silu_f(bfhi(zw[j]));
                ss += yz[2 * j] * yz[2 * j] + yz[2 * j + 1] * yz[2 * j + 1]; }
            const float rstd = 1.0f / sqrtf(wave_sum(ss) * (1.f / 512.f) + EPS);
            const f32x4 g0 = *(const f32x4*)(F.ssm_norm_g + ch), g1 = *(const f32x4*)(F.ssm_norm_g + ch + 4);
            v4u o; o.x = pk2(yz[0] * rstd * g0.x, yz[1] * rstd * g0.y); o.y = pk2(yz[2] * rstd * g0.z, yz[3] * rstd * g0.w);
            o.z = pk2(yz[4] * rstd * g1.x, yz[5] * rstd * g1.y); o.w = pk2(yz[6] * rstd * g1.z, yz[7] * rstd * g1.w);
            *(v4u*)(F.YA + (size_t)row * 1536 + 512 + ch) = o;
        }
    }
}

__device__ __forceinline__ void ph_rope(const Frame& F) {
    const int gw = F.vcu * NWAVES + F.wave, NGW = F.G * NWAVES;
    for (int row = gw; row < TL; row += NGW) {
        const int t = row & 2047; bf16* pr = F.P + (size_t)row * LDP1;
        for (int i = F.lane; i < 26 * 32; i += 64) {
            const int hb = i >> 5, f = i & 31;
            const int col = hb < 10 ? hb * 64 : 768 + (hb - 10) * 64;
            const float cs = F.ROPE[(t * 32 + f) * 2], sn = F.ROPE[(t * 32 + f) * 2 + 1];
            const float x1 = bf2f(pr[col + f]), x2 = bf2f(pr[col + 32 + f]);
            pr[col + f] = (bf16)f2bf(x1 * cs - x2 * sn); pr[col + 32 + f] = (bf16)f2bf(x2 * cs + x1 * sn);
        }
    }
}

__device__ __forceinline__ void ph_swa(const Frame& F) {
    const int gw = F.vcu * NWAVES + F.wave, NGW = F.G * NWAVES;
    const bf16* P = F.P;
    for (int u = gw; u < 2048; u += NGW) {
        const int qb = u & 31, h = (u >> 5) & 7, b = u >> 8, kvh = h >> 2;
        const int t = qb * 64 + F.lane; const size_t qrow = (size_t)b * 2048 + t;
        float q[64], o[64]; float m = -INFINITY, l = 0.f;
#pragma unroll
        for (int d = 0; d < 64; ++d) o[d] = 0.f;
        LOADQ64(q, P + qrow * LDP1 + h * 64, 0.125f);
        const int jlo = max(qb * 64 - 128, 0), jhi = min(qb * 64 + 63 + 128, 2047);
        for (int j = jlo; j <= jhi; ++j) {
            const int dj = t - j;
            if (dj <= 128 && dj >= -128) {
                const bf16* kp = P + ((size_t)b * 2048 + j) * LDP1 + 512 + kvh * 64;
                float s; DOT64(s, q, kp);
                ONLINE_UPD(s, m, l, o, kp + 128);
            }
        }
        for (int sc = 0; sc < 256; ++sc) {
            const bf16* kp = P + ((size_t)TL + b * 256 + sc) * LDP1 + 512 + kvh * 64;
            float s; DOT64(s, q, kp);
            ONLINE_UPD(s, m, l, o, kp + 128);
        }
        { const float sk = F.swa_sink[h]; if (sk > m) { const float cr = __expf(m - sk); l *= cr;
#pragma unroll
              for (int d = 0; d < 64; ++d) o[d] *= cr;
              m = sk; }
          l += __expf(sk - m); }
        const float inv = 1.f / l;
        STORE_O64(F.YA + qrow * 1536 + h * 64, o, inv);
    }
}

__device__ __forceinline__ void ph_retscan(const Frame& F) {
    LAS float* vs = (LAS float*)F.lds;
    LAS float* ks = vs + 32 * 64;
    LAS float* qs = ks + 32 * 64;
    LAS float* ybuf = qs + 32 * 64;
    const int p = F.tid >> 3, ng = F.tid & 7;
    for (int u = F.vcu; u < 256; u += F.G) {
        const int ph = u & 1, d = (u >> 1) & 1, h = (u >> 2) & 7, b = u >> 5;
        const float gamma = 1.f - expf(F.ret_log_decay[d * 8 + h]);
        float hst[8];
#pragma unroll
        for (int j = 0; j < 8; ++j) hst[j] = 0.f;
        for (int ck = 0; ck < 72; ++ck) {
            __syncthreads();
            for (int idx = F.tid; idx < 32 * 192; idx += 512) { const int i = idx / 192, c = idx % 192; const int row = scan_row(b, d, ck * 32 + i);
                const bf16* pr = F.P + (size_t)row * LDP1;
                if (c < 64) vs[i * 64 + c] = bf2f(pr[1792 + h * 128 + ph * 64 + c]);
                else if (c < 128) ks[i * 64 + (c - 64)] = 0.125f * bf2f(pr[1280 + h * 64 + (c - 64)]);
                else qs[i * 64 + (c - 128)] = bf2f(pr[768 + h * 64 + (c - 128)]); }
            __syncthreads();
            for (int i = 0; i < 32; ++i) {
                const float vv = vs[i * 64 + p];
                float y = 0.f;
#pragma unroll
                for (int j4 = 0; j4 < 2; ++j4) { const f32x4 kv = *(const LAS f32x4*)(ks + i * 64 + 8 * ng + 4 * j4), qv = *(const LAS f32x4*)(qs + i * 64 + 8 * ng + 4 * j4);
#pragma unroll
                    for (int jj = 0; jj < 4; ++jj) { hst[4 * j4 + jj] = hst[4 * j4 + jj] * gamma + vv * kv[jj]; y += hst[4 * j4 + jj] * qv[jj]; } }
                y += __shfl_xor(y, 1); y += __shfl_xor(y, 2); y += __shfl_xor(y, 4);
                if (ng == 0) ybuf[i * 64 + p] = y;
            }
            __syncthreads();
            if (ck >= 8) { bf16* Y = d ? F.YB : F.YF;
                for (int idx = F.tid; idx < 2048; idx += 512) { const int i = idx >> 6, pp = idx & 63; const int row = scan_row(b, d, ck * 32 + i);
                    Y[(size_t)row * 1024 + h * 128 + ph * 64 + pp] = (bf16)f2bf(ybuf[i * 64 + pp]); } }
        }
    }
}

__device__ __forceinline__ void ph_retout(const Frame& F) {
    const int gw = F.vcu * NWAVES + F.wave, NGW = F.G * NWAVES;
    for (int row = gw; row < TL; row += NGW) {
#pragma unroll
        for (int half = 0; half < 2; ++half) {
            const int ch = half * 512 + F.lane * 8;
            const v4u yf = *(const v4u*)(F.YF + (size_t)row * 1024 + ch), yb = *(const v4u*)(F.YB + (size_t)row * 1024 + ch), gv = *(const v4u*)(F.P + (size_t)row * LDP1 + 2816 + ch);
            const unsigned yfw[4] = {yf.x, yf.y, yf.z, yf.w}, ybw[4] = {yb.x, yb.y, yb.z, yb.w}, gw4[4] = {gv.x, gv.y, gv.z, gv.w};
            float y[8]; float s = 0.f;
#pragma unroll
            for (int j = 0; j < 4; ++j) { y[2 * j] = bflo(yfw[j]) + bflo(ybw[j]); y[2 * j + 1] = bfhi(yfw[j]) + bfhi(ybw[j]); s += y[2 * j] + y[2 * j + 1]; }
            s += __shfl_xor(s, 1); s += __shfl_xor(s, 2); s += __shfl_xor(s, 4); s += __shfl_xor(s, 8);
            const float mu = s * (1.f / 128.f); float q = 0.f;
#pragma unroll
            for (int j = 0; j < 8; ++j) { y[j] -= mu; q += y[j] * y[j]; }
            q += __shfl_xor(q, 1); q += __shfl_xor(q, 2); q += __shfl_xor(q, 4); q += __shfl_xor(q, 8);
            const float rstd = 1.0f / sqrtf(q * (1.f / 128.f) + EPS);
            float ov[8];
#pragma unroll
            for (int j = 0; j < 8; ++j) { const float gg = (j & 1) ? bfhi(gw4[j >> 1]) : bflo(gw4[j >> 1]); ov[j] = silu_f(gg) * (y[j] * rstd * F.ret_gn_g[ch + j] + F.ret_gn_b[ch + j]); }
            v4u o; o.x = pk2(ov[0], ov[1]); o.y = pk2(ov[2], ov[3]); o.z = pk2(ov[4], ov[5]); o.w = pk2(ov[6], ov[7]);
            *(v4u*)(F.YA + (size_t)row * 1536 + 512 + ch) = o;
        }
    }
}

__device__ __forceinline__ void ph_final(const Frame& F) {
    const int gw = F.vcu * NWAVES + F.wave, NGW = F.G * NWAVES;
    for (int row = gw; row < TL; row += NGW) {
        const f32x4* xr = (const f32x4*)(F.X + (size_t)row * 1024) + F.lane;
        f32x4 v[4]; float s = 0.f;
#pragma unroll
        for (int j = 0; j < 4; ++j) { v[j] = xr[64 * j]; s += (v[j].x * v[j].x + v[j].y * v[j].y) + (v[j].z * v[j].z + v[j].w * v[j].w); }
        const float rstd = 1.0f / sqrtf(wave_sum(s) * (1.f / 1024.f) + EPS);
        f32x4* o = (f32x4*)(F.out + (size_t)row * 1024) + F.lane;
#pragma unroll
        for (int j = 0; j < 4; ++j) o[64 * j] = v[j] * rstd * ((const f32x4*)F.final_g)[F.lane + 64 * j];
    }
}

enum { PH_CVT = 0, PH_NORM0, PH_IN0, PH_MIX0, PH_SCAN0, PH_SSMOUT, PH_OUT0, PH_NORM1, PH_F13, PH_F2, PH_NORM2, PH_IN1, PH_ROPE, PH_MIX1, PH_RETOUT, PH_OUT1, PH_NORM3, PH_MOE0,
       PH_FINAL = PH_MOE0 + 16, NPHASES };

struct Args { const float* in[31]; float* out; unsigned char* ws; int ph_lo, ph_hi; };

__global__ void __launch_bounds__(NWAVES * 64, 2) fwd(Args args) {
    extern __shared__ __attribute__((aligned(16))) unsigned char lds_raw[];
    Frame F;
    F.lds = (LAS unsigned char*)lds_raw;
    F.tid = threadIdx.x; F.lane = F.tid & 63; F.wave = __builtin_amdgcn_readfirstlane(F.tid >> 6);
    F.G = gridDim.x; { const int bx = blockIdx.x; F.vcu = (F.G % 8 == 0) ? (bx % 8) * (F.G / 8) + bx / 8 : bx; }
    F.x = args.in[0]; F.c = args.in[1]; F.ctx = args.in[2]; F.c_ctx = args.in[3]; F.ada_w = args.in[4]; F.ada_b = args.in[5]; F.norm_attn_g = args.in[6]; F.norm_ffn_g = args.in[7];
    F.ev_w_in = args.in[8]; F.ev_w_out = args.in[9]; F.na_rpb = args.in[10]; F.conv_w = args.in[11]; F.conv_b = args.in[12]; F.dt_bias = args.in[13]; F.a_log = args.in[14]; F.ssm_d = args.in[15];
    F.ssm_norm_g = args.in[16]; F.ffn_w1 = args.in[17]; F.ffn_w3 = args.in[18]; F.ffn_w2 = args.in[19]; F.od_w_in = args.in[20]; F.od_w_out = args.in[21]; F.swa_sink = args.in[22];
    F.ret_log_decay = args.in[23]; F.ret_gn_g = args.in[24]; F.ret_gn_b = args.in[25]; F.moe_router = args.in[26]; F.moe_w1 = args.in[27]; F.moe_w3 = args.in[28]; F.moe_w2 = args.in[29]; F.final_g = args.in[30];
    F.out = args.out;
    unsigned char* ws = args.ws;
    F.MOD = (float*)(ws + WS_MOD); F.GATE = (float*)(ws + WS_GATE); F.ROPE = (float*)(ws + WS_ROPE); F.X = (float*)(ws + WS_X);
    F.WIN0 = (bf16*)(ws + WS_WIN0); F.WOUT0 = (bf16*)(ws + WS_WOUT0); F.WF13 = (bf16*)(ws + WS_WF13); F.WF2 = (bf16*)(ws + WS_WF2); F.WIN1 = (bf16*)(ws + WS_WIN1); F.WOUT1 = (bf16*)(ws + WS_WOUT1);
    F.WM13 = (bf16*)(ws + WS_WM13); F.WM2 = (bf16*)(ws + WS_WM2); F.H = (bf16*)(ws + WS_H); F.P = (bf16*)(ws + WS_P); F.YA = (bf16*)(ws + WS_YA); F.XBC = (bf16*)(ws + WS_XBC);
    F.YF = (bf16*)(ws + WS_YF); F.YB = (bf16*)(ws + WS_YB); F.Gh = (bf16*)(ws + WS_G); F.MG = (bf16*)(ws + WS_MG);

    for (int u = F.tid; u < (LDS_BYTES - LDSCTL_OFF) / 4; u += NWAVES * 64) ((LAS unsigned*)(F.lds + LDSCTL_OFF))[u] = 0u;
    __syncthreads();
    volatile LAS unsigned* MISC = (volatile LAS unsigned*)(F.lds + MISC_OFF);
    XcdBarrier bar; bar.bar = (unsigned*)(ws + WS_CTL) + CW_BAR; bar.x = 0; bar.st = nullptr;
    const int lo = args.ph_lo, hi = args.ph_hi;
    if (hi - lo > 1) bar = xcd_barrier_post((unsigned*)(ws + WS_CTL) + CW_BAR, MISC + 8);
#define IN(k) (lo <= (k) && (k) < hi)
#define SEAM(k) do { if (IN(k) && IN((k) + 1)) xcd_barrier(bar); else __syncthreads(); } while (0)

    if (IN(PH_CVT)) { ph_cvt(F); SEAM(PH_CVT); }
    if (IN(PH_NORM0)) { ph_norm<0, false>(F, 0, 0, TT); SEAM(PH_NORM0); }
    if (IN(PH_IN0)) { EpiStore E{F.P, LDP0}; gemm_simple(F, F.H, F.WIN0, TT, LDP0, 1024, E); SEAM(PH_IN0); }
    if (IN(PH_MIX0)) { ph_attn0(F); ph_conv(F); SEAM(PH_MIX0); }
    if (IN(PH_SCAN0)) { ph_scan0(F); SEAM(PH_SCAN0); }
    if (IN(PH_SSMOUT)) { ph_ssmout(F); SEAM(PH_SSMOUT); }
    if (IN(PH_OUT0)) { EpiResid E{F.x, F.ctx, F.X, F.MOD + 2 * 1024, nullptr, 0, 0}; gemm_simple(F, F.YA, F.WOUT0, TT, 1024, 1536, E); SEAM(PH_OUT0); }
    if (IN(PH_NORM1)) { ph_norm<1, false>(F, 0, 1, TT); SEAM(PH_NORM1); }
    if (IN(PH_F13)) { EpiSwiglu E{F.Gh, DFF}; gemm_simple(F, F.H, F.WF13, TT, 2 * DFF, 1024, E); SEAM(PH_F13); }
    if (IN(PH_F2)) { EpiResid E{F.X, F.X + (size_t)TL * 1024, F.X, F.MOD + 5 * 1024, nullptr, 0, 0}; gemm_simple(F, F.Gh, F.WF2, TT, 1024, DFF, E); SEAM(PH_F2); }
    if (IN(PH_NORM2)) { ph_norm<1, false>(F, 1, 0, TT); SEAM(PH_NORM2); }
    if (IN(PH_IN1)) { EpiStore E{F.P, LDP1}; gemm_simple(F, F.H, F.WIN1, TT, LDP1, 1024, E); SEAM(PH_IN1); }
    if (IN(PH_ROPE)) { ph_rope(F); SEAM(PH_ROPE); }
    if (IN(PH_MIX1)) { ph_retscan(F); ph_swa(F); SEAM(PH_MIX1); }
    if (IN(PH_RETOUT)) { ph_retout(F); SEAM(PH_RETOUT); }
    if (IN(PH_OUT1)) { EpiResid E{F.X, F.X + (size_t)TL * 1024, F.X, F.MOD + 9 * 6144 + 2 * 1024, nullptr, 0, 0}; gemm_simple(F, F.YA, F.WOUT1, TL, 1024, 1536, E); SEAM(PH_OUT1); }
    if (IN(PH_NORM3)) { ph_norm<1, true>(F, 1, 1, TL); ph_cvt_moe(F); SEAM(PH_NORM3); }
    for (int e = 0; e < NEXP; ++e) {
        if (IN(PH_MOE0 + 2 * e)) { EpiSwiglu E{F.MG, DFE}; gemm_simple(F, F.H, F.WM13 + (size_t)e * 7168 * 1024, TL, 2 * DFE, 1024, E); SEAM(PH_MOE0 + 2 * e); }
        if (IN(PH_MOE0 + 2 * e + 1)) { EpiResid E{F.X, F.X + (size_t)TL * 1024, F.X, F.MOD + 9 * 6144 + 5 * 1024, F.GATE, 8, e}; gemm_simple(F, F.MG, F.WM2 + (size_t)e * 1024 * DFE, TL, 1024, DFE, E); SEAM(PH_MOE0 + 2 * e + 1); }
    }
    if (IN(PH_FINAL)) { ph_final(F); }
#undef IN
#undef SEAM
}

extern "C" void kernel_launch(void* const* d_in, const int* in_sizes, int n_in, void* d_out, int out_size, void* d_ws, size_t ws_size, hipStream_t stream) {
    static int grid = 0;
    if (grid == 0) {
        if (n_in != 31 || out_size != TL * DM || ws_size < WS_END) { fprintf(stderr, "kernel_launch: unexpected shapes (n_in %d out %d ws %zu need %zu)\n", n_in, out_size, ws_size, (size_t)WS_END); grid = -1; return; }
        int dev = 0, cus = 0, per_cu = 0;
        if (hipGetDevice(&dev) != hipSuccess || hipDeviceGetAttribute(&cus, hipDeviceAttributeMultiprocessorCount, dev) != hipSuccess) { grid = -1; return; }
        if (hipFuncSetAttribute((const void*)fwd, hipFuncAttributeMaxDynamicSharedMemorySize, LDS_BYTES) != hipSuccess) { grid = -1; return; }
        if (hipOccupancyMaxActiveBlocksPerMultiprocessor(&per_cu, (const void*)fwd, NWAVES * 64, LDS_BYTES) != hipSuccess || per_cu < 1) fprintf(stderr, "kernel_launch: occupancy query reports %d\n", per_cu);
        (void)hipGetLastError();
        grid = cus;
    }
    if (grid < 0) return;
    if (hipMemsetAsync((char*)d_ws + WS_CTL, 0, CTL_ZERO_BYTES, stream) != hipSuccess) return;
    Args a{};
    for (int i = 0; i < 31; ++i) a.in[i] = (const float*)d_in[i];
    a.out = (float*)d_out; a.ws = (unsigned char*)d_ws;
#if MK_ONE_LAUNCH
    a.ph_lo = 0; a.ph_hi = NPHASES;
    hipLaunchKernelGGL(fwd, dim3(grid), dim3(NWAVES * 64), LDS_BYTES, stream, a);
#else
    for (int ph = 0; ph < NPHASES; ++ph) { a.ph_lo = ph; a.ph_hi = ph + 1; hipLaunchKernelGGL(fwd, dim3(grid), dim3(NWAVES * 64), LDS_BYTES, stream, a); }
#endif
}
```

```cpp
#include <hip/hip_runtime.h>
#include <cstdio>
#include <cstdint>

#ifndef MK_ONE_LAUNCH
#define MK_ONE_LAUNCH 1
#endif

#define LAS __attribute__((address_space(3)))
typedef unsigned short bf16;
typedef short bf16x8 __attribute__((ext_vector_type(8)));
typedef float f32x4 __attribute__((ext_vector_type(4)));
typedef unsigned v4u __attribute__((ext_vector_type(4)));
typedef unsigned v2u __attribute__((ext_vector_type(2)));

constexpr int DM = 1024, NB = 8, SEQ = 2048, CTXL = 256;
constexpr int TL = NB * SEQ, TC = NB * CTXL, TT = TL + TC;
constexpr int LDP0 = 4352;
constexpr int LDP1 = 3840;
constexpr int DFF = 2816, DFE = 3584, NEXP = 8;
constexpr float EPS = 1e-6f;

constexpr size_t MiB = 1u << 20;
constexpr size_t WS_CTL = 0, CTL_ZERO_BYTES = 1 * MiB;
constexpr size_t WS_MOD = 1 * MiB;
constexpr size_t WS_GATE = 2 * MiB;
constexpr size_t WS_ROPE = 3 * MiB;
constexpr size_t WS_WIN0 = 4 * MiB;
constexpr size_t WS_WOUT0 = 13 * MiB;
constexpr size_t WS_WF13 = 16 * MiB;
constexpr size_t WS_WF2 = 27 * MiB;
constexpr size_t WS_WIN1 = 33 * MiB;
constexpr size_t WS_WOUT1 = 41 * MiB;
constexpr size_t WS_X = 44 * MiB;
constexpr size_t WS_H = 116 * MiB;
constexpr size_t WS_R = 152 * MiB;
constexpr size_t WS_P = WS_R;
constexpr size_t WS_YA = WS_R + 153 * MiB;
constexpr size_t WS_XBC = WS_R + 207 * MiB;
constexpr size_t WS_YF = WS_R + 261 * MiB;
constexpr size_t WS_YB = WS_R + 297 * MiB;
constexpr size_t WS_G = WS_R;
constexpr size_t WS_WM13 = WS_R;
constexpr size_t WS_WM2 = WS_R + 112 * MiB;
constexpr size_t WS_MG = WS_R + 168 * MiB;
constexpr size_t WS_END = WS_R + 333 * MiB;
static_assert(WS_P + (size_t)TT * LDP0 * 2 <= WS_YA && WS_YA + (size_t)TT * 1536 * 2 <= WS_XBC && WS_XBC + (size_t)TT * 1536 * 2 <= WS_YF && WS_YF + (size_t)TT * 1024 * 2 <= WS_YB && WS_YB + (size_t)TT * 1024 * 2 <= WS_END, "ws map");
static_assert(WS_WM13 + (size_t)8 * 7168 * 1024 * 2 <= WS_WM2 && WS_WM2 + (size_t)8 * 1024 * 3584 * 2 <= WS_MG && WS_MG + (size_t)TL * 3584 * 2 <= WS_END, "ws map moe");
static_assert(WS_X + (size_t)TT * 1024 * 4 <= WS_H && WS_H + (size_t)TT * 1024 * 2 <= WS_R, "ws map 2");
constexpr int CW_BAR = 4096;

constexpr int RING_BYTES = 131072, LDSCTL_OFF = RING_BYTES, MISC_OFF = LDSCTL_OFF + 320, LDS_BYTES = 147456;
constexpr int NWAVES = 8;

#define LDS_WAIT() asm volatile("s_waitcnt lgkmcnt(0)" ::: "memory")
__device__ __forceinline__ unsigned f2bf(float f) { unsigned u = __builtin_bit_cast(unsigned, f); return (u + 0x7fffu + ((u >> 16) & 1u)) >> 16; }
__device__ __forceinline__ unsigned pk2(float lo, float hi) { return f2bf(lo) | (f2bf(hi) << 16); }
__device__ __forceinline__ float bf2f(unsigned short b) { return __builtin_bit_cast(float, ((unsigned)b) << 16); }
__device__ __forceinline__ float bflo(unsigned w) { return __builtin_bit_cast(float, w << 16); }
__device__ __forceinline__ float bfhi(unsigned w) { return __builtin_bit_cast(float, w & 0xffff0000u); }
__device__ __forceinline__ float silu_f(float x) { return x / (1.f + __expf(-x)); }
__device__ __forceinline__ float wave_sum(float v) {
#pragma unroll
    for (int o = 1; o < 64; o <<= 1) v += __shfl_xor(v, o);
    return v;
}
__host__ __device__ __forceinline__ int perm32(int rho) { const int n = rho >> 4, i = rho & 15; return 8 * (i >> 2) + 4 * n + (i & 3); }

#define XB_TMO      128
#define XB_XCNT(j)  (256  + 64 * (j))
#define XB_XSUB(j)  (1280 + 64 * (j))
#define XB_XGEN(j)  (2304 + 64 * (j))
#define XB_TOP      3328
#define XB_TOPGEN   3392
#define XCD_BAR_WORDS 3456
#define XB_SPIN_CAP (1u << 18)
__device__ __forceinline__ unsigned xb_ld(unsigned* p)              { return __hip_atomic_load(p, __ATOMIC_RELAXED, __HIP_MEMORY_SCOPE_AGENT); }
__device__ __forceinline__ unsigned xb_add(unsigned* p, unsigned v) { return __hip_atomic_fetch_add(p, v, __ATOMIC_RELAXED, __HIP_MEMORY_SCOPE_AGENT); }
__device__ __forceinline__ unsigned xb_xcc_id() { return (unsigned)__builtin_amdgcn_s_getreg((3 << 11) | 20) & 0xFu; }
#define XB_SPIN(cond, bar) do { unsigned _sp = 0; while (cond) { __builtin_amdgcn_s_sleep(1); \
    if ((++_sp & 255u) == 0u) { if (xb_ld(&(bar)[XB_TMO])) break; if (_sp > XB_SPIN_CAP) { atomicAdd(&(bar)[XB_TMO], 1u); break; } } } } while (0)
struct XcdBarrier { unsigned* bar; unsigned x; volatile LAS unsigned* st; };
__device__ __forceinline__ XcdBarrier xcd_barrier_post(unsigned* bar, volatile LAS unsigned* st) {
    XcdBarrier b; b.bar = bar; b.x = xb_xcc_id(); b.st = st;
    if (threadIdx.x == 0) (void)xb_add(&bar[XB_XCNT(b.x)], 1u);
    return b;
}
__device__ __forceinline__ void xcd_barrier_complete(unsigned* bar, unsigned x, unsigned& nloc, unsigned& nx) {
    const unsigned G = gridDim.x * gridDim.y * gridDim.z;
    unsigned sum, cnt, mine, sp = 0u;
    for (;;) {
        sum = 0u; cnt = 0u; mine = 0u;
#pragma unroll
        for (unsigned j = 0; j < 16; ++j) { const unsigned c = xb_ld(&bar[XB_XCNT(j)]); sum += c; cnt += (c > 0u) ? 1u : 0u; mine = (j == x) ? c : mine; }
        if (sum == G) break;
        __builtin_amdgcn_s_sleep(1);
        if ((++sp & 255u) == 0u) { if (xb_ld(&bar[XB_TMO])) break; if (sp > XB_SPIN_CAP) { atomicAdd(&bar[XB_TMO], 1u); break; } }
    }
    nloc = mine > 0u ? mine : 1u; nx = cnt > 0u ? cnt : 1u;
}
__device__ __forceinline__ void xcd_barrier(const XcdBarrier& b) {
    asm volatile("s_waitcnt vmcnt(0)" ::: "memory");
    __syncthreads();
    if (threadIdx.x == 0) {
        unsigned* bar = b.bar;
        __builtin_amdgcn_s_waitcnt(0);
        unsigned nloc = b.st[0], nx = b.st[1];
        if (nloc == 0u) { xcd_barrier_complete(bar, b.x, nloc, nx); b.st[0] = nloc; b.st[1] = nx; }
        const unsigned old = xb_add(&bar[XB_XSUB(b.x)], 1u);
        const unsigned gen = old / nloc;
        if (old + 1u == (gen + 1u) * nloc) {
            __builtin_amdgcn_fence(__ATOMIC_RELEASE, "agent");
            asm volatile("s_waitcnt vmcnt(0)" ::: "memory");
            const unsigned og = xb_add(&bar[XB_TOP], 1u);
            const unsigned tg = og / nx;
            if (og + 1u == (tg + 1u) * nx) xb_add(&bar[XB_TOPGEN], 1u);
            else XB_SPIN(xb_ld(&bar[XB_TOPGEN]) == tg, bar);
            __builtin_amdgcn_fence(__ATOMIC_ACQUIRE, "agent");
            xb_add(&bar[XB_XGEN(b.x)], 1u);
            asm volatile("s_waitcnt vmcnt(0)" ::: "memory");
        } else {
            XB_SPIN(xb_ld(&bar[XB_XGEN(b.x)]) == gen, bar);
            __builtin_amdgcn_fence(__ATOMIC_ACQUIRE, "agent");
            asm volatile("s_waitcnt vmcnt(0)" ::: "memory");
        }
    }
    __syncthreads();
}

namespace pg8 {
#define PG8_LAS __attribute__((address_space(3)))
typedef unsigned short bf16_t;
typedef short bf16x8 __attribute__((ext_vector_type(8)));
typedef float f32x4 __attribute__((ext_vector_type(4)));
typedef unsigned u32x4 __attribute__((ext_vector_type(4)));
constexpr int BM = 256, BK = 64, HALF = 128, HTB = HALF * BK * 2  , STAGE_BYTES = 8 * HTB, NXCD = 8, WGM = 8;

__host__ __device__ __forceinline__ int lds_byte(int r, int c) { const int st = (r >> 4) * 2 + (c >> 5), rr = r & 15, cc = c & 31, ob = rr * 64 + cc * 2; return st * 1024 + (ob ^ (((ob >> 9) & 1) << 5)); }
__host__ __device__ __forceinline__ void stage_rc(int b, int& R, int& C) { const int st = b / 1024, sb = b % 1024, swz = sb ^ (((sb >> 9) & 1) << 5); R = (st >> 1) * 16 + swz / 64; C = (st & 1) * 32 + (swz % 64) / 2; }
__host__ __device__ __forceinline__ int perm32(int rho) { const int n = rho >> 4, i = rho & 15; return 8 * (i >> 2) + 4 * n + (i & 3); }

struct Unit { int pm, pn; };
struct Gemm { const bf16_t* A; const bf16_t* Bt; int M, N, K; };

struct StaticOrder {
    int nM, nN, nwg, G, c;
    __host__ __device__ void init(int M, int N, int G_, int c_) { nM = M / BM; nN = N / BM; nwg = nM * nN; G = G_; c = c_; }
    __host__ __device__ bool next(int i, Unit& u) const {
        const long L = (long)i * G + c; if (L >= nwg) return false;
        int wgid = (int)L; { const int q = nwg / NXCD, r = nwg % NXCD, xcd = wgid % NXCD, off = wgid / NXCD; wgid = (xcd < r ? xcd * (q + 1) : r * (q + 1) + (xcd - r) * q) + off; }
        const int nig = WGM * nN, gid = wgid / nig, fm = gid * WGM, gsz = (nM - fm) < WGM ? (nM - fm) : WGM;
        u.pm = fm + ((wgid % nig) % gsz); u.pn = (wgid % nig) / gsz; return true;
    }
    __device__ __forceinline__ void a_ready(const Unit&) const {}
    __device__ __forceinline__ void done(const Unit&) const {}
};

__device__ __forceinline__ unsigned cvt_pk_bf16(float lo, float hi) { unsigned r; asm volatile("v_cvt_pk_bf16_f32 %0, %1, %2" : "=v"(r) : "v"(lo), "v"(hi)); return r; }
template <class Epi, class Sched, bool ALIGN_EPI = false, bool SP2 = false>
__device__ __forceinline__ void gemm_phase(PG8_LAS unsigned char* lds, const Gemm g, const Sched& S, const Epi& E) {
    int tid_ = threadIdx.x; asm volatile("" : "+v"(tid_));
    const int tid = tid_, wid = __builtin_amdgcn_readfirstlane(tid >> 6), lane = tid & 63, wr = wid >> 2, wc = wid & 3, fr = lane & 15, fq = lane >> 4;
    const int K = g.K, nt = K / BK;
    unsigned voffA[2], voffB[2];
#pragma unroll
    for (int i = 0; i < 2; ++i) { int R, C; stage_rc(tid * 16 + i * 8192, R, C); const int Rb = Epi::PERM ? ((R & ~31) + perm32(R & 31)) : R;
        voffA[i] = (unsigned)(R * K + C) * 2u; voffB[i] = (unsigned)(Rb * K + C) * 2u; }
    const size_t kstep = (size_t)(BK * 2);
    const size_t hstep = (size_t)HALF * K * 2;
    const size_t tstep = 2 * hstep;
    const unsigned ldsw = (unsigned)wid * 1024u;
    const int aoff = lds_byte(wr * 64 + fr, fq * 8), boff = lds_byte(wc * 32 + fr, fq * 8);
#define PG8_SA(b, h) (((b) * 2 + (h)) * HTB)
#define PG8_SB(b, h) ((4 + (b) * 2 + (h)) * HTB)
#define PG8_STAGE(bufoff, gbase, voff) do { _Pragma("unroll") for (int _i = 0; _i < 2; ++_i) \
        __builtin_amdgcn_global_load_lds((const unsigned*)((const char*)(gbase) + (voff)[_i]), (PG8_LAS unsigned*)(lds + (bufoff) + ldsw + _i * 8192), 16, 0, 0); } while (0)
#define PG8_LDA(dst, b, h) do { _Pragma("unroll") for (int m = 0; m < 4; ++m) _Pragma("unroll") for (int k = 0; k < 2; ++k) dst[m][k] = *(const PG8_LAS bf16x8*)(lds + PG8_SA(b, h) + aoff + m * 2048 + k * 1024); } while (0)
#define PG8_LDB(dst, b, h) do { _Pragma("unroll") for (int n = 0; n < 2; ++n) _Pragma("unroll") for (int k = 0; k < 2; ++k) dst[n][k] = *(const PG8_LAS bf16x8*)(lds + PG8_SB(b, h) + boff + n * 2048 + k * 1024); } while (0)
#define PG8_MMA(ai, bj, At, Bt) do { __builtin_amdgcn_s_setprio(1); _Pragma("unroll") for (int m = 0; m < 4; ++m) _Pragma("unroll") for (int n = 0; n < 2; ++n) _Pragma("unroll") for (int k = 0; k < 2; ++k) \
        acc[ai][bj][m][n] = __builtin_amdgcn_mfma_f32_16x16x32_bf16(Bt[n][k], At[m][k], acc[ai][bj][m][n], 0, 0, 0); __builtin_amdgcn_s_setprio(0); } while (0)
#define PG8_WAIT_V(n) asm volatile("s_waitcnt vmcnt(" #n ")" ::: "memory")
#define PG8_WAIT_L(n) asm volatile("s_waitcnt lgkmcnt(" #n ")" ::: "memory")
#define PG8_BAR __builtin_amdgcn_s_barrier()
#define PG8_SCHED __builtin_amdgcn_sched_barrier(0)
    Unit cur, nxt; int ui = 0;
    if (!S.next(0, cur)) return;
    f32x4 acc[2][2][4][2];
#pragma unroll
    for (int a = 0; a < 2; ++a)
#pragma unroll
        for (int b = 0; b < 2; ++b)
#pragma unroll
            for (int m = 0; m < 4; ++m)
#pragma unroll
                for (int n = 0; n < 2; ++n) acc[a][b][m][n] = (f32x4){0.f, 0.f, 0.f, 0.f};
    bf16x8 At[4][2], B0[2][2], B1[2][2];
    const char* cA = (const char*)g.A + (size_t)cur.pm * tstep; const char* cB = (const char*)g.Bt + (size_t)cur.pn * tstep;
    S.a_ready(cur);
    if constexpr (SP2) {
        PG8_STAGE(PG8_SB(0, 0), cB, voffB); PG8_STAGE(PG8_SB(0, 1), cB + hstep, voffB); PG8_STAGE(PG8_SA(0, 0), cA, voffA); PG8_STAGE(PG8_SA(0, 1), cA + hstep, voffA);
        if (wr == 1) PG8_BAR;
        PG8_WAIT_V(2); PG8_BAR;
        PG8_STAGE(PG8_SB(1, 0), cB + kstep, voffB); PG8_STAGE(PG8_SA(1, 0), cA + kstep, voffA); PG8_STAGE(PG8_SB(1, 1), cB + hstep + kstep, voffB);
        PG8_WAIT_V(6); PG8_BAR;
    } else {
        PG8_STAGE(PG8_SB(0, 0), cB, voffB); PG8_STAGE(PG8_SA(0, 0), cA, voffA); PG8_STAGE(PG8_SB(0, 1), cB + hstep, voffB); PG8_STAGE(PG8_SA(0, 1), cA + hstep, voffA);
        if (wr == 1) PG8_BAR;
        PG8_WAIT_V(4); PG8_BAR;
        PG8_STAGE(PG8_SB(1, 0), cB + kstep, voffB); PG8_STAGE(PG8_SA(1, 0), cA + kstep, voffA); PG8_STAGE(PG8_SB(1, 1), cB + hstep + kstep, voffB);
        PG8_WAIT_V(6); PG8_BAR;
    }
    for (;;) {
        const bool has_next = S.next(ui + 1, nxt);
        const char* nA = has_next ? (const char*)g.A + (size_t)nxt.pm * tstep : cA; const char* nB = has_next ? (const char*)g.Bt + (size_t)nxt.pn * tstep : cB;
        for (int t = 0; t < nt; t += 2) {
            const bool last = (t == nt - 2);
            const char* a1 = cA + (size_t)(t + 1) * kstep;
            const char* a2 = last ? nA : cA + (size_t)(t + 2) * kstep; const char* b2 = last ? nB : cB + (size_t)(t + 2) * kstep;
            const char* a3 = a2 + kstep; const char* b3 = b2 + kstep;
            if (last && has_next) S.a_ready(nxt);
            if constexpr (SP2) {
            PG8_LDB(B0, 0, 0); PG8_LDB(B1, 0, 1); PG8_SCHED; PG8_LDA(At, 0, 0); PG8_STAGE(PG8_SA(1, 1), a1 + hstep, voffA);
            PG8_WAIT_V(8); PG8_WAIT_L(0); PG8_BAR; PG8_MMA(0, 0, At, B0); PG8_MMA(0, 1, At, B1); PG8_BAR; PG8_SCHED;
            PG8_LDA(At, 0, 1); PG8_STAGE(PG8_SB(0, 0), b2, voffB); PG8_STAGE(PG8_SB(0, 1), b2 + hstep, voffB); PG8_STAGE(PG8_SA(0, 0), a2, voffA);
            PG8_WAIT_V(8); PG8_WAIT_L(0); PG8_BAR; PG8_MMA(1, 0, At, B0); PG8_MMA(1, 1, At, B1); PG8_BAR; PG8_SCHED;
            PG8_LDB(B0, 1, 0); PG8_LDB(B1, 1, 1); PG8_SCHED; PG8_LDA(At, 1, 0); PG8_STAGE(PG8_SA(0, 1), a2 + hstep, voffA);
            PG8_WAIT_V(8); PG8_WAIT_L(0); PG8_BAR; PG8_MMA(0, 0, At, B0); PG8_MMA(0, 1, At, B1); PG8_BAR; PG8_SCHED;
            PG8_LDA(At, 1, 1); PG8_STAGE(PG8_SB(1, 0), b3, voffB); PG8_STAGE(PG8_SB(1, 1), b3 + hstep, voffB); PG8_STAGE(PG8_SA(1, 0), a3, voffA);
            PG8_WAIT_V(8); PG8_WAIT_L(0); PG8_BAR; PG8_MMA(1, 0, At, B0); PG8_MMA(1, 1, At, B1); PG8_BAR; PG8_SCHED;
            } else {
            PG8_LDB(B0, 0, 0); PG8_SCHED; PG8_LDA(At, 0, 0); PG8_STAGE(PG8_SA(1, 1), a1 + hstep, voffA);
            PG8_WAIT_L(8); PG8_BAR; PG8_WAIT_L(0); PG8_MMA(0, 0, At, B0); PG8_BAR; PG8_SCHED;
            PG8_LDB(B1, 0, 1); PG8_STAGE(PG8_SB(0, 0), b2, voffB);
            PG8_BAR; PG8_WAIT_L(0); PG8_MMA(0, 1, At, B1); PG8_BAR;
            PG8_LDA(At, 0, 1); PG8_STAGE(PG8_SA(0, 0), a2, voffA);
            PG8_BAR; PG8_WAIT_L(0); PG8_MMA(1, 0, At, B0); PG8_BAR; PG8_SCHED;
            PG8_STAGE(PG8_SB(0, 1), b2 + hstep, voffB);
            PG8_WAIT_V(6); PG8_BAR; PG8_MMA(1, 1, At, B1); PG8_BAR;
            PG8_LDB(B0, 1, 0); PG8_SCHED; PG8_LDA(At, 1, 0); PG8_STAGE(PG8_SA(0, 1), a2 + hstep, voffA);
            PG8_WAIT_L(8); PG8_BAR; PG8_WAIT_L(0); PG8_MMA(0, 0, At, B0); PG8_BAR; PG8_SCHED;
            PG8_LDB(B1, 1, 1); PG8_STAGE(PG8_SB(1, 0), b3, voffB);
            PG8_BAR; PG8_WAIT_L(0); PG8_MMA(0, 1, At, B1); PG8_BAR;
            PG8_LDA(At, 1, 1); PG8_STAGE(PG8_SA(1, 0), a3, voffA);
            PG8_BAR; PG8_WAIT_L(0); PG8_MMA(1, 0, At, B0); PG8_BAR; PG8_SCHED;
            PG8_STAGE(PG8_SB(1, 1), b3 + hstep, voffB);
            PG8_WAIT_V(6); PG8_BAR; PG8_MMA(1, 1, At, B1); PG8_BAR;
            }
        }
        if constexpr (ALIGN_EPI) { if (wr == 0) PG8_BAR; }
        if constexpr (!Epi::AFTER_DRAIN) { E(acc, cur, wr, wc, fr, fq); S.done(cur); }
        if (!has_next) break;
#pragma unroll
        for (int a = 0; a < 2; ++a)
#pragma unroll
            for (int b = 0; b < 2; ++b)
#pragma unroll
                for (int m = 0; m < 4; ++m)
#pragma unroll
                    for (int n = 0; n < 2; ++n) acc[a][b][m][n] = (f32x4){0.f, 0.f, 0.f, 0.f};
        cur = nxt; cA = nA; cB = nB; ++ui;
        if constexpr (ALIGN_EPI) { if (wr == 1) PG8_BAR; }
    }
    PG8_WAIT_V(0);
    if constexpr (!ALIGN_EPI) { if (wr == 0) PG8_BAR; }
    PG8_BAR;
    if constexpr (Epi::AFTER_DRAIN) { E.fused(acc, cur, wr, wc, fr, fq, lds, wid, lane); S.done(cur); }
#undef PG8_SA
#undef PG8_SB
#undef PG8_STAGE
#undef PG8_LDA
#undef PG8_LDB
#undef PG8_MMA
#undef PG8_WAIT_V
#undef PG8_WAIT_L
#undef PG8_BAR
#undef PG8_SCHED
}
}

struct Frame {
    LAS unsigned char* lds;
    int tid, lane, wave, vcu, G;
    const float *x, *c, *ctx, *c_ctx, *ada_w, *ada_b, *norm_attn_g, *norm_ffn_g, *ev_w_in, *ev_w_out, *na_rpb, *conv_w, *conv_b, *dt_bias, *a_log, *ssm_d, *ssm_norm_g,
        *ffn_w1, *ffn_w3, *ffn_w2, *od_w_in, *od_w_out, *swa_sink, *ret_log_decay, *ret_gn_g, *ret_gn_b, *moe_router, *moe_w1, *moe_w3, *moe_w2, *final_g;
    float* out;
    float *MOD, *GATE, *ROPE, *X;
    bf16 *WIN0, *WOUT0, *WF13, *WF2, *WIN1, *WOUT1, *WM13, *WM2, *H, *P, *YA, *XBC, *YF, *YB, *Gh, *MG;
};

__device__ __forceinline__ void tr_item(const float* W, int K, int N, bf16* WT, int ilv, LAS float* scr, int item, int lane) {
    const int nblk = N / 32, kb = item / nblk, nb = item % nblk, k0 = 64 * kb, n0 = 32 * nb;
#pragma unroll 8
    for (int i = 0; i < 32; ++i) { const int kk = 2 * i + (lane >> 5); scr[kk * 33 + (lane & 31)] = W[(size_t)(k0 + kk) * N + n0 + (lane & 31)]; }
    LDS_WAIT(); asm volatile("" ::: "memory");
    const int c = lane & 7;
#pragma unroll
    for (int j = 0; j < 4; ++j) { const int n = (lane >> 3) + 8 * j; const LAS float* s = scr + (8 * c) * 33 + n;
        v4u o; o.x = pk2(s[0 * 33], s[1 * 33]); o.y = pk2(s[2 * 33], s[3 * 33]); o.z = pk2(s[4 * 33], s[5 * 33]); o.w = pk2(s[6 * 33], s[7 * 33]);
        const int nn = n0 + n; const int row = ilv ? (8 * (nn >> 2) + (nn & 3) + (ilv == 2 ? 4 : 0)) : nn;
        *(v4u*)(WT + (size_t)row * K + k0 + 8 * c) = o; }
    LDS_WAIT(); asm volatile("" ::: "memory");
}

__device__ __forceinline__ void ph_cvt(const Frame& F) {
    LAS float* scr = (LAS float*)(F.lds + F.wave * 16384);
    const int gw = F.vcu * NWAVES + F.wave, NGW = F.G * NWAVES;
    constexpr int I_IN0 = 16 * 129, I_OUT = 24 * 32, I_F1 = 16 * 88, I_F2 = 44 * 32, I_IN1 = 16 * 120;
    constexpr int NITEMS = I_IN0 + I_OUT + 2 * I_F1 + I_F2 + I_IN1 + I_OUT;
    for (int it = gw; it < NITEMS; it += NGW) {
        int r = it;
        if (r < I_IN0) { tr_item(F.ev_w_in, 1024, 4128, F.WIN0, 0, scr, r, F.lane); continue; } r -= I_IN0;
        if (r < I_OUT) { tr_item(F.ev_w_out, 1536, 1024, F.WOUT0, 0, scr, r, F.lane); continue; } r -= I_OUT;
        if (r < I_F1) { tr_item(F.ffn_w1, 1024, DFF, F.WF13, 1, scr, r, F.lane); continue; } r -= I_F1;
        if (r < I_F1) { tr_item(F.ffn_w3, 1024, DFF, F.WF13, 2, scr, r, F.lane); continue; } r -= I_F1;
        if (r < I_F2) { tr_item(F.ffn_w2, DFF, 1024, F.WF2, 0, scr, r, F.lane); continue; } r -= I_F2;
        if (r < I_IN1) { tr_item(F.od_w_in, 1024, LDP1, F.WIN1, 0, scr, r, F.lane); continue; } r -= I_IN1;
        tr_item(F.od_w_out, 1536, 1024, F.WOUT1, 0, scr, r, F.lane);
    }
    { const int gt = F.vcu * 512 + F.tid, NGT = F.G * 512; v4u* z = (v4u*)(F.WIN0 + (size_t)4128 * 1024);
      for (int i = gt; i < 224 * 1024 / 8; i += NGT) z[i] = (v4u){0u, 0u, 0u, 0u}; }
    { const int gt = F.vcu * 512 + F.tid, NGT = F.G * 512;
      for (int i = gt; i < 2048 * 32; i += NGT) { const int t = i >> 5, f = i & 31; const float inv = powf(10000.f, -(float)(f & 15) / 16.f);
          const float ang = (float)((f < 16) ? (t >> 6) : (t & 63)) * inv; float sn, cs; sincosf(ang, &sn, &cs); F.ROPE[2 * i] = cs; F.ROPE[2 * i + 1] = sn; } }
    __syncthreads();
    LAS float* sv = (LAS float*)F.lds;
    LAS float* part = (LAS float*)(F.lds + 36864);
    for (int it = F.vcu; it < 192; it += F.G) {
        const int l = it / 96, n0 = (it % 96) * 64;
        for (int i = F.tid; i < 9 * 1024; i += 512) { const int r = i >> 10, k = i & 1023; const float v = (r < 8) ? F.c[r * 1024 + k] : F.c_ctx[k]; sv[i] = silu_f(v); }
        __syncthreads();
        float acc[9];
#pragma unroll
        for (int r = 0; r < 9; ++r) acc[r] = 0.f;
        const float* wp = F.ada_w + (size_t)l * 1024 * 6144 + n0 + F.lane;
        for (int k = F.wave * 128; k < F.wave * 128 + 128; ++k) { const float w = wp[(size_t)k * 6144];
#pragma unroll
            for (int r = 0; r < 9; ++r) acc[r] += sv[r * 1024 + k] * w; }
#pragma unroll
        for (int r = 0; r < 9; ++r) part[(F.wave * 9 + r) * 64 + F.lane] = acc[r];
        __syncthreads();
        for (int i = F.tid; i < 9 * 64; i += 512) { const int r = i >> 6, n = i & 63; float s = 0.f;
#pragma unroll
            for (int w = 0; w < 8; ++w) s += part[(w * 9 + r) * 64 + n];
            F.MOD[(size_t)(l * 9 + r) * 6144 + n0 + n] = s + F.ada_b[l * 6144 + n0 + n]; }
        __syncthreads();
    }
}

__device__ __forceinline__ void ph_cvt_moe(const Frame& F) {
    LAS float* scr = (LAS float*)(F.lds + F.wave * 16384);
    const int gw = F.vcu * NWAVES + F.wave, NGW = F.G * NWAVES;
    constexpr int I_1 = 16 * 112, I_2 = 56 * 32;
    constexpr int NITEMS = NEXP * (2 * I_1 + I_2);
    for (int it = gw; it < NITEMS; it += NGW) {
        const int e = it / (2 * I_1 + I_2); int r = it % (2 * I_1 + I_2);
        if (r < I_1) { tr_item(F.moe_w1 + (size_t)e * 1024 * DFE, 1024, DFE, F.WM13 + (size_t)e * 7168 * 1024, 1, scr, r, F.lane); continue; } r -= I_1;
        if (r < I_1) { tr_item(F.moe_w3 + (size_t)e * 1024 * DFE, 1024, DFE, F.WM13 + (size_t)e * 7168 * 1024, 2, scr, r, F.lane); continue; } r -= I_1;
        tr_item(F.moe_w2 + (size_t)e * DFE * 1024, DFE, 1024, F.WM2 + (size_t)e * 1024 * DFE, 0, scr, r, F.lane);
    }
}

template <int MODE, bool ROUTER>
__device__ __forceinline__ void ph_norm(const Frame& F, int layer, int which, int nrows) {
    const int gw = F.vcu * NWAVES + F.wave, NGW = F.G * NWAVES;
    const float* g = (which ? F.norm_ffn_g : F.norm_attn_g) + layer * 1024;
    for (int row = gw; row < nrows; row += NGW) {
        const int bidx = row < TL ? (row >> 11) : 8;
        const float* src = MODE == 0 ? (row < TL ? F.x + (size_t)row * 1024 : F.ctx + (size_t)(row - TL) * 1024) : F.X + (size_t)row * 1024;
        const float* mod = F.MOD + (size_t)(layer * 9 + bidx) * 6144 + (which ? 3 : 0) * 1024;
        const f32x4* xr = (const f32x4*)src + F.lane;
        f32x4 v[4]; float s = 0.f;
#pragma unroll
        for (int j = 0; j < 4; ++j) { v[j] = xr[64 * j]; s += (v[j].x * v[j].x + v[j].y * v[j].y) + (v[j].z * v[j].z + v[j].w * v[j].w); }
        const float rstd = 1.0f / sqrtf(wave_sum(s) * (1.f / 1024.f) + EPS);
        unsigned long long* o8 = (unsigned long long*)(F.H + (size_t)row * 1024) + F.lane;
#pragma unroll
        for (int j = 0; j < 4; ++j) {
            const f32x4 gg = ((const f32x4*)g)[F.lane + 64 * j], sh = ((const f32x4*)mod)[F.lane + 64 * j], sc = ((const f32x4*)(mod + 1024))[F.lane + 64 * j];
            v[j] = (v[j] * rstd * gg) * (sc + 1.0f) + sh;
            o8[64 * j] = (unsigned long long)pk2(v[j].x, v[j].y) | ((unsigned long long)pk2(v[j].z, v[j].w) << 32);
        }
        if (ROUTER) {
            float lg[8];
#pragma unroll
            for (int e = 0; e < 8; ++e) lg[e] = 0.f;
#pragma unroll
            for (int j = 0; j < 4; ++j)
#pragma unroll
                for (int i = 0; i < 4; ++i) { const int k = 4 * (F.lane + 64 * j) + i; const f32x4 r0 = ((const f32x4*)(F.moe_router + (size_t)k * 8))[0], r1 = ((const f32x4*)(F.moe_router + (size_t)k * 8))[1];
                    const float hv = v[j][i];
                    lg[0] += hv * r0.x; lg[1] += hv * r0.y; lg[2] += hv * r0.z; lg[3] += hv * r0.w; lg[4] += hv * r1.x; lg[5] += hv * r1.y; lg[6] += hv * r1.z; lg[7] += hv * r1.w; }
#pragma unroll
            for (int e = 0; e < 8; ++e) lg[e] = wave_sum(lg[e]);
            int i0 = 0; float v0 = lg[0];
#pragma unroll
            for (int e = 1; e < 8; ++e) if (lg[e] > v0) { v0 = lg[e]; i0 = e; }
            int i1 = -1; float v1 = -3.0e38f;
#pragma unroll
            for (int e = 0; e < 8; ++e) if (e != i0 && lg[e] > v1) { v1 = lg[e]; i1 = e; }
            const float e1 = __expf(v1 - v0), g0 = 1.f / (1.f + e1), g1 = e1 / (1.f + e1);
            if (F.lane < 8) F.GATE[(size_t)row * 8 + F.lane] = (F.lane == i0) ? g0 : ((F.lane == i1) ? g1 : 0.f);
        }
    }
}

template <class Epi>
__device__ __forceinline__ void gemm_simple(const Frame& F, const bf16* A, const bf16* Bt, int M, int N, int K, const Epi& E) {
    const int nN = N / 128, nU = (M / 256) * nN;
    const int wr = F.wave >> 1, wc = F.wave & 1, fr = F.lane & 15, fq = F.lane >> 4;
    for (int u = F.vcu; u < nU; u += F.G) {
        const int pm = u / nN, pn = u % nN, row0 = pm * 256 + wr * 64, col0 = pn * 128 + wc * 64;
        f32x4 acc[4][4];
#pragma unroll
        for (int i = 0; i < 4; ++i)
#pragma unroll
            for (int j = 0; j < 4; ++j) acc[i][j] = (f32x4){0.f, 0.f, 0.f, 0.f};
        const bf16* ap = A + (size_t)(row0 + fr) * K + fq * 8;
        const bf16* bp0 = Bt + (size_t)(col0 + perm32(fr)) * K + fq * 8;
        const bf16* bp1 = Bt + (size_t)(col0 + perm32(16 + fr)) * K + fq * 8;
#pragma unroll 2
        for (int k0 = 0; k0 < K; k0 += 32) {
            bf16x8 a[4], b[4];
#pragma unroll
            for (int i = 0; i < 4; ++i) a[i] = *(const bf16x8*)(ap + (size_t)(16 * i) * K + k0);
            b[0] = *(const bf16x8*)(bp0 + k0); b[1] = *(const bf16x8*)(bp1 + k0);
            b[2] = *(const bf16x8*)(bp0 + (size_t)32 * K + k0); b[3] = *(const bf16x8*)(bp1 + (size_t)32 * K + k0);
#pragma unroll
            for (int i = 0; i < 4; ++i)
#pragma unroll
                for (int j = 0; j < 4; ++j) acc[i][j] = __builtin_amdgcn_mfma_f32_16x16x32_bf16(b[j], a[i], acc[i][j], 0, 0, 0);
        }
#pragma unroll
        for (int i = 0; i < 4; ++i)
#pragma unroll
            for (int q = 0; q < 2; ++q) E(row0 + 16 * i + fr, col0 + 32 * q + 8 * fq, acc[i][2 * q], acc[i][2 * q + 1]);
    }
}

struct EpiStore {
    bf16* O; int ldc;
    __device__ __forceinline__ void operator()(int row, int col, f32x4 lo, f32x4 hi) const {
        v4u w; w.x = pk2(lo.x, lo.y); w.y = pk2(lo.z, lo.w); w.z = pk2(hi.x, hi.y); w.w = pk2(hi.z, hi.w);
        *(v4u*)(O + (size_t)row * ldc + col) = w; }
};
struct EpiSwiglu {
    bf16* O; int ldc;
    __device__ __forceinline__ void operator()(int row, int col, f32x4 lo, f32x4 hi) const {
        v2u w; w.x = pk2(silu_f(lo.x) * hi.x, silu_f(lo.y) * hi.y); w.y = pk2(silu_f(lo.z) * hi.z, silu_f(lo.w) * hi.w);
        *(v2u*)(O + (size_t)row * ldc + (col >> 1)) = w; }
};
struct EpiResid {
    const float* bl; const float* bc; float* X; const float* gate  ; const float* rs; int rs_ld, rs_off;
    __device__ __forceinline__ void operator()(int row, int col, f32x4 lo, f32x4 hi) const {
        const int bidx = row < TL ? (row >> 11) : 8;
        const float* b = row < TL ? bl + (size_t)row * 1024 + col : bc + (size_t)(row - TL) * 1024 + col;
        const float* gp = gate + (size_t)bidx * 6144 + col;
        float sc = 1.f; if (rs) sc = rs[(size_t)row * rs_ld + rs_off];
        const f32x4 g0 = ((const f32x4*)gp)[0] * sc, g1 = ((const f32x4*)gp)[1] * sc;
        const f32x4 b0 = ((const f32x4*)b)[0], b1 = ((const f32x4*)b)[1];
        float* o = X + (size_t)row * 1024 + col;
        ((f32x4*)o)[0] = b0 + g0 * lo; ((f32x4*)o)[1] = b1 + g1 * hi; }
};

template <class F8> struct EpiAdapt {
    static constexpr bool PERM = true, AFTER_DRAIN = false;
    F8 f;
    __device__ __forceinline__ void operator()(const pg8::f32x4 (&acc)[2][2][4][2], const pg8::Unit& u, int wr, int wc, int fr, int fq) const {
#pragma unroll
        for (int ai = 0; ai < 2; ++ai)
#pragma unroll
            for (int m = 0; m < 4; ++m) { const int row = u.pm * 256 + ai * 128 + wr * 64 + m * 16 + fr;
#pragma unroll
                for (int bj = 0; bj < 2; ++bj) f(row, u.pn * 256 + bj * 128 + wc * 32 + 8 * fq, acc[ai][bj][m][0], acc[ai][bj][m][1]);
                asm volatile("" ::: "memory"); }
    }
};
#ifndef USE_SIMPLE_GEMM
#define USE_SIMPLE_GEMM 0
#endif
template <class F8>
__device__ __forceinline__ void gemm_pg8(const Frame& F, const bf16* A, const bf16* Bt, int M, int N, int K, const F8& f) {
#if USE_SIMPLE_GEMM
    gemm_simple(F, A, Bt, M, N, K, f);
#else
    pg8::Gemm g{A, Bt, M, N, K}; pg8::StaticOrder S; S.init(M, N, F.G, (int)blockIdx.x);
    EpiAdapt<F8> E{f};
    pg8::gemm_phase<EpiAdapt<F8>, pg8::StaticOrder, true, true>(F.lds, g, S, E);
#endif
}

#define DOT64(s, q, kp) do { s = 0.f; _Pragma("unroll") for (int _c = 0; _c < 8; ++_c) { const v4u _w = ((const v4u*)(kp))[_c]; \
    s += q[8*_c+0] * bflo(_w.x) + q[8*_c+1] * bfhi(_w.x) + q[8*_c+2] * bflo(_w.y) + q[8*_c+3] * bfhi(_w.y) + q[8*_c+4] * bflo(_w.z) + q[8*_c+5] * bfhi(_w.z) + q[8*_c+6] * bflo(_w.w) + q[8*_c+7] * bfhi(_w.w); } } while (0)
#define ONLINE_UPD(s, m, l, o, vp) do { if (s > m) { const float _cr = __expf(m - s); l *= _cr; _Pragma("unroll") for (int _d = 0; _d < 64; ++_d) o[_d] *= _cr; m = s; } \
    const float _p = __expf(s - m); l += _p; _Pragma("unroll") for (int _c = 0; _c < 8; ++_c) { const v4u _w = ((const v4u*)(vp))[_c]; \
    o[8*_c+0] += _p * bflo(_w.x); o[8*_c+1] += _p * bfhi(_w.x); o[8*_c+2] += _p * bflo(_w.y); o[8*_c+3] += _p * bfhi(_w.y); o[8*_c+4] += _p * bflo(_w.z); o[8*_c+5] += _p * bfhi(_w.z); o[8*_c+6] += _p * bflo(_w.w); o[8*_c+7] += _p * bfhi(_w.w); } } while (0)
#define LOADQ64(q, qp, scale) do { _Pragma("unroll") for (int _c = 0; _c < 8; ++_c) { const v4u _w = ((const v4u*)(qp))[_c]; \
    q[8*_c+0] = scale * bflo(_w.x); q[8*_c+1] = scale * bfhi(_w.x); q[8*_c+2] = scale * bflo(_w.y); q[8*_c+3] = scale * bfhi(_w.y); q[8*_c+4] = scale * bflo(_w.z); q[8*_c+5] = scale * bfhi(_w.z); q[8*_c+6] = scale * bflo(_w.w); q[8*_c+7] = scale * bfhi(_w.w); } } while (0)
#define STORE_O64(op, o, inv) do { _Pragma("unroll") for (int _c = 0; _c < 8; ++_c) { v4u _w; _w.x = pk2(o[8*_c+0] * inv, o[8*_c+1] * inv); _w.y = pk2(o[8*_c+2] * inv, o[8*_c+3] * inv); \
    _w.z = pk2(o[8*_c+4] * inv, o[8*_c+5] * inv); _w.w = pk2(o[8*_c+6] * inv, o[8*_c+7] * inv); ((v4u*)(op))[_c] = _w; } } while (0)

__device__ __forceinline__ void ph_attn0(const Frame& F) {
    const int gw = F.vcu * NWAVES + F.wave, NGW = F.G * NWAVES;
    const bf16* P = F.P;
    for (int u = gw; u < 2048 + 256; u += NGW) {
        float q[64], o[64]; float m = -INFINITY, l = 0.f;
#pragma unroll
        for (int d = 0; d < 64; ++d) o[d] = 0.f;
        if (u < 2048) {
            const int h = u & 7, r = (u >> 3) & 31, b = u >> 8, qc = F.lane;
            const int r0 = min(max(r - 4, 0), 24), c0 = min(max(qc - 8, 0), 48);
            const size_t qrow = (size_t)b * 2048 + r * 64 + qc;
            LOADQ64(q, P + qrow * LDP0 + h * 64, 0.125f);
            for (int ri = 0; ri < 8; ++ri)
                for (int ci = 0; ci < 16; ++ci) {
                    const size_t krow = (size_t)b * 2048 + (r0 + ri) * 64 + c0 + ci;
                    const bf16* kp = P + krow * LDP0 + 512 + h * 64;
                    float s; DOT64(s, q, kp);
                    s += F.na_rpb[(h * 15 + (r0 + ri - r + 7)) * 31 + (c0 + ci - qc + 15)];
                    ONLINE_UPD(s, m, l, o, kp + 512);
                }
            for (int sc = 0; sc < 256; ++sc) {
                const size_t krow = (size_t)TL + b * 256 + sc;
                const bf16* kp = P + krow * LDP0 + 512 + h * 64;
                float s; DOT64(s, q, kp);
                ONLINE_UPD(s, m, l, o, kp + 512);
            }
            const float inv = 1.f / l;
            STORE_O64(F.YA + qrow * 1536 + h * 64, o, inv);
        } else {
            const int v = u - 2048, qb = v & 3, h = (v >> 2) & 7, b = v >> 5;
            const size_t qrow = (size_t)TL + b * 256 + qb * 64 + F.lane;
            LOADQ64(q, P + qrow * LDP0 + h * 64, 0.125f);
            for (int sc = 0; sc < 256; ++sc) {
                const size_t krow = (size_t)TL + b * 256 + sc;
                const bf16* kp = P + krow * LDP0 + 512 + h * 64;
                float s; DOT64(s, q, kp);
                ONLINE_UPD(s, m, l, o, kp + 512);
            }
            const float inv = 1.f / l;
            STORE_O64(F.YA + qrow * 1536 + h * 64, o, inv);
        }
    }
}

__device__ __forceinline__ void ph_conv(const Frame& F) {
    const int gt = F.vcu * 512 + F.tid, NGT = F.G * 512;
    for (int idx = gt; idx < TT * 192; idx += NGT) {
        const int row = idx / 192, ch = (idx % 192) * 8;
        int t, len; if (row < TL) { t = row & 2047; len = 2048; } else { t = (row - TL) & 255; len = 256; }
        float acc[8];
#pragma unroll
        for (int j = 0; j < 8; ++j) acc[j] = F.conv_b[ch + j];
#pragma unroll
        for (int k = 0; k < 5; ++k) { const int tt = t + k - 2;
            if (tt >= 0 && tt < len) { const v4u w = *(const v4u*)(F.P + (size_t)(row + k - 2) * LDP0 + 2560 + ch); const float* cw = F.conv_w + k * 1536 + ch;
                acc[0] += cw[0] * bflo(w.x); acc[1] += cw[1] * bfhi(w.x); acc[2] += cw[2] * bflo(w.y); acc[3] += cw[3] * bfhi(w.y);
                acc[4] += cw[4] * bflo(w.z); acc[5] += cw[5] * bfhi(w.z); acc[6] += cw[6] * bflo(w.w); acc[7] += cw[7] * bfhi(w.w); } }
        v4u o; o.x = pk2(silu_f(acc[0]), silu_f(acc[1])); o.y = pk2(silu_f(acc[2]), silu_f(acc[3])); o.z = pk2(silu_f(acc[4]), silu_f(acc[5])); o.w = pk2(silu_f(acc[6]), silu_f(acc[7]));
        *(v4u*)(F.XBC + (size_t)row * 1536 + ch) = o;
    }
}

__device__ __forceinline__ int scan_row(int b, int d, int s) {
    if (s < 256) return TL + b * 256 + (d ? 255 - s : s);
    const int t = s - 256; return b * 2048 + (d ? 2047 - t : t);
}
__device__ __forceinline__ void ph_scan0(const Frame& F) {
    LAS float* xs = (LAS float*)F.lds;
    LAS float* Bs = xs + 32 * 64;
    LAS float* Cs = Bs + 32 * 128;
    LAS float* dts = Cs + 32 * 128;
    LAS float* decs = dts + 32;
    LAS float* ybuf = decs + 32;
    const int p = F.tid >> 3, ng = F.tid & 7;
    for (int u = F.vcu; u < 256; u += F.G) {
        const int d = u & 1, h = (u >> 1) & 15, b = u >> 5, g = h >> 3;
        const float dtb = F.dt_bias[d * 16 + h], Acoef = -expf(F.a_log[d * 16 + h]);
        float hst[16];
#pragma unroll
        for (int j = 0; j < 16; ++j) hst[j] = 0.f;
        for (int ck = 0; ck < 72; ++ck) {
            __syncthreads();
            for (int idx = F.tid; idx < 32 * 320; idx += 512) { const int i = idx / 320, c = idx % 320; const int row = scan_row(b, d, ck * 32 + i);
                const int col = c < 64 ? h * 64 + c : (c < 192 ? 1024 + g * 128 + (c - 64) : 1280 + g * 128 + (c - 192));
                const float val = bf2f(F.XBC[(size_t)row * 1536 + col]);
                if (c < 64) xs[i * 64 + c] = val; else if (c < 192) Bs[i * 128 + (c - 64)] = val; else Cs[i * 128 + (c - 192)] = val; }
            if (F.tid < 32) { const int row = scan_row(b, d, ck * 32 + F.tid); const float raw = bf2f(F.P[(size_t)row * LDP0 + 4096 + d * 16 + h]) + dtb;
                const float dt = raw > 20.f ? raw : log1pf(__expf(raw)); dts[F.tid] = dt; decs[F.tid] = __expf(dt * Acoef); }
            __syncthreads();
            for (int i = 0; i < 32; ++i) {
                const float dt = dts[i], dec = decs[i], xv = xs[i * 64 + p] * dt;
                float y = 0.f;
#pragma unroll
                for (int j4 = 0; j4 < 4; ++j4) { const f32x4 bv = *(const LAS f32x4*)(Bs + i * 128 + 16 * ng + 4 * j4), cv = *(const LAS f32x4*)(Cs + i * 128 + 16 * ng + 4 * j4);
#pragma unroll
                    for (int jj = 0; jj < 4; ++jj) { hst[4 * j4 + jj] = hst[4 * j4 + jj] * dec + xv * bv[jj]; y += hst[4 * j4 + jj] * cv[jj]; } }
                y += __shfl_xor(y, 1); y += __shfl_xor(y, 2); y += __shfl_xor(y, 4);
                if (ng == 0) ybuf[i * 64 + p] = y;
            }
            __syncthreads();
            bf16* Y = d ? F.YB : F.YF;
            for (int idx = F.tid; idx < 2048; idx += 512) { const int i = idx >> 6, pp = idx & 63; const int row = scan_row(b, d, ck * 32 + i);
                Y[(size_t)row * 1024 + h * 64 + pp] = (bf16)f2bf(ybuf[i * 64 + pp]); }
        }
    }
}

__device__ __forceinline__ void ph_ssmout(const Frame& F) {
    const int gw = F.vcu * NWAVES + F.wave, NGW = F.G * NWAVES;
    for (int row = gw; row < TT; row += NGW) {
#pragma unroll
        for (int grp = 0; grp < 2; ++grp) {
            const int ch = grp * 512 + F.lane * 8;
            const v4u yf = *(const v4u*)(F.YF + (size_t)row * 1024 + ch), yb = *(const v4u*)(F.YB + (size_t)row * 1024 + ch);
            const v4u xv = *(const v4u*)(F.XBC + (size_t)row * 1536 + ch), zv = *(const v4u*)(F.P + (size_t)row * LDP0 + 1536 + ch);
            const float dsk = F.ssm_d[ch >> 6];
            float yz[8];
            const unsigned yfw[4] = {yf.x, yf.y, yf.z, yf.w}, ybw[4] = {yb.x, yb.y, yb.z, yb.w}, xw[4] = {xv.x, xv.y, xv.z, xv.w}, zw[4] = {zv.x, zv.y, zv.z, zv.w};
            float ss = 0.f;
#pragma unroll
            for (int j = 0; j < 4; ++j) {
                const float y0 = bflo(yfw[j]) + bflo(ybw[j]) + bflo(xw[j]) * dsk, y1 = bfhi(yfw[j]) + bfhi(ybw[j]) + bfhi(xw[j]) * dsk;
                yz[2 * j] = y0 * silu_f(bflo(zw[j])); yz[2 * j + 1] = y1 * silu_f(bfhi(zw[j]));
                ss += yz[2 * j] * yz[2 * j] + yz[2 * j + 1] * yz[2 * j + 1]; }
            const float rstd = 1.0f / sqrtf(wave_sum(ss) * (1.f / 512.f) + EPS);
            const f32x4 g0 = *(const f32x4*)(F.ssm_norm_g + ch), g1 = *(const f32x4*)(F.ssm_norm_g + ch + 4);
            v4u o; o.x = pk2(yz[0] * rstd * g0.x, yz[1] * rstd * g0.y); o.y = pk2(yz[2] * rstd * g0.z, yz[3] * rstd * g0.w);
            o.z = pk2(yz[4] * rstd * g1.x, yz[5] * rstd * g1.y); o.w = pk2(yz[6] * rstd * g1.z, yz[7] * rstd * g1.w);
            *(v4u*)(F.YA + (size_t)row * 1536 + 512 + ch) = o;
        }
    }
}

__device__ __forceinline__ void ph_rope(const Frame& F) {
    const int gw = F.vcu * NWAVES + F.wave, NGW = F.G * NWAVES;
    for (int row = gw; row < TL; row += NGW) {
        const int t = row & 2047; bf16* pr = F.P + (size_t)row * LDP1;
        for (int i = F.lane; i < 26 * 32; i += 64) {
            const int hb = i >> 5, f = i & 31;
            const int col = hb < 10 ? hb * 64 : 768 + (hb - 10) * 64;
            const float cs = F.ROPE[(t * 32 + f) * 2], sn = F.ROPE[(t * 32 + f) * 2 + 1];
            const float x1 = bf2f(pr[col + f]), x2 = bf2f(pr[col + 32 + f]);
            pr[col + f] = (bf16)f2bf(x1 * cs - x2 * sn); pr[col + 32 + f] = (bf16)f2bf(x2 * cs + x1 * sn);
        }
    }
}

__device__ __forceinline__ void ph_swa(const Frame& F) {
    const int gw = F.vcu * NWAVES + F.wave, NGW = F.G * NWAVES;
    const bf16* P = F.P;
    for (int u = gw; u < 2048; u += NGW) {
        const int qb = u & 31, h = (u >> 5) & 7, b = u >> 8, kvh = h >> 2;
        const int t = qb * 64 + F.lane; const size_t qrow = (size_t)b * 2048 + t;
        float q[64], o[64]; float m = -INFINITY, l = 0.f;
#pragma unroll
        for (int d = 0; d < 64; ++d) o[d] = 0.f;
        LOADQ64(q, P + qrow * LDP1 + h * 64, 0.125f);
        const int jlo = max(qb * 64 - 128, 0), jhi = min(qb * 64 + 63 + 128, 2047);
        for (int j = jlo; j <= jhi; ++j) {
            const int dj = t - j;
            if (dj <= 128 && dj >= -128) {
                const bf16* kp = P + ((size_t)b * 2048 + j) * LDP1 + 512 + kvh * 64;
                float s; DOT64(s, q, kp);
                ONLINE_UPD(s, m, l, o, kp + 128);
            }
        }
        for (int sc = 0; sc < 256; ++sc) {
            const bf16* kp = P + ((size_t)TL + b * 256 + sc) * LDP1 + 512 + kvh * 64;
            float s; DOT64(s, q, kp);
            ONLINE_UPD(s, m, l, o, kp + 128);
        }
        { const float sk = F.swa_sink[h]; if (sk > m) { const float cr = __expf(m - sk); l *= cr;
#pragma unroll
              for (int d = 0; d < 64; ++d) o[d] *= cr;
              m = sk; }
          l += __expf(sk - m); }
        const float inv = 1.f / l;
        STORE_O64(F.YA + qrow * 1536 + h * 64, o, inv);
    }
}

__device__ __forceinline__ void ph_retscan(const Frame& F) {
    LAS float* vs = (LAS float*)F.lds;
    LAS float* ks = vs + 32 * 64;
    LAS float* qs = ks + 32 * 64;
    LAS float* ybuf = qs + 32 * 64;
    const int p = F.tid >> 3, ng = F.tid & 7;
    for (int u = F.vcu; u < 256; u += F.G) {
        const int ph = u & 1, d = (u >> 1) & 1, h = (u >> 2) & 7, b = u >> 5;
        const float gamma = 1.f - expf(F.ret_log_decay[d * 8 + h]);
        float hst[8];
#pragma unroll
        for (int j = 0; j < 8; ++j) hst[j] = 0.f;
        for (int ck = 0; ck < 72; ++ck) {
            __syncthreads();
            for (int idx = F.tid; idx < 32 * 192; idx += 512) { const int i = idx / 192, c = idx % 192; const int row = scan_row(b, d, ck * 32 + i);
                const bf16* pr = F.P + (size_t)row * LDP1;
                if (c < 64) vs[i * 64 + c] = bf2f(pr[1792 + h * 128 + ph * 64 + c]);
                else if (c < 128) ks[i * 64 + (c - 64)] = 0.125f * bf2f(pr[1280 + h * 64 + (c - 64)]);
                else qs[i * 64 + (c - 128)] = bf2f(pr[768 + h * 64 + (c - 128)]); }
            __syncthreads();
            for (int i = 0; i < 32; ++i) {
                const float vv = vs[i * 64 + p];
                float y = 0.f;
#pragma unroll
                for (int j4 = 0; j4 < 2; ++j4) { const f32x4 kv = *(const LAS f32x4*)(ks + i * 64 + 8 * ng + 4 * j4), qv = *(const LAS f32x4*)(qs + i * 64 + 8 * ng + 4 * j4);
#pragma unroll
                    for (int jj = 0; jj < 4; ++jj) { hst[4 * j4 + jj] = hst[4 * j4 + jj] * gamma + vv * kv[jj]; y += hst[4 * j4 + jj] * qv[jj]; } }
                y += __shfl_xor(y, 1); y += __shfl_xor(y, 2); y += __shfl_xor(y, 4);
                if (ng == 0) ybuf[i * 64 + p] = y;
            }
            __syncthreads();
            if (ck >= 8) { bf16* Y = d ? F.YB : F.YF;
                for (int idx = F.tid; idx < 2048; idx += 512) { const int i = idx >> 6, pp = idx & 63; const int row = scan_row(b, d, ck * 32 + i);
                    Y[(size_t)row * 1024 + h * 128 + ph * 64 + pp] = (bf16)f2bf(ybuf[i * 64 + pp]); } }
        }
    }
}

__device__ __forceinline__ void ph_retout(const Frame& F) {
    const int gw = F.vcu * NWAVES + F.wave, NGW = F.G * NWAVES;
    for (int row = gw; row < TL; row += NGW) {
#pragma unroll
        for (int half = 0; half < 2; ++half) {
            const int ch = half * 512 + F.lane * 8;
            const v4u yf = *(const v4u*)(F.YF + (size_t)row * 1024 + ch), yb = *(const v4u*)(F.YB + (size_t)row * 1024 + ch), gv = *(const v4u*)(F.P + (size_t)row * LDP1 + 2816 + ch);
            const unsigned yfw[4] = {yf.x, yf.y, yf.z, yf.w}, ybw[4] = {yb.x, yb.y, yb.z, yb.w}, gw4[4] = {gv.x, gv.y, gv.z, gv.w};
            float y[8]; float s = 0.f;
#pragma unroll
            for (int j = 0; j < 4; ++j) { y[2 * j] = bflo(yfw[j]) + bflo(ybw[j]); y[2 * j + 1] = bfhi(yfw[j]) + bfhi(ybw[j]); s += y[2 * j] + y[2 * j + 1]; }
            s += __shfl_xor(s, 1); s += __shfl_xor(s, 2); s += __shfl_xor(s, 4); s += __shfl_xor(s, 8);
            const float mu = s * (1.f / 128.f); float q = 0.f;
#pragma unroll
            for (int j = 0; j < 8; ++j) { y[j] -= mu; q += y[j] * y[j]; }
            q += __shfl_xor(q, 1); q += __shfl_xor(q, 2); q += __shfl_xor(q, 4); q += __shfl_xor(q, 8);
            const float rstd = 1.0f / sqrtf(q * (1.f / 128.f) + EPS);
            float ov[8];
#pragma unroll
            for (int j = 0; j < 8; ++j) { const float gg = (j & 1) ? bfhi(gw4[j >> 1]) : bflo(gw4[j >> 1]); ov[j] = silu_f(gg) * (y[j] * rstd * F.ret_gn_g[ch + j] + F.ret_gn_b[ch + j]); }
            v4u o; o.x = pk2(ov[0], ov[1]); o.y = pk2(ov[2], ov[3]); o.z = pk2(ov[4], ov[5]); o.w = pk2(ov[6], ov[7]);
            *(v4u*)(F.YA + (size_t)row * 1536 + 512 + ch) = o;
        }
    }
}

__device__ __forceinline__ void ph_final(const Frame& F) {
    const int gw = F.vcu * NWAVES + F.wave, NGW = F.G * NWAVES;
    for (int row = gw; row < TL; row += NGW) {
        const f32x4* xr = (const f32x4*)(F.X + (size_t)row * 1024) + F.lane;
        f32x4 v[4]; float s = 0.f;
#pragma unroll
        for (int j = 0; j < 4; ++j) { v[j] = xr[64 * j]; s += (v[j].x * v[j].x + v[j].y * v[j].y) + (v[j].z * v[j].z + v[j].w * v[j].w); }
        const float rstd = 1.0f / sqrtf(wave_sum(s) * (1.f / 1024.f) + EPS);
        f32x4* o = (f32x4*)(F.out + (size_t)row * 1024) + F.lane;
#pragma unroll
        for (int j = 0; j < 4; ++j) o[64 * j] = v[j] * rstd * ((const f32x4*)F.final_g)[F.lane + 64 * j];
    }
}

enum { PH_CVT = 0, PH_NORM0, PH_IN0, PH_MIX0, PH_SCAN0, PH_SSMOUT, PH_OUT0, PH_NORM1, PH_F13, PH_F2, PH_NORM2, PH_IN1, PH_ROPE, PH_MIX1, PH_RETOUT, PH_OUT1, PH_NORM3, PH_MOE0,
       PH_FINAL = PH_MOE0 + 16, NPHASES };

struct Args { const float* in[31]; float* out; unsigned char* ws; int ph_lo, ph_hi; };

__global__ void __launch_bounds__(NWAVES * 64, 2) fwd(Args args) {
    extern __shared__ __attribute__((aligned(16))) unsigned char lds_raw[];
    Frame F;
    F.lds = (LAS unsigned char*)lds_raw;
    F.tid = threadIdx.x; F.lane = F.tid & 63; F.wave = __builtin_amdgcn_readfirstlane(F.tid >> 6);
    F.G = gridDim.x; { const int bx = blockIdx.x; F.vcu = (F.G % 8 == 0) ? (bx % 8) * (F.G / 8) + bx / 8 : bx; }
    F.x = args.in[0]; F.c = args.in[1]; F.ctx = args.in[2]; F.c_ctx = args.in[3]; F.ada_w = args.in[4]; F.ada_b = args.in[5]; F.norm_attn_g = args.in[6]; F.norm_ffn_g = args.in[7];
    F.ev_w_in = args.in[8]; F.ev_w_out = args.in[9]; F.na_rpb = args.in[10]; F.conv_w = args.in[11]; F.conv_b = args.in[12]; F.dt_bias = args.in[13]; F.a_log = args.in[14]; F.ssm_d = args.in[15];
    F.ssm_norm_g = args.in[16]; F.ffn_w1 = args.in[17]; F.ffn_w3 = args.in[18]; F.ffn_w2 = args.in[19]; F.od_w_in = args.in[20]; F.od_w_out = args.in[21]; F.swa_sink = args.in[22];
    F.ret_log_decay = args.in[23]; F.ret_gn_g = args.in[24]; F.ret_gn_b = args.in[25]; F.moe_router = args.in[26]; F.moe_w1 = args.in[27]; F.moe_w3 = args.in[28]; F.moe_w2 = args.in[29]; F.final_g = args.in[30];
    F.out = args.out;
    unsigned char* ws = args.ws;
    F.MOD = (float*)(ws + WS_MOD); F.GATE = (float*)(ws + WS_GATE); F.ROPE = (float*)(ws + WS_ROPE); F.X = (float*)(ws + WS_X);
    F.WIN0 = (bf16*)(ws + WS_WIN0); F.WOUT0 = (bf16*)(ws + WS_WOUT0); F.WF13 = (bf16*)(ws + WS_WF13); F.WF2 = (bf16*)(ws + WS_WF2); F.WIN1 = (bf16*)(ws + WS_WIN1); F.WOUT1 = (bf16*)(ws + WS_WOUT1);
    F.WM13 = (bf16*)(ws + WS_WM13); F.WM2 = (bf16*)(ws + WS_WM2); F.H = (bf16*)(ws + WS_H); F.P = (bf16*)(ws + WS_P); F.YA = (bf16*)(ws + WS_YA); F.XBC = (bf16*)(ws + WS_XBC);
    F.YF = (bf16*)(ws + WS_YF); F.YB = (bf16*)(ws + WS_YB); F.Gh = (bf16*)(ws + WS_G); F.MG = (bf16*)(ws + WS_MG);

    for (int u = F.tid; u < (LDS_BYTES - LDSCTL_OFF) / 4; u += NWAVES * 64) ((LAS unsigned*)(F.lds + LDSCTL_OFF))[u] = 0u;
    __syncthreads();
    volatile LAS unsigned* MISC = (volatile LAS unsigned*)(F.lds + MISC_OFF);
    XcdBarrier bar; bar.bar = (unsigned*)(ws + WS_CTL) + CW_BAR; bar.x = 0; bar.st = nullptr;
    const int lo = args.ph_lo, hi = args.ph_hi;
    if (hi - lo > 1) bar = xcd_barrier_post((unsigned*)(ws + WS_CTL) + CW_BAR, MISC + 8);
#define IN(k) (lo <= (k) && (k) < hi)
#define SEAM(k) do { if (IN(k) && IN((k) + 1)) xcd_barrier(bar); else __syncthreads(); } while (0)

    if (IN(PH_CVT)) { ph_cvt(F); SEAM(PH_CVT); }
    if (IN(PH_NORM0)) { ph_norm<0, false>(F, 0, 0, TT); SEAM(PH_NORM0); }
    if (IN(PH_IN0)) { EpiStore E{F.P, LDP0}; gemm_pg8(F, F.H, F.WIN0, TT, LDP0, 1024, E); SEAM(PH_IN0); }
    if (IN(PH_MIX0)) { ph_attn0(F); ph_conv(F); SEAM(PH_MIX0); }
    if (IN(PH_SCAN0)) { ph_scan0(F); SEAM(PH_SCAN0); }
    if (IN(PH_SSMOUT)) { ph_ssmout(F); SEAM(PH_SSMOUT); }
    if (IN(PH_OUT0)) { EpiResid E{F.x, F.ctx, F.X, F.MOD + 2 * 1024, nullptr, 0, 0}; gemm_pg8(F, F.YA, F.WOUT0, TT, 1024, 1536, E); SEAM(PH_OUT0); }
    if (IN(PH_NORM1)) { ph_norm<1, false>(F, 0, 1, TT); SEAM(PH_NORM1); }
    if (IN(PH_F13)) { EpiSwiglu E{F.Gh, DFF}; gemm_pg8(F, F.H, F.WF13, TT, 2 * DFF, 1024, E); SEAM(PH_F13); }
    if (IN(PH_F2)) { EpiResid E{F.X, F.X + (size_t)TL * 1024, F.X, F.MOD + 5 * 1024, nullptr, 0, 0}; gemm_pg8(F, F.Gh, F.WF2, TT, 1024, DFF, E); SEAM(PH_F2); }
    if (IN(PH_NORM2)) { ph_norm<1, false>(F, 1, 0, TT); SEAM(PH_NORM2); }
    if (IN(PH_IN1)) { EpiStore E{F.P, LDP1}; gemm_pg8(F, F.H, F.WIN1, TT, LDP1, 1024, E); SEAM(PH_IN1); }
    if (IN(PH_ROPE)) { ph_rope(F); SEAM(PH_ROPE); }
    if (IN(PH_MIX1)) { ph_retscan(F); ph_swa(F); SEAM(PH_MIX1); }
    if (IN(PH_RETOUT)) { ph_retout(F); SEAM(PH_RETOUT); }
    if (IN(PH_OUT1)) { EpiResid E{F.X, F.X + (size_t)TL * 1024, F.X, F.MOD + 9 * 6144 + 2 * 1024, nullptr, 0, 0}; gemm_pg8(F, F.YA, F.WOUT1, TL, 1024, 1536, E); SEAM(PH_OUT1); }
    if (IN(PH_NORM3)) { ph_norm<1, true>(F, 1, 1, TL); ph_cvt_moe(F); SEAM(PH_NORM3); }
    for (int e = 0; e < NEXP; ++e) {
        if (IN(PH_MOE0 + 2 * e)) { EpiSwiglu E{F.MG, DFE}; gemm_pg8(F, F.H, F.WM13 + (size_t)e * 7168 * 1024, TL, 2 * DFE, 1024, E); SEAM(PH_MOE0 + 2 * e); }
        if (IN(PH_MOE0 + 2 * e + 1)) { EpiResid E{F.X, F.X + (size_t)TL * 1024, F.X, F.MOD + 9 * 6144 + 5 * 1024, F.GATE, 8, e}; gemm_pg8(F, F.MG, F.WM2 + (size_t)e * 1024 * DFE, TL, 1024, DFE, E); SEAM(PH_MOE0 + 2 * e + 1); }
    }
    if (IN(PH_FINAL)) { ph_final(F); }
#undef IN
#undef SEAM
}

extern "C" void kernel_launch(void* const* d_in, const int* in_sizes, int n_in, void* d_out, int out_size, void* d_ws, size_t ws_size, hipStream_t stream) {
    static int grid = 0;
    if (grid == 0) {
        if (n_in != 31 || out_size != TL * DM || ws_size < WS_END) { fprintf(stderr, "kernel_launch: unexpected shapes (n_in %d out %d ws %zu need %zu)\n", n_in, out_size, ws_size, (size_t)WS_END); grid = -1; return; }
        int dev = 0, cus = 0, per_cu = 0;
        if (hipGetDevice(&dev) != hipSuccess || hipDeviceGetAttribute(&cus, hipDeviceAttributeMultiprocessorCount, dev) != hipSuccess) { grid = -1; return; }
        if (hipFuncSetAttribute((const void*)fwd, hipFuncAttributeMaxDynamicSharedMemorySize, LDS_BYTES) != hipSuccess) { grid = -1; return; }
        if (hipOccupancyMaxActiveBlocksPerMultiprocessor(&per_cu, (const void*)fwd, NWAVES * 64, LDS_BYTES) != hipSuccess || per_cu < 1) fprintf(stderr, "kernel_launch: occupancy query reports %d\n", per_cu);
        (void)hipGetLastError();
        grid = cus;
    }
    if (grid < 0) return;
    if (hipMemsetAsync((char*)d_ws + WS_CTL, 0, CTL_ZERO_BYTES, stream) != hipSuccess) return;
    Args a{};
    for (int i = 0; i < 31; ++i) a.in[i] = (const float*)d_in[i];
    a.out = (float*)d_out; a.ws = (unsigned char*)d_ws;
#if MK_ONE_LAUNCH
    a.ph_lo = 0; a.ph_hi = NPHASES;
    hipLaunchKernelGGL(fwd, dim3(grid), dim3(NWAVES * 64), LDS_BYTES, stream, a);
#else
    for (int ph = 0; ph < NPHASES; ++ph) { a.ph_lo = ph; a.ph_hi = ph + 1; hipLaunchKernelGGL(fwd, dim3(grid), dim3(NWAVES * 64), LDS_BYTES, stream, a); }
#endif
}
```

```cpp
#include <hip/hip_runtime.h>
#include <cstdio>
#include <cstdint>

#ifndef MK_ONE_LAUNCH
#define MK_ONE_LAUNCH 1
#endif

#define LAS __attribute__((address_space(3)))
typedef unsigned short bf16;
typedef short bf16x8 __attribute__((ext_vector_type(8)));
typedef float f32x4 __attribute__((ext_vector_type(4)));
typedef unsigned v4u __attribute__((ext_vector_type(4)));
typedef unsigned v2u __attribute__((ext_vector_type(2)));

constexpr int DM = 1024, NB = 8, SEQ = 2048, CTXL = 256;
constexpr int TL = NB * SEQ, TC = NB * CTXL, TT = TL + TC;
constexpr int LDP0 = 4352;
constexpr int LDP1 = 3840;
constexpr int DFF = 2816, DFE = 3584, NEXP = 8;
constexpr float EPS = 1e-6f;

constexpr size_t MiB = 1u << 20;
constexpr size_t WS_CTL = 0, CTL_ZERO_BYTES = 1 * MiB;
constexpr size_t WS_MOD = 1 * MiB;
constexpr size_t WS_GATE = 2 * MiB;
constexpr size_t WS_ROPE = 3 * MiB;
constexpr size_t WS_WIN0 = 4 * MiB;
constexpr size_t WS_WOUT0 = 13 * MiB;
constexpr size_t WS_WF13 = 16 * MiB;
constexpr size_t WS_WF2 = 27 * MiB;
constexpr size_t WS_WIN1 = 33 * MiB;
constexpr size_t WS_WOUT1 = 41 * MiB;
constexpr size_t WS_X = 44 * MiB;
constexpr size_t WS_H = 116 * MiB;
constexpr size_t WS_R = 152 * MiB;
constexpr size_t WS_P = WS_R;
constexpr size_t WS_YA = WS_R + 153 * MiB;
constexpr size_t WS_XBC = WS_R + 207 * MiB;
constexpr size_t WS_YF = WS_R + 261 * MiB;
constexpr size_t WS_YB = WS_R + 297 * MiB;
constexpr size_t WS_G = WS_R;
constexpr size_t WS_HP = WS_R;
constexpr size_t WS_WM13 = WS_R + 68 * MiB;
constexpr size_t WS_WM2 = WS_R + 180 * MiB;
constexpr size_t WS_MG = WS_R + 236 * MiB;
constexpr size_t WS_END = WS_R + 362 * MiB;
constexpr size_t WS_TOPK = WS_GATE + 128 * 1024, WS_SLOT = WS_GATE + 192 * 1024, WS_CNT = WS_GATE + 320 * 1024, WS_TILEE = WS_GATE + 384 * 1024, WS_MMETA = WS_GATE + 385 * 1024;
static_assert(WS_P + (size_t)TT * LDP0 * 2 <= WS_YA && WS_YA + (size_t)TT * 1536 * 2 <= WS_XBC && WS_XBC + (size_t)TT * 1536 * 2 <= WS_YF && WS_YF + (size_t)TT * 1024 * 2 <= WS_YB && WS_YB + (size_t)TT * 1024 * 2 <= WS_END, "ws map");
static_assert(WS_HP + (size_t)34816 * 1024 * 2 <= WS_WM13 && WS_WM13 + (size_t)8 * 7168 * 1024 * 2 <= WS_WM2 && WS_WM2 + (size_t)8 * 1024 * 3584 * 2 <= WS_MG && WS_MG + (size_t)72 * 256 * 3584 * 2 <= WS_END, "ws map moe");
static_assert(WS_X + (size_t)TT * 1024 * 4 <= WS_H && WS_H + (size_t)TT * 1024 * 2 <= WS_R, "ws map 2");
constexpr int CW_BAR = 4096;

constexpr int RING_BYTES = 131072, LDSCTL_OFF = RING_BYTES, MISC_OFF = LDSCTL_OFF + 320, LDS_BYTES = 147456;
constexpr int NWAVES = 8;

#define LDS_WAIT() asm volatile("s_waitcnt lgkmcnt(0)" ::: "memory")
__device__ __forceinline__ unsigned f2bf(float f) { unsigned u = __builtin_bit_cast(unsigned, f); return (u + 0x7fffu + ((u >> 16) & 1u)) >> 16; }
__device__ __forceinline__ unsigned pk2(float lo, float hi) { return f2bf(lo) | (f2bf(hi) << 16); }
__device__ __forceinline__ float bf2f(unsigned short b) { return __builtin_bit_cast(float, ((unsigned)b) << 16); }
__device__ __forceinline__ float bflo(unsigned w) { return __builtin_bit_cast(float, w << 16); }
__device__ __forceinline__ float bfhi(unsigned w) { return __builtin_bit_cast(float, w & 0xffff0000u); }
__device__ __forceinline__ float silu_f(float x) { return x / (1.f + __expf(-x)); }
__device__ __forceinline__ float wave_sum(float v) {
#pragma unroll
    for (int o = 1; o < 64; o <<= 1) v += __shfl_xor(v, o);
    return v;
}
__host__ __device__ __forceinline__ int perm32(int rho) { const int n = rho >> 4, i = rho & 15; return 8 * (i >> 2) + 4 * n + (i & 3); }

#define XB_TMO      128
#define XB_XCNT(j)  (256  + 64 * (j))
#define XB_XSUB(j)  (1280 + 64 * (j))
#define XB_XGEN(j)  (2304 + 64 * (j))
#define XB_TOP      3328
#define XB_TOPGEN   3392
#define XCD_BAR_WORDS 3456
#define XB_SPIN_CAP (1u << 18)
__device__ __forceinline__ unsigned xb_ld(unsigned* p)              { return __hip_atomic_load(p, __ATOMIC_RELAXED, __HIP_MEMORY_SCOPE_AGENT); }
__device__ __forceinline__ unsigned xb_add(unsigned* p, unsigned v) { return __hip_atomic_fetch_add(p, v, __ATOMIC_RELAXED, __HIP_MEMORY_SCOPE_AGENT); }
__device__ __forceinline__ unsigned xb_xcc_id() { return (unsigned)__builtin_amdgcn_s_getreg((3 << 11) | 20) & 0xFu; }
#define XB_SPIN(cond, bar) do { unsigned _sp = 0; while (cond) { __builtin_amdgcn_s_sleep(1); \
    if ((++_sp & 255u) == 0u) { if (xb_ld(&(bar)[XB_TMO])) break; if (_sp > XB_SPIN_CAP) { atomicAdd(&(bar)[XB_TMO], 1u); break; } } } } while (0)
struct XcdBarrier { unsigned* bar; unsigned x; volatile LAS unsigned* st; };
__device__ __forceinline__ XcdBarrier xcd_barrier_post(unsigned* bar, volatile LAS unsigned* st) {
    XcdBarrier b; b.bar = bar; b.x = xb_xcc_id(); b.st = st;
    if (threadIdx.x == 0) (void)xb_add(&bar[XB_XCNT(b.x)], 1u);
    return b;
}
__device__ __forceinline__ void xcd_barrier_complete(unsigned* bar, unsigned x, unsigned& nloc, unsigned& nx) {
    const unsigned G = gridDim.x * gridDim.y * gridDim.z;
    unsigned sum, cnt, mine, sp = 0u;
    for (;;) {
        sum = 0u; cnt = 0u; mine = 0u;
#pragma unroll
        for (unsigned j = 0; j < 16; ++j) { const unsigned c = xb_ld(&bar[XB_XCNT(j)]); sum += c; cnt += (c > 0u) ? 1u : 0u; mine = (j == x) ? c : mine; }
        if (sum == G) break;
        __builtin_amdgcn_s_sleep(1);
        if ((++sp & 255u) == 0u) { if (xb_ld(&bar[XB_TMO])) break; if (sp > XB_SPIN_CAP) { atomicAdd(&bar[XB_TMO], 1u); break; } }
    }
    nloc = mine > 0u ? mine : 1u; nx = cnt > 0u ? cnt : 1u;
}
__device__ __forceinline__ void xcd_barrier(const XcdBarrier& b) {
    asm volatile("s_waitcnt vmcnt(0)" ::: "memory");
    __syncthreads();
    if (threadIdx.x == 0) {
        unsigned* bar = b.bar;
        __builtin_amdgcn_s_waitcnt(0);
        unsigned nloc = b.st[0], nx = b.st[1];
        if (nloc == 0u) { xcd_barrier_complete(bar, b.x, nloc, nx); b.st[0] = nloc; b.st[1] = nx; }
        const unsigned old = xb_add(&bar[XB_XSUB(b.x)], 1u);
        const unsigned gen = old / nloc;
        if (old + 1u == (gen + 1u) * nloc) {
            __builtin_amdgcn_fence(__ATOMIC_RELEASE, "agent");
            asm volatile("s_waitcnt vmcnt(0)" ::: "memory");
            const unsigned og = xb_add(&bar[XB_TOP], 1u);
            const unsigned tg = og / nx;
            if (og + 1u == (tg + 1u) * nx) xb_add(&bar[XB_TOPGEN], 1u);
            else XB_SPIN(xb_ld(&bar[XB_TOPGEN]) == tg, bar);
            __builtin_amdgcn_fence(__ATOMIC_ACQUIRE, "agent");
            xb_add(&bar[XB_XGEN(b.x)], 1u);
            asm volatile("s_waitcnt vmcnt(0)" ::: "memory");
        } else {
            XB_SPIN(xb_ld(&bar[XB_XGEN(b.x)]) == gen, bar);
            __builtin_amdgcn_fence(__ATOMIC_ACQUIRE, "agent");
            asm volatile("s_waitcnt vmcnt(0)" ::: "memory");
        }
    }
    __syncthreads();
}

namespace pg8 {
#define PG8_LAS __attribute__((address_space(3)))
typedef unsigned short bf16_t;
typedef short bf16x8 __attribute__((ext_vector_type(8)));
typedef float f32x4 __attribute__((ext_vector_type(4)));
typedef unsigned u32x4 __attribute__((ext_vector_type(4)));
constexpr int BM = 256, BK = 64, HALF = 128, HTB = HALF * BK * 2  , STAGE_BYTES = 8 * HTB, NXCD = 8, WGM = 8;

__host__ __device__ __forceinline__ int lds_byte(int r, int c) { const int st = (r >> 4) * 2 + (c >> 5), rr = r & 15, cc = c & 31, ob = rr * 64 + cc * 2; return st * 1024 + (ob ^ (((ob >> 9) & 1) << 5)); }
__host__ __device__ __forceinline__ void stage_rc(int b, int& R, int& C) { const int st = b / 1024, sb = b % 1024, swz = sb ^ (((sb >> 9) & 1) << 5); R = (st >> 1) * 16 + swz / 64; C = (st & 1) * 32 + (swz % 64) / 2; }
__host__ __device__ __forceinline__ int perm32(int rho) { const int n = rho >> 4, i = rho & 15; return 8 * (i >> 2) + 4 * n + (i & 3); }

struct Unit { int pm, pn; };
struct Gemm { const bf16_t* A; const bf16_t* Bt; int M, N, K; };

struct StaticOrder {
    int nM, nN, nwg, G, c;
    __host__ __device__ void init(int M, int N, int G_, int c_) { nM = M / BM; nN = N / BM; nwg = nM * nN; G = G_; c = c_; }
    __host__ __device__ bool next(int i, Unit& u) const {
        const long L = (long)i * G + c; if (L >= nwg) return false;
        int wgid = (int)L; { const int q = nwg / NXCD, r = nwg % NXCD, xcd = wgid % NXCD, off = wgid / NXCD; wgid = (xcd < r ? xcd * (q + 1) : r * (q + 1) + (xcd - r) * q) + off; }
        const int nig = WGM * nN, gid = wgid / nig, fm = gid * WGM, gsz = (nM - fm) < WGM ? (nM - fm) : WGM;
        u.pm = fm + ((wgid % nig) % gsz); u.pn = (wgid % nig) / gsz; return true;
    }
    __device__ __forceinline__ void a_ready(const Unit&) const {}
    __device__ __forceinline__ void done(const Unit&) const {}
};

__device__ __forceinline__ unsigned cvt_pk_bf16(float lo, float hi) { unsigned r; asm volatile("v_cvt_pk_bf16_f32 %0, %1, %2" : "=v"(r) : "v"(lo), "v"(hi)); return r; }
template <class Epi, class Sched, bool ALIGN_EPI = false, bool SP2 = false>
__device__ __forceinline__ void gemm_phase(PG8_LAS unsigned char* lds, const Gemm g, const Sched& S, const Epi& E) {
    int tid_ = threadIdx.x; asm volatile("" : "+v"(tid_));
    const int tid = tid_, wid = __builtin_amdgcn_readfirstlane(tid >> 6), lane = tid & 63, wr = wid >> 2, wc = wid & 3, fr = lane & 15, fq = lane >> 4;
    const int K = g.K, nt = K / BK;
    unsigned voffA[2], voffB[2];
#pragma unroll
    for (int i = 0; i < 2; ++i) { int R, C; stage_rc(tid * 16 + i * 8192, R, C); const int Rb = Epi::PERM ? ((R & ~31) + perm32(R & 31)) : R;
        voffA[i] = (unsigned)(R * K + C) * 2u; voffB[i] = (unsigned)(Rb * K + C) * 2u; }
    const size_t kstep = (size_t)(BK * 2);
    const size_t hstep = (size_t)HALF * K * 2;
    const size_t tstep = 2 * hstep;
    const unsigned ldsw = (unsigned)wid * 1024u;
    const int aoff = lds_byte(wr * 64 + fr, fq * 8), boff = lds_byte(wc * 32 + fr, fq * 8);
#define PG8_SA(b, h) (((b) * 2 + (h)) * HTB)
#define PG8_SB(b, h) ((4 + (b) * 2 + (h)) * HTB)
#define PG8_STAGE(bufoff, gbase, voff) do { _Pragma("unroll") for (int _i = 0; _i < 2; ++_i) \
        __builtin_amdgcn_global_load_lds((const unsigned*)((const char*)(gbase) + (voff)[_i]), (PG8_LAS unsigned*)(lds + (bufoff) + ldsw + _i * 8192), 16, 0, 0); } while (0)
#define PG8_LDA(dst, b, h) do { _Pragma("unroll") for (int m = 0; m < 4; ++m) _Pragma("unroll") for (int k = 0; k < 2; ++k) dst[m][k] = *(const PG8_LAS bf16x8*)(lds + PG8_SA(b, h) + aoff + m * 2048 + k * 1024); } while (0)
#define PG8_LDB(dst, b, h) do { _Pragma("unroll") for (int n = 0; n < 2; ++n) _Pragma("unroll") for (int k = 0; k < 2; ++k) dst[n][k] = *(const PG8_LAS bf16x8*)(lds + PG8_SB(b, h) + boff + n * 2048 + k * 1024); } while (0)
#define PG8_MMA(ai, bj, At, Bt) do { __builtin_amdgcn_s_setprio(1); _Pragma("unroll") for (int m = 0; m < 4; ++m) _Pragma("unroll") for (int n = 0; n < 2; ++n) _Pragma("unroll") for (int k = 0; k < 2; ++k) \
        acc[ai][bj][m][n] = __builtin_amdgcn_mfma_f32_16x16x32_bf16(Bt[n][k], At[m][k], acc[ai][bj][m][n], 0, 0, 0); __builtin_amdgcn_s_setprio(0); } while (0)
#define PG8_WAIT_V(n) asm volatile("s_waitcnt vmcnt(" #n ")" ::: "memory")
#define PG8_WAIT_L(n) asm volatile("s_waitcnt lgkmcnt(" #n ")" ::: "memory")
#define PG8_BAR __builtin_amdgcn_s_barrier()
#define PG8_SCHED __builtin_amdgcn_sched_barrier(0)
    Unit cur, nxt; int ui = 0;
    if (!S.next(0, cur)) return;
    f32x4 acc[2][2][4][2];
#pragma unroll
    for (int a = 0; a < 2; ++a)
#pragma unroll
        for (int b = 0; b < 2; ++b)
#pragma unroll
            for (int m = 0; m < 4; ++m)
#pragma unroll
                for (int n = 0; n < 2; ++n) acc[a][b][m][n] = (f32x4){0.f, 0.f, 0.f, 0.f};
    bf16x8 At[4][2], B0[2][2], B1[2][2];
    const char* cA = (const char*)g.A + (size_t)cur.pm * tstep; const char* cB = (const char*)g.Bt + (size_t)cur.pn * tstep;
    S.a_ready(cur);
    if constexpr (SP2) {
        PG8_STAGE(PG8_SB(0, 0), cB, voffB); PG8_STAGE(PG8_SB(0, 1), cB + hstep, voffB); PG8_STAGE(PG8_SA(0, 0), cA, voffA); PG8_STAGE(PG8_SA(0, 1), cA + hstep, voffA);
        if (wr == 1) PG8_BAR;
        PG8_WAIT_V(2); PG8_BAR;
        PG8_STAGE(PG8_SB(1, 0), cB + kstep, voffB); PG8_STAGE(PG8_SA(1, 0), cA + kstep, voffA); PG8_STAGE(PG8_SB(1, 1), cB + hstep + kstep, voffB);
        PG8_WAIT_V(6); PG8_BAR;
    } else {
        PG8_STAGE(PG8_SB(0, 0), cB, voffB); PG8_STAGE(PG8_SA(0, 0), cA, voffA); PG8_STAGE(PG8_SB(0, 1), cB + hstep, voffB); PG8_STAGE(PG8_SA(0, 1), cA + hstep, voffA);
        if (wr == 1) PG8_BAR;
        PG8_WAIT_V(4); PG8_BAR;
        PG8_STAGE(PG8_SB(1, 0), cB + kstep, voffB); PG8_STAGE(PG8_SA(1, 0), cA + kstep, voffA); PG8_STAGE(PG8_SB(1, 1), cB + hstep + kstep, voffB);
        PG8_WAIT_V(6); PG8_BAR;
    }
    for (;;) {
        const bool has_next = S.next(ui + 1, nxt);
        const char* nA = has_next ? (const char*)g.A + (size_t)nxt.pm * tstep : cA; const char* nB = has_next ? (const char*)g.Bt + (size_t)nxt.pn * tstep : cB;
        for (int t = 0; t < nt; t += 2) {
            const bool last = (t == nt - 2);
            const char* a1 = cA + (size_t)(t + 1) * kstep;
            const char* a2 = last ? nA : cA + (size_t)(t + 2) * kstep; const char* b2 = last ? nB : cB + (size_t)(t + 2) * kstep;
            const char* a3 = a2 + kstep; const char* b3 = b2 + kstep;
            if (last && has_next) S.a_ready(nxt);
            if constexpr (SP2) {
            PG8_LDB(B0, 0, 0); PG8_LDB(B1, 0, 1); PG8_SCHED; PG8_LDA(At, 0, 0); PG8_STAGE(PG8_SA(1, 1), a1 + hstep, voffA);
            PG8_WAIT_V(8); PG8_WAIT_L(0); PG8_BAR; PG8_MMA(0, 0, At, B0); PG8_MMA(0, 1, At, B1); PG8_BAR; PG8_SCHED;
            PG8_LDA(At, 0, 1); PG8_STAGE(PG8_SB(0, 0), b2, voffB); PG8_STAGE(PG8_SB(0, 1), b2 + hstep, voffB); PG8_STAGE(PG8_SA(0, 0), a2, voffA);
            PG8_WAIT_V(8); PG8_WAIT_L(0); PG8_BAR; PG8_MMA(1, 0, At, B0); PG8_MMA(1, 1, At, B1); PG8_BAR; PG8_SCHED;
            PG8_LDB(B0, 1, 0); PG8_LDB(B1, 1, 1); PG8_SCHED; PG8_LDA(At, 1, 0); PG8_STAGE(PG8_SA(0, 1), a2 + hstep, voffA);
            PG8_WAIT_V(8); PG8_WAIT_L(0); PG8_BAR; PG8_MMA(0, 0, At, B0); PG8_MMA(0, 1, At, B1); PG8_BAR; PG8_SCHED;
            PG8_LDA(At, 1, 1); PG8_STAGE(PG8_SB(1, 0), b3, voffB); PG8_STAGE(PG8_SB(1, 1), b3 + hstep, voffB); PG8_STAGE(PG8_SA(1, 0), a3, voffA);
            PG8_WAIT_V(8); PG8_WAIT_L(0); PG8_BAR; PG8_MMA(1, 0, At, B0); PG8_MMA(1, 1, At, B1); PG8_BAR; PG8_SCHED;
            } else {
            PG8_LDB(B0, 0, 0); PG8_SCHED; PG8_LDA(At, 0, 0); PG8_STAGE(PG8_SA(1, 1), a1 + hstep, voffA);
            PG8_WAIT_L(8); PG8_BAR; PG8_WAIT_L(0); PG8_MMA(0, 0, At, B0); PG8_BAR; PG8_SCHED;
            PG8_LDB(B1, 0, 1); PG8_STAGE(PG8_SB(0, 0), b2, voffB);
            PG8_BAR; PG8_WAIT_L(0); PG8_MMA(0, 1, At, B1); PG8_BAR;
            PG8_LDA(At, 0, 1); PG8_STAGE(PG8_SA(0, 0), a2, voffA);
            PG8_BAR; PG8_WAIT_L(0); PG8_MMA(1, 0, At, B0); PG8_BAR; PG8_SCHED;
            PG8_STAGE(PG8_SB(0, 1), b2 + hstep, voffB);
            PG8_WAIT_V(6); PG8_BAR; PG8_MMA(1, 1, At, B1); PG8_BAR;
            PG8_LDB(B0, 1, 0); PG8_SCHED; PG8_LDA(At, 1, 0); PG8_STAGE(PG8_SA(0, 1), a2 + hstep, voffA);
            PG8_WAIT_L(8); PG8_BAR; PG8_WAIT_L(0); PG8_MMA(0, 0, At, B0); PG8_BAR; PG8_SCHED;
            PG8_LDB(B1, 1, 1); PG8_STAGE(PG8_SB(1, 0), b3, voffB);
            PG8_BAR; PG8_WAIT_L(0); PG8_MMA(0, 1, At, B1); PG8_BAR;
            PG8_LDA(At, 1, 1); PG8_STAGE(PG8_SA(1, 0), a3, voffA);
            PG8_BAR; PG8_WAIT_L(0); PG8_MMA(1, 0, At, B0); PG8_BAR; PG8_SCHED;
            PG8_STAGE(PG8_SB(1, 1), b3 + hstep, voffB);
            PG8_WAIT_V(6); PG8_BAR; PG8_MMA(1, 1, At, B1); PG8_BAR;
            }
        }
        if constexpr (ALIGN_EPI) { if (wr == 0) PG8_BAR; }
        if constexpr (!Epi::AFTER_DRAIN) { E(acc, cur, wr, wc, fr, fq); S.done(cur); }
        if (!has_next) break;
#pragma unroll
        for (int a = 0; a < 2; ++a)
#pragma unroll
            for (int b = 0; b < 2; ++b)
#pragma unroll
                for (int m = 0; m < 4; ++m)
#pragma unroll
                    for (int n = 0; n < 2; ++n) acc[a][b][m][n] = (f32x4){0.f, 0.f, 0.f, 0.f};
        cur = nxt; cA = nA; cB = nB; ++ui;
        if constexpr (ALIGN_EPI) { if (wr == 1) PG8_BAR; }
    }
    PG8_WAIT_V(0);
    if constexpr (!ALIGN_EPI) { if (wr == 0) PG8_BAR; }
    PG8_BAR;
    if constexpr (Epi::AFTER_DRAIN) { E.fused(acc, cur, wr, wc, fr, fq, lds, wid, lane); S.done(cur); }
#undef PG8_SA
#undef PG8_SB
#undef PG8_STAGE
#undef PG8_LDA
#undef PG8_LDB
#undef PG8_MMA
#undef PG8_WAIT_V
#undef PG8_WAIT_L
#undef PG8_BAR
#undef PG8_SCHED
}
}

struct Frame {
    LAS unsigned char* lds;
    int tid, lane, wave, vcu, G;
    const float *x, *c, *ctx, *c_ctx, *ada_w, *ada_b, *norm_attn_g, *norm_ffn_g, *ev_w_in, *ev_w_out, *na_rpb, *conv_w, *conv_b, *dt_bias, *a_log, *ssm_d, *ssm_norm_g,
        *ffn_w1, *ffn_w3, *ffn_w2, *od_w_in, *od_w_out, *swa_sink, *ret_log_decay, *ret_gn_g, *ret_gn_b, *moe_router, *moe_w1, *moe_w3, *moe_w2, *final_g;
    float* out;
    float *MOD, *GATE, *ROPE, *X;
    bf16 *WIN0, *WOUT0, *WF13, *WF2, *WIN1, *WOUT1, *WM13, *WM2, *H, *P, *YA, *XBC, *YF, *YB, *Gh, *MG, *HP;
    int *TOPK, *SLOT, *CNT, *TILEE, *MMETA;
};

__device__ __forceinline__ void tr_item(const float* W, int K, int N, bf16* WT, int ilv, LAS float* scr, int item, int lane) {
    const int nblk = N / 32, kb = item / nblk, nb = item % nblk, k0 = 64 * kb, n0 = 32 * nb;
#pragma unroll 8
    for (int i = 0; i < 32; ++i) { const int kk = 2 * i + (lane >> 5); scr[kk * 33 + (lane & 31)] = W[(size_t)(k0 + kk) * N + n0 + (lane & 31)]; }
    LDS_WAIT(); asm volatile("" ::: "memory");
    const int c = lane & 7;
#pragma unroll
    for (int j = 0; j < 4; ++j) { const int n = (lane >> 3) + 8 * j; const LAS float* s = scr + (8 * c) * 33 + n;
        v4u o; o.x = pk2(s[0 * 33], s[1 * 33]); o.y = pk2(s[2 * 33], s[3 * 33]); o.z = pk2(s[4 * 33], s[5 * 33]); o.w = pk2(s[6 * 33], s[7 * 33]);
        const int nn = n0 + n; const int row = ilv ? (8 * (nn >> 2) + (nn & 3) + (ilv == 2 ? 4 : 0)) : nn;
        *(v4u*)(WT + (size_t)row * K + k0 + 8 * c) = o; }
    LDS_WAIT(); asm volatile("" ::: "memory");
}

__device__ __forceinline__ void ph_cvt(const Frame& F) {
    LAS float* scr = (LAS float*)(F.lds + F.wave * 16384);
    const int gw = F.vcu * NWAVES + F.wave, NGW = F.G * NWAVES;
    constexpr int I_IN0 = 16 * 129, I_OUT = 24 * 32, I_F1 = 16 * 88, I_F2 = 44 * 32, I_IN1 = 16 * 120;
    constexpr int NITEMS = I_IN0 + I_OUT + 2 * I_F1 + I_F2 + I_IN1 + I_OUT;
    for (int it = gw; it < NITEMS; it += NGW) {
        int r = it;
        if (r < I_IN0) { tr_item(F.ev_w_in, 1024, 4128, F.WIN0, 0, scr, r, F.lane); continue; } r -= I_IN0;
        if (r < I_OUT) { tr_item(F.ev_w_out, 1536, 1024, F.WOUT0, 0, scr, r, F.lane); continue; } r -= I_OUT;
        if (r < I_F1) { tr_item(F.ffn_w1, 1024, DFF, F.WF13, 1, scr, r, F.lane); continue; } r -= I_F1;
        if (r < I_F1) { tr_item(F.ffn_w3, 1024, DFF, F.WF13, 2, scr, r, F.lane); continue; } r -= I_F1;
        if (r < I_F2) { tr_item(F.ffn_w2, DFF, 1024, F.WF2, 0, scr, r, F.lane); continue; } r -= I_F2;
        if (r < I_IN1) { tr_item(F.od_w_in, 1024, LDP1, F.WIN1, 0, scr, r, F.lane); continue; } r -= I_IN1;
        tr_item(F.od_w_out, 1536, 1024, F.WOUT1, 0, scr, r, F.lane);
    }
    { const int gt = F.vcu * 512 + F.tid, NGT = F.G * 512; v4u* z = (v4u*)(F.WIN0 + (size_t)4128 * 1024);
      for (int i = gt; i < 224 * 1024 / 8; i += NGT) z[i] = (v4u){0u, 0u, 0u, 0u}; }
    { const int gt = F.vcu * 512 + F.tid, NGT = F.G * 512;
      for (int i = gt; i < 2048 * 32; i += NGT) { const int t = i >> 5, f = i & 31; const float inv = powf(10000.f, -(float)(f & 15) / 16.f);
          const float ang = (float)((f < 16) ? (t >> 6) : (t & 63)) * inv; float sn, cs; sincosf(ang, &sn, &cs); F.ROPE[2 * i] = cs; F.ROPE[2 * i + 1] = sn; } }
    __syncthreads();
    LAS float* sv = (LAS float*)F.lds;
    LAS float* part = (LAS float*)(F.lds + 36864);
    for (int it = F.vcu; it < 192; it += F.G) {
        const int l = it / 96, n0 = (it % 96) * 64;
        for (int i = F.tid; i < 9 * 1024; i += 512) { const int r = i >> 10, k = i & 1023; const float v = (r < 8) ? F.c[r * 1024 + k] : F.c_ctx[k]; sv[i] = silu_f(v); }
        __syncthreads();
        float acc[9];
#pragma unroll
        for (int r = 0; r < 9; ++r) acc[r] = 0.f;
        const float* wp = F.ada_w + (size_t)l * 1024 * 6144 + n0 + F.lane;
        for (int k = F.wave * 128; k < F.wave * 128 + 128; ++k) { const float w = wp[(size_t)k * 6144];
#pragma unroll
            for (int r = 0; r < 9; ++r) acc[r] += sv[r * 1024 + k] * w; }
#pragma unroll
        for (int r = 0; r < 9; ++r) part[(F.wave * 9 + r) * 64 + F.lane] = acc[r];
        __syncthreads();
        for (int i = F.tid; i < 9 * 64; i += 512) { const int r = i >> 6, n = i & 63; float s = 0.f;
#pragma unroll
            for (int w = 0; w < 8; ++w) s += part[(w * 9 + r) * 64 + n];
            F.MOD[(size_t)(l * 9 + r) * 6144 + n0 + n] = s + F.ada_b[l * 6144 + n0 + n]; }
        __syncthreads();
    }
}

__device__ __forceinline__ void ph_cvt_moe(const Frame& F) {
    LAS float* scr = (LAS float*)(F.lds + F.wave * 16384);
    const int gw = F.vcu * NWAVES + F.wave, NGW = F.G * NWAVES;
    constexpr int I_1 = 16 * 112, I_2 = 56 * 32;
    constexpr int NITEMS = NEXP * (2 * I_1 + I_2);
    for (int it = gw; it < NITEMS; it += NGW) {
        const int e = it / (2 * I_1 + I_2); int r = it % (2 * I_1 + I_2);
        if (r < I_1) { tr_item(F.moe_w1 + (size_t)e * 1024 * DFE, 1024, DFE, F.WM13 + (size_t)e * 7168 * 1024, 1, scr, r, F.lane); continue; } r -= I_1;
        if (r < I_1) { tr_item(F.moe_w3 + (size_t)e * 1024 * DFE, 1024, DFE, F.WM13 + (size_t)e * 7168 * 1024, 2, scr, r, F.lane); continue; } r -= I_1;
        tr_item(F.moe_w2 + (size_t)e * DFE * 1024, DFE, 1024, F.WM2 + (size_t)e * 1024 * DFE, 0, scr, r, F.lane);
    }
}

template <int MODE, bool ROUTER>
__device__ __forceinline__ void ph_norm(const Frame& F, int layer, int which, int nrows) {
    const int gw = F.vcu * NWAVES + F.wave, NGW = F.G * NWAVES;
    const float* g = (which ? F.norm_ffn_g : F.norm_attn_g) + layer * 1024;
    for (int row = gw; row < nrows; row += NGW) {
        const int bidx = row < TL ? (row >> 11) : 8;
        const float* src = MODE == 0 ? (row < TL ? F.x + (size_t)row * 1024 : F.ctx + (size_t)(row - TL) * 1024) : F.X + (size_t)row * 1024;
        const float* mod = F.MOD + (size_t)(layer * 9 + bidx) * 6144 + (which ? 3 : 0) * 1024;
        const f32x4* xr = (const f32x4*)src + F.lane;
        f32x4 v[4]; float s = 0.f;
#pragma unroll
        for (int j = 0; j < 4; ++j) { v[j] = xr[64 * j]; s += (v[j].x * v[j].x + v[j].y * v[j].y) + (v[j].z * v[j].z + v[j].w * v[j].w); }
        const float rstd = 1.0f / sqrtf(wave_sum(s) * (1.f / 1024.f) + EPS);
        unsigned long long* o8 = (unsigned long long*)(F.H + (size_t)row * 1024) + F.lane;
#pragma unroll
        for (int j = 0; j < 4; ++j) {
            const f32x4 gg = ((const f32x4*)g)[F.lane + 64 * j], sh = ((const f32x4*)mod)[F.lane + 64 * j], sc = ((const f32x4*)(mod + 1024))[F.lane + 64 * j];
            v[j] = (v[j] * rstd * gg) * (sc + 1.0f) + sh;
            o8[64 * j] = (unsigned long long)pk2(v[j].x, v[j].y) | ((unsigned long long)pk2(v[j].z, v[j].w) << 32);
        }
        if (ROUTER) {
            float lg[8];
#pragma unroll
            for (int e = 0; e < 8; ++e) lg[e] = 0.f;
#pragma unroll
            for (int j = 0; j < 4; ++j)
#pragma unroll
                for (int i = 0; i < 4; ++i) { const int k = 4 * (F.lane + 64 * j) + i; const f32x4 r0 = ((const f32x4*)(F.moe_router + (size_t)k * 8))[0], r1 = ((const f32x4*)(F.moe_router + (size_t)k * 8))[1];
                    const float hv = v[j][i];
                    lg[0] += hv * r0.x; lg[1] += hv * r0.y; lg[2] += hv * r0.z; lg[3] += hv * r0.w; lg[4] += hv * r1.x; lg[5] += hv * r1.y; lg[6] += hv * r1.z; lg[7] += hv * r1.w; }
#pragma unroll
            for (int e = 0; e < 8; ++e) lg[e] = wave_sum(lg[e]);
            int i0 = 0; float v0 = lg[0];
#pragma unroll
            for (int e = 1; e < 8; ++e) if (lg[e] > v0) { v0 = lg[e]; i0 = e; }
            int i1 = -1; float v1 = -3.0e38f;
#pragma unroll
            for (int e = 0; e < 8; ++e) if (e != i0 && lg[e] > v1) { v1 = lg[e]; i1 = e; }
            const float e1 = __expf(v1 - v0), g0 = 1.f / (1.f + e1), g1 = e1 / (1.f + e1);
            if (F.lane < 8) F.GATE[(size_t)row * 8 + F.lane] = (F.lane == i0) ? g0 : ((F.lane == i1) ? g1 : 0.f);
        }
    }
}

template <class Epi>
__device__ __forceinline__ void gemm_simple(const Frame& F, const bf16* A, const bf16* Bt, int M, int N, int K, const Epi& E) {
    const int nN = N / 128, nU = (M / 256) * nN;
    const int wr = F.wave >> 1, wc = F.wave & 1, fr = F.lane & 15, fq = F.lane >> 4;
    for (int u = F.vcu; u < nU; u += F.G) {
        const int pm = u / nN, pn = u % nN, row0 = pm * 256 + wr * 64, col0 = pn * 128 + wc * 64;
        f32x4 acc[4][4];
#pragma unroll
        for (int i = 0; i < 4; ++i)
#pragma unroll
            for (int j = 0; j < 4; ++j) acc[i][j] = (f32x4){0.f, 0.f, 0.f, 0.f};
        const bf16* ap = A + (size_t)(row0 + fr) * K + fq * 8;
        const bf16* bp0 = Bt + (size_t)(col0 + perm32(fr)) * K + fq * 8;
        const bf16* bp1 = Bt + (size_t)(col0 + perm32(16 + fr)) * K + fq * 8;
#pragma unroll 2
        for (int k0 = 0; k0 < K; k0 += 32) {
            bf16x8 a[4], b[4];
#pragma unroll
            for (int i = 0; i < 4; ++i) a[i] = *(const bf16x8*)(ap + (size_t)(16 * i) * K + k0);
            b[0] = *(const bf16x8*)(bp0 + k0); b[1] = *(const bf16x8*)(bp1 + k0);
            b[2] = *(const bf16x8*)(bp0 + (size_t)32 * K + k0); b[3] = *(const bf16x8*)(bp1 + (size_t)32 * K + k0);
#pragma unroll
            for (int i = 0; i < 4; ++i)
#pragma unroll
                for (int j = 0; j < 4; ++j) acc[i][j] = __builtin_amdgcn_mfma_f32_16x16x32_bf16(b[j], a[i], acc[i][j], 0, 0, 0);
        }
#pragma unroll
        for (int i = 0; i < 4; ++i)
#pragma unroll
            for (int q = 0; q < 2; ++q) E(row0 + 16 * i + fr, col0 + 32 * q + 8 * fq, acc[i][2 * q], acc[i][2 * q + 1]);
    }
}

struct EpiStore {
    bf16* O; int ldc;
    __device__ __forceinline__ void operator()(int row, int col, f32x4 lo, f32x4 hi) const {
        v4u w; w.x = pk2(lo.x, lo.y); w.y = pk2(lo.z, lo.w); w.z = pk2(hi.x, hi.y); w.w = pk2(hi.z, hi.w);
        *(v4u*)(O + (size_t)row * ldc + col) = w; }
};
struct EpiSwiglu {
    bf16* O; int ldc;
    __device__ __forceinline__ void operator()(int row, int col, f32x4 lo, f32x4 hi) const {
        v2u w; w.x = pk2(silu_f(lo.x) * hi.x, silu_f(lo.y) * hi.y); w.y = pk2(silu_f(lo.z) * hi.z, silu_f(lo.w) * hi.w);
        *(v2u*)(O + (size_t)row * ldc + (col >> 1)) = w; }
};
struct EpiResid {
    const float* bl; const float* bc; float* X; const float* gate  ; const float* rs; int rs_ld, rs_off;
    __device__ __forceinline__ void operator()(int row, int col, f32x4 lo, f32x4 hi) const {
        const int bidx = row < TL ? (row >> 11) : 8;
        const float* b = row < TL ? bl + (size_t)row * 1024 + col : bc + (size_t)(row - TL) * 1024 + col;
        const float* gp = gate + (size_t)bidx * 6144 + col;
        float sc = 1.f; if (rs) sc = rs[(size_t)row * rs_ld + rs_off];
        const f32x4 g0 = ((const f32x4*)gp)[0] * sc, g1 = ((const f32x4*)gp)[1] * sc;
        const f32x4 b0 = ((const f32x4*)b)[0], b1 = ((const f32x4*)b)[1];
        float* o = X + (size_t)row * 1024 + col;
        ((f32x4*)o)[0] = b0 + g0 * lo; ((f32x4*)o)[1] = b1 + g1 * hi; }
};

template <class F8> struct EpiAdapt {
    static constexpr bool PERM = true, AFTER_DRAIN = false;
    F8 f;
    __device__ __forceinline__ void operator()(const pg8::f32x4 (&acc)[2][2][4][2], const pg8::Unit& u, int wr, int wc, int fr, int fq) const {
#pragma unroll
        for (int ai = 0; ai < 2; ++ai)
#pragma unroll
            for (int m = 0; m < 4; ++m) { const int row = u.pm * 256 + ai * 128 + wr * 64 + m * 16 + fr;
#pragma unroll
                for (int bj = 0; bj < 2; ++bj) f(row, u.pn * 256 + bj * 128 + wc * 32 + 8 * fq, acc[ai][bj][m][0], acc[ai][bj][m][1]);
                asm volatile("" ::: "memory"); }
    }
};
#ifndef USE_SIMPLE_GEMM
#define USE_SIMPLE_GEMM 0
#endif
template <class F8>
__device__ __forceinline__ void gemm_pg8(const Frame& F, const bf16* A, const bf16* Bt, int M, int N, int K, const F8& f) {
#if USE_SIMPLE_GEMM
    gemm_simple(F, A, Bt, M, N, K, f);
#else
    pg8::Gemm g{A, Bt, M, N, K}; pg8::StaticOrder S; S.init(M, N, F.G, (int)blockIdx.x);
    EpiAdapt<F8> E{f};
    pg8::gemm_phase<EpiAdapt<F8>, pg8::StaticOrder, true, true>(F.lds, g, S, E);
#endif
}

#define DOT64(s, q, kp) do { s = 0.f; _Pragma("unroll") for (int _c = 0; _c < 8; ++_c) { const v4u _w = ((const v4u*)(kp))[_c]; \
    s += q[8*_c+0] * bflo(_w.x) + q[8*_c+1] * bfhi(_w.x) + q[8*_c+2] * bflo(_w.y) + q[8*_c+3] * bfhi(_w.y) + q[8*_c+4] * bflo(_w.z) + q[8*_c+5] * bfhi(_w.z) + q[8*_c+6] * bflo(_w.w) + q[8*_c+7] * bfhi(_w.w); } } while (0)
#define ONLINE_UPD(s, m, l, o, vp) do { if (s > m) { const float _cr = __expf(m - s); l *= _cr; _Pragma("unroll") for (int _d = 0; _d < 64; ++_d) o[_d] *= _cr; m = s; } \
    const float _p = __expf(s - m); l += _p; _Pragma("unroll") for (int _c = 0; _c < 8; ++_c) { const v4u _w = ((const v4u*)(vp))[_c]; \
    o[8*_c+0] += _p * bflo(_w.x); o[8*_c+1] += _p * bfhi(_w.x); o[8*_c+2] += _p * bflo(_w.y); o[8*_c+3] += _p * bfhi(_w.y); o[8*_c+4] += _p * bflo(_w.z); o[8*_c+5] += _p * bfhi(_w.z); o[8*_c+6] += _p * bflo(_w.w); o[8*_c+7] += _p * bfhi(_w.w); } } while (0)
#define LOADQ64(q, qp, scale) do { _Pragma("unroll") for (int _c = 0; _c < 8; ++_c) { const v4u _w = ((const v4u*)(qp))[_c]; \
    q[8*_c+0] = scale * bflo(_w.x); q[8*_c+1] = scale * bfhi(_w.x); q[8*_c+2] = scale * bflo(_w.y); q[8*_c+3] = scale * bfhi(_w.y); q[8*_c+4] = scale * bflo(_w.z); q[8*_c+5] = scale * bfhi(_w.z); q[8*_c+6] = scale * bflo(_w.w); q[8*_c+7] = scale * bfhi(_w.w); } } while (0)
#define STORE_O64(op, o, inv) do { _Pragma("unroll") for (int _c = 0; _c < 8; ++_c) { v4u _w; _w.x = pk2(o[8*_c+0] * inv, o[8*_c+1] * inv); _w.y = pk2(o[8*_c+2] * inv, o[8*_c+3] * inv); \
    _w.z = pk2(o[8*_c+4] * inv, o[8*_c+5] * inv); _w.w = pk2(o[8*_c+6] * inv, o[8*_c+7] * inv); ((v4u*)(op))[_c] = _w; } } while (0)

__device__ __forceinline__ void ph_attn0(const Frame& F) {
    const int gw = F.vcu * NWAVES + F.wave, NGW = F.G * NWAVES;
    const bf16* P = F.P;
    for (int u = gw; u < 2048 + 256; u += NGW) {
        float q[64], o[64]; float m = -INFINITY, l = 0.f;
#pragma unroll
        for (int d = 0; d < 64; ++d) o[d] = 0.f;
        if (u < 2048) {
            const int h = u & 7, r = (u >> 3) & 31, b = u >> 8, qc = F.lane;
            const int r0 = min(max(r - 4, 0), 24), c0 = min(max(qc - 8, 0), 48);
            const size_t qrow = (size_t)b * 2048 + r * 64 + qc;
            LOADQ64(q, P + qrow * LDP0 + h * 64, 0.125f);
            for (int ri = 0; ri < 8; ++ri)
                for (int ci = 0; ci < 16; ++ci) {
                    const size_t krow = (size_t)b * 2048 + (r0 + ri) * 64 + c0 + ci;
                    const bf16* kp = P + krow * LDP0 + 512 + h * 64;
                    float s; DOT64(s, q, kp);
                    s += F.na_rpb[(h * 15 + (r0 + ri - r + 7)) * 31 + (c0 + ci - qc + 15)];
                    ONLINE_UPD(s, m, l, o, kp + 512);
                }
            for (int sc = 0; sc < 256; ++sc) {
                const size_t krow = (size_t)TL + b * 256 + sc;
                const bf16* kp = P + krow * LDP0 + 512 + h * 64;
                float s; DOT64(s, q, kp);
                ONLINE_UPD(s, m, l, o, kp + 512);
            }
            const float inv = 1.f / l;
            STORE_O64(F.YA + qrow * 1536 + h * 64, o, inv);
        } else {
            const int v = u - 2048, qb = v & 3, h = (v >> 2) & 7, b = v >> 5;
            const size_t qrow = (size_t)TL + b * 256 + qb * 64 + F.lane;
            LOADQ64(q, P + qrow * LDP0 + h * 64, 0.125f);
            for (int sc = 0; sc < 256; ++sc) {
                const size_t krow = (size_t)TL + b * 256 + sc;
                const bf16* kp = P + krow * LDP0 + 512 + h * 64;
                float s; DOT64(s, q, kp);
                ONLINE_UPD(s, m, l, o, kp + 512);
            }
            const float inv = 1.f / l;
            STORE_O64(F.YA + qrow * 1536 + h * 64, o, inv);
        }
    }
}

__device__ __forceinline__ void ph_conv(const Frame& F) {
    const int gt = F.vcu * 512 + F.tid, NGT = F.G * 512;
    for (int idx = gt; idx < TT * 192; idx += NGT) {
        const int row = idx / 192, ch = (idx % 192) * 8;
        int t, len; if (row < TL) { t = row & 2047; len = 2048; } else { t = (row - TL) & 255; len = 256; }
        float acc[8];
#pragma unroll
        for (int j = 0; j < 8; ++j) acc[j] = F.conv_b[ch + j];
#pragma unroll
        for (int k = 0; k < 5; ++k) { const int tt = t + k - 2;
            if (tt >= 0 && tt < len) { const v4u w = *(const v4u*)(F.P + (size_t)(row + k - 2) * LDP0 + 2560 + ch); const float* cw = F.conv_w + k * 1536 + ch;
                acc[0] += cw[0] * bflo(w.x); acc[1] += cw[1] * bfhi(w.x); acc[2] += cw[2] * bflo(w.y); acc[3] += cw[3] * bfhi(w.y);
                acc[4] += cw[4] * bflo(w.z); acc[5] += cw[5] * bfhi(w.z); acc[6] += cw[6] * bflo(w.w); acc[7] += cw[7] * bfhi(w.w); } }
        v4u o; o.x = pk2(silu_f(acc[0]), silu_f(acc[1])); o.y = pk2(silu_f(acc[2]), silu_f(acc[3])); o.z = pk2(silu_f(acc[4]), silu_f(acc[5])); o.w = pk2(silu_f(acc[6]), silu_f(acc[7]));
        *(v4u*)(F.XBC + (size_t)row * 1536 + ch) = o;
    }
}

__device__ __forceinline__ int scan_row(int b, int d, int s) {
    if (s < 256) return TL + b * 256 + (d ? 255 - s : s);
    const int t = s - 256; return b * 2048 + (d ? 2047 - t : t);
}
__device__ __forceinline__ void ph_scan0(const Frame& F) {
    LAS float* xs = (LAS float*)F.lds;
    LAS float* Bs = xs + 32 * 64;
    LAS float* Cs = Bs + 32 * 128;
    LAS float* dts = Cs + 32 * 128;
    LAS float* decs = dts + 32;
    LAS float* ybuf = decs + 32;
    const int p = F.tid >> 3, ng = F.tid & 7;
    for (int u = F.vcu; u < 256; u += F.G) {
        const int d = u & 1, h = (u >> 1) & 15, b = u >> 5, g = h >> 3;
        const float dtb = F.dt_bias[d * 16 + h], Acoef = -expf(F.a_log[d * 16 + h]);
        float hst[16];
#pragma unroll
        for (int j = 0; j < 16; ++j) hst[j] = 0.f;
        for (int ck = 0; ck < 72; ++ck) {
            __syncthreads();
            for (int idx = F.tid; idx < 32 * 320; idx += 512) { const int i = idx / 320, c = idx % 320; const int row = scan_row(b, d, ck * 32 + i);
                const int col = c < 64 ? h * 64 + c : (c < 192 ? 1024 + g * 128 + (c - 64) : 1280 + g * 128 + (c - 192));
                const float val = bf2f(F.XBC[(size_t)row * 1536 + col]);
                if (c < 64) xs[i * 64 + c] = val; else if (c < 192) Bs[i * 128 + (c - 64)] = val; else Cs[i * 128 + (c - 192)] = val; }
            if (F.tid < 32) { const int row = scan_row(b, d, ck * 32 + F.tid); const float raw = bf2f(F.P[(size_t)row * LDP0 + 4096 + d * 16 + h]) + dtb;
                const float dt = raw > 20.f ? raw : log1pf(__expf(raw)); dts[F.tid] = dt; decs[F.tid] = __expf(dt * Acoef); }
            __syncthreads();
            for (int i = 0; i < 32; ++i) {
                const float dt = dts[i], dec = decs[i], xv = xs[i * 64 + p] * dt;
                float y = 0.f;
#pragma unroll
                for (int j4 = 0; j4 < 4; ++j4) { const f32x4 bv = *(const LAS f32x4*)(Bs + i * 128 + 16 * ng + 4 * j4), cv = *(const LAS f32x4*)(Cs + i * 128 + 16 * ng + 4 * j4);
#pragma unroll
                    for (int jj = 0; jj < 4; ++jj) { hst[4 * j4 + jj] = hst[4 * j4 + jj] * dec + xv * bv[jj]; y += hst[4 * j4 + jj] * cv[jj]; } }
                y += __shfl_xor(y, 1); y += __shfl_xor(y, 2); y += __shfl_xor(y, 4);
                if (ng == 0) ybuf[i * 64 + p] = y;
            }
            __syncthreads();
            bf16* Y = d ? F.YB : F.YF;
            for (int idx = F.tid; idx < 2048; idx += 512) { const int i = idx >> 6, pp = idx & 63; const int row = scan_row(b, d, ck * 32 + i);
                Y[(size_t)row * 1024 + h * 64 + pp] = (bf16)f2bf(ybuf[i * 64 + pp]); }
        }
    }
}

typedef short s16x4 __attribute__((ext_vector_type(4)));
__device__ __forceinline__ s16x4 lds_tr(const LAS unsigned char* p) { return __builtin_bit_cast(s16x4, __builtin_amdgcn_ds_read_tr16_b64_v4i16((LAS s16x4*)p)); }
__device__ __forceinline__ bf16x8 cat8(s16x4 a, s16x4 b) { return __builtin_shufflevector(a, b, 0, 1, 2, 3, 4, 5, 6, 7); }
template <int NST, bool RET>
__device__ __forceinline__ void chunk_scan(const Frame& F) {
    constexpr int SC = NST * 2 + 16, SX = 64 * 2 + 16, SH = NST * 2 + 16, NKS = NST / 32, NHT = NST / 32;
    LAS unsigned char* Cs = F.lds;
    LAS unsigned char* Bs = Cs + 128 * SC;
    LAS unsigned char* Xs = Bs + 128 * SC;
    LAS unsigned char* Xw = Xs + 128 * SX;
    LAS unsigned char* Hs = Xw + 128 * SX;
    LAS float* acs = (LAS float*)(Hs + 64 * SH);
    LAS float* dts = acs + 128;
    const int w = F.wave, lane = F.lane, l15 = lane & 15, g = lane >> 4, q4 = l15 >> 2, p4 = lane & 3;
    for (int u = F.vcu; u < 256; u += F.G) {
        int d, h, b, grp = 0, ph = 0;
        if (RET) { ph = u & 1; d = (u >> 1) & 1; h = (u >> 2) & 7; b = u >> 5; } else { d = u & 1; h = (u >> 1) & 15; b = u >> 5; grp = h >> 3; }
        float dtb = 0.f, Acoef = 0.f, lgam = 0.f;
        if (RET) lgam = log1pf(-expf(F.ret_log_decay[d * 8 + h])); else { dtb = F.dt_bias[d * 16 + h]; Acoef = -expf(F.a_log[d * 16 + h]); }
        const int nt = RET ? (w & 3) : w, pt0 = RET ? 2 * (w >> 2) : 0;
        const int ycol = RET ? h * 128 + ph * 64 : h * 64;
        bf16* Y = d ? F.YB : F.YF;
        f32x4 Hacc[NHT];
#pragma unroll
        for (int k = 0; k < NHT; ++k) Hacc[k] = (f32x4){0.f, 0.f, 0.f, 0.f};
        __syncthreads();
        for (int idx = F.tid; idx < 64 * SH / 16; idx += 512) ((LAS v4u*)Hs)[idx] = (v4u){0u, 0u, 0u, 0u};
        for (int ck = 0; ck < 18; ++ck) {
            float atot;
            { float dt0 = 1.f, dt1 = 1.f, a0 = lgam, a1 = lgam;
              if (!RET) { const int r0 = scan_row(b, d, ck * 128 + lane), r1 = scan_row(b, d, ck * 128 + 64 + lane);
                  const float x0 = bf2f(F.P[(size_t)r0 * LDP0 + 4096 + d * 16 + h]) + dtb, x1 = bf2f(F.P[(size_t)r1 * LDP0 + 4096 + d * 16 + h]) + dtb;
                  dt0 = x0 > 20.f ? x0 : log1pf(__expf(x0)); dt1 = x1 > 20.f ? x1 : log1pf(__expf(x1)); a0 = dt0 * Acoef; a1 = dt1 * Acoef; }
              float v0 = a0, v1 = a1;
#pragma unroll
              for (int o = 1; o < 64; o <<= 1) { const float n0 = __shfl_up(v0, o), n1 = __shfl_up(v1, o); if (lane >= o) { v0 += n0; v1 += n1; } }
              v1 += __shfl(v0, 63); atot = __shfl(v1, 63);
              acs[lane] = v0; acs[64 + lane] = v1; dts[lane] = dt0; dts[64 + lane] = dt1; }
            LDS_WAIT(); asm volatile("" ::: "memory");
            for (int idx = F.tid; idx < 128 * (NST / 8); idx += 512) { const int i = idx / (NST / 8), c = idx % (NST / 8); const size_t row = scan_row(b, d, ck * 128 + i);
                if (RET) { const bf16* pr = F.P + row * LDP1 + h * 64 + c * 8; const v4u cv = *(const v4u*)(pr + 768), kv = *(const v4u*)(pr + 1280);
                    v4u ks; ks.x = pk2(0.125f * bflo(kv.x), 0.125f * bfhi(kv.x)); ks.y = pk2(0.125f * bflo(kv.y), 0.125f * bfhi(kv.y)); ks.z = pk2(0.125f * bflo(kv.z), 0.125f * bfhi(kv.z)); ks.w = pk2(0.125f * bflo(kv.w), 0.125f * bfhi(kv.w));
                    *(LAS v4u*)(Cs + i * SC + c * 16) = cv; *(LAS v4u*)(Bs + i * SC + c * 16) = ks; }
                else { const bf16* pr = F.XBC + row * 1536 + grp * 128 + c * 8;
                    *(LAS v4u*)(Cs + i * SC + c * 16) = *(const v4u*)(pr + 1280); *(LAS v4u*)(Bs + i * SC + c * 16) = *(const v4u*)(pr + 1024); } }
            for (int idx = F.tid; idx < 1024; idx += 512) { const int i = idx >> 3, c = idx & 7; const size_t row = scan_row(b, d, ck * 128 + i);
                const v4u xv = RET ? *(const v4u*)(F.P + row * LDP1 + 1792 + h * 128 + ph * 64 + c * 8) : *(const v4u*)(F.XBC + row * 1536 + h * 64 + c * 8);
                const float dtj = dts[i], wj = dtj * __expf(atot - acs[i]);
                v4u a, bq; a.x = pk2(dtj * bflo(xv.x), dtj * bfhi(xv.x)); a.y = pk2(dtj * bflo(xv.y), dtj * bfhi(xv.y)); a.z = pk2(dtj * bflo(xv.z), dtj * bfhi(xv.z)); a.w = pk2(dtj * bflo(xv.w), dtj * bfhi(xv.w));
                bq.x = pk2(wj * bflo(xv.x), wj * bfhi(xv.x)); bq.y = pk2(wj * bflo(xv.y), wj * bfhi(xv.y)); bq.z = pk2(wj * bflo(xv.z), wj * bfhi(xv.z)); bq.w = pk2(wj * bflo(xv.w), wj * bfhi(xv.w));
                *(LAS v4u*)(Xs + i * SX + c * 16) = a; *(LAS v4u*)(Xw + i * SX + c * 16) = bq; }
            __syncthreads();
            if (!RET || ck >= 2) {
                const float aci = acs[16 * w + l15];
                bf16x8 Cf[NKS];
#pragma unroll
                for (int s = 0; s < NKS; ++s) Cf[s] = *(const LAS bf16x8*)(Cs + (16 * w + l15) * SC + (32 * s + 8 * g) * 2);
                f32x4 Yacc[4];
                const float eaci = __expf(aci);
#pragma unroll
                for (int pt = 0; pt < 4; ++pt) { f32x4 acc = (f32x4){0.f, 0.f, 0.f, 0.f};
#pragma unroll
                    for (int s = 0; s < NKS; ++s) { const bf16x8 hf = *(const LAS bf16x8*)(Hs + (16 * pt + l15) * SH + (32 * s + 8 * g) * 2); acc = __builtin_amdgcn_mfma_f32_16x16x32_bf16(hf, Cf[s], acc, 0, 0, 0); }
                    Yacc[pt] = acc * eaci; }
#pragma unroll
                for (int sp = 0; sp < 4; ++sp) {
                    if (2 * sp <= w) {
                        v2u Lh[2];
#pragma unroll
                        for (int hh = 0; hh < 2; ++hh) { const int jt = 2 * sp + hh;
                            if (jt <= w) { f32x4 cb = (f32x4){0.f, 0.f, 0.f, 0.f};
#pragma unroll
                                for (int s = 0; s < NKS; ++s) { const bf16x8 bf = *(const LAS bf16x8*)(Bs + (16 * jt + l15) * SC + (32 * s + 8 * g) * 2); cb = __builtin_amdgcn_mfma_f32_16x16x32_bf16(bf, Cf[s], cb, 0, 0, 0); }
                                const f32x4 acj = *(const LAS f32x4*)(acs + 16 * jt + 4 * g);
                                float val[4];
#pragma unroll
                                for (int r = 0; r < 4; ++r) { const float arg = fminf(aci - acj[r], 0.f); val[r] = cb[r] * __expf(arg); if (jt == w && (4 * g + r) > l15) val[r] = 0.f; }
                                Lh[hh].x = pk2(val[0], val[1]); Lh[hh].y = pk2(val[2], val[3]); }
                            else { Lh[hh].x = 0u; Lh[hh].y = 0u; } }
                        v4u lw; lw.x = Lh[0].x; lw.y = Lh[0].y; lw.z = Lh[1].x; lw.w = Lh[1].y;
                        const bf16x8 Lf = __builtin_bit_cast(bf16x8, lw);
#pragma unroll
                        for (int pt = 0; pt < 4; ++pt) { const s16x4 x0 = lds_tr(Xs + (32 * sp + 4 * g + q4) * SX + (16 * pt + 4 * p4) * 2), x1 = lds_tr(Xs + (32 * sp + 16 + 4 * g + q4) * SX + (16 * pt + 4 * p4) * 2);
                            Yacc[pt] = __builtin_amdgcn_mfma_f32_16x16x32_bf16(cat8(x0, x1), Lf, Yacc[pt], 0, 0, 0); }
                    }
                }
                const size_t row = scan_row(b, d, ck * 128 + 16 * w + l15);
#pragma unroll
                for (int pt = 0; pt < 4; ++pt) { v2u o; o.x = pk2(Yacc[pt].x, Yacc[pt].y); o.y = pk2(Yacc[pt].z, Yacc[pt].w); *(v2u*)(Y + row * 1024 + ycol + 16 * pt + 4 * g) = o; }
            }
            if (ck < 17) {
                const float eat = __expf(atot);
#pragma unroll
                for (int k = 0; k < NHT; ++k) Hacc[k] = Hacc[k] * eat;
#pragma unroll
                for (int s = 0; s < 4; ++s) {
                    const s16x4 b0 = lds_tr(Bs + (32 * s + 8 * g + q4) * SC + (16 * nt + 4 * p4) * 2), b1 = lds_tr(Bs + (32 * s + 8 * g + 4 + q4) * SC + (16 * nt + 4 * p4) * 2);
                    const bf16x8 Bf = cat8(b0, b1);
#pragma unroll
                    for (int k = 0; k < NHT; ++k) { const int pt = pt0 + k;
                        const s16x4 x0 = lds_tr(Xw + (32 * s + 8 * g + q4) * SX + (16 * pt + 4 * p4) * 2), x1 = lds_tr(Xw + (32 * s + 8 * g + 4 + q4) * SX + (16 * pt + 4 * p4) * 2);
                        Hacc[k] = __builtin_amdgcn_mfma_f32_16x16x32_bf16(cat8(x0, x1), Bf, Hacc[k], 0, 0, 0); }
                }
            }
            __syncthreads();
            if (ck < 17) {
#pragma unroll
                for (int k = 0; k < NHT; ++k)
#pragma unroll
                    for (int r = 0; r < 4; ++r) *(LAS bf16*)(Hs + (16 * (pt0 + k) + 4 * g + r) * SH + (16 * nt + l15) * 2) = (bf16)f2bf(Hacc[k][r]);
            }
        }
    }
}

template <int MODE>
__device__ __forceinline__ void attn16(const Frame& F, int u) {
    constexpr int PITCH = MODE == 2 ? LDP1 : LDP0;
    constexpr int SV = 144;
    LAS unsigned char* vb = F.lds + F.wave * 4608;
    const int lane = F.lane, l15 = lane & 15, g = lane >> 4, q4 = l15 >> 2, p4 = lane & 3;
    int b, h, nloc; size_t qrow0, locbase, ctxbase; int kcol, vcol;
    int r = 0, r0 = 0, jq = 0, kstart = 0, t0 = 0, jb_lo = 0;
    if (MODE == 0) { jq = u & 3; h = (u >> 2) & 7; r = (u >> 5) & 31; b = u >> 10; r0 = min(max(r - 4, 0), 24); kstart = min(max(16 * jq - 8, 0), 32);
        qrow0 = (size_t)b * 2048 + r * 64 + 16 * jq; locbase = (size_t)b * 2048 + r0 * 64 + kstart; nloc = 8; kcol = 512 + h * 64; vcol = 1024 + h * 64; }
    else if (MODE == 1) { const int qt = u & 15; h = (u >> 4) & 7; b = u >> 7; qrow0 = (size_t)TL + b * 256 + qt * 16; locbase = 0; nloc = 0; kcol = 512 + h * 64; vcol = 1024 + h * 64; }
    else { const int hq = u & 3, qt = (u >> 2) & 127, kvh = (u >> 9) & 1; b = u >> 10; h = kvh * 4 + hq; t0 = qt * 16; qrow0 = (size_t)b * 2048 + t0;
        jb_lo = max(t0 - 128, 0) >> 5; const int jb_hi = min(t0 + 15 + 128, 2047) >> 5; nloc = jb_hi - jb_lo + 1; locbase = (size_t)b * 2048 + jb_lo * 32; kcol = 512 + kvh * 64; vcol = 640 + kvh * 64; }
    ctxbase = (size_t)TL + b * 256;
    const int nblk = nloc + 8;
    const bf16* P = F.P;
    bf16x8 qf[2];
#pragma unroll
    for (int s = 0; s < 2; ++s) { const v4u w = *(const v4u*)(P + (qrow0 + l15) * PITCH + h * 64 + 32 * s + 8 * g); v4u o;
        o.x = pk2(0.125f * bflo(w.x), 0.125f * bfhi(w.x)); o.y = pk2(0.125f * bflo(w.y), 0.125f * bfhi(w.y)); o.z = pk2(0.125f * bflo(w.z), 0.125f * bfhi(w.z)); o.w = pk2(0.125f * bflo(w.w), 0.125f * bfhi(w.w));
        qf[s] = __builtin_bit_cast(bf16x8, o); }
    int dc[2][4]; bool okc[2][4];
    if (MODE == 0) { const int qc = 16 * jq + l15, c0 = min(max(qc - 8, 0), 48);
#pragma unroll
        for (int t = 0; t < 2; ++t)
#pragma unroll
            for (int rr = 0; rr < 4; ++rr) { const int kc = kstart + 16 * t + 4 * g + rr; okc[t][rr] = (kc >= c0) && (kc < c0 + 16); dc[t][rr] = min(max(kc - qc + 15, 0), 30); } }
    f32x4 oacc[4];
#pragma unroll
    for (int dt = 0; dt < 4; ++dt) oacc[dt] = (f32x4){0.f, 0.f, 0.f, 0.f};
    float m = -INFINITY, lsum = 0.f;
    bf16x8 kf[2][2]; v4u vr[4];
    { const size_t rb = (nloc > 0) ? locbase : ctxbase;
#pragma unroll
      for (int t = 0; t < 2; ++t)
#pragma unroll
          for (int s = 0; s < 2; ++s) kf[t][s] = *(const bf16x8*)(P + (rb + 16 * t + l15) * PITCH + kcol + 32 * s + 8 * g);
#pragma unroll
      for (int k = 0; k < 4; ++k) { const int idx = lane + 64 * k; vr[k] = *(const v4u*)(P + (rb + (idx >> 3)) * PITCH + vcol + (idx & 7) * 8); } }
    for (int kb = 0; kb < nblk; ++kb) {
        f32x4 st[2];
#pragma unroll
        for (int t = 0; t < 2; ++t) { f32x4 a = (f32x4){0.f, 0.f, 0.f, 0.f}; a = __builtin_amdgcn_mfma_f32_16x16x32_bf16(kf[t][0], qf[0], a, 0, 0, 0); st[t] = __builtin_amdgcn_mfma_f32_16x16x32_bf16(kf[t][1], qf[1], a, 0, 0, 0); }
#pragma unroll
        for (int k = 0; k < 4; ++k) { const int idx = lane + 64 * k; *(LAS v4u*)(vb + (idx >> 3) * SV + (idx & 7) * 16) = vr[k]; }
        asm volatile("" ::: "memory");
        if (kb + 1 < nblk) { const int nb = kb + 1; const size_t rb = (nb < nloc) ? locbase + (MODE == 0 ? nb * 64 : nb * 32) : ctxbase + (nb - nloc) * 32;
#pragma unroll
            for (int t = 0; t < 2; ++t)
#pragma unroll
                for (int s = 0; s < 2; ++s) kf[t][s] = *(const bf16x8*)(P + (rb + 16 * t + l15) * PITCH + kcol + 32 * s + 8 * g);
#pragma unroll
            for (int k = 0; k < 4; ++k) { const int idx = lane + 64 * k; vr[k] = *(const v4u*)(P + (rb + (idx >> 3)) * PITCH + vcol + (idx & 7) * 8); } }
        if (kb < nloc) {
            if (MODE == 0) { const float* rp = F.na_rpb + (h * 15 + (r0 + kb - r + 7)) * 31;
#pragma unroll
                for (int t = 0; t < 2; ++t)
#pragma unroll
                    for (int rr = 0; rr < 4; ++rr) st[t][rr] = okc[t][rr] ? st[t][rr] + rp[dc[t][rr]] : -INFINITY; }
            if (MODE == 2) { const int tq = t0 + l15;
#pragma unroll
                for (int t = 0; t < 2; ++t)
#pragma unroll
                    for (int rr = 0; rr < 4; ++rr) { const int dj = tq - ((jb_lo + kb) * 32 + 16 * t + 4 * g + rr); if (dj > 128 || dj < -128) st[t][rr] = -INFINITY; } }
        }
        float mx = fmaxf(fmaxf(fmaxf(st[0][0], st[0][1]), fmaxf(st[0][2], st[0][3])), fmaxf(fmaxf(st[1][0], st[1][1]), fmaxf(st[1][2], st[1][3])));
        mx = fmaxf(mx, __shfl_xor(mx, 16)); mx = fmaxf(mx, __shfl_xor(mx, 32));
        const float mn = fmaxf(m, mx), mu = (mn == -INFINITY) ? 0.f : mn;
        const float corr = __expf(m - mu);
        m = mn;
        float ps = 0.f; v4u pw;
        { float p[8];
#pragma unroll
          for (int t = 0; t < 2; ++t)
#pragma unroll
              for (int rr = 0; rr < 4; ++rr) { p[4 * t + rr] = __expf(st[t][rr] - mu); ps += p[4 * t + rr]; }
          pw.x = pk2(p[0], p[1]); pw.y = pk2(p[2], p[3]); pw.z = pk2(p[4], p[5]); pw.w = pk2(p[6], p[7]); }
        lsum = lsum * corr + ps;
        const bf16x8 pf = __builtin_bit_cast(bf16x8, pw);
#pragma unroll
        for (int dt = 0; dt < 4; ++dt) { oacc[dt] = oacc[dt] * corr;
            const s16x4 v0 = lds_tr(vb + (4 * g + q4) * SV + (16 * dt + 4 * p4) * 2), v1 = lds_tr(vb + (16 + 4 * g + q4) * SV + (16 * dt + 4 * p4) * 2);
            oacc[dt] = __builtin_amdgcn_mfma_f32_16x16x32_bf16(cat8(v0, v1), pf, oacc[dt], 0, 0, 0); }
        asm volatile("" ::: "memory");
    }
    lsum += __shfl_xor(lsum, 16); lsum += __shfl_xor(lsum, 32);
    if (MODE == 2) { const float sk = F.swa_sink[h]; const float mn = fmaxf(m, sk); const float corr = __expf(m - mn); lsum = lsum * corr + __expf(sk - mn);
#pragma unroll
        for (int dt = 0; dt < 4; ++dt) oacc[dt] = oacc[dt] * corr; }
    const float inv = 1.f / lsum;
    bf16* orow = F.YA + (qrow0 + l15) * 1536 + h * 64;
#pragma unroll
    for (int dt = 0; dt < 4; ++dt) { v2u o; o.x = pk2(oacc[dt].x * inv, oacc[dt].y * inv); o.y = pk2(oacc[dt].z * inv, oacc[dt].w * inv); *(v2u*)(orow + 16 * dt + 4 * g) = o; }
}
__device__ __forceinline__ void ph_attn0_mfma(const Frame& F) {
    const int gw = F.vcu * NWAVES + F.wave, NGW = F.G * NWAVES;
    for (int u = gw; u < 8192 + 1024; u += NGW) { if (u < 8192) attn16<0>(F, u); else attn16<1>(F, u - 8192); }
}
__device__ __forceinline__ void ph_swa_mfma(const Frame& F) {
    const int gw = F.vcu * NWAVES + F.wave, NGW = F.G * NWAVES;
    for (int u = gw; u < 8192; u += NGW) attn16<2>(F, u);
}

__device__ __forceinline__ void ph_ssmout(const Frame& F) {
    const int gw = F.vcu * NWAVES + F.wave, NGW = F.G * NWAVES;
    for (int row = gw; row < TT; row += NGW) {
#pragma unroll
        for (int grp = 0; grp < 2; ++grp) {
            const int ch = grp * 512 + F.lane * 8;
            const v4u yf = *(const v4u*)(F.YF + (size_t)row * 1024 + ch), yb = *(const v4u*)(F.YB + (size_t)row * 1024 + ch);
            const v4u xv = *(const v4u*)(F.XBC + (size_t)row * 1536 + ch), zv = *(const v4u*)(F.P + (size_t)row * LDP0 + 1536 + ch);
            const float dsk = F.ssm_d[ch >> 6];
            float yz[8];
            const unsigned yfw[4] = {yf.x, yf.y, yf.z, yf.w}, ybw[4] = {yb.x, yb.y, yb.z, yb.w}, xw[4] = {xv.x, xv.y, xv.z, xv.w}, zw[4] = {zv.x, zv.y, zv.z, zv.w};
            float ss = 0.f;
#pragma unroll
            for (int j = 0; j < 4; ++j) {
                const float y0 = bflo(yfw[j]) + bflo(ybw[j]) + bflo(xw[j]) * dsk, y1 = bfhi(yfw[j]) + bfhi(ybw[j]) + bfhi(xw[j]) * dsk;
                yz[2 * j] = y0 * silu_f(bflo(zw[j])); yz[2 * j + 1] = y1 * silu_f(bfhi(zw[j]));
                ss += yz[2 * j] * yz[2 * j] + yz[2 * j + 1] * yz[2 * j + 1]; }
            const float rstd = 1.0f / sqrtf(wave_sum(ss) * (1.f / 512.f) + EPS);
            const f32x4 g0 = *(const f32x4*)(F.ssm_norm_g + ch), g1 = *(const f32x4*)(F.ssm_norm_g + ch + 4);
            v4u o; o.x = pk2(yz[0] * rstd * g0.x, yz[1] * rstd * g0.y); o.y = pk2(yz[2] * rstd * g0.z, yz[3] * rstd * g0.w);
            o.z = pk2(yz[4] * rstd * g1.x, yz[5] * rstd * g1.y); o.w = pk2(yz[6] * rstd * g1.z, yz[7] * rstd * g1.w);
            *(v4u*)(F.YA + (size_t)row * 1536 + 512 + ch) = o;
        }
    }
}

__device__ __forceinline__ void ph_rope(const Frame& F) {
    const int gw = F.vcu * NWAVES + F.wave, NGW = F.G * NWAVES;
    for (int row = gw; row < TL; row += NGW) {
        const int t = row & 2047; bf16* pr = F.P + (size_t)row * LDP1;
        for (int i = F.lane; i < 26 * 32; i += 64) {
            const int hb = i >> 5, f = i & 31;
            const int col = hb < 10 ? hb * 64 : 768 + (hb - 10) * 64;
            const float cs = F.ROPE[(t * 32 + f) * 2], sn = F.ROPE[(t * 32 + f) * 2 + 1];
            const float x1 = bf2f(pr[col + f]), x2 = bf2f(pr[col + 32 + f]);
            pr[col + f] = (bf16)f2bf(x1 * cs - x2 * sn); pr[col + 32 + f] = (bf16)f2bf(x2 * cs + x1 * sn);
        }
    }
}

__device__ __forceinline__ void ph_swa(const Frame& F) {
    const int gw = F.vcu * NWAVES + F.wave, NGW = F.G * NWAVES;
    const bf16* P = F.P;
    for (int u = gw; u < 2048; u += NGW) {
        const int qb = u & 31, h = (u >> 5) & 7, b = u >> 8, kvh = h >> 2;
        const int t = qb * 64 + F.lane; const size_t qrow = (size_t)b * 2048 + t;
        float q[64], o[64]; float m = -INFINITY, l = 0.f;
#pragma unroll
        for (int d = 0; d < 64; ++d) o[d] = 0.f;
        LOADQ64(q, P + qrow * LDP1 + h * 64, 0.125f);
        const int jlo = max(qb * 64 - 128, 0), jhi = min(qb * 64 + 63 + 128, 2047);
        for (int j = jlo; j <= jhi; ++j) {
            const int dj = t - j;
            if (dj <= 128 && dj >= -128) {
                const bf16* kp = P + ((size_t)b * 2048 + j) * LDP1 + 512 + kvh * 64;
                float s; DOT64(s, q, kp);
                ONLINE_UPD(s, m, l, o, kp + 128);
            }
        }
        for (int sc = 0; sc < 256; ++sc) {
            const bf16* kp = P + ((size_t)TL + b * 256 + sc) * LDP1 + 512 + kvh * 64;
            float s; DOT64(s, q, kp);
            ONLINE_UPD(s, m, l, o, kp + 128);
        }
        { const float sk = F.swa_sink[h]; if (sk > m) { const float cr = __expf(m - sk); l *= cr;
#pragma unroll
              for (int d = 0; d < 64; ++d) o[d] *= cr;
              m = sk; }
          l += __expf(sk - m); }
        const float inv = 1.f / l;
        STORE_O64(F.YA + qrow * 1536 + h * 64, o, inv);
    }
}

__device__ __forceinline__ void ph_retscan(const Frame& F) {
    LAS float* vs = (LAS float*)F.lds;
    LAS float* ks = vs + 32 * 64;
    LAS float* qs = ks + 32 * 64;
    LAS float* ybuf = qs + 32 * 64;
    const int p = F.tid >> 3, ng = F.tid & 7;
    for (int u = F.vcu; u < 256; u += F.G) {
        const int ph = u & 1, d = (u >> 1) & 1, h = (u >> 2) & 7, b = u >> 5;
        const float gamma = 1.f - expf(F.ret_log_decay[d * 8 + h]);
        float hst[8];
#pragma unroll
        for (int j = 0; j < 8; ++j) hst[j] = 0.f;
        for (int ck = 0; ck < 72; ++ck) {
            __syncthreads();
            for (int idx = F.tid; idx < 32 * 192; idx += 512) { const int i = idx / 192, c = idx % 192; const int row = scan_row(b, d, ck * 32 + i);
                const bf16* pr = F.P + (size_t)row * LDP1;
                if (c < 64) vs[i * 64 + c] = bf2f(pr[1792 + h * 128 + ph * 64 + c]);
                else if (c < 128) ks[i * 64 + (c - 64)] = 0.125f * bf2f(pr[1280 + h * 64 + (c - 64)]);
                else qs[i * 64 + (c - 128)] = bf2f(pr[768 + h * 64 + (c - 128)]); }
            __syncthreads();
            for (int i = 0; i < 32; ++i) {
                const float vv = vs[i * 64 + p];
                float y = 0.f;
#pragma unroll
                for (int j4 = 0; j4 < 2; ++j4) { const f32x4 kv = *(const LAS f32x4*)(ks + i * 64 + 8 * ng + 4 * j4), qv = *(const LAS f32x4*)(qs + i * 64 + 8 * ng + 4 * j4);
#pragma unroll
                    for (int jj = 0; jj < 4; ++jj) { hst[4 * j4 + jj] = hst[4 * j4 + jj] * gamma + vv * kv[jj]; y += hst[4 * j4 + jj] * qv[jj]; } }
                y += __shfl_xor(y, 1); y += __shfl_xor(y, 2); y += __shfl_xor(y, 4);
                if (ng == 0) ybuf[i * 64 + p] = y;
            }
            __syncthreads();
            if (ck >= 8) { bf16* Y = d ? F.YB : F.YF;
                for (int idx = F.tid; idx < 2048; idx += 512) { const int i = idx >> 6, pp = idx & 63; const int row = scan_row(b, d, ck * 32 + i);
                    Y[(size_t)row * 1024 + h * 128 + ph * 64 + pp] = (bf16)f2bf(ybuf[i * 64 + pp]); } }
        }
    }
}

__device__ __forceinline__ void ph_retout(const Frame& F) {
    const int gw = F.vcu * NWAVES + F.wave, NGW = F.G * NWAVES;
    for (int row = gw; row < TL; row += NGW) {
#pragma unroll
        for (int half = 0; half < 2; ++half) {
            const int ch = half * 512 + F.lane * 8;
            const v4u yf = *(const v4u*)(F.YF + (size_t)row * 1024 + ch), yb = *(const v4u*)(F.YB + (size_t)row * 1024 + ch), gv = *(const v4u*)(F.P + (size_t)row * LDP1 + 2816 + ch);
            const unsigned yfw[4] = {yf.x, yf.y, yf.z, yf.w}, ybw[4] = {yb.x, yb.y, yb.z, yb.w}, gw4[4] = {gv.x, gv.y, gv.z, gv.w};
            float y[8]; float s = 0.f;
#pragma unroll
            for (int j = 0; j < 4; ++j) { y[2 * j] = bflo(yfw[j]) + bflo(ybw[j]); y[2 * j + 1] = bfhi(yfw[j]) + bfhi(ybw[j]); s += y[2 * j] + y[2 * j + 1]; }
            s += __shfl_xor(s, 1); s += __shfl_xor(s, 2); s += __shfl_xor(s, 4); s += __shfl_xor(s, 8);
            const float mu = s * (1.f / 128.f); float q = 0.f;
#pragma unroll
            for (int j = 0; j < 8; ++j) { y[j] -= mu; q += y[j] * y[j]; }
            q += __shfl_xor(q, 1); q += __shfl_xor(q, 2); q += __shfl_xor(q, 4); q += __shfl_xor(q, 8);
            const float rstd = 1.0f / sqrtf(q * (1.f / 128.f) + EPS);
            float ov[8];
#pragma unroll
            for (int j = 0; j < 8; ++j) { const float gg = (j & 1) ? bfhi(gw4[j >> 1]) : bflo(gw4[j >> 1]); ov[j] = silu_f(gg) * (y[j] * rstd * F.ret_gn_g[ch + j] + F.ret_gn_b[ch + j]); }
            v4u o; o.x = pk2(ov[0], ov[1]); o.y = pk2(ov[2], ov[3]); o.z = pk2(ov[4], ov[5]); o.w = pk2(ov[6], ov[7]);
            *(v4u*)(F.YA + (size_t)row * 1536 + 512 + ch) = o;
        }
    }
}

#define SEL8(arr, idx) (((idx) == 0 ? arr[0] : 0) + ((idx) == 1 ? arr[1] : 0) + ((idx) == 2 ? arr[2] : 0) + ((idx) == 3 ? arr[3] : 0) + ((idx) == 4 ? arr[4] : 0) + ((idx) == 5 ? arr[5] : 0) + ((idx) == 6 ? arr[6] : 0) + ((idx) == 7 ? arr[7] : 0))
__device__ __forceinline__ void ph_norm3_route(const Frame& F) {
    const int gw = F.vcu * NWAVES + F.wave, NGW = F.G * NWAVES;
    const float* g = F.norm_ffn_g + 1024;
    for (int ch = gw; ch < 2048; ch += NGW) {
        int cnt[8];
#pragma unroll
        for (int e = 0; e < 8; ++e) cnt[e] = 0;
        for (int i = 0; i < 8; ++i) {
            const int row = ch * 8 + i, bidx = row >> 11;
            const float* mod = F.MOD + (size_t)(9 + bidx) * 6144 + 3 * 1024;
            const f32x4* xr = (const f32x4*)(F.X + (size_t)row * 1024) + F.lane;
            f32x4 v[4]; float s = 0.f;
#pragma unroll
            for (int j = 0; j < 4; ++j) { v[j] = xr[64 * j]; s += (v[j].x * v[j].x + v[j].y * v[j].y) + (v[j].z * v[j].z + v[j].w * v[j].w); }
            const float rstd = 1.0f / sqrtf(wave_sum(s) * (1.f / 1024.f) + EPS);
            unsigned long long* o8 = (unsigned long long*)(F.H + (size_t)row * 1024) + F.lane;
#pragma unroll
            for (int j = 0; j < 4; ++j) {
                const f32x4 gg = ((const f32x4*)g)[F.lane + 64 * j], sh = ((const f32x4*)mod)[F.lane + 64 * j], sc = ((const f32x4*)(mod + 1024))[F.lane + 64 * j];
                v[j] = (v[j] * rstd * gg) * (sc + 1.0f) + sh;
                o8[64 * j] = (unsigned long long)pk2(v[j].x, v[j].y) | ((unsigned long long)pk2(v[j].z, v[j].w) << 32);
            }
            float lg[8];
#pragma unroll
            for (int e = 0; e < 8; ++e) lg[e] = 0.f;
#pragma unroll
            for (int j = 0; j < 4; ++j)
#pragma unroll
                for (int q = 0; q < 4; ++q) { const int k = 4 * (F.lane + 64 * j) + q; const f32x4 r0 = ((const f32x4*)(F.moe_router + (size_t)k * 8))[0], r1 = ((const f32x4*)(F.moe_router + (size_t)k * 8))[1];
                    const float hv = v[j][q];
                    lg[0] += hv * r0.x; lg[1] += hv * r0.y; lg[2] += hv * r0.z; lg[3] += hv * r0.w; lg[4] += hv * r1.x; lg[5] += hv * r1.y; lg[6] += hv * r1.z; lg[7] += hv * r1.w; }
#pragma unroll
            for (int e = 0; e < 8; ++e) lg[e] = wave_sum(lg[e]);
            int i0 = 0; float v0 = lg[0];
#pragma unroll
            for (int e = 1; e < 8; ++e) if (lg[e] > v0) { v0 = lg[e]; i0 = e; }
            int i1 = -1; float v1 = -3.0e38f;
#pragma unroll
            for (int e = 0; e < 8; ++e) if (e != i0 && lg[e] > v1) { v1 = lg[e]; i1 = e; }
            const float e1 = __expf(v1 - v0), g0 = 1.f / (1.f + e1), g1 = e1 / (1.f + e1);
            const int r0 = SEL8(cnt, i0);
#pragma unroll
            for (int e = 0; e < 8; ++e) cnt[e] += (e == i0) ? 1 : 0;
            const int r1 = SEL8(cnt, i1);
#pragma unroll
            for (int e = 0; e < 8; ++e) cnt[e] += (e == i1) ? 1 : 0;
            if (F.lane == 0) { F.TOPK[row] = i0 | (i1 << 4) | (r0 << 8) | (r1 << 16); F.GATE[row * 2] = g0; F.GATE[row * 2 + 1] = g1; }
        }
        if (F.lane < 8) F.CNT[ch * 8 + F.lane] = SEL8(cnt, F.lane);
    }
}

__device__ __forceinline__ void ph_route2(const Frame& F) {
    LAS int* coff = (LAS int*)F.lds;
    LAS int* wtot = coff + 2048 * 8;
    LAS int* meta = wtot + 64;
    const int t = F.tid;
    int loc[4][8], tot[8], incl[8];
#pragma unroll
    for (int i = 0; i < 4; ++i) { const int4 a = ((const int4*)(F.CNT + (4 * t + i) * 8))[0], b = ((const int4*)(F.CNT + (4 * t + i) * 8))[1];
        loc[i][0] = a.x; loc[i][1] = a.y; loc[i][2] = a.z; loc[i][3] = a.w; loc[i][4] = b.x; loc[i][5] = b.y; loc[i][6] = b.z; loc[i][7] = b.w; }
#pragma unroll
    for (int e = 0; e < 8; ++e) { int run = 0;
#pragma unroll
        for (int i = 0; i < 4; ++i) { const int tmp = loc[i][e]; loc[i][e] = run; run += tmp; }
        tot[e] = run; int v = run;
#pragma unroll
        for (int o = 1; o < 64; o <<= 1) { const int n = __shfl_up(v, o); if (F.lane >= o) v += n; }
        incl[e] = v;
        if (F.lane == 63) wtot[F.wave * 8 + e] = v; }
    __syncthreads();
#pragma unroll
    for (int e = 0; e < 8; ++e) { int woff = 0;
        for (int w = 0; w < F.wave; ++w) woff += wtot[w * 8 + e];
        const int excl = woff + incl[e] - tot[e];
#pragma unroll
        for (int i = 0; i < 4; ++i) coff[(4 * t + i) * 8 + e] = excl + loc[i][e]; }
    if (t < 8) { int s = 0; for (int w = 0; w < 8; ++w) s += wtot[w * 8 + t]; meta[8 + t] = s; }
    __syncthreads();
    if (t == 0) { int base = 0; for (int e = 0; e < 8; ++e) { meta[e] = base; base += (meta[8 + e] + 255) & ~255; } meta[16] = base >> 8; }
    __syncthreads();
    if (F.vcu == 0 && t < 144) { int e = 0;
#pragma unroll
        for (int q = 1; q < 8; ++q) if (t * 256 >= meta[q]) e = q;
        F.TILEE[t] = e; if (t == 0) F.MMETA[0] = meta[16]; }
    const int gw = F.vcu * NWAVES + F.wave, NGW = F.G * NWAVES;
    for (int ch = gw; ch < 2048; ch += NGW) {
        for (int i = 0; i < 8; ++i) {
            const int row = ch * 8 + i, tk = F.TOPK[row], e0 = tk & 15, e1 = (tk >> 4) & 15, r0 = (tk >> 8) & 255, r1 = (tk >> 16) & 255;
            const int s0 = meta[e0] + coff[ch * 8 + e0] + r0, s1 = meta[e1] + coff[ch * 8 + e1] + r1;
            const v4u a = ((const v4u*)(F.H + (size_t)row * 1024))[F.lane], b = ((const v4u*)(F.H + (size_t)row * 1024))[F.lane + 64];
            ((v4u*)(F.HP + (size_t)s0 * 1024))[F.lane] = a; ((v4u*)(F.HP + (size_t)s0 * 1024))[F.lane + 64] = b;
            ((v4u*)(F.HP + (size_t)s1 * 1024))[F.lane] = a; ((v4u*)(F.HP + (size_t)s1 * 1024))[F.lane + 64] = b;
            if (F.lane == 0) { F.SLOT[row * 2] = s0; F.SLOT[row * 2 + 1] = s1; }
        }
    }
    for (int it = gw; it < 2048; it += NGW) { const int e = it >> 8, r = it & 255, row = meta[e] + meta[8 + e] + r;
        if (row < meta[e] + ((meta[8 + e] + 255) & ~255)) { ((v4u*)(F.HP + (size_t)row * 1024))[F.lane] = (v4u){0u, 0u, 0u, 0u}; ((v4u*)(F.HP + (size_t)row * 1024))[F.lane + 64] = (v4u){0u, 0u, 0u, 0u}; } }
}

struct MoeOrder {
    const int* tile_e; int t0, t1, nN, G, c;
    __device__ __forceinline__ bool next(int i, pg8::Unit& u) const {
        const int L = i * G + c; if (L >= (t1 - t0) * nN) return false;
        const int pm = t0 + L / nN; u.pm = pm; u.pn = tile_e[pm] * nN + (L % nN); return true; }
    __device__ __forceinline__ void a_ready(const pg8::Unit&) const {}
    __device__ __forceinline__ void done(const pg8::Unit&) const {}
};
struct EpiSwigluMoe {
    bf16* O; int row0;
    __device__ __forceinline__ void operator()(int row, int col, f32x4 lo, f32x4 hi) const {
        v2u w; w.x = pk2(silu_f(lo.x) * hi.x, silu_f(lo.y) * hi.y); w.y = pk2(silu_f(lo.z) * hi.z, silu_f(lo.w) * hi.w);
        *(v2u*)(O + (size_t)(row - row0) * DFE + ((col % 7168) >> 1)) = w; }
};
struct EpiStoreMoe {
    bf16* O;
    __device__ __forceinline__ void operator()(int row, int col, f32x4 lo, f32x4 hi) const {
        v4u w; w.x = pk2(lo.x, lo.y); w.y = pk2(lo.z, lo.w); w.z = pk2(hi.x, hi.y); w.w = pk2(hi.z, hi.w);
        *(v4u*)(O + (size_t)row * 1024 + (col & 1023)) = w; }
};
template <class F8>
__device__ __forceinline__ void gemm_moe(const Frame& F, const bf16* A, const bf16* Bt, int K, int nN, int t0, int t1, const F8& f) {
    pg8::Gemm g{A, Bt, 0, 0, K}; MoeOrder S{F.TILEE, t0, t1, nN, F.G, (int)blockIdx.x};
    EpiAdapt<F8> E{f};
    pg8::gemm_phase<EpiAdapt<F8>, MoeOrder, true, true>(F.lds, g, S, E);
}

__device__ __forceinline__ void ph_final(const Frame& F) {
    const int gw = F.vcu * NWAVES + F.wave, NGW = F.G * NWAVES;
    for (int row = gw; row < TL; row += NGW) {
        const int s0 = F.SLOT[row * 2], s1 = F.SLOT[row * 2 + 1]; const float g0 = F.GATE[row * 2], g1 = F.GATE[row * 2 + 1];
        const float* g2 = F.MOD + (size_t)(9 + (row >> 11)) * 6144 + 5 * 1024;
        const f32x4* xr = (const f32x4*)(F.X + (size_t)row * 1024) + F.lane;
        const v2u* y0 = (const v2u*)(F.HP + (size_t)s0 * 1024) + F.lane; const v2u* y1 = (const v2u*)(F.HP + (size_t)s1 * 1024) + F.lane;
        f32x4 v[4]; float s = 0.f;
#pragma unroll
        for (int j = 0; j < 4; ++j) { const v2u a = y0[64 * j], b = y1[64 * j]; const f32x4 gg = ((const f32x4*)g2)[F.lane + 64 * j];
            f32x4 y; y.x = g0 * bflo(a.x) + g1 * bflo(b.x); y.y = g0 * bfhi(a.x) + g1 * bfhi(b.x); y.z = g0 * bflo(a.y) + g1 * bflo(b.y); y.w = g0 * bfhi(a.y) + g1 * bfhi(b.y);
            v[j] = xr[64 * j] + gg * y; s += (v[j].x * v[j].x + v[j].y * v[j].y) + (v[j].z * v[j].z + v[j].w * v[j].w); }
        const float rstd = 1.0f / sqrtf(wave_sum(s) * (1.f / 1024.f) + EPS);
        f32x4* o = (f32x4*)(F.out + (size_t)row * 1024) + F.lane;
#pragma unroll
        for (int j = 0; j < 4; ++j) o[64 * j] = v[j] * rstd * ((const f32x4*)F.final_g)[F.lane + 64 * j];
    }
}

enum { PH_CVT = 0, PH_NORM0, PH_IN0, PH_MIX0, PH_SCAN0, PH_SSMOUT, PH_OUT0, PH_NORM1, PH_F13, PH_F2, PH_NORM2, PH_IN1, PH_ROPE, PH_MIX1, PH_RETOUT, PH_OUT1, PH_NORM3, PH_ROUTE2, PH_MG1A, PH_MG2A, PH_MG1B, PH_MG2B, PH_FINAL, NPHASES };

struct Args { const float* in[31]; float* out; unsigned char* ws; int ph_lo, ph_hi; };

__global__ void __launch_bounds__(NWAVES * 64, 2) fwd(Args args) {
    extern __shared__ __attribute__((aligned(16))) unsigned char lds_raw[];
    Frame F;
    F.lds = (LAS unsigned char*)lds_raw;
    F.tid = threadIdx.x; F.lane = F.tid & 63; F.wave = __builtin_amdgcn_readfirstlane(F.tid >> 6);
    F.G = gridDim.x; { const int bx = blockIdx.x; F.vcu = (F.G % 8 == 0) ? (bx % 8) * (F.G / 8) + bx / 8 : bx; }
    F.x = args.in[0]; F.c = args.in[1]; F.ctx = args.in[2]; F.c_ctx = args.in[3]; F.ada_w = args.in[4]; F.ada_b = args.in[5]; F.norm_attn_g = args.in[6]; F.norm_ffn_g = args.in[7];
    F.ev_w_in = args.in[8]; F.ev_w_out = args.in[9]; F.na_rpb = args.in[10]; F.conv_w = args.in[11]; F.conv_b = args.in[12]; F.dt_bias = args.in[13]; F.a_log = args.in[14]; F.ssm_d = args.in[15];
    F.ssm_norm_g = args.in[16]; F.ffn_w1 = args.in[17]; F.ffn_w3 = args.in[18]; F.ffn_w2 = args.in[19]; F.od_w_in = args.in[20]; F.od_w_out = args.in[21]; F.swa_sink = args.in[22];
    F.ret_log_decay = args.in[23]; F.ret_gn_g = args.in[24]; F.ret_gn_b = args.in[25]; F.moe_router = args.in[26]; F.moe_w1 = args.in[27]; F.moe_w3 = args.in[28]; F.moe_w2 = args.in[29]; F.final_g = args.in[30];
    F.out = args.out;
    unsigned char* ws = args.ws;
    F.MOD = (float*)(ws + WS_MOD); F.GATE = (float*)(ws + WS_GATE); F.ROPE = (float*)(ws + WS_ROPE); F.X = (float*)(ws + WS_X);
    F.WIN0 = (bf16*)(ws + WS_WIN0); F.WOUT0 = (bf16*)(ws + WS_WOUT0); F.WF13 = (bf16*)(ws + WS_WF13); F.WF2 = (bf16*)(ws + WS_WF2); F.WIN1 = (bf16*)(ws + WS_WIN1); F.WOUT1 = (bf16*)(ws + WS_WOUT1);
    F.WM13 = (bf16*)(ws + WS_WM13); F.WM2 = (bf16*)(ws + WS_WM2); F.H = (bf16*)(ws + WS_H); F.P = (bf16*)(ws + WS_P); F.YA = (bf16*)(ws + WS_YA); F.XBC = (bf16*)(ws + WS_XBC);
    F.YF = (bf16*)(ws + WS_YF); F.YB = (bf16*)(ws + WS_YB); F.Gh = (bf16*)(ws + WS_G); F.MG = (bf16*)(ws + WS_MG); F.HP = (bf16*)(ws + WS_HP);
    F.TOPK = (int*)(ws + WS_TOPK); F.SLOT = (int*)(ws + WS_SLOT); F.CNT = (int*)(ws + WS_CNT); F.TILEE = (int*)(ws + WS_TILEE); F.MMETA = (int*)(ws + WS_MMETA);

    for (int u = F.tid; u < (LDS_BYTES - LDSCTL_OFF) / 4; u += NWAVES * 64) ((LAS unsigned*)(F.lds + LDSCTL_OFF))[u] = 0u;
    __syncthreads();
    volatile LAS unsigned* MISC = (volatile LAS unsigned*)(F.lds + MISC_OFF);
    XcdBarrier bar; bar.bar = (unsigned*)(ws + WS_CTL) + CW_BAR; bar.x = 0; bar.st = nullptr;
    const int lo = args.ph_lo, hi = args.ph_hi;
    if (hi - lo > 1) bar = xcd_barrier_post((unsigned*)(ws + WS_CTL) + CW_BAR, MISC + 8);
#define IN(k) (lo <= (k) && (k) < hi)
#define SEAM(k) do { if (IN(k) && IN((k) + 1)) xcd_barrier(bar); else __syncthreads(); } while (0)

    if (IN(PH_CVT)) { ph_cvt(F); SEAM(PH_CVT); }
    if (IN(PH_NORM0)) { ph_norm<0, false>(F, 0, 0, TT); SEAM(PH_NORM0); }
    if (IN(PH_IN0)) { EpiStore E{F.P, LDP0}; gemm_pg8(F, F.H, F.WIN0, TT, LDP0, 1024, E); SEAM(PH_IN0); }
    if (IN(PH_MIX0)) { ph_attn0_mfma(F); ph_conv(F); SEAM(PH_MIX0); }
    if (IN(PH_SCAN0)) { chunk_scan<128, false>(F); SEAM(PH_SCAN0); }
    if (IN(PH_SSMOUT)) { ph_ssmout(F); SEAM(PH_SSMOUT); }
    if (IN(PH_OUT0)) { EpiResid E{F.x, F.ctx, F.X, F.MOD + 2 * 1024, nullptr, 0, 0}; gemm_pg8(F, F.YA, F.WOUT0, TT, 1024, 1536, E); SEAM(PH_OUT0); }
    if (IN(PH_NORM1)) { ph_norm<1, false>(F, 0, 1, TT); SEAM(PH_NORM1); }
    if (IN(PH_F13)) { EpiSwiglu E{F.Gh, DFF}; gemm_pg8(F, F.H, F.WF13, TT, 2 * DFF, 1024, E); SEAM(PH_F13); }
    if (IN(PH_F2)) { EpiResid E{F.X, F.X + (size_t)TL * 1024, F.X, F.MOD + 5 * 1024, nullptr, 0, 0}; gemm_pg8(F, F.Gh, F.WF2, TT, 1024, DFF, E); SEAM(PH_F2); }
    if (IN(PH_NORM2)) { ph_norm<1, false>(F, 1, 0, TT); SEAM(PH_NORM2); }
    if (IN(PH_IN1)) { EpiStore E{F.P, LDP1}; gemm_pg8(F, F.H, F.WIN1, TT, LDP1, 1024, E); SEAM(PH_IN1); }
    if (IN(PH_ROPE)) { ph_rope(F); SEAM(PH_ROPE); }
    if (IN(PH_MIX1)) { chunk_scan<64, true>(F); __syncthreads(); ph_swa_mfma(F); SEAM(PH_MIX1); }
    if (IN(PH_RETOUT)) { ph_retout(F); SEAM(PH_RETOUT); }
    if (IN(PH_OUT1)) { EpiResid E{F.X, F.X + (size_t)TL * 1024, F.X, F.MOD + 9 * 6144 + 2 * 1024, nullptr, 0, 0}; gemm_pg8(F, F.YA, F.WOUT1, TL, 1024, 1536, E); SEAM(PH_OUT1); }
    if (IN(PH_NORM3)) { ph_norm3_route(F); ph_cvt_moe(F); SEAM(PH_NORM3); }
    if (IN(PH_ROUTE2)) { ph_route2(F); SEAM(PH_ROUTE2); }
    {
        int MT = 0; if (IN(PH_MG1A) || IN(PH_MG2A) || IN(PH_MG1B) || IN(PH_MG2B)) MT = __builtin_amdgcn_readfirstlane(F.MMETA[0]);
        const int ta = MT < 64 ? MT : 64;
        if (IN(PH_MG1A)) { EpiSwigluMoe E{F.MG, 0}; gemm_moe(F, F.HP, F.WM13, 1024, 28, 0, ta, E); SEAM(PH_MG1A); }
        if (IN(PH_MG2A)) { EpiStoreMoe E{F.HP}; gemm_moe(F, F.MG, F.WM2, DFE, 4, 0, ta, E); SEAM(PH_MG2A); }
        if (IN(PH_MG1B)) { EpiSwigluMoe E{F.MG, 64 * 256}; gemm_moe(F, F.HP, F.WM13, 1024, 28, 64, MT, E); SEAM(PH_MG1B); }
        if (IN(PH_MG2B)) { EpiStoreMoe E{F.HP}; gemm_moe(F, F.MG - (size_t)64 * 256 * DFE, F.WM2, DFE, 4, 64, MT, E); SEAM(PH_MG2B); }
    }
    if (IN(PH_FINAL)) { ph_final(F); }
#undef IN
#undef SEAM
}

extern "C" void kernel_launch(void* const* d_in, const int* in_sizes, int n_in, void* d_out, int out_size, void* d_ws, size_t ws_size, hipStream_t stream) {
    static int grid = 0;
    if (grid == 0) {
        if (n_in != 31 || out_size != TL * DM || ws_size < WS_END) { fprintf(stderr, "kernel_launch: unexpected shapes (n_in %d out %d ws %zu need %zu)\n", n_in, out_size, ws_size, (size_t)WS_END); grid = -1; return; }
        int dev = 0, cus = 0, per_cu = 0;
        if (hipGetDevice(&dev) != hipSuccess || hipDeviceGetAttribute(&cus, hipDeviceAttributeMultiprocessorCount, dev) != hipSuccess) { grid = -1; return; }
        if (hipFuncSetAttribute((const void*)fwd, hipFuncAttributeMaxDynamicSharedMemorySize, LDS_BYTES) != hipSuccess) { grid = -1; return; }
        if (hipOccupancyMaxActiveBlocksPerMultiprocessor(&per_cu, (const void*)fwd, NWAVES * 64, LDS_BYTES) != hipSuccess || per_cu < 1) fprintf(stderr, "kernel_launch: occupancy query reports %d\n", per_cu);
        (void)hipGetLastError();
        grid = cus;
    }
    if (grid < 0) return;
    if (hipMemsetAsync((char*)d_ws + WS_CTL, 0, CTL_ZERO_BYTES, stream) != hipSuccess) return;
    Args a{};
    for (int i = 0; i < 31; ++i) a.in[i] = (const float*)d_in[i];
    a.out = (float*)d_out; a.ws = (unsigned char*)d_ws;
#if MK_ONE_LAUNCH
    a.ph_lo = 0; a.ph_hi = NPHASES;
    hipLaunchKernelGGL(fwd, dim3(grid), dim3(NWAVES * 64), LDS_BYTES, stream, a);
#else
    for (int ph = 0; ph < NPHASES; ++ph) { a.ph_lo = ph; a.ph_hi = ph + 1; hipLaunchKernelGGL(fwd, dim3(grid), dim3(NWAVES * 64), LDS_BYTES, stream, a); }
#endif
}
```

```cpp
#include <hip/hip_runtime.h>
#include <cstdio>
#include <cstdint>

#ifndef MK_ONE_LAUNCH
#define MK_ONE_LAUNCH 1
#endif

#define LAS __attribute__((address_space(3)))
typedef unsigned short bf16;
typedef short bf16x8 __attribute__((ext_vector_type(8)));
typedef float f32x4 __attribute__((ext_vector_type(4)));
typedef unsigned v4u __attribute__((ext_vector_type(4)));
typedef unsigned v2u __attribute__((ext_vector_type(2)));

constexpr int DM = 1024, NB = 8, SEQ = 2048, CTXL = 256;
constexpr int TL = NB * SEQ, TC = NB * CTXL, TT = TL + TC;
constexpr int LDP0 = 4352;
constexpr int LDP1 = 3840;
constexpr int DFF = 2816, DFE = 3584, NEXP = 8;
constexpr float EPS = 1e-6f;
constexpr int LDHP = 1088;
constexpr int LDYA1 = 1600;

constexpr size_t MiB = 1u << 20;
constexpr size_t WS_CTL = 0, CTL_ZERO_BYTES = 1 * MiB;
constexpr size_t WS_MOD = 1 * MiB;
constexpr size_t WS_GATE = 2 * MiB;
constexpr size_t WS_ROPE = 3 * MiB;
constexpr size_t WS_WIN0 = 4 * MiB;
constexpr size_t WS_WOUT0 = 13 * MiB;
constexpr size_t WS_WF13 = 16 * MiB;
constexpr size_t WS_WF2 = 27 * MiB;
constexpr size_t WS_WIN1 = 33 * MiB;
constexpr size_t WS_WOUT1 = 40 * MiB + MiB / 2;
constexpr size_t WS_X = 44 * MiB;
constexpr size_t WS_H = 116 * MiB;
constexpr size_t WS_R = 152 * MiB;
constexpr size_t WS_P = WS_R;
constexpr size_t WS_YA0 = WS_R + 153 * MiB;
constexpr size_t WS_XBC = WS_R + 207 * MiB;
constexpr size_t WS_YF0 = WS_R + 261 * MiB;
constexpr size_t WS_YB0 = WS_R + 297 * MiB;
constexpr size_t WS_YA1 = WS_R + 135 * MiB;
constexpr size_t WS_YF1 = WS_R + 189 * MiB;
constexpr size_t WS_YB1 = WS_R + 221 * MiB;
constexpr size_t WS_G = WS_R;
constexpr size_t WS_HP = WS_R;
constexpr size_t WS_MG = WS_R + 73 * MiB;
constexpr size_t WS_PART = WS_R + 207 * MiB;
constexpr size_t WS_WM13 = WS_R + 256 * MiB;
constexpr size_t WS_END = WS_R + 375 * MiB;
constexpr size_t WS_TOPK = WS_GATE + 128 * 1024, WS_SLOT = WS_GATE + 192 * 1024, WS_CNT = WS_GATE + 320 * 1024, WS_TILEE = WS_GATE + 384 * 1024, WS_MMETA = WS_GATE + 385 * 1024;
static_assert(WS_P + (size_t)TT * LDP0 * 2 <= WS_YA0 && WS_YA0 + (size_t)TT * 1536 * 2 <= WS_XBC && WS_XBC + (size_t)TT * 1536 * 2 <= WS_YF0 && WS_YF0 + (size_t)TT * 1024 * 2 <= WS_YB0 && WS_YB0 + (size_t)TT * 1024 * 2 <= WS_END, "ws map layer 0");
static_assert(WS_WOUT1 + (size_t)1024 * LDYA1 * 2 <= WS_X && WS_P + (size_t)TT * LDP1 * 2 <= WS_YA1 && WS_YA1 + (size_t)TL * LDYA1 * 2 <= WS_YF1 && WS_YF1 + (size_t)TL * 1024 * 2 <= WS_YB1 && WS_YB1 + (size_t)TL * 1024 * 2 <= WS_WM13, "ws map layer 1");
static_assert(WS_HP + (size_t)34816 * LDHP * 2 <= WS_MG && WS_MG + (size_t)72 * 256 * 3584 * 2 <= WS_WM13 && WS_WM13 + (size_t)8 * 7168 * LDHP * 2 <= WS_END && WS_XBC >= WS_R + 194 * MiB, "ws map moe");
static_assert(WS_G + (size_t)TT * DFF * 2 <= WS_PART && WS_YA0 + (size_t)TT * 1536 * 2 <= WS_PART && WS_PART + (size_t)6 * TC * 1024 * 4 <= WS_WM13, "partial slabs");
static_assert(WS_X + (size_t)TT * 1024 * 4 <= WS_H && WS_H + (size_t)TT * 1024 * 2 <= WS_R, "ws map 2");
static_assert((size_t)8 * 1024 * 3584 * 2 <= (size_t)TL * DM * 4, "WM2 fits d_out");
constexpr size_t WS_Y2T = WS_R + 199 * MiB;
static_assert(WS_MG + (size_t)72 * 256 * 3584 * 2 <= WS_Y2T && WS_Y2T + (size_t)7 * 2048 * 1024 * 4 <= WS_WM13, "Y2T slabs");
constexpr int CW_Q2 = 8192, CW_Q13 = 8256;
constexpr int CW_BAR = 4096;

constexpr int RING_BYTES = 131072, LDSCTL_OFF = RING_BYTES, MISC_OFF = LDSCTL_OFF + 320, LDS_BYTES = 147456;
constexpr int NWAVES = 8;

#define LDS_WAIT() asm volatile("s_waitcnt lgkmcnt(0)" ::: "memory")
__device__ __forceinline__ unsigned f2bf(float f) { unsigned u = __builtin_bit_cast(unsigned, f); return (u + 0x7fffu + ((u >> 16) & 1u)) >> 16; }
typedef float f32x2_t __attribute__((ext_vector_type(2))); typedef __bf16 bf16x2_t __attribute__((ext_vector_type(2)));
__device__ __forceinline__ unsigned pk2(float lo, float hi) { f32x2_t v = {lo, hi}; bf16x2_t b = __builtin_convertvector(v, bf16x2_t); return __builtin_bit_cast(unsigned, b); }
__device__ __forceinline__ float bf2f(unsigned short b) { return __builtin_bit_cast(float, ((unsigned)b) << 16); }
__device__ __forceinline__ float bflo(unsigned w) { return __builtin_bit_cast(float, w << 16); }
__device__ __forceinline__ float bfhi(unsigned w) { return __builtin_bit_cast(float, w & 0xffff0000u); }
__device__ __forceinline__ float silu_f(float x) { return x * __builtin_amdgcn_rcpf(1.f + __expf(-x)); }
__device__ __forceinline__ float wave_sum(float v) {
#pragma unroll
    for (int o = 1; o < 64; o <<= 1) v += __shfl_xor(v, o);
    return v;
}
__host__ __device__ __forceinline__ int perm32(int rho) { const int n = rho >> 4, i = rho & 15; return 8 * (i >> 2) + 4 * n + (i & 3); }

#define XB_TMO      128
#define XB_XCNT(j)  (256  + 64 * (j))
#define XB_XSUB(j)  (1280 + 64 * (j))
#define XB_XGEN(j)  (2304 + 64 * (j))
#define XB_TOP      3328
#define XB_TOPGEN   3392
#define XCD_BAR_WORDS 3456
#define XB_SPIN_CAP (1u << 18)
__device__ __forceinline__ unsigned xb_ld(unsigned* p)              { return __hip_atomic_load(p, __ATOMIC_RELAXED, __HIP_MEMORY_SCOPE_AGENT); }
__device__ __forceinline__ unsigned xb_add(unsigned* p, unsigned v) { return __hip_atomic_fetch_add(p, v, __ATOMIC_RELAXED, __HIP_MEMORY_SCOPE_AGENT); }
__device__ __forceinline__ unsigned xb_xcc_id() { return (unsigned)__builtin_amdgcn_s_getreg((3 << 11) | 20) & 0xFu; }
#define XB_SPIN(cond, bar) do { unsigned _sp = 0; while (cond) { __builtin_amdgcn_s_sleep(1); \
    if ((++_sp & 255u) == 0u) { if (xb_ld(&(bar)[XB_TMO])) break; if (_sp > XB_SPIN_CAP) { atomicAdd(&(bar)[XB_TMO], 1u); break; } } } } while (0)
struct XcdBarrier { unsigned* bar; unsigned x; volatile LAS unsigned* st; };
__device__ __forceinline__ XcdBarrier xcd_barrier_post(unsigned* bar, volatile LAS unsigned* st) {
    XcdBarrier b; b.bar = bar; b.x = xb_xcc_id(); b.st = st;
    if (threadIdx.x == 0) (void)xb_add(&bar[XB_XCNT(b.x)], 1u);
    return b;
}
__device__ __forceinline__ void xcd_barrier_complete(unsigned* bar, unsigned x, unsigned& nloc, unsigned& nx) {
    const unsigned G = gridDim.x * gridDim.y * gridDim.z;
    unsigned sum, cnt, mine, sp = 0u;
    for (;;) {
        sum = 0u; cnt = 0u; mine = 0u;
#pragma unroll
        for (unsigned j = 0; j < 16; ++j) { const unsigned c = xb_ld(&bar[XB_XCNT(j)]); sum += c; cnt += (c > 0u) ? 1u : 0u; mine = (j == x) ? c : mine; }
        if (sum == G) break;
        __builtin_amdgcn_s_sleep(1);
        if ((++sp & 255u) == 0u) { if (xb_ld(&bar[XB_TMO])) break; if (sp > XB_SPIN_CAP) { atomicAdd(&bar[XB_TMO], 1u); break; } }
    }
    nloc = mine > 0u ? mine : 1u; nx = cnt > 0u ? cnt : 1u;
}
__device__ __forceinline__ void xcd_barrier(const XcdBarrier& b) {
    asm volatile("s_waitcnt vmcnt(0)" ::: "memory");
    __syncthreads();
    if (threadIdx.x == 0) {
        unsigned* bar = b.bar;
        __builtin_amdgcn_s_waitcnt(0);
        unsigned nloc = b.st[0], nx = b.st[1];
        if (nloc == 0u) { xcd_barrier_complete(bar, b.x, nloc, nx); b.st[0] = nloc; b.st[1] = nx; }
        const unsigned old = xb_add(&bar[XB_XSUB(b.x)], 1u);
        const unsigned gen = old / nloc;
        if (old + 1u == (gen + 1u) * nloc) {
            __builtin_amdgcn_fence(__ATOMIC_RELEASE, "agent");
            asm volatile("s_waitcnt vmcnt(0)" ::: "memory");
            const unsigned og = xb_add(&bar[XB_TOP], 1u);
            const unsigned tg = og / nx;
            if (og + 1u == (tg + 1u) * nx) xb_add(&bar[XB_TOPGEN], 1u);
            else XB_SPIN(xb_ld(&bar[XB_TOPGEN]) == tg, bar);
            __builtin_amdgcn_fence(__ATOMIC_ACQUIRE, "agent");
            xb_add(&bar[XB_XGEN(b.x)], 1u);
            asm volatile("s_waitcnt vmcnt(0)" ::: "memory");
        } else {
            XB_SPIN(xb_ld(&bar[XB_XGEN(b.x)]) == gen, bar);
            __builtin_amdgcn_fence(__ATOMIC_ACQUIRE, "agent");
            asm volatile("s_waitcnt vmcnt(0)" ::: "memory");
        }
    }
    __syncthreads();
}

namespace pg8 {
#define PG8_LAS __attribute__((address_space(3)))
typedef unsigned short bf16_t;
typedef short bf16x8 __attribute__((ext_vector_type(8)));
typedef float f32x4 __attribute__((ext_vector_type(4)));
typedef unsigned u32x4 __attribute__((ext_vector_type(4)));
constexpr int BM = 256, BK = 64, HALF = 128, HTB = HALF * BK * 2  , STAGE_BYTES = 8 * HTB, NXCD = 8, WGM = 8;

__host__ __device__ __forceinline__ int lds_byte(int r, int c) { const int st = (r >> 4) * 2 + (c >> 5), rr = r & 15, cc = c & 31, ob = rr * 64 + cc * 2; return st * 1024 + (ob ^ (((ob >> 9) & 1) << 5)); }
__host__ __device__ __forceinline__ void stage_rc(int b, int& R, int& C) { const int st = b / 1024, sb = b % 1024, swz = sb ^ (((sb >> 9) & 1) << 5); R = (st >> 1) * 16 + swz / 64; C = (st & 1) * 32 + (swz % 64) / 2; }
__host__ __device__ __forceinline__ int perm32(int rho) { const int n = rho >> 4, i = rho & 15; return 8 * (i >> 2) + 4 * n + (i & 3); }

struct Unit { int pm, pn, k0, nk; };
struct Gemm { const bf16_t* A; const bf16_t* Bt; int M, N, K, ld; };

struct StaticOrder {
    int nM, nN, nwg, G, c;
    __host__ __device__ __forceinline__ void init(int M, int N, int G_, int c_) { nM = M / BM; nN = N / BM; nwg = nM * nN; G = G_; c = c_; }
    __host__ __device__ __forceinline__ bool next(int i, Unit& u) const {
        const long L = (long)i * G + c; if (L >= nwg) return false;
        int wgid = (int)L; { const int q = nwg / NXCD, r = nwg % NXCD, xcd = wgid % NXCD, off = wgid / NXCD; wgid = (xcd < r ? xcd * (q + 1) : r * (q + 1) + (xcd - r) * q) + off; }
        const int nig = WGM * nN, gid = wgid / nig, fm = gid * WGM, gsz = (nM - fm) < WGM ? (nM - fm) : WGM;
        u.pm = fm + ((wgid % nig) % gsz); u.pn = (wgid % nig) / gsz; u.k0 = 0; u.nk = 0; return true;
    }
    __device__ __forceinline__ void a_ready(const Unit&) const {}
    __device__ __forceinline__ void done(const Unit&) const {}
};

__device__ __forceinline__ unsigned cvt_pk_bf16(float lo, float hi) { unsigned r; asm volatile("v_cvt_pk_bf16_f32 %0, %1, %2" : "=v"(r) : "v"(lo), "v"(hi)); return r; }
template <class Epi, class Sched, bool ALIGN_EPI = false, bool SP2 = false>
__device__ __forceinline__ void gemm_phase(PG8_LAS unsigned char* lds, const Gemm g, const Sched& S, const Epi& E) {
    int tid_ = threadIdx.x; asm volatile("" : "+v"(tid_));
    const int tid = tid_, wid = __builtin_amdgcn_readfirstlane(tid >> 6), lane = tid & 63, wr = wid >> 2, wc = wid & 3, fr = lane & 15, fq = lane >> 4;
    const int K = g.K, nt_full = K / BK, LD = g.ld ? g.ld : K;
    unsigned voffA[2], voffB[2];
#pragma unroll
    for (int i = 0; i < 2; ++i) { int R, C; stage_rc(tid * 16 + i * 8192, R, C); const int Rb = Epi::PERM ? ((R & ~31) + perm32(R & 31)) : R;
        voffA[i] = (unsigned)(R * LD + C) * 2u; voffB[i] = (unsigned)(Rb * LD + C) * 2u; }
    const size_t kstep = (size_t)(BK * 2);
    const size_t hstep = (size_t)HALF * LD * 2;
    const size_t tstep = 2 * hstep;
    const unsigned ldsw = (unsigned)wid * 1024u;
    const int aoff = lds_byte(wr * 64 + fr, fq * 8), boff = lds_byte(wc * 32 + fr, fq * 8);
#define PG8_SA(b, h) (((b) * 2 + (h)) * HTB)
#define PG8_SB(b, h) ((4 + (b) * 2 + (h)) * HTB)
#define PG8_STAGE(bufoff, gbase, voff) do { _Pragma("unroll") for (int _i = 0; _i < 2; ++_i) \
        __builtin_amdgcn_global_load_lds((const unsigned*)((const char*)(gbase) + (voff)[_i]), (PG8_LAS unsigned*)(lds + (bufoff) + ldsw + _i * 8192), 16, 0, 0); } while (0)
#define PG8_LDA(dst, b, h) do { _Pragma("unroll") for (int m = 0; m < 4; ++m) _Pragma("unroll") for (int k = 0; k < 2; ++k) dst[m][k] = *(const PG8_LAS bf16x8*)(lds + PG8_SA(b, h) + aoff + m * 2048 + k * 1024); } while (0)
#define PG8_LDB(dst, b, h) do { _Pragma("unroll") for (int n = 0; n < 2; ++n) _Pragma("unroll") for (int k = 0; k < 2; ++k) dst[n][k] = *(const PG8_LAS bf16x8*)(lds + PG8_SB(b, h) + boff + n * 2048 + k * 1024); } while (0)
#define PG8_MMA(ai, bj, At, Bt) do { __builtin_amdgcn_s_setprio(1); _Pragma("unroll") for (int m = 0; m < 4; ++m) _Pragma("unroll") for (int n = 0; n < 2; ++n) _Pragma("unroll") for (int k = 0; k < 2; ++k) \
        acc[ai][bj][m][n] = __builtin_amdgcn_mfma_f32_16x16x32_bf16(Bt[n][k], At[m][k], acc[ai][bj][m][n], 0, 0, 0); __builtin_amdgcn_s_setprio(0); } while (0)
#define PG8_WAIT_V(n) asm volatile("s_waitcnt vmcnt(" #n ")" ::: "memory")
#define PG8_WAIT_L(n) asm volatile("s_waitcnt lgkmcnt(" #n ")" ::: "memory")
#define PG8_BAR __builtin_amdgcn_s_barrier()
#define PG8_SCHED __builtin_amdgcn_sched_barrier(0)
    Unit cur{0, 0, 0, 0}, nxt{0, 0, 0, 0}; int ui = 0;
    if (!S.next(0, cur)) return;
    f32x4 acc[2][2][4][2];
#pragma unroll
    for (int a = 0; a < 2; ++a)
#pragma unroll
        for (int b = 0; b < 2; ++b)
#pragma unroll
            for (int m = 0; m < 4; ++m)
#pragma unroll
                for (int n = 0; n < 2; ++n) acc[a][b][m][n] = (f32x4){0.f, 0.f, 0.f, 0.f};
    bf16x8 At[4][2], B0[2][2], B1[2][2];
    const char* cA = (const char*)g.A + (size_t)cur.pm * tstep + (size_t)cur.k0 * 2; const char* cB = (const char*)g.Bt + (size_t)cur.pn * tstep + (size_t)cur.k0 * 2;
    S.a_ready(cur);
    if constexpr (SP2) {
        PG8_STAGE(PG8_SB(0, 0), cB, voffB); PG8_STAGE(PG8_SB(0, 1), cB + hstep, voffB); PG8_STAGE(PG8_SA(0, 0), cA, voffA); PG8_STAGE(PG8_SA(0, 1), cA + hstep, voffA);
        if (wr == 1) PG8_BAR;
        PG8_WAIT_V(2); PG8_BAR;
        PG8_STAGE(PG8_SB(1, 0), cB + kstep, voffB); PG8_STAGE(PG8_SA(1, 0), cA + kstep, voffA); PG8_STAGE(PG8_SB(1, 1), cB + hstep + kstep, voffB);
        PG8_WAIT_V(6); PG8_BAR;
    } else {
        PG8_STAGE(PG8_SB(0, 0), cB, voffB); PG8_STAGE(PG8_SA(0, 0), cA, voffA); PG8_STAGE(PG8_SB(0, 1), cB + hstep, voffB); PG8_STAGE(PG8_SA(0, 1), cA + hstep, voffA);
        if (wr == 1) PG8_BAR;
        PG8_WAIT_V(4); PG8_BAR;
        PG8_STAGE(PG8_SB(1, 0), cB + kstep, voffB); PG8_STAGE(PG8_SA(1, 0), cA + kstep, voffA); PG8_STAGE(PG8_SB(1, 1), cB + hstep + kstep, voffB);
        PG8_WAIT_V(6); PG8_BAR;
    }
    for (;;) {
        const bool has_next = S.next(ui + 1, nxt);
        const char* nA = has_next ? (const char*)g.A + (size_t)nxt.pm * tstep + (size_t)nxt.k0 * 2 : cA; const char* nB = has_next ? (const char*)g.Bt + (size_t)nxt.pn * tstep + (size_t)nxt.k0 * 2 : cB;
        const int nt = cur.nk ? cur.nk : nt_full;
        for (int t = 0; t < nt; t += 2) {
            const bool last = (t == nt - 2);
            const char* a1 = cA + (size_t)(t + 1) * kstep;
            const char* a2 = last ? nA : cA + (size_t)(t + 2) * kstep; const char* b2 = last ? nB : cB + (size_t)(t + 2) * kstep;
            const char* a3 = a2 + kstep; const char* b3 = b2 + kstep;
            if (last && has_next) S.a_ready(nxt);
            if constexpr (SP2) {
            PG8_LDB(B0, 0, 0); PG8_LDB(B1, 0, 1); PG8_SCHED; PG8_LDA(At, 0, 0); PG8_STAGE(PG8_SA(1, 1), a1 + hstep, voffA);
            PG8_WAIT_V(8); PG8_WAIT_L(0); PG8_BAR; PG8_MMA(0, 0, At, B0); PG8_MMA(0, 1, At, B1); PG8_BAR; PG8_SCHED;
            PG8_LDA(At, 0, 1); PG8_STAGE(PG8_SB(0, 0), b2, voffB); PG8_STAGE(PG8_SB(0, 1), b2 + hstep, voffB); PG8_STAGE(PG8_SA(0, 0), a2, voffA);
            PG8_WAIT_V(8); PG8_WAIT_L(0); PG8_BAR; PG8_MMA(1, 0, At, B0); PG8_MMA(1, 1, At, B1); PG8_BAR; PG8_SCHED;
            PG8_LDB(B0, 1, 0); PG8_LDB(B1, 1, 1); PG8_SCHED; PG8_LDA(At, 1, 0); PG8_STAGE(PG8_SA(0, 1), a2 + hstep, voffA);
            PG8_WAIT_V(8); PG8_WAIT_L(0); PG8_BAR; PG8_MMA(0, 0, At, B0); PG8_MMA(0, 1, At, B1); PG8_BAR; PG8_SCHED;
            PG8_LDA(At, 1, 1); PG8_STAGE(PG8_SB(1, 0), b3, voffB); PG8_STAGE(PG8_SB(1, 1), b3 + hstep, voffB); PG8_STAGE(PG8_SA(1, 0), a3, voffA);
            PG8_WAIT_V(8); PG8_WAIT_L(0); PG8_BAR; PG8_MMA(1, 0, At, B0); PG8_MMA(1, 1, At, B1); PG8_BAR; PG8_SCHED;
            } else {
            PG8_LDB(B0, 0, 0); PG8_SCHED; PG8_LDA(At, 0, 0); PG8_STAGE(PG8_SA(1, 1), a1 + hstep, voffA);
            PG8_WAIT_L(8); PG8_BAR; PG8_WAIT_L(0); PG8_MMA(0, 0, At, B0); PG8_BAR; PG8_SCHED;
            PG8_LDB(B1, 0, 1); PG8_STAGE(PG8_SB(0, 0), b2, voffB);
            PG8_BAR; PG8_WAIT_L(0); PG8_MMA(0, 1, At, B1); PG8_BAR;
            PG8_LDA(At, 0, 1); PG8_STAGE(PG8_SA(0, 0), a2, voffA);
            PG8_BAR; PG8_WAIT_L(0); PG8_MMA(1, 0, At, B0); PG8_BAR; PG8_SCHED;
            PG8_STAGE(PG8_SB(0, 1), b2 + hstep, voffB);
            PG8_WAIT_V(6); PG8_BAR; PG8_MMA(1, 1, At, B1); PG8_BAR;
            PG8_LDB(B0, 1, 0); PG8_SCHED; PG8_LDA(At, 1, 0); PG8_STAGE(PG8_SA(0, 1), a2 + hstep, voffA);
            PG8_WAIT_L(8); PG8_BAR; PG8_WAIT_L(0); PG8_MMA(0, 0, At, B0); PG8_BAR; PG8_SCHED;
            PG8_LDB(B1, 1, 1); PG8_STAGE(PG8_SB(1, 0), b3, voffB);
            PG8_BAR; PG8_WAIT_L(0); PG8_MMA(0, 1, At, B1); PG8_BAR;
            PG8_LDA(At, 1, 1); PG8_STAGE(PG8_SA(1, 0), a3, voffA);
            PG8_BAR; PG8_WAIT_L(0); PG8_MMA(1, 0, At, B0); PG8_BAR; PG8_SCHED;
            PG8_STAGE(PG8_SB(1, 1), b3 + hstep, voffB);
            PG8_WAIT_V(6); PG8_BAR; PG8_MMA(1, 1, At, B1); PG8_BAR;
            }
        }
        if constexpr (ALIGN_EPI) { if (wr == 0) PG8_BAR; }
        if constexpr (!Epi::AFTER_DRAIN) { E(acc, cur, wr, wc, fr, fq); S.done(cur); }
        if (!has_next) break;
#pragma unroll
        for (int a = 0; a < 2; ++a)
#pragma unroll
            for (int b = 0; b < 2; ++b)
#pragma unroll
                for (int m = 0; m < 4; ++m)
#pragma unroll
                    for (int n = 0; n < 2; ++n) acc[a][b][m][n] = (f32x4){0.f, 0.f, 0.f, 0.f};
        cur = nxt; cA = nA; cB = nB; ++ui;
        if constexpr (ALIGN_EPI) { if (wr == 1) PG8_BAR; }
    }
    PG8_WAIT_V(0);
    if constexpr (!ALIGN_EPI) { if (wr == 0) PG8_BAR; }
    PG8_BAR;
    if constexpr (Epi::AFTER_DRAIN) { E.fused(acc, cur, wr, wc, fr, fq, lds, wid, lane); S.done(cur); }
#undef PG8_SA
#undef PG8_SB
#undef PG8_STAGE
#undef PG8_LDA
#undef PG8_LDB
#undef PG8_MMA
#undef PG8_WAIT_V
#undef PG8_WAIT_L
#undef PG8_BAR
#undef PG8_SCHED
}
}

struct Frame {
    LAS unsigned char* lds;
    int tid, lane, wave, vcu, G;
    const float *x, *c, *ctx, *c_ctx, *ada_w, *ada_b, *norm_attn_g, *norm_ffn_g, *ev_w_in, *ev_w_out, *na_rpb, *conv_w, *conv_b, *dt_bias, *a_log, *ssm_d, *ssm_norm_g,
        *ffn_w1, *ffn_w3, *ffn_w2, *od_w_in, *od_w_out, *swa_sink, *ret_log_decay, *ret_gn_g, *ret_gn_b, *moe_router, *moe_w1, *moe_w3, *moe_w2, *final_g;
    float* out;
    float *MOD, *GATE, *ROPE, *X;
    bf16 *WIN0, *WOUT0, *WF13, *WF2, *WIN1, *WOUT1, *WM13, *WM2, *H, *P, *YA0, *YA1, *XBC, *YF0, *YB0, *YF1, *YB1, *Gh, *MG, *HP;
    unsigned* ctl;
    int *TOPK, *SLOT, *CNT, *TILEE, *MMETA; float *Y2T, *PART;
};

__device__ __forceinline__ void tr_item(const float* W, int K, int N, bf16* WT, int ilv, LAS float* scr, int item, int lane, int ldk = 0) {
    if (ldk == 0) ldk = K;
    const int nblk = N / 32, kb = item / nblk, nb = item % nblk, k0 = 64 * kb, n0 = 32 * nb;
#pragma unroll 8
    for (int i = 0; i < 32; ++i) { const int kk = 2 * i + (lane >> 5); scr[kk * 33 + (lane & 31)] = __builtin_nontemporal_load(W + (size_t)(k0 + kk) * N + n0 + (lane & 31)); }
    LDS_WAIT(); asm volatile("" ::: "memory");
    const int c = lane & 7;
#pragma unroll
    for (int j = 0; j < 4; ++j) { const int n = (lane >> 3) + 8 * j; const LAS float* s = scr + (8 * c) * 33 + n;
        v4u o; o.x = pk2(s[0 * 33], s[1 * 33]); o.y = pk2(s[2 * 33], s[3 * 33]); o.z = pk2(s[4 * 33], s[5 * 33]); o.w = pk2(s[6 * 33], s[7 * 33]);
        const int nn = n0 + n; int row = nn;
        if (ilv == 1 || ilv == 2) row = 8 * (nn >> 2) + (nn & 3) + (ilv == 2 ? 4 : 0);
        if (ilv == 3 && (nn < 640 || (nn >= 768 && nn < 1792))) row = (nn & ~63) + 8 * ((nn & 31) >> 2) + 4 * ((nn >> 5) & 1) + (nn & 3);
        __builtin_nontemporal_store(o, (v4u*)(WT + (size_t)row * ldk + k0 + 8 * c)); }
    LDS_WAIT(); asm volatile("" ::: "memory");
}

__device__ __forceinline__ void ph_cvt(const Frame& F) {
    LAS float* scr = (LAS float*)(F.lds + F.wave * 16384);
    const int gw = F.vcu * NWAVES + F.wave, NGW = F.G * NWAVES;
    constexpr int I_IN0 = 16 * 129, I_OUT = 24 * 32, I_F1 = 16 * 88, I_F2 = 44 * 32, I_IN1 = 16 * 120;
    constexpr int NITEMS = I_IN0 + I_OUT + 2 * I_F1 + I_F2 + I_IN1 + I_OUT;
    for (int it = gw; it < NITEMS; it += NGW) {
        int r = it;
        if (r < I_IN0) { tr_item(F.ev_w_in, 1024, 4128, F.WIN0, 0, scr, r, F.lane); continue; } r -= I_IN0;
        if (r < I_OUT) { tr_item(F.ev_w_out, 1536, 1024, F.WOUT0, 0, scr, r, F.lane); continue; } r -= I_OUT;
        if (r < I_F1) { tr_item(F.ffn_w1, 1024, DFF, F.WF13, 1, scr, r, F.lane); continue; } r -= I_F1;
        if (r < I_F1) { tr_item(F.ffn_w3, 1024, DFF, F.WF13, 2, scr, r, F.lane); continue; } r -= I_F1;
        if (r < I_F2) { tr_item(F.ffn_w2, DFF, 1024, F.WF2, 0, scr, r, F.lane); continue; } r -= I_F2;
        if (r < I_IN1) { tr_item(F.od_w_in, 1024, LDP1, F.WIN1, 3, scr, r, F.lane); continue; } r -= I_IN1;
        tr_item(F.od_w_out, 1536, 1024, F.WOUT1, 0, scr, r, F.lane, LDYA1);
    }
    { const int gt = F.vcu * 512 + F.tid, NGT = F.G * 512; v4u* z = (v4u*)(F.WIN0 + (size_t)4128 * 1024);
      for (int i = gt; i < 224 * 1024 / 8; i += NGT) z[i] = (v4u){0u, 0u, 0u, 0u}; }
    { const int gt = F.vcu * 512 + F.tid, NGT = F.G * 512;
      for (int i = gt; i < 2048 * 32; i += NGT) { const int t = i >> 5, f = i & 31; const float inv = powf(10000.f, -(float)(f & 15) / 16.f);
          const float ang = (float)((f < 16) ? (t >> 6) : (t & 63)) * inv; float sn, cs; sincosf(ang, &sn, &cs); F.ROPE[2 * i] = cs; F.ROPE[2 * i + 1] = sn; } }
    __syncthreads();
    LAS float* sv = (LAS float*)F.lds;
    LAS float* part = (LAS float*)(F.lds + 36864);
    for (int it = F.vcu; it < 192; it += F.G) {
        const int l = it / 96, n0 = (it % 96) * 64;
        for (int i = F.tid; i < 9 * 1024; i += 512) { const int r = i >> 10, k = i & 1023; const float v = (r < 8) ? F.c[r * 1024 + k] : F.c_ctx[k]; sv[i] = silu_f(v); }
        __syncthreads();
        float acc[9];
#pragma unroll
        for (int r = 0; r < 9; ++r) acc[r] = 0.f;
        const float* wp = F.ada_w + (size_t)l * 1024 * 6144 + n0 + F.lane;
        for (int k = F.wave * 128; k < F.wave * 128 + 128; ++k) { const float w = wp[(size_t)k * 6144];
#pragma unroll
            for (int r = 0; r < 9; ++r) acc[r] += sv[r * 1024 + k] * w; }
#pragma unroll
        for (int r = 0; r < 9; ++r) part[(F.wave * 9 + r) * 64 + F.lane] = acc[r];
        __syncthreads();
        for (int i = F.tid; i < 9 * 64; i += 512) { const int r = i >> 6, n = i & 63; float s = 0.f;
#pragma unroll
            for (int w = 0; w < 8; ++w) s += part[(w * 9 + r) * 64 + n];
            F.MOD[(size_t)(l * 9 + r) * 6144 + n0 + n] = s + F.ada_b[l * 6144 + n0 + n]; }
        __syncthreads();
    }
}

__device__ __forceinline__ int cvt_claim(const Frame& F, int word, int n) {
    int it = 0;
    if (F.lane == 0) it = (int)__hip_atomic_fetch_add(F.ctl + word, (unsigned)n, __ATOMIC_RELAXED, __HIP_MEMORY_SCOPE_AGENT);
    return __builtin_amdgcn_readfirstlane(it);
}
__device__ __forceinline__ bool cvt_pull(const Frame& F, int budget, bool allow13) {
    LAS float* scr = (LAS float*)(F.lds + F.wave * 16384);
    constexpr int I_1 = 16 * 112, I_2 = 56 * 32, N2 = NEXP * I_2, N13 = NEXP * 2 * I_1;
    int left = budget;
    { const int b = cvt_claim(F, CW_Q2, budget);
      for (int it = b; it < b + budget && it < N2; ++it) { const int e = it / I_2, r = it % I_2; tr_item(F.moe_w2 + (size_t)e * DFE * 1024, DFE, 1024, F.WM2 + (size_t)e * 1024 * DFE, 0, scr, r, F.lane); --left; } }
    if (left == 0) return true;
    if (!allow13) return false;
    const int b = cvt_claim(F, CW_Q13, left);
    if (b >= N13) return false;
    for (int it = b; it < b + left && it < N13; ++it) { const int e = it / (2 * I_1), r = it % (2 * I_1);
        if (r < I_1) tr_item(F.moe_w1 + (size_t)e * 1024 * DFE, 1024, DFE, F.WM13 + (size_t)e * 7168 * LDHP, 1, scr, r, F.lane, LDHP);
        else tr_item(F.moe_w3 + (size_t)e * 1024 * DFE, 1024, DFE, F.WM13 + (size_t)e * 7168 * LDHP, 2, scr, r - I_1, F.lane, LDHP); }
    return true;
}
__device__ __forceinline__ void cvt_drain(const Frame& F) {
    LAS float* scr = (LAS float*)(F.lds + F.wave * 16384);
    constexpr int I_1 = 16 * 112, I_2 = 56 * 32, N2 = NEXP * I_2, N13 = NEXP * 2 * I_1, CH = 16;
    for (;;) { const int b = cvt_claim(F, CW_Q2, CH); if (b >= N2) break;
        for (int it = b; it < b + CH && it < N2; ++it) { const int e = it / I_2, r = it % I_2; tr_item(F.moe_w2 + (size_t)e * DFE * 1024, DFE, 1024, F.WM2 + (size_t)e * 1024 * DFE, 0, scr, r, F.lane); } }
    for (;;) { const int b = cvt_claim(F, CW_Q13, CH); if (b >= N13) break;
        for (int it = b; it < b + CH && it < N13; ++it) { const int e = it / (2 * I_1), r = it % (2 * I_1);
            if (r < I_1) tr_item(F.moe_w1 + (size_t)e * 1024 * DFE, 1024, DFE, F.WM13 + (size_t)e * 7168 * LDHP, 1, scr, r, F.lane, LDHP);
            else tr_item(F.moe_w3 + (size_t)e * 1024 * DFE, 1024, DFE, F.WM13 + (size_t)e * 7168 * LDHP, 2, scr, r - I_1, F.lane, LDHP); } }
}
__device__ __forceinline__ bool short_round(const Frame& F, int units) { const int rem = units % F.G; return rem != 0 && (int)blockIdx.x >= rem; }

template <int MODE, bool ROUTER, int CTXSUM = 0>
__device__ __forceinline__ void ph_norm(const Frame& F, int layer, int which, int nrows) {
    const int gw = F.vcu * NWAVES + F.wave, NGW = F.G * NWAVES;
    const float* g = (which ? F.norm_ffn_g : F.norm_attn_g) + layer * 1024;
    for (int row = gw; row < nrows; row += NGW) {
        const int bidx = row < TL ? (row >> 11) : 8;
        const float* src = MODE == 0 ? (row < TL ? F.x + (size_t)row * 1024 : F.ctx + (size_t)(row - TL) * 1024) : F.X + (size_t)row * 1024;
        const float* mod = F.MOD + (size_t)(layer * 9 + bidx) * 6144 + (which ? 3 : 0) * 1024;
        const f32x4* xr = (const f32x4*)src + F.lane;
        f32x4 v[4]; float s = 0.f;
#pragma unroll
        for (int j = 0; j < 4; ++j) { v[j] = xr[64 * j];
            if (CTXSUM != 0 && row >= TL) { if (CTXSUM == 1) v[j] = ((const f32x4*)(F.ctx + (size_t)(row - TL) * 1024))[F.lane + 64 * j];
                f32x4 sum = (f32x4){0.f, 0.f, 0.f, 0.f};
#pragma unroll
                for (int sl = 0; sl < 6; ++sl) sum += ((const f32x4*)(F.PART + ((size_t)sl * TC + (row - TL)) * 1024))[F.lane + 64 * j];
                const f32x4 gq = ((const f32x4*)(F.MOD + (size_t)8 * 6144 + (CTXSUM == 1 ? 2 : 5) * 1024))[F.lane + 64 * j];
                v[j] = v[j] + gq * sum; ((f32x4*)(F.X + (size_t)row * 1024))[F.lane + 64 * j] = v[j]; }
            s += (v[j].x * v[j].x + v[j].y * v[j].y) + (v[j].z * v[j].z + v[j].w * v[j].w); }
        const float rstd = 1.0f / sqrtf(wave_sum(s) * (1.f / 1024.f) + EPS);
        unsigned long long* o8 = (unsigned long long*)(F.H + (size_t)row * 1024) + F.lane;
#pragma unroll
        for (int j = 0; j < 4; ++j) {
            const f32x4 gg = ((const f32x4*)g)[F.lane + 64 * j], sh = ((const f32x4*)mod)[F.lane + 64 * j], sc = ((const f32x4*)(mod + 1024))[F.lane + 64 * j];
            v[j] = (v[j] * rstd * gg) * (sc + 1.0f) + sh;
            o8[64 * j] = (unsigned long long)pk2(v[j].x, v[j].y) | ((unsigned long long)pk2(v[j].z, v[j].w) << 32);
        }
        if (ROUTER) {
            float lg[8];
#pragma unroll
            for (int e = 0; e < 8; ++e) lg[e] = 0.f;
#pragma unroll
            for (int j = 0; j < 4; ++j)
#pragma unroll
                for (int i = 0; i < 4; ++i) { const int k = 4 * (F.lane + 64 * j) + i; const f32x4 r0 = ((const f32x4*)(F.moe_router + (size_t)k * 8))[0], r1 = ((const f32x4*)(F.moe_router + (size_t)k * 8))[1];
                    const float hv = v[j][i];
                    lg[0] += hv * r0.x; lg[1] += hv * r0.y; lg[2] += hv * r0.z; lg[3] += hv * r0.w; lg[4] += hv * r1.x; lg[5] += hv * r1.y; lg[6] += hv * r1.z; lg[7] += hv * r1.w; }
#pragma unroll
            for (int e = 0; e < 8; ++e) lg[e] = wave_sum(lg[e]);
            int i0 = 0; float v0 = lg[0];
#pragma unroll
            for (int e = 1; e < 8; ++e) if (lg[e] > v0) { v0 = lg[e]; i0 = e; }
            int i1 = -1; float v1 = -3.0e38f;
#pragma unroll
            for (int e = 0; e < 8; ++e) if (e != i0 && lg[e] > v1) { v1 = lg[e]; i1 = e; }
            const float e1 = __expf(v1 - v0), g0 = 1.f / (1.f + e1), g1 = e1 / (1.f + e1);
            if (F.lane < 8) F.GATE[(size_t)row * 8 + F.lane] = (F.lane == i0) ? g0 : ((F.lane == i1) ? g1 : 0.f);
        }
    }
}

template <class Epi>
__device__ __forceinline__ void gemm_simple(const Frame& F, const bf16* A, const bf16* Bt, int M, int N, int K, const Epi& E) {
    const int nN = N / 128, nU = (M / 256) * nN;
    const int wr = F.wave >> 1, wc = F.wave & 1, fr = F.lane & 15, fq = F.lane >> 4;
    for (int u = F.vcu; u < nU; u += F.G) {
        const int pm = u / nN, pn = u % nN, row0 = pm * 256 + wr * 64, col0 = pn * 128 + wc * 64;
        f32x4 acc[4][4];
#pragma unroll
        for (int i = 0; i < 4; ++i)
#pragma unroll
            for (int j = 0; j < 4; ++j) acc[i][j] = (f32x4){0.f, 0.f, 0.f, 0.f};
        const bf16* ap = A + (size_t)(row0 + fr) * K + fq * 8;
        const bf16* bp0 = Bt + (size_t)(col0 + perm32(fr)) * K + fq * 8;
        const bf16* bp1 = Bt + (size_t)(col0 + perm32(16 + fr)) * K + fq * 8;
#pragma unroll 2
        for (int k0 = 0; k0 < K; k0 += 32) {
            bf16x8 a[4], b[4];
#pragma unroll
            for (int i = 0; i < 4; ++i) a[i] = *(const bf16x8*)(ap + (size_t)(16 * i) * K + k0);
            b[0] = *(const bf16x8*)(bp0 + k0); b[1] = *(const bf16x8*)(bp1 + k0);
            b[2] = *(const bf16x8*)(bp0 + (size_t)32 * K + k0); b[3] = *(const bf16x8*)(bp1 + (size_t)32 * K + k0);
#pragma unroll
            for (int i = 0; i < 4; ++i)
#pragma unroll
                for (int j = 0; j < 4; ++j) acc[i][j] = __builtin_amdgcn_mfma_f32_16x16x32_bf16(b[j], a[i], acc[i][j], 0, 0, 0);
        }
#pragma unroll
        for (int i = 0; i < 4; ++i)
#pragma unroll
            for (int q = 0; q < 2; ++q) E(row0 + 16 * i + fr, col0 + 32 * q + 8 * fq, acc[i][2 * q], acc[i][2 * q + 1]);
    }
}

struct EpiStore {
    bf16* O; int ldc;
    __device__ __forceinline__ void operator()(int row, int col, f32x4 lo, f32x4 hi, int part = 0) const {
        v4u w; w.x = pk2(lo.x, lo.y); w.y = pk2(lo.z, lo.w); w.z = pk2(hi.x, hi.y); w.w = pk2(hi.z, hi.w);
        *(v4u*)(O + (size_t)row * ldc + col) = w; }
};
struct EpiSwiglu {
    bf16* O; int ldc;
    __device__ __forceinline__ void operator()(int row, int col, f32x4 lo, f32x4 hi, int part = 0) const {
        v2u w; w.x = pk2(silu_f(lo.x) * hi.x, silu_f(lo.y) * hi.y); w.y = pk2(silu_f(lo.z) * hi.z, silu_f(lo.w) * hi.w);
        *(v2u*)(O + (size_t)row * ldc + (col >> 1)) = w; }
};
struct EpiResid {
    const float* bl; const float* bc; float* X; const float* gate  ; const float* rs; int rs_ld, rs_off;
    __device__ __forceinline__ void operator()(int row, int col, f32x4 lo, f32x4 hi, int part = 0) const {
        const int bidx = row < TL ? (row >> 11) : 8;
        const float* b = row < TL ? bl + (size_t)row * 1024 + col : bc + (size_t)(row - TL) * 1024 + col;
        const float* gp = gate + (size_t)bidx * 6144 + col;
        float sc = 1.f; if (rs) sc = rs[(size_t)row * rs_ld + rs_off];
        const f32x4 g0 = ((const f32x4*)gp)[0] * sc, g1 = ((const f32x4*)gp)[1] * sc;
        const f32x4 b0 = ((const f32x4*)b)[0], b1 = ((const f32x4*)b)[1];
        float* o = X + (size_t)row * 1024 + col;
        ((f32x4*)o)[0] = b0 + g0 * lo; ((f32x4*)o)[1] = b1 + g1 * hi; }
};

struct EpiRope {
    bf16* O; const LAS float* tab;
    __device__ __forceinline__ void operator()(int row, int col, f32x4 lo, f32x4 hi, int part = 0) const {
        if (col < 640 || (col >= 768 && col < 1792)) {
            const int hb = col & ~63, d0 = (col & 63) >> 1;
            f32x4 c01 = (f32x4){1.f, 0.f, 1.f, 0.f}, c23 = (f32x4){1.f, 0.f, 1.f, 0.f};
            if (row < TL) { const int t = row & 2047, pos = (d0 < 16) ? (t >> 6) : 32 + (t & 63); const LAS float* tp = tab + (pos * 16 + (d0 & 15)) * 2; c01 = ((const LAS f32x4*)tp)[0]; c23 = ((const LAS f32x4*)tp)[1]; }
            v2u a, b;
            a.x = pk2(lo.x * c01.x - hi.x * c01.y, lo.y * c01.z - hi.y * c01.w); a.y = pk2(lo.z * c23.x - hi.z * c23.y, lo.w * c23.z - hi.w * c23.w);
            b.x = pk2(hi.x * c01.x + lo.x * c01.y, hi.y * c01.z + lo.y * c01.w); b.y = pk2(hi.z * c23.x + lo.z * c23.y, hi.w * c23.z + lo.w * c23.w);
            *(v2u*)(O + (size_t)row * LDP1 + hb + d0) = a; *(v2u*)(O + (size_t)row * LDP1 + hb + 32 + d0) = b;
        } else { v4u w; w.x = pk2(lo.x, lo.y); w.y = pk2(lo.z, lo.w); w.z = pk2(hi.x, hi.y); w.w = pk2(hi.z, hi.w); *(v4u*)(O + (size_t)row * LDP1 + col) = w; }
    }
};
struct In1Order {
    int G, c;
    __device__ __forceinline__ bool next(int i, pg8::Unit& u) const {
        const int L0 = i * G + c; if (L0 >= 1016) return false;
        const int L = (L0 & 7) * 127 + (L0 >> 3);
        if (L < 960) { const int grp = L / 120, rem = L % 120; u.pm = grp * 8 + (rem & 7); u.pn = rem >> 3; }
        else { const int q = L - 960, j = q >> 3; u.pm = 64 + (q & 7); u.pn = (j == 0) ? 2 : 4 + j; }
        u.k0 = 0; u.nk = 0; return true; }
    __device__ __forceinline__ void a_ready(const pg8::Unit&) const {}
    __device__ __forceinline__ void done(const pg8::Unit&) const {}
};
struct EpiNull {
    __device__ __forceinline__ void operator()(int row, int col, f32x4 lo, f32x4 hi, int part = 0) const { asm volatile("" :: "v"(lo), "v"(hi), "v"(row), "v"(col)); }
};
template <class F8> struct EpiAdapt {
    static constexpr bool PERM = true, AFTER_DRAIN = false;
    F8 f;
    __device__ __forceinline__ void operator()(const pg8::f32x4 (&acc)[2][2][4][2], const pg8::Unit& u, int wr, int wc, int fr, int fq) const {
#pragma unroll
        for (int ai = 0; ai < 2; ++ai)
#pragma unroll
            for (int m = 0; m < 4; ++m) { const int row = u.pm * 256 + ai * 128 + wr * 64 + m * 16 + fr;
#pragma unroll
                for (int bj = 0; bj < 2; ++bj) f(row, u.pn * 256 + bj * 128 + wc * 32 + 8 * fq, acc[ai][bj][m][0], acc[ai][bj][m][1], u.nk != 0 ? 1 + u.k0 : 0);
                if (m & 1) asm volatile("" ::: "memory"); }
    }
};
#ifndef USE_SIMPLE_GEMM
#define USE_SIMPLE_GEMM 0
#endif
template <class F8>
__device__ __forceinline__ void gemm_pg8(const Frame& F, const bf16* A, const bf16* Bt, int M, int N, int K, const F8& f, int ld = 0) {
#if USE_SIMPLE_GEMM
    gemm_simple(F, A, Bt, M, N, K, f);
#else
    pg8::Gemm g{A, Bt, M, N, K, ld}; pg8::StaticOrder S; S.init(M, N, F.G, (int)blockIdx.x);
    EpiAdapt<F8> E{f};
    pg8::gemm_phase<EpiAdapt<F8>, pg8::StaticOrder, true, true>(F.lds, g, S, E);
#endif
}

struct EpiResidTail {
    EpiResid R; float* part; int kslice;
    __device__ __forceinline__ void operator()(int row, int col, f32x4 lo, f32x4 hi, int p = 0) const {
        if (p == 0) { R(row, col, lo, hi, 0); return; }
        float* o = part + ((size_t)((p - 1) / kslice) * TC + (row - TL)) * 1024 + col; ((f32x4*)o)[0] = lo; ((f32x4*)o)[1] = hi; }
};
struct TailOrder {
    pg8::StaticOrder S0; int G, c, K;
    __device__ __forceinline__ void init(int G_, int c_, int K_) { S0.init(TL, 1024, G_, c_); G = G_; c = c_; K = K_; }
    __device__ __forceinline__ bool next(int i, pg8::Unit& u) const {
        const int r0 = (256 + G - 1) / G;
        if (i < r0) return S0.next(i, u);
        const int q = (i - r0) * G + c; if (q >= 32 * 6) return false;
        const int bu = q & 31, sl = q >> 5; u.pm = 64 + (bu >> 2); u.pn = bu & 3;
        if (K == 1536) { u.k0 = sl * 256; u.nk = 4; } else { u.k0 = sl * 512; u.nk = (sl == 5) ? 4 : 8; }
        return true; }
    __device__ __forceinline__ void a_ready(const pg8::Unit&) const {}
    __device__ __forceinline__ void done(const pg8::Unit&) const {}
};
template <class F8>
__device__ __forceinline__ void gemm_tail(const Frame& F, const bf16* A, const bf16* Bt, int K, const F8& f) {
    pg8::Gemm g{A, Bt, TT, 1024, K, 0}; TailOrder S; S.init(F.G, (int)blockIdx.x, K);
    EpiAdapt<F8> E{f};
    pg8::gemm_phase<EpiAdapt<F8>, TailOrder, true, true>(F.lds, g, S, E);
}

#define DOT64(s, q, kp) do { s = 0.f; _Pragma("unroll") for (int _c = 0; _c < 8; ++_c) { const v4u _w = ((const v4u*)(kp))[_c]; \
    s += q[8*_c+0] * bflo(_w.x) + q[8*_c+1] * bfhi(_w.x) + q[8*_c+2] * bflo(_w.y) + q[8*_c+3] * bfhi(_w.y) + q[8*_c+4] * bflo(_w.z) + q[8*_c+5] * bfhi(_w.z) + q[8*_c+6] * bflo(_w.w) + q[8*_c+7] * bfhi(_w.w); } } while (0)
#define ONLINE_UPD(s, m, l, o, vp) do { if (s > m) { const float _cr = __expf(m - s); l *= _cr; _Pragma("unroll") for (int _d = 0; _d < 64; ++_d) o[_d] *= _cr; m = s; } \
    const float _p = __expf(s - m); l += _p; _Pragma("unroll") for (int _c = 0; _c < 8; ++_c) { const v4u _w = ((const v4u*)(vp))[_c]; \
    o[8*_c+0] += _p * bflo(_w.x); o[8*_c+1] += _p * bfhi(_w.x); o[8*_c+2] += _p * bflo(_w.y); o[8*_c+3] += _p * bfhi(_w.y); o[8*_c+4] += _p * bflo(_w.z); o[8*_c+5] += _p * bfhi(_w.z); o[8*_c+6] += _p * bflo(_w.w); o[8*_c+7] += _p * bfhi(_w.w); } } while (0)
#define LOADQ64(q, qp, scale) do { _Pragma("unroll") for (int _c = 0; _c < 8; ++_c) { const v4u _w = ((const v4u*)(qp))[_c]; \
    q[8*_c+0] = scale * bflo(_w.x); q[8*_c+1] = scale * bfhi(_w.x); q[8*_c+2] = scale * bflo(_w.y); q[8*_c+3] = scale * bfhi(_w.y); q[8*_c+4] = scale * bflo(_w.z); q[8*_c+5] = scale * bfhi(_w.z); q[8*_c+6] = scale * bflo(_w.w); q[8*_c+7] = scale * bfhi(_w.w); } } while (0)
#define STORE_O64(op, o, inv) do { _Pragma("unroll") for (int _c = 0; _c < 8; ++_c) { v4u _w; _w.x = pk2(o[8*_c+0] * inv, o[8*_c+1] * inv); _w.y = pk2(o[8*_c+2] * inv, o[8*_c+3] * inv); \
    _w.z = pk2(o[8*_c+4] * inv, o[8*_c+5] * inv); _w.w = pk2(o[8*_c+6] * inv, o[8*_c+7] * inv); ((v4u*)(op))[_c] = _w; } } while (0)

__device__ __forceinline__ void ph_conv(const Frame& F) {
    const int gt = F.vcu * 512 + F.tid, NGT = F.G * 512;
    for (int idx = gt; idx < TT * 192; idx += NGT) {
        const int row = idx / 192, ch = (idx % 192) * 8;
        int t, len; if (row < TL) { t = row & 2047; len = 2048; } else { t = (row - TL) & 255; len = 256; }
        float acc[8];
#pragma unroll
        for (int j = 0; j < 8; ++j) acc[j] = F.conv_b[ch + j];
#pragma unroll
        for (int k = 0; k < 5; ++k) { const int tt = t + k - 2;
            if (tt >= 0 && tt < len) { const v4u w = *(const v4u*)(F.P + (size_t)(row + k - 2) * LDP0 + 2560 + ch); const float* cw = F.conv_w + k * 1536 + ch;
                acc[0] += cw[0] * bflo(w.x); acc[1] += cw[1] * bfhi(w.x); acc[2] += cw[2] * bflo(w.y); acc[3] += cw[3] * bfhi(w.y);
                acc[4] += cw[4] * bflo(w.z); acc[5] += cw[5] * bfhi(w.z); acc[6] += cw[6] * bflo(w.w); acc[7] += cw[7] * bfhi(w.w); } }
        v4u o; o.x = pk2(silu_f(acc[0]), silu_f(acc[1])); o.y = pk2(silu_f(acc[2]), silu_f(acc[3])); o.z = pk2(silu_f(acc[4]), silu_f(acc[5])); o.w = pk2(silu_f(acc[6]), silu_f(acc[7]));
        *(v4u*)(F.XBC + (size_t)row * 1536 + ch) = o;
    }
}

__device__ __forceinline__ int scan_row(int b, int d, int s) {
    if (s < 256) return TL + b * 256 + (d ? 255 - s : s);
    const int t = s - 256; return b * 2048 + (d ? 2047 - t : t);
}

typedef short s16x4 __attribute__((ext_vector_type(4)));
__device__ __forceinline__ s16x4 lds_tr(const LAS unsigned char* p) { return __builtin_bit_cast(s16x4, __builtin_amdgcn_ds_read_tr16_b64_v4i16((LAS s16x4*)p)); }
__device__ __forceinline__ bf16x8 cat8(s16x4 a, s16x4 b) { return __builtin_shufflevector(a, b, 0, 1, 2, 3, 4, 5, 6, 7); }
template <int NST, bool RET>
__device__ __forceinline__ void chunk_scan(const Frame& F) {
    constexpr int SC = NST * 2 + 16, SX = 64 * 2 + 16, SH = NST * 2 + 16, NKS = NST / 32, NHT = NST / 32, NP = NST / 32  , PPR = NST / 8  ;
    LAS unsigned char* Cs = F.lds;
    LAS unsigned char* Bs = Cs + 128 * SC;
    LAS unsigned char* Xs = Bs + 128 * SC;
    LAS unsigned char* Xw = Xs + 128 * SX;
    LAS unsigned char* Hs = Xw + 128 * SX;
    LAS float* acs = (LAS float*)(Hs + 64 * SH);
    LAS float* dts = acs + 128;
    const int w = F.wave, lane = F.lane, l15 = lane & 15, g = lane >> 4, q4 = l15 >> 2, p4 = lane & 3;
    for (int u = F.vcu; u < 256; u += F.G) {
        int d, h, b, grp = 0, ph = 0;
        if (RET) { ph = u & 1; d = (u >> 1) & 1; h = (u >> 2) & 7; b = u >> 5; } else { d = u & 1; h = (u >> 1) & 15; b = u >> 5; grp = h >> 3; }
        float dtb = 0.f, Acoef = 0.f, lgam = 0.f;
        if (RET) lgam = log1pf(-expf(F.ret_log_decay[d * 8 + h])); else { dtb = F.dt_bias[d * 16 + h]; Acoef = -expf(F.a_log[d * 16 + h]); }
        const int nt = RET ? (w & 3) : w, pt0 = RET ? 2 * (w >> 2) : 0;
        const int ycol = RET ? h * 128 + ph * 64 : h * 64;
        bf16* Y = RET ? (d ? F.YB1 : F.YF1) : (d ? F.YB0 : F.YF0);
        f32x4 Hacc[NHT];
#pragma unroll
        for (int k = 0; k < NHT; ++k) Hacc[k] = (f32x4){0.f, 0.f, 0.f, 0.f};
        __syncthreads();
        for (int idx = F.tid; idx < 64 * SH / 16; idx += 512) ((LAS v4u*)Hs)[idx] = (v4u){0u, 0u, 0u, 0u};
        v4u rc[NP], rb[NP], rx[2]; unsigned short rdt0 = 0, rdt1 = 0;
#define SCAN_ISSUE(ck_) do { \
            _Pragma("unroll") for (int k = 0; k < NP; ++k) { const int idx = F.tid + 512 * k, i = idx / PPR, c = idx % PPR; const size_t row = scan_row(b, d, (ck_) * 128 + i); \
                if (RET) { const bf16* pr = F.P + row * LDP1 + h * 64 + c * 8; rc[k] = *(const v4u*)(pr + 768); rb[k] = *(const v4u*)(pr + 1280); } \
                else { const bf16* pr = F.XBC + row * 1536 + grp * 128 + c * 8; rc[k] = *(const v4u*)(pr + 1280); rb[k] = *(const v4u*)(pr + 1024); } } \
            _Pragma("unroll") for (int k = 0; k < 2; ++k) { const int idx = F.tid + 512 * k, i = idx >> 3, c = idx & 7; const size_t row = scan_row(b, d, (ck_) * 128 + i); \
                rx[k] = RET ? *(const v4u*)(F.P + row * LDP1 + 1792 + h * 128 + ph * 64 + c * 8) : *(const v4u*)(F.XBC + row * 1536 + h * 64 + c * 8); } \
            if (!RET) { rdt0 = F.P[(size_t)scan_row(b, d, (ck_) * 128 + lane) * LDP0 + 4096 + d * 16 + h]; rdt1 = F.P[(size_t)scan_row(b, d, (ck_) * 128 + 64 + lane) * LDP0 + 4096 + d * 16 + h]; } \
        } while (0)
        SCAN_ISSUE(0);
        for (int ck = 0; ck < 18; ++ck) {
            float atot;
            { float dt0 = 1.f, dt1 = 1.f, a0 = lgam, a1 = lgam;
              if (!RET) { const float x0 = bf2f(rdt0) + dtb, x1 = bf2f(rdt1) + dtb;
                  dt0 = x0 > 20.f ? x0 : log1pf(__expf(x0)); dt1 = x1 > 20.f ? x1 : log1pf(__expf(x1)); a0 = dt0 * Acoef; a1 = dt1 * Acoef; }
              float v0 = a0, v1 = a1;
#pragma unroll
              for (int o = 1; o < 64; o <<= 1) { const float n0 = __shfl_up(v0, o), n1 = __shfl_up(v1, o); if (lane >= o) { v0 += n0; v1 += n1; } }
              v1 += __shfl(v0, 63); atot = __shfl(v1, 63);
              acs[lane] = v0; acs[64 + lane] = v1; dts[lane] = dt0; dts[64 + lane] = dt1; }
            LDS_WAIT(); asm volatile("" ::: "memory");
#pragma unroll
            for (int k = 0; k < NP; ++k) { const int idx = F.tid + 512 * k, i = idx / PPR, c = idx % PPR;
                v4u kv = rb[k];
                if (RET) { kv.x = pk2(0.125f * bflo(kv.x), 0.125f * bfhi(kv.x)); kv.y = pk2(0.125f * bflo(kv.y), 0.125f * bfhi(kv.y)); kv.z = pk2(0.125f * bflo(kv.z), 0.125f * bfhi(kv.z)); kv.w = pk2(0.125f * bflo(kv.w), 0.125f * bfhi(kv.w)); }
                *(LAS v4u*)(Cs + i * SC + c * 16) = rc[k]; *(LAS v4u*)(Bs + i * SC + c * 16) = kv; }
#pragma unroll
            for (int k = 0; k < 2; ++k) { const int idx = F.tid + 512 * k, i = idx >> 3, c = idx & 7; const v4u xv = rx[k];
                const float dtj = dts[i], wj = dtj * __expf(atot - acs[i]);
                v4u a, bq; a.x = pk2(dtj * bflo(xv.x), dtj * bfhi(xv.x)); a.y = pk2(dtj * bflo(xv.y), dtj * bfhi(xv.y)); a.z = pk2(dtj * bflo(xv.z), dtj * bfhi(xv.z)); a.w = pk2(dtj * bflo(xv.w), dtj * bfhi(xv.w));
                bq.x = pk2(wj * bflo(xv.x), wj * bfhi(xv.x)); bq.y = pk2(wj * bflo(xv.y), wj * bfhi(xv.y)); bq.z = pk2(wj * bflo(xv.z), wj * bfhi(xv.z)); bq.w = pk2(wj * bflo(xv.w), wj * bfhi(xv.w));
                *(LAS v4u*)(Xs + i * SX + c * 16) = a; *(LAS v4u*)(Xw + i * SX + c * 16) = bq; }
            if (ck + 1 < 18) SCAN_ISSUE(ck + 1);
            __syncthreads();
            if (!RET || ck >= 2) {
                const float aci = acs[16 * w + l15];
                bf16x8 Cf[NKS];
#pragma unroll
                for (int s = 0; s < NKS; ++s) Cf[s] = *(const LAS bf16x8*)(Cs + (16 * w + l15) * SC + (32 * s + 8 * g) * 2);
                f32x4 Yacc[4];
                const float eaci = __expf(aci);
#pragma unroll
                for (int pt = 0; pt < 4; ++pt) { f32x4 acc = (f32x4){0.f, 0.f, 0.f, 0.f};
#pragma unroll
                    for (int s = 0; s < NKS; ++s) { const bf16x8 hf = *(const LAS bf16x8*)(Hs + (16 * pt + l15) * SH + (32 * s + 8 * g) * 2); acc = __builtin_amdgcn_mfma_f32_16x16x32_bf16(hf, Cf[s], acc, 0, 0, 0); }
                    Yacc[pt] = acc * eaci; }
#pragma unroll
                for (int sp = 0; sp < 4; ++sp) {
                    if (2 * sp <= w) {
                        v2u Lh[2];
#pragma unroll
                        for (int hh = 0; hh < 2; ++hh) { const int jt = 2 * sp + hh;
                            if (jt <= w) { f32x4 cb = (f32x4){0.f, 0.f, 0.f, 0.f};
#pragma unroll
                                for (int s = 0; s < NKS; ++s) { const bf16x8 bf = *(const LAS bf16x8*)(Bs + (16 * jt + l15) * SC + (32 * s + 8 * g) * 2); cb = __builtin_amdgcn_mfma_f32_16x16x32_bf16(bf, Cf[s], cb, 0, 0, 0); }
                                const f32x4 acj = *(const LAS f32x4*)(acs + 16 * jt + 4 * g);
                                float val[4];
#pragma unroll
                                for (int r = 0; r < 4; ++r) { const float arg = fminf(aci - acj[r], 0.f); val[r] = cb[r] * __expf(arg); if (jt == w && (4 * g + r) > l15) val[r] = 0.f; }
                                Lh[hh].x = pk2(val[0], val[1]); Lh[hh].y = pk2(val[2], val[3]); }
                            else { Lh[hh].x = 0u; Lh[hh].y = 0u; } }
                        v4u lw; lw.x = Lh[0].x; lw.y = Lh[0].y; lw.z = Lh[1].x; lw.w = Lh[1].y;
                        const bf16x8 Lf = __builtin_bit_cast(bf16x8, lw);
#pragma unroll
                        for (int pt = 0; pt < 4; ++pt) { const s16x4 x0 = lds_tr(Xs + (32 * sp + 4 * g + q4) * SX + (16 * pt + 4 * p4) * 2), x1 = lds_tr(Xs + (32 * sp + 16 + 4 * g + q4) * SX + (16 * pt + 4 * p4) * 2);
                            Yacc[pt] = __builtin_amdgcn_mfma_f32_16x16x32_bf16(cat8(x0, x1), Lf, Yacc[pt], 0, 0, 0); }
                    }
                }
                const size_t row = scan_row(b, d, ck * 128 + 16 * w + l15);
#pragma unroll
                for (int pt = 0; pt < 4; ++pt) { v2u o; o.x = pk2(Yacc[pt].x, Yacc[pt].y); o.y = pk2(Yacc[pt].z, Yacc[pt].w); *(v2u*)(Y + row * 1024 + ycol + 16 * pt + 4 * g) = o; }
            }
            if (ck < 17) {
                const float eat = __expf(atot);
#pragma unroll
                for (int k = 0; k < NHT; ++k) Hacc[k] = Hacc[k] * eat;
#pragma unroll
                for (int s = 0; s < 4; ++s) {
                    const s16x4 b0 = lds_tr(Bs + (32 * s + 8 * g + q4) * SC + (16 * nt + 4 * p4) * 2), b1 = lds_tr(Bs + (32 * s + 8 * g + 4 + q4) * SC + (16 * nt + 4 * p4) * 2);
                    const bf16x8 Bf = cat8(b0, b1);
#pragma unroll
                    for (int k = 0; k < NHT; ++k) { const int pt = pt0 + k;
                        const s16x4 x0 = lds_tr(Xw + (32 * s + 8 * g + q4) * SX + (16 * pt + 4 * p4) * 2), x1 = lds_tr(Xw + (32 * s + 8 * g + 4 + q4) * SX + (16 * pt + 4 * p4) * 2);
                        Hacc[k] = __builtin_amdgcn_mfma_f32_16x16x32_bf16(cat8(x0, x1), Bf, Hacc[k], 0, 0, 0); }
                }
            }
            __syncthreads();
            if (ck < 17) {
#pragma unroll
                for (int k = 0; k < NHT; ++k)
#pragma unroll
                    for (int r = 0; r < 4; ++r) *(LAS bf16*)(Hs + (16 * (pt0 + k) + 4 * g + r) * SH + (16 * nt + l15) * 2) = (bf16)f2bf(Hacc[k][r]);
            }
        }
#undef SCAN_ISSUE
    }
}

template <int MODE>
__device__ __forceinline__ void attn16(const Frame& F, int u) {
    constexpr int PITCH = MODE == 2 ? LDP1 : LDP0;
    constexpr int SV = 144, VBUF = 4608;
    LAS unsigned char* vb = F.lds + F.wave * 10240;
    LAS float* btab = (LAS float*)(vb + 2 * VBUF);
    const int lane = F.lane, l15 = lane & 15, g = lane >> 4, q4 = l15 >> 2, p4 = lane & 3;
    int b, h, nloc; size_t qrow0, locbase, ctxbase; int kcol, vcol;
    int r = 0, r0 = 0, jq = 0, kstart = 0, t0 = 0, jb_lo = 0;
    if (MODE == 0) { jq = u & 3; h = (u >> 2) & 7; r = (u >> 5) & 31; b = u >> 10; r0 = min(max(r - 4, 0), 24); kstart = min(max(16 * jq - 8, 0), 32);
        qrow0 = (size_t)b * 2048 + r * 64 + 16 * jq; locbase = (size_t)b * 2048 + r0 * 64 + kstart; nloc = 8; kcol = 512 + h * 64; vcol = 1024 + h * 64; }
    else if (MODE == 1) { const int qt = u & 15; h = (u >> 4) & 7; b = u >> 7; qrow0 = (size_t)TL + b * 256 + qt * 16; locbase = 0; nloc = 0; kcol = 512 + h * 64; vcol = 1024 + h * 64; }
    else { const int hq = u & 3, qt = (u >> 2) & 127, kvh = (u >> 9) & 1; b = u >> 10; h = kvh * 4 + hq; t0 = qt * 16; qrow0 = (size_t)b * 2048 + t0;
        jb_lo = max(t0 - 128, 0) >> 5; const int jb_hi = min(t0 + 15 + 128, 2047) >> 5; nloc = jb_hi - jb_lo + 1; locbase = (size_t)b * 2048 + jb_lo * 32; kcol = 512 + kvh * 64; vcol = 640 + kvh * 64; }
    ctxbase = (size_t)TL + b * 256;
    const int nblk = nloc + 8, nit = (nblk + 1) >> 1;
    const bf16* P = F.P;
    if (MODE == 0) {
#pragma unroll
        for (int k = 0; k < 4; ++k) { const int i = lane + 64 * k, kb = i >> 5, c = i & 31; btab[i] = (c < 31) ? F.na_rpb[(h * 15 + (r0 - r + 7 + kb)) * 31 + c] : 0.f; } }
    bf16x8 qf[2];
#pragma unroll
    for (int s = 0; s < 2; ++s) { const v4u w = *(const v4u*)(P + (qrow0 + l15) * PITCH + h * 64 + 32 * s + 8 * g); v4u o;
        o.x = pk2(0.125f * bflo(w.x), 0.125f * bfhi(w.x)); o.y = pk2(0.125f * bflo(w.y), 0.125f * bfhi(w.y)); o.z = pk2(0.125f * bflo(w.z), 0.125f * bfhi(w.z)); o.w = pk2(0.125f * bflo(w.w), 0.125f * bfhi(w.w));
        qf[s] = __builtin_bit_cast(bf16x8, o); }
    int dc[2][4]; bool okc[2][4];
    if (MODE == 0) { const int qc = 16 * jq + l15, c0 = min(max(qc - 8, 0), 48);
#pragma unroll
        for (int t = 0; t < 2; ++t)
#pragma unroll
            for (int rr = 0; rr < 4; ++rr) { const int kc = kstart + 16 * t + 4 * g + rr; okc[t][rr] = (kc >= c0) && (kc < c0 + 16); dc[t][rr] = min(max(kc - qc + 15, 0), 30); } }
    f32x4 oacc[4];
#pragma unroll
    for (int dt = 0; dt < 4; ++dt) oacc[dt] = (f32x4){0.f, 0.f, 0.f, 0.f};
    float m = -INFINITY, lsum = 0.f;
    bf16x8 kf[2][2][2]; v4u vr[2][4];
#define ATT_LOAD(it_) do { _Pragma("unroll") for (int bb = 0; bb < 2; ++bb) { int kb_ = 2 * (it_) + bb; kb_ = kb_ < nblk ? kb_ : nblk - 1; \
        const size_t rb_ = (kb_ < nloc) ? locbase + (MODE == 0 ? kb_ * 64 : kb_ * 32) : ctxbase + (kb_ - nloc) * 32; \
        _Pragma("unroll") for (int t = 0; t < 2; ++t) _Pragma("unroll") for (int s = 0; s < 2; ++s) kf[bb][t][s] = *(const bf16x8*)(P + (rb_ + 16 * t + l15) * PITCH + kcol + 32 * s + 8 * g); \
        _Pragma("unroll") for (int k = 0; k < 4; ++k) { const int idx = lane + 64 * k; vr[bb][k] = *(const v4u*)(P + (rb_ + (idx >> 3)) * PITCH + vcol + (idx & 7) * 8); } } } while (0)
    ATT_LOAD(0);
    for (int it = 0; it < nit; ++it) {
        f32x4 st[2][2];
#pragma unroll
        for (int bb = 0; bb < 2; ++bb)
#pragma unroll
            for (int t = 0; t < 2; ++t) { f32x4 a = (f32x4){0.f, 0.f, 0.f, 0.f}; a = __builtin_amdgcn_mfma_f32_16x16x32_bf16(kf[bb][t][0], qf[0], a, 0, 0, 0); st[bb][t] = __builtin_amdgcn_mfma_f32_16x16x32_bf16(kf[bb][t][1], qf[1], a, 0, 0, 0); }
#pragma unroll
        for (int bb = 0; bb < 2; ++bb)
#pragma unroll
            for (int k = 0; k < 4; ++k) { const int idx = lane + 64 * k; *(LAS v4u*)(vb + bb * VBUF + (idx >> 3) * SV + (idx & 7) * 16) = vr[bb][k]; }
        asm volatile("" ::: "memory");
        if (it + 1 < nit) ATT_LOAD(it + 1);
#pragma unroll
        for (int bb = 0; bb < 2; ++bb) { const int kb = 2 * it + bb;
            if (kb >= nblk) {
#pragma unroll
                for (int t = 0; t < 2; ++t) st[bb][t] = (f32x4){-INFINITY, -INFINITY, -INFINITY, -INFINITY}; }
            else if (kb < nloc) {
                if (MODE == 0) {
#pragma unroll
                    for (int t = 0; t < 2; ++t)
#pragma unroll
                        for (int rr = 0; rr < 4; ++rr) st[bb][t][rr] = okc[t][rr] ? st[bb][t][rr] + btab[kb * 32 + dc[t][rr]] : -INFINITY; }
                if (MODE == 2) { const int tq = t0 + l15;
#pragma unroll
                    for (int t = 0; t < 2; ++t)
#pragma unroll
                        for (int rr = 0; rr < 4; ++rr) { const int dj = tq - ((jb_lo + kb) * 32 + 16 * t + 4 * g + rr); if (dj > 128 || dj < -128) st[bb][t][rr] = -INFINITY; } }
            } }
        float mx = -INFINITY;
#pragma unroll
        for (int bb = 0; bb < 2; ++bb)
#pragma unroll
            for (int t = 0; t < 2; ++t) mx = fmaxf(mx, fmaxf(fmaxf(st[bb][t][0], st[bb][t][1]), fmaxf(st[bb][t][2], st[bb][t][3])));
        mx = fmaxf(mx, __shfl_xor(mx, 16)); mx = fmaxf(mx, __shfl_xor(mx, 32));
        const float mn = fmaxf(m, mx), mu = (mn == -INFINITY) ? 0.f : mn;
        const float corr = __expf(m - mu);
        m = mn;
        float ps = 0.f; bf16x8 pf[2];
#pragma unroll
        for (int bb = 0; bb < 2; ++bb) { float p[8];
#pragma unroll
            for (int t = 0; t < 2; ++t)
#pragma unroll
                for (int rr = 0; rr < 4; ++rr) { p[4 * t + rr] = __expf(st[bb][t][rr] - mu); ps += p[4 * t + rr]; }
            v4u pw; pw.x = pk2(p[0], p[1]); pw.y = pk2(p[2], p[3]); pw.z = pk2(p[4], p[5]); pw.w = pk2(p[6], p[7]); pf[bb] = __builtin_bit_cast(bf16x8, pw); }
        lsum = lsum * corr + ps;
#pragma unroll
        for (int dt = 0; dt < 4; ++dt) { oacc[dt] = oacc[dt] * corr;
#pragma unroll
            for (int bb = 0; bb < 2; ++bb) {
                const s16x4 v0 = lds_tr(vb + bb * VBUF + (4 * g + q4) * SV + (16 * dt + 4 * p4) * 2), v1 = lds_tr(vb + bb * VBUF + (16 + 4 * g + q4) * SV + (16 * dt + 4 * p4) * 2);
                oacc[dt] = __builtin_amdgcn_mfma_f32_16x16x32_bf16(cat8(v0, v1), pf[bb], oacc[dt], 0, 0, 0); } }
        asm volatile("" ::: "memory");
    }
#undef ATT_LOAD
    lsum += __shfl_xor(lsum, 16); lsum += __shfl_xor(lsum, 32);
    if (MODE == 2) { const float sk = F.swa_sink[h]; const float mn = fmaxf(m, sk); const float corr = __expf(m - mn); lsum = lsum * corr + __expf(sk - mn);
#pragma unroll
        for (int dt = 0; dt < 4; ++dt) oacc[dt] = oacc[dt] * corr; }
    const float inv = 1.f / lsum;
    bf16* orow = (MODE == 2 ? F.YA1 + (qrow0 + l15) * LDYA1 : F.YA0 + (qrow0 + l15) * 1536) + h * 64;
#pragma unroll
    for (int dt = 0; dt < 4; ++dt) { v2u o; o.x = pk2(oacc[dt].x * inv, oacc[dt].y * inv); o.y = pk2(oacc[dt].z * inv, oacc[dt].w * inv); *(v2u*)(orow + 16 * dt + 4 * g) = o; }
}
template <int MODE>
__device__ __forceinline__ void attn_wg(const Frame& F, int item) {
    constexpr int PITCH = MODE == 2 ? LDP1 : LDP0;
    constexpr int SK = 144, TILE = 64 * SK, NH = (MODE == 2) ? 1 : 2, BUFB = NH * 2 * TILE, NPC = NH * 2;
    LAS unsigned char* lds = F.lds;
    LAS float* btab = (LAS float*)(F.lds + 2 * BUFB) + F.wave * 256;
    const int w = F.wave, lane = F.lane, l15 = lane & 15, g = lane >> 4, q4 = l15 >> 2, p4 = lane & 3;
    int b, h, hsel = 0, nloc, kcol0, vcol0; size_t qrow0;
    int r = 0, r0 = 0, jq = 0, kstart = 0, t0w = 0, jb_lo = 0;
    if (MODE == 0) { const int hp = item & 3; r = (item >> 2) & 31; b = item >> 7; hsel = w >> 2; jq = w & 3; h = 2 * hp + hsel; r0 = min(max(r - 4, 0), 24); kstart = min(max(16 * jq - 8, 0), 32);
        qrow0 = (size_t)b * 2048 + r * 64 + 16 * jq; nloc = 8; kcol0 = 512 + 2 * hp * 64; vcol0 = 1024 + 2 * hp * 64; }
    else if (MODE == 1) { const int qg = item & 3, hp = (item >> 2) & 3; b = item >> 4; hsel = w >> 2; h = 2 * hp + hsel; qrow0 = (size_t)TL + b * 256 + qg * 64 + (w & 3) * 16; nloc = 0; kcol0 = 512 + 2 * hp * 64; vcol0 = 1024 + 2 * hp * 64; }
    else { const int qg = item & 63, kvh = (item >> 6) & 1; b = item >> 7; h = kvh * 4 + (w & 3); const int t0 = qg * 32; t0w = t0 + 16 * (w >> 2); qrow0 = (size_t)b * 2048 + t0w;
        jb_lo = max(t0 - 128, 0) >> 6; const int jb_hi = min(t0 + 31 + 128, 2047) >> 6; nloc = jb_hi - jb_lo + 1; kcol0 = 512 + kvh * 64; vcol0 = 640 + kvh * 64; }
    const int nst = nloc + 4;
    const bf16* P = F.P;
    __syncthreads();
    if (MODE == 0) {
#pragma unroll
        for (int k = 0; k < 4; ++k) { const int i = lane + 64 * k, kb = i >> 5, c = i & 31; btab[i] = (c < 31) ? F.na_rpb[(h * 15 + (r0 - r + 7 + kb)) * 31 + c] : 0.f; } }
    bf16x8 qf[2];
#pragma unroll
    for (int s = 0; s < 2; ++s) { const v4u wv = *(const v4u*)(P + (qrow0 + l15) * PITCH + h * 64 + 32 * s + 8 * g); v4u o;
        o.x = pk2(0.125f * bflo(wv.x), 0.125f * bfhi(wv.x)); o.y = pk2(0.125f * bflo(wv.y), 0.125f * bfhi(wv.y)); o.z = pk2(0.125f * bflo(wv.z), 0.125f * bfhi(wv.z)); o.w = pk2(0.125f * bflo(wv.w), 0.125f * bfhi(wv.w));
        qf[s] = __builtin_bit_cast(bf16x8, o); }
    int dc[2][4]; bool okc[2][4];
    if (MODE == 0) { const int qc = 16 * jq + l15, c0 = min(max(qc - 8, 0), 48);
#pragma unroll
        for (int t = 0; t < 2; ++t)
#pragma unroll
            for (int rr = 0; rr < 4; ++rr) { const int kc = kstart + 16 * t + 4 * g + rr; okc[t][rr] = (kc >= c0) && (kc < c0 + 16); dc[t][rr] = min(max(kc - qc + 15, 0), 30); } }
    f32x4 oacc[4];
#pragma unroll
    for (int dt = 0; dt < 4; ++dt) oacc[dt] = (f32x4){0.f, 0.f, 0.f, 0.f};
    float m = -INFINITY, lsum = 0.f;
    v4u pre[NPC];
#define AWG_LOAD(st_) do { const size_t rb_ = ((st_) < nloc) ? (size_t)b * 2048 + (MODE == 0 ? (r0 + (st_)) * 64 : (jb_lo + (st_)) * 64) : (size_t)TL + b * 256 + ((st_) - nloc) * 64; \
        _Pragma("unroll") for (int k = 0; k < NPC; ++k) { const int idx = F.tid + 512 * k, which = idx / (NH * 512), rem = idx % (NH * 512), hh = rem >> 9, key = (rem & 511) >> 3, c = rem & 7; \
            pre[k] = *(const v4u*)(P + (rb_ + key) * PITCH + (which ? vcol0 : kcol0) + hh * 64 + c * 8); } } while (0)
#define AWG_STORE(buf_) do { _Pragma("unroll") for (int k = 0; k < NPC; ++k) { const int idx = F.tid + 512 * k, which = idx / (NH * 512), rem = idx % (NH * 512), hh = rem >> 9, key = (rem & 511) >> 3, c = rem & 7; \
            *(LAS v4u*)(lds + (buf_) * BUFB + (which * NH + hh) * TILE + key * SK + c * 16) = pre[k]; } } while (0)
    AWG_LOAD(0); AWG_STORE(0);
    __syncthreads();
    for (int st = 0; st < nst; ++st) {
        if (st + 1 < nst) AWG_LOAD(st + 1);
        const LAS unsigned char* Kt = lds + (st & 1) * BUFB + hsel * TILE;
        const LAS unsigned char* Vt = lds + (st & 1) * BUFB + (NH + hsel) * TILE;
        const bool loc = st < nloc;
        const int nb = (MODE == 0 && loc) ? 1 : 2, koff0 = (MODE == 0 && loc) ? kstart : 0;
        f32x4 sc[2][2];
#pragma unroll
        for (int bb = 0; bb < 2; ++bb) {
            if (bb < nb) {
#pragma unroll
                for (int t = 0; t < 2; ++t) { const LAS unsigned char* kp = Kt + (koff0 + 32 * bb + 16 * t + l15) * SK + 8 * g * 2;
                    f32x4 a = (f32x4){0.f, 0.f, 0.f, 0.f}; a = __builtin_amdgcn_mfma_f32_16x16x32_bf16(*(const LAS bf16x8*)kp, qf[0], a, 0, 0, 0); sc[bb][t] = __builtin_amdgcn_mfma_f32_16x16x32_bf16(*(const LAS bf16x8*)(kp + 64), qf[1], a, 0, 0, 0); }
                if (loc) {
                    if (MODE == 0) {
#pragma unroll
                        for (int t = 0; t < 2; ++t)
#pragma unroll
                            for (int rr = 0; rr < 4; ++rr) sc[bb][t][rr] = okc[t][rr] ? sc[bb][t][rr] + btab[st * 32 + dc[t][rr]] : -INFINITY; }
                    if (MODE == 2) { const int tq = t0w + l15;
#pragma unroll
                        for (int t = 0; t < 2; ++t)
#pragma unroll
                            for (int rr = 0; rr < 4; ++rr) { const int dj = tq - ((jb_lo + st) * 64 + 32 * bb + 16 * t + 4 * g + rr); if (dj > 128 || dj < -128) sc[bb][t][rr] = -INFINITY; } }
                }
            } else {
#pragma unroll
                for (int t = 0; t < 2; ++t) sc[bb][t] = (f32x4){-INFINITY, -INFINITY, -INFINITY, -INFINITY}; }
        }
        float mx = -INFINITY;
#pragma unroll
        for (int bb = 0; bb < 2; ++bb)
#pragma unroll
            for (int t = 0; t < 2; ++t) mx = fmaxf(mx, fmaxf(fmaxf(sc[bb][t][0], sc[bb][t][1]), fmaxf(sc[bb][t][2], sc[bb][t][3])));
        mx = fmaxf(mx, __shfl_xor(mx, 16)); mx = fmaxf(mx, __shfl_xor(mx, 32));
        const float mn = fmaxf(m, mx), mu = (mn == -INFINITY) ? 0.f : mn;
        const float corr = __expf(m - mu);
        m = mn;
        float ps = 0.f; bf16x8 pf[2];
#pragma unroll
        for (int bb = 0; bb < 2; ++bb) { float p[8];
#pragma unroll
            for (int t = 0; t < 2; ++t)
#pragma unroll
                for (int rr = 0; rr < 4; ++rr) { p[4 * t + rr] = __expf(sc[bb][t][rr] - mu); ps += p[4 * t + rr]; }
            v4u pw; pw.x = pk2(p[0], p[1]); pw.y = pk2(p[2], p[3]); pw.z = pk2(p[4], p[5]); pw.w = pk2(p[6], p[7]); pf[bb] = __builtin_bit_cast(bf16x8, pw); }
        lsum = lsum * corr + ps;
#pragma unroll
        for (int dt = 0; dt < 4; ++dt) { oacc[dt] = oacc[dt] * corr;
#pragma unroll
            for (int bb = 0; bb < 2; ++bb) {
                if (bb < nb) { const LAS unsigned char* vp = Vt + (koff0 + 32 * bb) * SK + (16 * dt + 4 * p4) * 2;
                    const s16x4 v0 = lds_tr(vp + (4 * g + q4) * SK), v1 = lds_tr(vp + (16 + 4 * g + q4) * SK);
                    oacc[dt] = __builtin_amdgcn_mfma_f32_16x16x32_bf16(cat8(v0, v1), pf[bb], oacc[dt], 0, 0, 0); } } }
        if (st + 1 < nst) AWG_STORE((st + 1) & 1);
        __syncthreads();
    }
#undef AWG_LOAD
#undef AWG_STORE
    lsum += __shfl_xor(lsum, 16); lsum += __shfl_xor(lsum, 32);
    if (MODE == 2) { const float sk = F.swa_sink[h]; const float mn = fmaxf(m, sk); const float corr = __expf(m - mn); lsum = lsum * corr + __expf(sk - mn);
#pragma unroll
        for (int dt = 0; dt < 4; ++dt) oacc[dt] = oacc[dt] * corr; }
    const float inv = 1.f / lsum;
    bf16* orow = (MODE == 2 ? F.YA1 + (qrow0 + l15) * LDYA1 : F.YA0 + (qrow0 + l15) * 1536) + h * 64;
#pragma unroll
    for (int dt = 0; dt < 4; ++dt) { v2u o; o.x = pk2(oacc[dt].x * inv, oacc[dt].y * inv); o.y = pk2(oacc[dt].z * inv, oacc[dt].w * inv); *(v2u*)(orow + 16 * dt + 4 * g) = o; }
}
__device__ __forceinline__ void ph_attn0_mfma(const Frame& F) {
    for (int it = F.vcu; it < 1024; it += F.G) attn_wg<0>(F, it);
    for (int it = F.vcu; it < 128; it += F.G) attn_wg<1>(F, it);
}
__device__ __forceinline__ void ph_swa_mfma(const Frame& F) {
    for (int it = F.vcu; it < 1024; it += F.G) attn_wg<2>(F, it);
}

__device__ __forceinline__ void ph_ssmout(const Frame& F) {
    const int gw = F.vcu * NWAVES + F.wave, NGW = F.G * NWAVES;
    for (int row = gw; row < TT; row += NGW) {
#pragma unroll
        for (int grp = 0; grp < 2; ++grp) {
            const int ch = grp * 512 + F.lane * 8;
            const v4u yf = *(const v4u*)(F.YF0 + (size_t)row * 1024 + ch), yb = *(const v4u*)(F.YB0 + (size_t)row * 1024 + ch);
            const v4u xv = *(const v4u*)(F.XBC + (size_t)row * 1536 + ch), zv = *(const v4u*)(F.P + (size_t)row * LDP0 + 1536 + ch);
            const float dsk = F.ssm_d[ch >> 6];
            float yz[8];
            const unsigned yfw[4] = {yf.x, yf.y, yf.z, yf.w}, ybw[4] = {yb.x, yb.y, yb.z, yb.w}, xw[4] = {xv.x, xv.y, xv.z, xv.w}, zw[4] = {zv.x, zv.y, zv.z, zv.w};
            float ss = 0.f;
#pragma unroll
            for (int j = 0; j < 4; ++j) {
                const float y0 = bflo(yfw[j]) + bflo(ybw[j]) + bflo(xw[j]) * dsk, y1 = bfhi(yfw[j]) + bfhi(ybw[j]) + bfhi(xw[j]) * dsk;
                yz[2 * j] = y0 * silu_f(bflo(zw[j])); yz[2 * j + 1] = y1 * silu_f(bfhi(zw[j]));
                ss += yz[2 * j] * yz[2 * j] + yz[2 * j + 1] * yz[2 * j + 1]; }
            const float rstd = 1.0f / sqrtf(wave_sum(ss) * (1.f / 512.f) + EPS);
            const f32x4 g0 = *(const f32x4*)(F.ssm_norm_g + ch), g1 = *(const f32x4*)(F.ssm_norm_g + ch + 4);
            v4u o; o.x = pk2(yz[0] * rstd * g0.x, yz[1] * rstd * g0.y); o.y = pk2(yz[2] * rstd * g0.z, yz[3] * rstd * g0.w);
            o.z = pk2(yz[4] * rstd * g1.x, yz[5] * rstd * g1.y); o.w = pk2(yz[6] * rstd * g1.z, yz[7] * rstd * g1.w);
            *(v4u*)(F.YA0 + (size_t)row * 1536 + 512 + ch) = o;
        }
    }
}

__device__ __forceinline__ void ph_retout(const Frame& F) {
    const int gw = F.vcu * NWAVES + F.wave, NGW = F.G * NWAVES;
    for (int row = gw; row < TL; row += NGW) {
#pragma unroll
        for (int half = 0; half < 2; ++half) {
            const int ch = half * 512 + F.lane * 8;
            const v4u yf = *(const v4u*)(F.YF1 + (size_t)row * 1024 + ch), yb = *(const v4u*)(F.YB1 + (size_t)row * 1024 + ch), gv = *(const v4u*)(F.P + (size_t)row * LDP1 + 2816 + ch);
            const unsigned yfw[4] = {yf.x, yf.y, yf.z, yf.w}, ybw[4] = {yb.x, yb.y, yb.z, yb.w}, gw4[4] = {gv.x, gv.y, gv.z, gv.w};
            float y[8]; float s = 0.f;
#pragma unroll
            for (int j = 0; j < 4; ++j) { y[2 * j] = bflo(yfw[j]) + bflo(ybw[j]); y[2 * j + 1] = bfhi(yfw[j]) + bfhi(ybw[j]); s += y[2 * j] + y[2 * j + 1]; }
            s += __shfl_xor(s, 1); s += __shfl_xor(s, 2); s += __shfl_xor(s, 4); s += __shfl_xor(s, 8);
            const float mu = s * (1.f / 128.f); float q = 0.f;
#pragma unroll
            for (int j = 0; j < 8; ++j) { y[j] -= mu; q += y[j] * y[j]; }
            q += __shfl_xor(q, 1); q += __shfl_xor(q, 2); q += __shfl_xor(q, 4); q += __shfl_xor(q, 8);
            const float rstd = 1.0f / sqrtf(q * (1.f / 128.f) + EPS);
            float ov[8];
#pragma unroll
            for (int j = 0; j < 8; ++j) { const float gg = (j & 1) ? bfhi(gw4[j >> 1]) : bflo(gw4[j >> 1]); ov[j] = silu_f(gg) * (y[j] * rstd * F.ret_gn_g[ch + j] + F.ret_gn_b[ch + j]); }
            v4u o; o.x = pk2(ov[0], ov[1]); o.y = pk2(ov[2], ov[3]); o.z = pk2(ov[4], ov[5]); o.w = pk2(ov[6], ov[7]);
            *(v4u*)(F.YA1 + (size_t)row * LDYA1 + 512 + ch) = o;
        }
    }
}

#define SEL8(arr, idx) (((idx) == 0 ? arr[0] : 0) + ((idx) == 1 ? arr[1] : 0) + ((idx) == 2 ? arr[2] : 0) + ((idx) == 3 ? arr[3] : 0) + ((idx) == 4 ? arr[4] : 0) + ((idx) == 5 ? arr[5] : 0) + ((idx) == 6 ? arr[6] : 0) + ((idx) == 7 ? arr[7] : 0))
__device__ __forceinline__ void ph_norm3_route(const Frame& F) {
    const int gw = F.vcu * NWAVES + F.wave, NGW = F.G * NWAVES;
    const float* g = F.norm_ffn_g + 1024;
    for (int ch = gw; ch < 2048; ch += NGW) {
        int cnt[8];
#pragma unroll
        for (int e = 0; e < 8; ++e) cnt[e] = 0;
        for (int i = 0; i < 8; ++i) {
            const int row = ch * 8 + i, bidx = row >> 11;
            const float* mod = F.MOD + (size_t)(9 + bidx) * 6144 + 3 * 1024;
            const f32x4* xr = (const f32x4*)(F.X + (size_t)row * 1024) + F.lane;
            f32x4 v[4]; float s = 0.f;
#pragma unroll
            for (int j = 0; j < 4; ++j) { v[j] = xr[64 * j]; s += (v[j].x * v[j].x + v[j].y * v[j].y) + (v[j].z * v[j].z + v[j].w * v[j].w); }
            const float rstd = 1.0f / sqrtf(wave_sum(s) * (1.f / 1024.f) + EPS);
            unsigned long long* o8 = (unsigned long long*)(F.H + (size_t)row * 1024) + F.lane;
#pragma unroll
            for (int j = 0; j < 4; ++j) {
                const f32x4 gg = ((const f32x4*)g)[F.lane + 64 * j], sh = ((const f32x4*)mod)[F.lane + 64 * j], sc = ((const f32x4*)(mod + 1024))[F.lane + 64 * j];
                v[j] = (v[j] * rstd * gg) * (sc + 1.0f) + sh;
                o8[64 * j] = (unsigned long long)pk2(v[j].x, v[j].y) | ((unsigned long long)pk2(v[j].z, v[j].w) << 32);
            }
            float lg[8];
#pragma unroll
            for (int e = 0; e < 8; ++e) lg[e] = 0.f;
#pragma unroll
            for (int j = 0; j < 4; ++j)
#pragma unroll
                for (int q = 0; q < 4; ++q) { const int k = 4 * (F.lane + 64 * j) + q; const f32x4 r0 = ((const f32x4*)(F.moe_router + (size_t)k * 8))[0], r1 = ((const f32x4*)(F.moe_router + (size_t)k * 8))[1];
                    const float hv = v[j][q];
                    lg[0] += hv * r0.x; lg[1] += hv * r0.y; lg[2] += hv * r0.z; lg[3] += hv * r0.w; lg[4] += hv * r1.x; lg[5] += hv * r1.y; lg[6] += hv * r1.z; lg[7] += hv * r1.w; }
#pragma unroll
            for (int e = 0; e < 8; ++e) lg[e] = wave_sum(lg[e]);
            int i0 = 0; float v0 = lg[0];
#pragma unroll
            for (int e = 1; e < 8; ++e) if (lg[e] > v0) { v0 = lg[e]; i0 = e; }
            int i1 = -1; float v1 = -3.0e38f;
#pragma unroll
            for (int e = 0; e < 8; ++e) if (e != i0 && lg[e] > v1) { v1 = lg[e]; i1 = e; }
            const float e1 = __expf(v1 - v0), g0 = 1.f / (1.f + e1), g1 = e1 / (1.f + e1);
            const int r0 = SEL8(cnt, i0);
#pragma unroll
            for (int e = 0; e < 8; ++e) cnt[e] += (e == i0) ? 1 : 0;
            const int r1 = SEL8(cnt, i1);
#pragma unroll
            for (int e = 0; e < 8; ++e) cnt[e] += (e == i1) ? 1 : 0;
            if (F.lane == 0) { F.TOPK[row] = i0 | (i1 << 4) | (r0 << 8) | (r1 << 16); F.GATE[row * 2] = g0; F.GATE[row * 2 + 1] = g1; }
        }
        if (F.lane < 8) F.CNT[ch * 8 + F.lane] = SEL8(cnt, F.lane);
    }
}

__device__ __forceinline__ void ph_route2(const Frame& F) {
    LAS int* coff = (LAS int*)F.lds;
    LAS int* wtot = coff + 2048 * 8;
    LAS int* meta = wtot + 64;
    const int t = F.tid;
    int loc[4][8], tot[8], incl[8];
#pragma unroll
    for (int i = 0; i < 4; ++i) { const int4 a = ((const int4*)(F.CNT + (4 * t + i) * 8))[0], b = ((const int4*)(F.CNT + (4 * t + i) * 8))[1];
        loc[i][0] = a.x; loc[i][1] = a.y; loc[i][2] = a.z; loc[i][3] = a.w; loc[i][4] = b.x; loc[i][5] = b.y; loc[i][6] = b.z; loc[i][7] = b.w; }
#pragma unroll
    for (int e = 0; e < 8; ++e) { int run = 0;
#pragma unroll
        for (int i = 0; i < 4; ++i) { const int tmp = loc[i][e]; loc[i][e] = run; run += tmp; }
        tot[e] = run; int v = run;
#pragma unroll
        for (int o = 1; o < 64; o <<= 1) { const int n = __shfl_up(v, o); if (F.lane >= o) v += n; }
        incl[e] = v;
        if (F.lane == 63) wtot[F.wave * 8 + e] = v; }
    __syncthreads();
#pragma unroll
    for (int e = 0; e < 8; ++e) { int woff = 0;
        for (int w = 0; w < F.wave; ++w) woff += wtot[w * 8 + e];
        const int excl = woff + incl[e] - tot[e];
#pragma unroll
        for (int i = 0; i < 4; ++i) coff[(4 * t + i) * 8 + e] = excl + loc[i][e]; }
    if (t < 8) { int s = 0; for (int w = 0; w < 8; ++w) s += wtot[w * 8 + t]; meta[8 + t] = s; }
    __syncthreads();
    if (t == 0) { int base = 0; for (int e = 0; e < 8; ++e) { meta[e] = base; base += (meta[8 + e] + 255) & ~255; } meta[16] = base >> 8; }
    __syncthreads();
    if (F.vcu == 0 && t < 144) { int e = 0;
#pragma unroll
        for (int q = 1; q < 8; ++q) if (t * 256 >= meta[q]) e = q;
        F.TILEE[t] = e; if (t == 0) F.MMETA[0] = meta[16]; }
    const int gw = F.vcu * NWAVES + F.wave, NGW = F.G * NWAVES;
    for (int ch = gw; ch < 2048; ch += NGW) {
        for (int i = 0; i < 8; ++i) {
            const int row = ch * 8 + i, tk = F.TOPK[row], e0 = tk & 15, e1 = (tk >> 4) & 15, r0 = (tk >> 8) & 255, r1 = (tk >> 16) & 255;
            const int s0 = meta[e0] + coff[ch * 8 + e0] + r0, s1 = meta[e1] + coff[ch * 8 + e1] + r1;
            const v4u a = ((const v4u*)(F.H + (size_t)row * 1024))[F.lane], b = ((const v4u*)(F.H + (size_t)row * 1024))[F.lane + 64];
            ((v4u*)(F.HP + (size_t)s0 * LDHP))[F.lane] = a; ((v4u*)(F.HP + (size_t)s0 * LDHP))[F.lane + 64] = b;
            ((v4u*)(F.HP + (size_t)s1 * LDHP))[F.lane] = a; ((v4u*)(F.HP + (size_t)s1 * LDHP))[F.lane + 64] = b;
            if (F.lane == 0) { F.SLOT[row * 2] = s0; F.SLOT[row * 2 + 1] = s1; }
        }
    }
    for (int it = gw; it < 2048; it += NGW) { const int e = it >> 8, r = it & 255, row = meta[e] + meta[8 + e] + r;
        if (row < meta[e] + ((meta[8 + e] + 255) & ~255)) { ((v4u*)(F.HP + (size_t)row * LDHP))[F.lane] = (v4u){0u, 0u, 0u, 0u}; ((v4u*)(F.HP + (size_t)row * LDHP))[F.lane + 64] = (v4u){0u, 0u, 0u, 0u}; } }
}

struct MoeOrder {
    const int* tile_e; int t0, t1, nN, G, c;
    __device__ __forceinline__ bool next(int i, pg8::Unit& u) const {
        const int ntiles = t1 - t0; u.k0 = 0; u.nk = 0;
        if ((G & 7) != 0) { const int L = i * G + c; if (L >= ntiles * nN) return false; const int pm = t0 + L / nN; u.pm = pm; u.pn = tile_e[pm] * nN + (L % nN); return true; }
        const int x = c & 7, wpx = G >> 3, s = i * wpx + (c >> 3), nblk = ntiles >> 3, rem = ntiles & 7;
        const int nbx = (nblk > x) ? ((nblk - x + 7) >> 3) : 0, full = nbx * 8 * nN;
        int pm, pl;
        if (s < full) { const int blk = x + 8 * (s / (8 * nN)), w = s % (8 * nN); pm = t0 + 8 * blk + (w & 7); pl = w >> 3; }
        else { const int q = (s - full) * 8 + x; if (rem == 0 || q >= rem * nN) return false; pm = t0 + 8 * nblk + (q % rem); pl = q / rem; }
        u.pm = pm; u.pn = tile_e[pm] * nN + pl; return true; }
    __device__ __forceinline__ void a_ready(const pg8::Unit&) const {}
    __device__ __forceinline__ void done(const pg8::Unit&) const {}
};
struct Moe2BOrder {
    const int* tile_e; int MT, G, c;
    __device__ __forceinline__ bool next(int i, pg8::Unit& u) const {
        const int t1 = MT < 128 ? MT : 128, nfull = (t1 - 64) * 4, L = i * G + c;
        if (L < nfull) { const int pm = 64 + (L >> 2); u.pm = pm; u.pn = tile_e[pm] * 4 + (L & 3); u.k0 = 0; u.nk = 0; return true; }
        const int nb = (MT - t1) * 4; if (nb <= 0) return false;
        const int r0 = (nfull + G - 1) / G; if (i < r0) return false;
        const int NS = 7, q = (i - r0) * G + c; if (q >= nb * NS) return false;
        const int bu = q % nb, sl = q / nb, pm = t1 + (bu >> 2); u.pm = pm; u.pn = tile_e[pm] * 4 + (bu & 3); u.k0 = sl * (DFE / NS); u.nk = DFE / NS / 64; return true; }
    __device__ __forceinline__ void a_ready(const pg8::Unit&) const {}
    __device__ __forceinline__ void done(const pg8::Unit&) const {}
};
struct EpiSwigluMoe {
    bf16* O; int row0;
    __device__ __forceinline__ void operator()(int row, int col, f32x4 lo, f32x4 hi, int part = 0) const {
        v2u w; w.x = pk2(silu_f(lo.x) * hi.x, silu_f(lo.y) * hi.y); w.y = pk2(silu_f(lo.z) * hi.z, silu_f(lo.w) * hi.w);
        *(v2u*)(O + (size_t)(row - row0) * DFE + ((col % 7168) >> 1)) = w; }
};
struct EpiStoreMoe {
    bf16* O; float* T;
    __device__ __forceinline__ void operator()(int row, int col, f32x4 lo, f32x4 hi, int part = 0) const {
        if (part) { float* o = T + ((size_t)((part - 1) / 512) * 2048 + (row - 128 * 256)) * 1024 + (col & 1023); ((f32x4*)o)[0] = lo; ((f32x4*)o)[1] = hi; return; }
        v4u w; w.x = pk2(lo.x, lo.y); w.y = pk2(lo.z, lo.w); w.z = pk2(hi.x, hi.y); w.w = pk2(hi.z, hi.w);
        *(v4u*)(O + (size_t)row * LDHP + (col & 1023)) = w; }
};
template <class F8>
__device__ __forceinline__ void gemm_moe(const Frame& F, const bf16* A, const bf16* Bt, int K, int nN, int t0, int t1, const F8& f, int ld = 0) {
    pg8::Gemm g{A, Bt, 0, 0, K, ld}; MoeOrder S{F.TILEE, t0, t1, nN, F.G, (int)blockIdx.x};
    EpiAdapt<F8> E{f};
    pg8::gemm_phase<EpiAdapt<F8>, MoeOrder, true, true>(F.lds, g, S, E);
}

__device__ __forceinline__ void ph_final(const Frame& F) {
    const int gw = F.vcu * NWAVES + F.wave, NGW = F.G * NWAVES;
    for (int row = gw; row < TL; row += NGW) {
        const int s0 = F.SLOT[row * 2], s1 = F.SLOT[row * 2 + 1]; const float g0 = F.GATE[row * 2], g1 = F.GATE[row * 2 + 1];
        const float* g2 = F.MOD + (size_t)(9 + (row >> 11)) * 6144 + 5 * 1024;
        const f32x4* xr = (const f32x4*)(F.X + (size_t)row * 1024) + F.lane;
        const v2u* y0 = (const v2u*)(F.HP + (size_t)s0 * LDHP) + F.lane; const v2u* y1 = (const v2u*)(F.HP + (size_t)s1 * LDHP) + F.lane;
        const f32x4* t0 = (const f32x4*)(F.Y2T + (size_t)(s0 - 32768) * 1024) + F.lane; const f32x4* t1 = (const f32x4*)(F.Y2T + (size_t)(s1 - 32768) * 1024) + F.lane;
        f32x4 v[4]; float s = 0.f;
#pragma unroll
        for (int j = 0; j < 4; ++j) { const f32x4 gg = ((const f32x4*)g2)[F.lane + 64 * j];
            f32x4 ya, yb;
            if (s0 >= 32768) { ya = t0[64 * j];
#pragma unroll
                for (int sl = 1; sl < 7; ++sl) ya += t0[64 * j + (size_t)sl * 2048 * 256]; } else { const v2u a = y0[64 * j]; ya = (f32x4){bflo(a.x), bfhi(a.x), bflo(a.y), bfhi(a.y)}; }
            if (s1 >= 32768) { yb = t1[64 * j];
#pragma unroll
                for (int sl = 1; sl < 7; ++sl) yb += t1[64 * j + (size_t)sl * 2048 * 256]; } else { const v2u b = y1[64 * j]; yb = (f32x4){bflo(b.x), bfhi(b.x), bflo(b.y), bfhi(b.y)}; }
            f32x4 y = ya * g0 + yb * g1;
            v[j] = xr[64 * j] + gg * y; s += (v[j].x * v[j].x + v[j].y * v[j].y) + (v[j].z * v[j].z + v[j].w * v[j].w); }
        const float rstd = 1.0f / sqrtf(wave_sum(s) * (1.f / 1024.f) + EPS);
        f32x4* o = (f32x4*)(F.out + (size_t)row * 1024) + F.lane;
#pragma unroll
        for (int j = 0; j < 4; ++j) o[64 * j] = v[j] * rstd * ((const f32x4*)F.final_g)[F.lane + 64 * j];
    }
}

enum { PH_CVT = 0, PH_NORM0, PH_IN0, PH_MIX0, PH_SCAN0, PH_SSMOUT, PH_OUT0, PH_NORM1, PH_F13, PH_F2, PH_NORM2, PH_IN1, PH_MIX1, PH_RETOUT, PH_OUT1, PH_NORM3, PH_ROUTE2, PH_MG1A, PH_MG2A, PH_MG1B, PH_MG2B, PH_FINAL, NPHASES };

struct Args { const float* in[31]; float* out; unsigned char* ws; int ph_lo, ph_hi; };

__global__ void __launch_bounds__(NWAVES * 64, 2) fwd(Args args) {
    extern __shared__ __attribute__((aligned(16))) unsigned char lds_raw[];
    Frame F;
    F.lds = (LAS unsigned char*)lds_raw;
    F.tid = threadIdx.x; F.lane = F.tid & 63; F.wave = __builtin_amdgcn_readfirstlane(F.tid >> 6);
    F.G = gridDim.x; { const int bx = blockIdx.x; F.vcu = (F.G % 8 == 0) ? (bx % 8) * (F.G / 8) + bx / 8 : bx; }
    F.x = args.in[0]; F.c = args.in[1]; F.ctx = args.in[2]; F.c_ctx = args.in[3]; F.ada_w = args.in[4]; F.ada_b = args.in[5]; F.norm_attn_g = args.in[6]; F.norm_ffn_g = args.in[7];
    F.ev_w_in = args.in[8]; F.ev_w_out = args.in[9]; F.na_rpb = args.in[10]; F.conv_w = args.in[11]; F.conv_b = args.in[12]; F.dt_bias = args.in[13]; F.a_log = args.in[14]; F.ssm_d = args.in[15];
    F.ssm_norm_g = args.in[16]; F.ffn_w1 = args.in[17]; F.ffn_w3 = args.in[18]; F.ffn_w2 = args.in[19]; F.od_w_in = args.in[20]; F.od_w_out = args.in[21]; F.swa_sink = args.in[22];
    F.ret_log_decay = args.in[23]; F.ret_gn_g = args.in[24]; F.ret_gn_b = args.in[25]; F.moe_router = args.in[26]; F.moe_w1 = args.in[27]; F.moe_w3 = args.in[28]; F.moe_w2 = args.in[29]; F.final_g = args.in[30];
    F.out = args.out;
    unsigned char* ws = args.ws;
    F.MOD = (float*)(ws + WS_MOD); F.GATE = (float*)(ws + WS_GATE); F.ROPE = (float*)(ws + WS_ROPE); F.X = (float*)(ws + WS_X);
    F.WIN0 = (bf16*)(ws + WS_WIN0); F.WOUT0 = (bf16*)(ws + WS_WOUT0); F.WF13 = (bf16*)(ws + WS_WF13); F.WF2 = (bf16*)(ws + WS_WF2); F.WIN1 = (bf16*)(ws + WS_WIN1); F.WOUT1 = (bf16*)(ws + WS_WOUT1);
    F.WM13 = (bf16*)(ws + WS_WM13); F.WM2 = (bf16*)args.out; F.H = (bf16*)(ws + WS_H); F.P = (bf16*)(ws + WS_P); F.YA0 = (bf16*)(ws + WS_YA0); F.YA1 = (bf16*)(ws + WS_YA1); F.XBC = (bf16*)(ws + WS_XBC);
    F.YF0 = (bf16*)(ws + WS_YF0); F.YB0 = (bf16*)(ws + WS_YB0); F.YF1 = (bf16*)(ws + WS_YF1); F.YB1 = (bf16*)(ws + WS_YB1); F.Gh = (bf16*)(ws + WS_G); F.MG = (bf16*)(ws + WS_MG); F.HP = (bf16*)(ws + WS_HP);
    F.ctl = (unsigned*)(ws + WS_CTL); F.Y2T = (float*)(ws + WS_Y2T); F.PART = (float*)(ws + WS_PART);
    F.TOPK = (int*)(ws + WS_TOPK); F.SLOT = (int*)(ws + WS_SLOT); F.CNT = (int*)(ws + WS_CNT); F.TILEE = (int*)(ws + WS_TILEE); F.MMETA = (int*)(ws + WS_MMETA);

    for (int u = F.tid; u < (LDS_BYTES - LDSCTL_OFF) / 4; u += NWAVES * 64) ((LAS unsigned*)(F.lds + LDSCTL_OFF))[u] = 0u;
    __syncthreads();
    volatile LAS unsigned* MISC = (volatile LAS unsigned*)(F.lds + MISC_OFF);
    XcdBarrier bar; bar.bar = (unsigned*)(ws + WS_CTL) + CW_BAR; bar.x = 0; bar.st = nullptr;
    const int lo = args.ph_lo, hi = args.ph_hi;
    if (hi - lo > 1) bar = xcd_barrier_post((unsigned*)(ws + WS_CTL) + CW_BAR, MISC + 8);
#ifndef QB_IN0
#define QB_IN0 0
#define QB_OUT0 0
#define QB_F13 0
#define QB_F2 0
#endif
#ifndef PROBE_PH
#define PROBE_PH -1
#endif
#ifndef PROBE_TAG
#define PROBE_TAG 0
#endif
#define TREP(tag) for (int _tr = 0; _tr < ((tag) == PROBE_TAG ? 2 : 1); ++_tr)
#define REPS(k) for (int _rep = 0; _rep < ((k) == PROBE_PH ? 2 : 1); ++_rep)
#define IN(k) (lo <= (k) && (k) < hi)
#define SEAM(k) do { if (IN(k) && IN((k) + 1)) xcd_barrier(bar); else __syncthreads(); } while (0)

    if (IN(PH_CVT)) { REPS(PH_CVT) { ph_cvt(F); __syncthreads(); } SEAM(PH_CVT); }
    if (IN(PH_NORM0)) { REPS(PH_NORM0) ph_norm<0, false>(F, 0, 0, TT); SEAM(PH_NORM0); }
    if (IN(PH_IN0)) { REPS(PH_IN0) { EpiStore E{F.P, LDP0}; gemm_pg8(F, F.H, F.WIN0, TT, LDP0, 1024, E); } TREP(8) { if (_tr == 1) { EpiNull E0; gemm_pg8(F, F.H, F.WIN0, TT, LDP0, 512, E0, 1024); } } TREP(11) { if (_tr == 1) { EpiNull E0; gemm_pg8(F, F.H, F.WIN0, TT, LDP0, 1024, E0, 1024); } } if (short_round(F, 72 * 17)) cvt_pull(F, QB_IN0, false); SEAM(PH_IN0); }
    if (IN(PH_MIX0)) { REPS(PH_MIX0) { TREP(1) ph_attn0_mfma(F); TREP(2) ph_conv(F); } SEAM(PH_MIX0); }
    if (IN(PH_SCAN0)) { REPS(PH_SCAN0) chunk_scan<128, false>(F); SEAM(PH_SCAN0); }
    if (IN(PH_SSMOUT)) { REPS(PH_SSMOUT) ph_ssmout(F); SEAM(PH_SSMOUT); }
    if (IN(PH_OUT0)) REPS(PH_OUT0) { EpiResidTail E{EpiResid{F.x, F.ctx, F.X, F.MOD + 2 * 1024, nullptr, 0, 0}, F.PART, 256}; gemm_tail(F, F.YA0, F.WOUT0, 1536, E); if (short_round(F, 256 + 192)) cvt_pull(F, QB_OUT0, true); SEAM(PH_OUT0); }
    if (IN(PH_NORM1)) { ph_norm<1, false, 1>(F, 0, 1, TT); SEAM(PH_NORM1); }
    if (IN(PH_F13)) { REPS(PH_F13) { EpiSwiglu E{F.Gh, DFF}; gemm_pg8(F, F.H, F.WF13, TT, 2 * DFF, 1024, E); } if (short_round(F, 72 * 22)) cvt_pull(F, QB_F13, true); SEAM(PH_F13); }
    if (IN(PH_F2)) { EpiResidTail E{EpiResid{F.X, F.X + (size_t)TL * 1024, F.X, F.MOD + 5 * 1024, nullptr, 0, 0}, F.PART, 512}; gemm_tail(F, F.Gh, F.WF2, DFF, E); TREP(9) { if (_tr == 1) { EpiNull E0; gemm_tail(F, F.Gh, F.WF2, DFF, E0); } } if (short_round(F, 256 + 192)) cvt_pull(F, QB_F2, true); SEAM(PH_F2); }
    if (IN(PH_NORM2)) { ph_norm<1, false, 2>(F, 1, 0, TT); SEAM(PH_NORM2); }
    if (IN(PH_IN1)) { LAS float* rtab = (LAS float*)(F.lds + RING_BYTES + 1024);
        for (int i = F.tid; i < 96 * 16; i += 512) { const int pos = i >> 4, f = i & 15; const float* sp = F.ROPE + ((size_t)(pos < 32 ? pos * 64 : (pos - 32)) * 32 + (pos < 32 ? f : 16 + f)) * 2; rtab[2 * i] = sp[0]; rtab[2 * i + 1] = sp[1]; }
        __syncthreads();
        REPS(PH_IN1) { pg8::Gemm g{F.H, F.WIN1, TT, LDP1, 1024, 0}; In1Order S{F.G, (int)blockIdx.x}; EpiAdapt<EpiRope> E{EpiRope{F.P, rtab}};
            pg8::gemm_phase<EpiAdapt<EpiRope>, In1Order, true, true>(F.lds, g, S, E); } SEAM(PH_IN1); }
    if (IN(PH_MIX1)) { REPS(PH_MIX1) { TREP(4) { chunk_scan<64, true>(F); __syncthreads(); } TREP(5) { ph_swa_mfma(F); __syncthreads(); } } SEAM(PH_MIX1); }
    if (IN(PH_RETOUT)) { REPS(PH_RETOUT) { ph_retout(F); } SEAM(PH_RETOUT); }
    if (IN(PH_OUT1)) { EpiResid E{F.X, F.X + (size_t)TL * 1024, F.X, F.MOD + 9 * 6144 + 2 * 1024, nullptr, 0, 0}; gemm_pg8(F, F.YA1, F.WOUT1, TL, 1024, 1536, E, LDYA1); TREP(10) { if (_tr == 1) { EpiNull E0; gemm_pg8(F, F.YA1, F.WOUT1, TL, 1024, 1536, E0, LDYA1); } } SEAM(PH_OUT1); }
    if (IN(PH_NORM3)) { REPS(PH_NORM3) { TREP(6) ph_norm3_route(F); cvt_drain(F); } SEAM(PH_NORM3); }
    if (IN(PH_ROUTE2)) { REPS(PH_ROUTE2) { ph_route2(F); __syncthreads(); } SEAM(PH_ROUTE2); }
    {
        int MT = 0; if (IN(PH_MG1A) || IN(PH_MG2A) || IN(PH_MG1B) || IN(PH_MG2B)) MT = __builtin_amdgcn_readfirstlane(F.MMETA[0]);
        const int ta = MT < 64 ? MT : 64;
        if (IN(PH_MG1A)) { REPS(PH_MG1A) { EpiSwigluMoe E{F.MG, 0}; gemm_moe(F, F.HP, F.WM13, 1024, 28, 0, ta, E, LDHP); } SEAM(PH_MG1A); }
        if (IN(PH_MG2A)) { EpiStoreMoe E{F.HP, F.Y2T}; gemm_moe(F, F.MG, F.WM2, DFE, 4, 0, ta, E); SEAM(PH_MG2A); }
        if (IN(PH_MG1B)) { REPS(PH_MG1B) { EpiSwigluMoe E{F.MG, 64 * 256}; gemm_moe(F, F.HP, F.WM13, 1024, 28, 64, MT, E, LDHP); } SEAM(PH_MG1B); }
        if (IN(PH_MG2B)) REPS(PH_MG2B) { EpiStoreMoe Ef{F.HP, F.Y2T}; pg8::Gemm g{F.MG - (size_t)64 * 256 * DFE, F.WM2, 0, 0, DFE, 0}; Moe2BOrder S{F.TILEE, MT, F.G, (int)blockIdx.x}; EpiAdapt<EpiStoreMoe> E{Ef};
            pg8::gemm_phase<EpiAdapt<EpiStoreMoe>, Moe2BOrder, true, true>(F.lds, g, S, E); SEAM(PH_MG2B); }
    }
    if (IN(PH_FINAL)) { REPS(PH_FINAL) ph_final(F); }
#undef IN
#undef SEAM
}

extern "C" void kernel_launch(void* const* d_in, const int* in_sizes, int n_in, void* d_out, int out_size, void* d_ws, size_t ws_size, hipStream_t stream) {
    static int grid = 0;
    if (grid == 0) {
        if (n_in != 31 || out_size != TL * DM || ws_size < WS_END) { fprintf(stderr, "kernel_launch: unexpected shapes (n_in %d out %d ws %zu need %zu)\n", n_in, out_size, ws_size, (size_t)WS_END); grid = -1; return; }
        int dev = 0, cus = 0, per_cu = 0;
        if (hipGetDevice(&dev) != hipSuccess || hipDeviceGetAttribute(&cus, hipDeviceAttributeMultiprocessorCount, dev) != hipSuccess) { grid = -1; return; }
        if (hipFuncSetAttribute((const void*)fwd, hipFuncAttributeMaxDynamicSharedMemorySize, LDS_BYTES) != hipSuccess) { grid = -1; return; }
        if (hipOccupancyMaxActiveBlocksPerMultiprocessor(&per_cu, (const void*)fwd, NWAVES * 64, LDS_BYTES) != hipSuccess || per_cu < 1) fprintf(stderr, "kernel_launch: occupancy query reports %d\n", per_cu);
        (void)hipGetLastError();
        grid = cus;
    }
    if (grid < 0) return;
    if (hipMemsetAsync((char*)d_ws + WS_CTL, 0, CTL_ZERO_BYTES, stream) != hipSuccess) return;
    Args a{};
    for (int i = 0; i < 31; ++i) a.in[i] = (const float*)d_in[i];
    a.out = (float*)d_out; a.ws = (unsigned char*)d_ws;
#if MK_ONE_LAUNCH
    a.ph_lo = 0; a.ph_hi = NPHASES;
    hipLaunchKernelGGL(fwd, dim3(grid), dim3(NWAVES * 64), LDS_BYTES, stream, a);
#else
    for (int ph = 0; ph < NPHASES; ++ph) { a.ph_lo = ph; a.ph_hi = ph + 1; hipLaunchKernelGGL(fwd, dim3(grid), dim3(NWAVES * 64), LDS_BYTES, stream, a); }
#endif
}
```

```cpp
#include <hip/hip_runtime.h>
#include <cstdio>
#include <cstdint>

#ifndef MK_ONE_LAUNCH
#define MK_ONE_LAUNCH 1
#endif

#define LAS __attribute__((address_space(3)))
typedef unsigned short bf16;
typedef short bf16x8 __attribute__((ext_vector_type(8)));
typedef float f32x4 __attribute__((ext_vector_type(4)));
typedef unsigned v4u __attribute__((ext_vector_type(4)));
typedef unsigned v2u __attribute__((ext_vector_type(2)));

constexpr int DM = 1024, NB = 8, SEQ = 2048, CTXL = 256;
constexpr int TL = NB * SEQ, TC = NB * CTXL, TT = TL + TC;
constexpr int LDP0 = 4352;
constexpr int LDP1 = 3840;
constexpr int DFF = 2816, DFE = 3584, NEXP = 8;
constexpr float EPS = 1e-6f;
constexpr int LDHP = 1088;
constexpr int LDYA1 = 1600;

constexpr size_t MiB = 1u << 20;
constexpr size_t WS_CTL = 0, CTL_ZERO_BYTES = 1 * MiB;
constexpr size_t WS_MOD = 1 * MiB;
constexpr size_t WS_GATE = 2 * MiB;
constexpr size_t WS_ROPE = 3 * MiB;
constexpr size_t WS_WIN0 = 4 * MiB;
constexpr size_t WS_WOUT0 = 13 * MiB;
constexpr size_t WS_WF13 = 16 * MiB;
constexpr size_t WS_WF2 = 27 * MiB;
constexpr size_t WS_WIN1 = 33 * MiB;
constexpr size_t WS_WOUT1 = 40 * MiB + MiB / 2;
constexpr size_t WS_X = 44 * MiB;
constexpr size_t WS_H = 116 * MiB;
constexpr size_t WS_R = 152 * MiB;
constexpr size_t WS_P = WS_R;
constexpr size_t WS_YA0 = WS_R + 153 * MiB;
constexpr size_t WS_XBC = WS_R + 207 * MiB;
constexpr size_t WS_YF0 = WS_R + 261 * MiB;
constexpr size_t WS_YB0 = WS_R + 297 * MiB;
constexpr size_t WS_YA1 = WS_R + 135 * MiB;
constexpr size_t WS_YF1 = WS_R + 189 * MiB;
constexpr size_t WS_YB1 = WS_R + 221 * MiB;
constexpr size_t WS_G = WS_R;
constexpr size_t WS_HP = WS_R;
constexpr size_t WS_MG = WS_R + 73 * MiB;
constexpr size_t WS_PART = WS_R + 207 * MiB;
constexpr size_t WS_WM13 = WS_R + 256 * MiB;
constexpr size_t WS_END = WS_R + 375 * MiB;
constexpr size_t WS_TOPK = WS_GATE + 128 * 1024, WS_SLOT = WS_GATE + 192 * 1024, WS_CNT = WS_GATE + 320 * 1024, WS_TILEE = WS_GATE + 384 * 1024, WS_MMETA = WS_GATE + 385 * 1024;
static_assert(WS_P + (size_t)TT * LDP0 * 2 <= WS_YA0 && WS_YA0 + (size_t)TT * 1536 * 2 <= WS_XBC && WS_XBC + (size_t)TT * 1536 * 2 <= WS_YF0 && WS_YF0 + (size_t)TT * 1024 * 2 <= WS_YB0 && WS_YB0 + (size_t)TT * 1024 * 2 <= WS_END, "ws map layer 0");
static_assert(WS_WOUT1 + (size_t)1024 * LDYA1 * 2 <= WS_X && WS_P + (size_t)TT * LDP1 * 2 <= WS_YA1 && WS_YA1 + (size_t)TL * LDYA1 * 2 <= WS_YF1 && WS_YF1 + (size_t)TL * 1024 * 2 <= WS_YB1 && WS_YB1 + (size_t)TL * 1024 * 2 <= WS_WM13, "ws map layer 1");
static_assert(WS_HP + (size_t)34816 * LDHP * 2 <= WS_MG && WS_MG + (size_t)72 * 256 * 3584 * 2 <= WS_WM13 && WS_WM13 + (size_t)8 * 7168 * LDHP * 2 <= WS_END && WS_XBC >= WS_R + 194 * MiB, "ws map moe");
static_assert(WS_G + (size_t)TT * DFF * 2 <= WS_PART && WS_YA0 + (size_t)TT * 1536 * 2 <= WS_PART && WS_PART + (size_t)6 * TC * 1024 * 4 <= WS_WM13, "partial slabs");
static_assert(WS_X + (size_t)TT * 1024 * 4 <= WS_H && WS_H + (size_t)TT * 1024 * 2 <= WS_R, "ws map 2");
static_assert((size_t)8 * 1024 * 3584 * 2 <= (size_t)TL * DM * 4, "WM2 fits d_out");
constexpr size_t WS_Y2T = WS_R + 199 * MiB;
static_assert(WS_MG + (size_t)72 * 256 * 3584 * 2 <= WS_Y2T && WS_Y2T + (size_t)7 * 2048 * 1024 * 4 <= WS_WM13, "Y2T slabs");
constexpr int CW_Q2 = 8192, CW_Q13 = 8256;
constexpr int CW_BAR = 4096;

constexpr int RING_BYTES = 131072, LDS_BYTES = 147456, LDSCTL_OFF = LDS_BYTES - 1024, MISC_OFF = LDSCTL_OFF + 320;
constexpr int NWAVES = 8;

#define NTL(p) __builtin_nontemporal_load(p)
#define NTS(v, p) __builtin_nontemporal_store(v, p)
#define LDS_WAIT() asm volatile("s_waitcnt lgkmcnt(0)" ::: "memory")
__device__ __forceinline__ unsigned f2bf(float f) { unsigned u = __builtin_bit_cast(unsigned, f); return (u + 0x7fffu + ((u >> 16) & 1u)) >> 16; }
typedef float f32x2_t __attribute__((ext_vector_type(2))); typedef __bf16 bf16x2_t __attribute__((ext_vector_type(2)));
__device__ __forceinline__ unsigned pk2(float lo, float hi) { f32x2_t v = {lo, hi}; bf16x2_t b = __builtin_convertvector(v, bf16x2_t); return __builtin_bit_cast(unsigned, b); }
__device__ __forceinline__ float bf2f(unsigned short b) { return __builtin_bit_cast(float, ((unsigned)b) << 16); }
__device__ __forceinline__ float bflo(unsigned w) { return __builtin_bit_cast(float, w << 16); }
__device__ __forceinline__ float bfhi(unsigned w) { return __builtin_bit_cast(float, w & 0xffff0000u); }
__device__ __forceinline__ float silu_f(float x) { return x * __builtin_amdgcn_rcpf(1.f + __expf(-x)); }
__device__ __forceinline__ float wave_sum(float v) {
#pragma unroll
    for (int o = 1; o < 64; o <<= 1) v += __shfl_xor(v, o);
    return v;
}
__host__ __device__ __forceinline__ int perm32(int rho) { const int n = rho >> 4, i = rho & 15; return 8 * (i >> 2) + 4 * n + (i & 3); }

#define XB_TMO      128
#define XB_XCNT(j)  (256  + 64 * (j))
#define XB_XSUB(j)  (1280 + 64 * (j))
#define XB_XGEN(j)  (2304 + 64 * (j))
#define XB_TOP      3328
#define XB_TOPGEN   3392
#define XCD_BAR_WORDS 3456
#define XB_SPIN_CAP (1u << 18)
__device__ __forceinline__ unsigned xb_ld(unsigned* p)              { return __hip_atomic_load(p, __ATOMIC_RELAXED, __HIP_MEMORY_SCOPE_AGENT); }
__device__ __forceinline__ unsigned xb_add(unsigned* p, unsigned v) { return __hip_atomic_fetch_add(p, v, __ATOMIC_RELAXED, __HIP_MEMORY_SCOPE_AGENT); }
__device__ __forceinline__ unsigned xb_xcc_id() { return (unsigned)__builtin_amdgcn_s_getreg((3 << 11) | 20) & 0xFu; }
#define XB_SPIN(cond, bar) do { unsigned _sp = 0; while (cond) { __builtin_amdgcn_s_sleep(1); \
    if ((++_sp & 255u) == 0u) { if (xb_ld(&(bar)[XB_TMO])) break; if (_sp > XB_SPIN_CAP) { atomicAdd(&(bar)[XB_TMO], 1u); break; } } } } while (0)
struct XcdBarrier { unsigned* bar; unsigned x; volatile LAS unsigned* st; };
__device__ __forceinline__ XcdBarrier xcd_barrier_post(unsigned* bar, volatile LAS unsigned* st) {
    XcdBarrier b; b.bar = bar; b.x = xb_xcc_id(); b.st = st;
    if (threadIdx.x == 0) (void)xb_add(&bar[XB_XCNT(b.x)], 1u);
    return b;
}
__device__ __forceinline__ void xcd_barrier_complete(unsigned* bar, unsigned x, unsigned& nloc, unsigned& nx) {
    const unsigned G = gridDim.x * gridDim.y * gridDim.z;
    unsigned sum, cnt, mine, sp = 0u;
    for (;;) {
        sum = 0u; cnt = 0u; mine = 0u;
#pragma unroll
        for (unsigned j = 0; j < 16; ++j) { const unsigned c = xb_ld(&bar[XB_XCNT(j)]); sum += c; cnt += (c > 0u) ? 1u : 0u; mine = (j == x) ? c : mine; }
        if (sum == G) break;
        __builtin_amdgcn_s_sleep(1);
        if ((++sp & 255u) == 0u) { if (xb_ld(&bar[XB_TMO])) break; if (sp > XB_SPIN_CAP) { atomicAdd(&bar[XB_TMO], 1u); break; } }
    }
    nloc = mine > 0u ? mine : 1u; nx = cnt > 0u ? cnt : 1u;
}
__device__ __forceinline__ void xcd_barrier(const XcdBarrier& b) {
    asm volatile("s_waitcnt vmcnt(0)" ::: "memory");
    __syncthreads();
    if (threadIdx.x == 0) {
        unsigned* bar = b.bar;
        __builtin_amdgcn_s_waitcnt(0);
        unsigned nloc = b.st[0], nx = b.st[1];
        if (nloc == 0u) { xcd_barrier_complete(bar, b.x, nloc, nx); b.st[0] = nloc; b.st[1] = nx; }
        const unsigned old = xb_add(&bar[XB_XSUB(b.x)], 1u);
        const unsigned gen = old / nloc;
        if (old + 1u == (gen + 1u) * nloc) {
            __builtin_amdgcn_fence(__ATOMIC_RELEASE, "agent");
            asm volatile("s_waitcnt vmcnt(0)" ::: "memory");
            const unsigned og = xb_add(&bar[XB_TOP], 1u);
            const unsigned tg = og / nx;
            if (og + 1u == (tg + 1u) * nx) xb_add(&bar[XB_TOPGEN], 1u);
            else XB_SPIN(xb_ld(&bar[XB_TOPGEN]) == tg, bar);
            __builtin_amdgcn_fence(__ATOMIC_ACQUIRE, "agent");
            xb_add(&bar[XB_XGEN(b.x)], 1u);
            asm volatile("s_waitcnt vmcnt(0)" ::: "memory");
        } else {
            XB_SPIN(xb_ld(&bar[XB_XGEN(b.x)]) == gen, bar);
            __builtin_amdgcn_fence(__ATOMIC_ACQUIRE, "agent");
            asm volatile("s_waitcnt vmcnt(0)" ::: "memory");
        }
    }
    __syncthreads();
}

namespace pg8 {
#define PG8_LAS __attribute__((address_space(3)))
typedef unsigned short bf16_t;
typedef short bf16x8 __attribute__((ext_vector_type(8)));
typedef float f32x4 __attribute__((ext_vector_type(4)));
typedef unsigned u32x4 __attribute__((ext_vector_type(4)));
constexpr int BM = 256, BK = 64, HALF = 128, HTB = HALF * BK * 2  , STAGE_BYTES = 8 * HTB, NXCD = 8, WGM = 8;

__host__ __device__ __forceinline__ int lds_byte(int r, int c) { const int st = (r >> 4) * 2 + (c >> 5), rr = r & 15, cc = c & 31, ob = rr * 64 + cc * 2; return st * 1024 + (ob ^ (((ob >> 9) & 1) << 5)); }
__host__ __device__ __forceinline__ void stage_rc(int b, int& R, int& C) { const int st = b / 1024, sb = b % 1024, swz = sb ^ (((sb >> 9) & 1) << 5); R = (st >> 1) * 16 + swz / 64; C = (st & 1) * 32 + (swz % 64) / 2; }
__host__ __device__ __forceinline__ int perm32(int rho) { const int n = rho >> 4, i = rho & 15; return 8 * (i >> 2) + 4 * n + (i & 3); }

struct Unit { int pm, pn, k0, nk; };
struct Gemm { const bf16_t* A; const bf16_t* Bt; int M, N, K, ld; };

struct StaticOrder {
    int nM, nN, nwg, G, c;
    __host__ __device__ __forceinline__ void init(int M, int N, int G_, int c_) { nM = M / BM; nN = N / BM; nwg = nM * nN; G = G_; c = c_; }
    __host__ __device__ __forceinline__ bool next(int i, Unit& u) const {
        const long L = (long)i * G + c; if (L >= nwg) return false;
        int wgid = (int)L; { const int q = nwg / NXCD, r = nwg % NXCD, xcd = wgid % NXCD, off = wgid / NXCD; wgid = (xcd < r ? xcd * (q + 1) : r * (q + 1) + (xcd - r) * q) + off; }
        const int nig = WGM * nN, gid = wgid / nig, fm = gid * WGM, gsz = (nM - fm) < WGM ? (nM - fm) : WGM;
        u.pm = fm + ((wgid % nig) % gsz); u.pn = (wgid % nig) / gsz; u.k0 = 0; u.nk = 0; return true;
    }
    __device__ __forceinline__ void a_ready(const Unit&) const {}
    __device__ __forceinline__ void done(const Unit&) const {}
};

__device__ __forceinline__ unsigned cvt_pk_bf16(float lo, float hi) { unsigned r; asm volatile("v_cvt_pk_bf16_f32 %0, %1, %2" : "=v"(r) : "v"(lo), "v"(hi)); return r; }
template <class Epi, class Sched, bool ALIGN_EPI = false, bool SP2 = false>
__device__ __forceinline__ void gemm_phase(PG8_LAS unsigned char* lds, const Gemm g, const Sched& S, const Epi& E) {
    int tid_ = threadIdx.x; asm volatile("" : "+v"(tid_));
    const int tid = tid_, wid = __builtin_amdgcn_readfirstlane(tid >> 6), lane = tid & 63, wr = wid >> 2, wc = wid & 3, fr = lane & 15, fq = lane >> 4;
    const int K = g.K, nt_full = K / BK, LD = g.ld ? g.ld : K;
    unsigned voffA[2], voffB[2];
#pragma unroll
    for (int i = 0; i < 2; ++i) { int R, C; stage_rc(tid * 16 + i * 8192, R, C); const int Rb = Epi::PERM ? ((R & ~31) + perm32(R & 31)) : R;
        voffA[i] = (unsigned)(R * LD + C) * 2u; voffB[i] = (unsigned)(Rb * LD + C) * 2u; }
    const size_t kstep = (size_t)(BK * 2);
    const size_t hstep = (size_t)HALF * LD * 2;
    const size_t tstep = 2 * hstep;
    const unsigned ldsw = (unsigned)wid * 1024u;
    const int aoff = lds_byte(wr * 64 + fr, fq * 8), boff = lds_byte(wc * 32 + fr, fq * 8);
#define PG8_SA(b, h) (((b) * 2 + (h)) * HTB)
#define PG8_SB(b, h) ((4 + (b) * 2 + (h)) * HTB)
#define PG8_STAGE(bufoff, gbase, voff) do { _Pragma("unroll") for (int _i = 0; _i < 2; ++_i) \
        __builtin_amdgcn_global_load_lds((const unsigned*)((const char*)(gbase) + (voff)[_i]), (PG8_LAS unsigned*)(lds + (bufoff) + ldsw + _i * 8192), 16, 0, 0); } while (0)
#define PG8_LDA(dst, b, h) do { _Pragma("unroll") for (int m = 0; m < 4; ++m) _Pragma("unroll") for (int k = 0; k < 2; ++k) dst[m][k] = *(const PG8_LAS bf16x8*)(lds + PG8_SA(b, h) + aoff + m * 2048 + k * 1024); } while (0)
#define PG8_LDB(dst, b, h) do { _Pragma("unroll") for (int n = 0; n < 2; ++n) _Pragma("unroll") for (int k = 0; k < 2; ++k) dst[n][k] = *(const PG8_LAS bf16x8*)(lds + PG8_SB(b, h) + boff + n * 2048 + k * 1024); } while (0)
#define PG8_MMA(ai, bj, At, Bt) do { __builtin_amdgcn_s_setprio(1); _Pragma("unroll") for (int m = 0; m < 4; ++m) _Pragma("unroll") for (int n = 0; n < 2; ++n) _Pragma("unroll") for (int k = 0; k < 2; ++k) \
        acc[ai][bj][m][n] = __builtin_amdgcn_mfma_f32_16x16x32_bf16(Bt[n][k], At[m][k], acc[ai][bj][m][n], 0, 0, 0); __builtin_amdgcn_s_setprio(0); } while (0)
#define PG8_WAIT_V(n) asm volatile("s_waitcnt vmcnt(" #n ")" ::: "memory")
#define PG8_WAIT_L(n) asm volatile("s_waitcnt lgkmcnt(" #n ")" ::: "memory")
#define PG8_BAR __builtin_amdgcn_s_barrier()
#define PG8_SCHED __builtin_amdgcn_sched_barrier(0)
    Unit cur{0, 0, 0, 0}, nxt{0, 0, 0, 0}; int ui = 0;
    if (!S.next(0, cur)) return;
    f32x4 acc[2][2][4][2];
#pragma unroll
    for (int a = 0; a < 2; ++a)
#pragma unroll
        for (int b = 0; b < 2; ++b)
#pragma unroll
            for (int m = 0; m < 4; ++m)
#pragma unroll
                for (int n = 0; n < 2; ++n) acc[a][b][m][n] = (f32x4){0.f, 0.f, 0.f, 0.f};
    bf16x8 At[4][2], B0[2][2], B1[2][2];
    const char* cA = (const char*)g.A + (size_t)cur.pm * tstep + (size_t)cur.k0 * 2; const char* cB = (const char*)g.Bt + (size_t)cur.pn * tstep + (size_t)cur.k0 * 2;
    S.a_ready(cur);
    if constexpr (SP2) {
        PG8_STAGE(PG8_SB(0, 0), cB, voffB); PG8_STAGE(PG8_SB(0, 1), cB + hstep, voffB); PG8_STAGE(PG8_SA(0, 0), cA, voffA); PG8_STAGE(PG8_SA(0, 1), cA + hstep, voffA);
        if (wr == 1) PG8_BAR;
        PG8_WAIT_V(2); PG8_BAR;
        PG8_STAGE(PG8_SB(1, 0), cB + kstep, voffB); PG8_STAGE(PG8_SA(1, 0), cA + kstep, voffA); PG8_STAGE(PG8_SB(1, 1), cB + hstep + kstep, voffB);
        PG8_WAIT_V(6); PG8_BAR;
    } else {
        PG8_STAGE(PG8_SB(0, 0), cB, voffB); PG8_STAGE(PG8_SA(0, 0), cA, voffA); PG8_STAGE(PG8_SB(0, 1), cB + hstep, voffB); PG8_STAGE(PG8_SA(0, 1), cA + hstep, voffA);
        if (wr == 1) PG8_BAR;
        PG8_WAIT_V(4); PG8_BAR;
        PG8_STAGE(PG8_SB(1, 0), cB + kstep, voffB); PG8_STAGE(PG8_SA(1, 0), cA + kstep, voffA); PG8_STAGE(PG8_SB(1, 1), cB + hstep + kstep, voffB);
        PG8_WAIT_V(6); PG8_BAR;
    }
    for (;;) {
        const bool has_next = S.next(ui + 1, nxt);
        const char* nA = has_next ? (const char*)g.A + (size_t)nxt.pm * tstep + (size_t)nxt.k0 * 2 : cA; const char* nB = has_next ? (const char*)g.Bt + (size_t)nxt.pn * tstep + (size_t)nxt.k0 * 2 : cB;
        const int nt = cur.nk ? cur.nk : nt_full;
        for (int t = 0; t < nt; t += 2) {
            const bool last = (t == nt - 2);
            const char* a1 = cA + (size_t)(t + 1) * kstep;
            const char* a2 = last ? nA : cA + (size_t)(t + 2) * kstep; const char* b2 = last ? nB : cB + (size_t)(t + 2) * kstep;
            const char* a3 = a2 + kstep; const char* b3 = b2 + kstep;
            if (last && has_next) S.a_ready(nxt);
            if constexpr (SP2) {
            PG8_LDB(B0, 0, 0); PG8_LDB(B1, 0, 1); PG8_SCHED; PG8_LDA(At, 0, 0); PG8_STAGE(PG8_SA(1, 1), a1 + hstep, voffA);
            PG8_WAIT_V(8); PG8_WAIT_L(0); PG8_BAR; PG8_MMA(0, 0, At, B0); PG8_MMA(0, 1, At, B1); PG8_BAR; PG8_SCHED;
            PG8_LDA(At, 0, 1); PG8_STAGE(PG8_SB(0, 0), b2, voffB); PG8_STAGE(PG8_SB(0, 1), b2 + hstep, voffB); PG8_STAGE(PG8_SA(0, 0), a2, voffA);
            PG8_WAIT_V(8); PG8_WAIT_L(0); PG8_BAR; PG8_MMA(1, 0, At, B0); PG8_MMA(1, 1, At, B1); PG8_BAR; PG8_SCHED;
            PG8_LDB(B0, 1, 0); PG8_LDB(B1, 1, 1); PG8_SCHED; PG8_LDA(At, 1, 0); PG8_STAGE(PG8_SA(0, 1), a2 + hstep, voffA);
            PG8_WAIT_V(8); PG8_WAIT_L(0); PG8_BAR; PG8_MMA(0, 0, At, B0); PG8_MMA(0, 1, At, B1); PG8_BAR; PG8_SCHED;
            PG8_LDA(At, 1, 1); PG8_STAGE(PG8_SB(1, 0), b3, voffB); PG8_STAGE(PG8_SB(1, 1), b3 + hstep, voffB); PG8_STAGE(PG8_SA(1, 0), a3, voffA);
            PG8_WAIT_V(8); PG8_WAIT_L(0); PG8_BAR; PG8_MMA(1, 0, At, B0); PG8_MMA(1, 1, At, B1); PG8_BAR; PG8_SCHED;
            } else {
            PG8_LDB(B0, 0, 0); PG8_SCHED; PG8_LDA(At, 0, 0); PG8_STAGE(PG8_SA(1, 1), a1 + hstep, voffA);
            PG8_WAIT_L(8); PG8_BAR; PG8_WAIT_L(0); PG8_MMA(0, 0, At, B0); PG8_BAR; PG8_SCHED;
            PG8_LDB(B1, 0, 1); PG8_STAGE(PG8_SB(0, 0), b2, voffB);
            PG8_BAR; PG8_WAIT_L(0); PG8_MMA(0, 1, At, B1); PG8_BAR;
            PG8_LDA(At, 0, 1); PG8_STAGE(PG8_SA(0, 0), a2, voffA);
            PG8_BAR; PG8_WAIT_L(0); PG8_MMA(1, 0, At, B0); PG8_BAR; PG8_SCHED;
            PG8_STAGE(PG8_SB(0, 1), b2 + hstep, voffB);
            PG8_WAIT_V(6); PG8_BAR; PG8_MMA(1, 1, At, B1); PG8_BAR;
            PG8_LDB(B0, 1, 0); PG8_SCHED; PG8_LDA(At, 1, 0); PG8_STAGE(PG8_SA(0, 1), a2 + hstep, voffA);
            PG8_WAIT_L(8); PG8_BAR; PG8_WAIT_L(0); PG8_MMA(0, 0, At, B0); PG8_BAR; PG8_SCHED;
            PG8_LDB(B1, 1, 1); PG8_STAGE(PG8_SB(1, 0), b3, voffB);
            PG8_BAR; PG8_WAIT_L(0); PG8_MMA(0, 1, At, B1); PG8_BAR;
            PG8_LDA(At, 1, 1); PG8_STAGE(PG8_SA(1, 0), a3, voffA);
            PG8_BAR; PG8_WAIT_L(0); PG8_MMA(1, 0, At, B0); PG8_BAR; PG8_SCHED;
            PG8_STAGE(PG8_SB(1, 1), b3 + hstep, voffB);
            PG8_WAIT_V(6); PG8_BAR; PG8_MMA(1, 1, At, B1); PG8_BAR;
            }
        }
        if constexpr (ALIGN_EPI) { if (wr == 0) PG8_BAR; }
        if constexpr (!Epi::AFTER_DRAIN) { E(acc, cur, wr, wc, fr, fq); S.done(cur); }
        if (!has_next) break;
#pragma unroll
        for (int a = 0; a < 2; ++a)
#pragma unroll
            for (int b = 0; b < 2; ++b)
#pragma unroll
                for (int m = 0; m < 4; ++m)
#pragma unroll
                    for (int n = 0; n < 2; ++n) acc[a][b][m][n] = (f32x4){0.f, 0.f, 0.f, 0.f};
        cur = nxt; cA = nA; cB = nB; ++ui;
        if constexpr (ALIGN_EPI) { if (wr == 1) PG8_BAR; }
    }
    PG8_WAIT_V(0);
    if constexpr (!ALIGN_EPI) { if (wr == 0) PG8_BAR; }
    PG8_BAR;
    if constexpr (Epi::AFTER_DRAIN) { E.fused(acc, cur, wr, wc, fr, fq, lds, wid, lane); S.done(cur); }
#undef PG8_SA
#undef PG8_SB
#undef PG8_STAGE
#undef PG8_LDA
#undef PG8_LDB
#undef PG8_MMA
#undef PG8_WAIT_V
#undef PG8_WAIT_L
#undef PG8_BAR
#undef PG8_SCHED
}
}

struct Frame {
    LAS unsigned char* lds;
    int tid, lane, wave, vcu, G;
    const float *x, *c, *ctx, *c_ctx, *ada_w, *ada_b, *norm_attn_g, *norm_ffn_g, *ev_w_in, *ev_w_out, *na_rpb, *conv_w, *conv_b, *dt_bias, *a_log, *ssm_d, *ssm_norm_g,
        *ffn_w1, *ffn_w3, *ffn_w2, *od_w_in, *od_w_out, *swa_sink, *ret_log_decay, *ret_gn_g, *ret_gn_b, *moe_router, *moe_w1, *moe_w3, *moe_w2, *final_g;
    float* out;
    float *MOD, *GATE, *ROPE, *X;
    bf16 *WIN0, *WOUT0, *WF13, *WF2, *WIN1, *WOUT1, *WM13, *WM2, *H, *P, *YA0, *YA1, *XBC, *YF0, *YB0, *YF1, *YB1, *Gh, *MG, *HP;
    unsigned* ctl;
    int *TOPK, *SLOT, *CNT, *TILEE, *MMETA; float *Y2T, *PART;
};

__device__ __forceinline__ void tr_item(const float* W, int K, int N, bf16* WT, int ilv, LAS float* scr, int item, int lane, int ldk = 0) {
    if (ldk == 0) ldk = K;
    const int nblk = N / 32, kb = item / nblk, nb = item % nblk, k0 = 64 * kb, n0 = 32 * nb;
#pragma unroll 8
    for (int i = 0; i < 32; ++i) { const int kk = 2 * i + (lane >> 5); scr[kk * 33 + (lane & 31)] = __builtin_nontemporal_load(W + (size_t)(k0 + kk) * N + n0 + (lane & 31)); }
    LDS_WAIT(); asm volatile("" ::: "memory");
    const int c = lane & 7;
#pragma unroll
    for (int j = 0; j < 4; ++j) { const int n = (lane >> 3) + 8 * j; const LAS float* s = scr + (8 * c) * 33 + n;
        v4u o; o.x = pk2(s[0 * 33], s[1 * 33]); o.y = pk2(s[2 * 33], s[3 * 33]); o.z = pk2(s[4 * 33], s[5 * 33]); o.w = pk2(s[6 * 33], s[7 * 33]);
        const int nn = n0 + n; int row = nn;
        if (ilv == 1 || ilv == 2) row = 8 * (nn >> 2) + (nn & 3) + (ilv == 2 ? 4 : 0);
        if (ilv == 3 && (nn < 640 || (nn >= 768 && nn < 1792))) row = (nn & ~63) + 8 * ((nn & 31) >> 2) + 4 * ((nn >> 5) & 1) + (nn & 3);
        __builtin_nontemporal_store(o, (v4u*)(WT + (size_t)row * ldk + k0 + 8 * c)); }
    LDS_WAIT(); asm volatile("" ::: "memory");
}

__device__ __forceinline__ void tr_item64(const float* W, int K, int N, bf16* WT, int ilv, LAS float* scr, int item, int lane, int ldk = 0) {
    if (ldk == 0) ldk = K;
    const int nblk = N / 64, kb = item / nblk, nb = item % nblk, k0 = 64 * kb, n0 = 64 * nb, c4 = (lane & 15) * 4;
    f32x4 v[16];
#pragma unroll
    for (int i = 0; i < 16; ++i) v[i] = NTL((const f32x4*)(W + (size_t)(k0 + 4 * i + (lane >> 4)) * N + n0 + c4));
#pragma unroll
    for (int i = 0; i < 16; ++i) { LAS float* d = scr + (4 * i + (lane >> 4)) * 65 + c4; d[0] = v[i].x; d[1] = v[i].y; d[2] = v[i].z; d[3] = v[i].w; }
    LDS_WAIT(); asm volatile("" ::: "memory");
    const int c = lane & 7;
#pragma unroll
    for (int j = 0; j < 8; ++j) { const int n = (lane >> 3) + 8 * j; const LAS float* s = scr + (8 * c) * 65 + n;
        v4u o; o.x = pk2(s[0 * 65], s[1 * 65]); o.y = pk2(s[2 * 65], s[3 * 65]); o.z = pk2(s[4 * 65], s[5 * 65]); o.w = pk2(s[6 * 65], s[7 * 65]);
        const int nn = n0 + n; int row = nn;
        if (ilv == 1 || ilv == 2) row = 8 * (nn >> 2) + (nn & 3) + (ilv == 2 ? 4 : 0);
        if (ilv == 3 && (nn < 640 || (nn >= 768 && nn < 1792))) row = (nn & ~63) + 8 * ((nn & 31) >> 2) + 4 * ((nn >> 5) & 1) + (nn & 3);
        NTS(o, (v4u*)(WT + (size_t)row * ldk + k0 + 8 * c)); }
    LDS_WAIT(); asm volatile("" ::: "memory");
}

__device__ __forceinline__ void ph_cvt(const Frame& F) {
    LAS float* scr = (LAS float*)(F.lds + F.wave * 16640);
    const int gw = F.vcu * NWAVES + F.wave, NGW = F.G * NWAVES;
    constexpr int I_IN0 = 16 * 129, I_OUT = 24 * 16, I_F1 = 16 * 44, I_F2 = 44 * 16, I_IN1 = 16 * 60;
    constexpr int NITEMS = I_IN0 + I_OUT + 2 * I_F1 + I_F2 + I_IN1 + I_OUT;
    for (int it = gw; it < NITEMS; it += NGW) {
        int r = it;
        if (r < I_IN0) { tr_item(F.ev_w_in, 1024, 4128, F.WIN0, 0, scr, r, F.lane); continue; } r -= I_IN0;
        if (r < I_OUT) { tr_item64(F.ev_w_out, 1536, 1024, F.WOUT0, 0, scr, r, F.lane); continue; } r -= I_OUT;
        if (r < I_F1) { tr_item64(F.ffn_w1, 1024, DFF, F.WF13, 1, scr, r, F.lane); continue; } r -= I_F1;
        if (r < I_F1) { tr_item64(F.ffn_w3, 1024, DFF, F.WF13, 2, scr, r, F.lane); continue; } r -= I_F1;
        if (r < I_F2) { tr_item64(F.ffn_w2, DFF, 1024, F.WF2, 0, scr, r, F.lane); continue; } r -= I_F2;
        if (r < I_IN1) { tr_item64(F.od_w_in, 1024, LDP1, F.WIN1, 3, scr, r, F.lane); continue; } r -= I_IN1;
        tr_item64(F.od_w_out, 1536, 1024, F.WOUT1, 0, scr, r, F.lane, LDYA1);
    }
    { const int gt = F.vcu * 512 + F.tid, NGT = F.G * 512; v4u* z = (v4u*)(F.WIN0 + (size_t)4128 * 1024);
      for (int i = gt; i < 224 * 1024 / 8; i += NGT) z[i] = (v4u){0u, 0u, 0u, 0u}; }
    { const int gt = F.vcu * 512 + F.tid, NGT = F.G * 512;
      for (int i = gt; i < 2048 * 32; i += NGT) { const int t = i >> 5, f = i & 31; const float inv = powf(10000.f, -(float)(f & 15) / 16.f);
          const float ang = (float)((f < 16) ? (t >> 6) : (t & 63)) * inv; float sn, cs; sincosf(ang, &sn, &cs); F.ROPE[2 * i] = cs; F.ROPE[2 * i + 1] = sn; } }
    __syncthreads();
    LAS float* sv = (LAS float*)F.lds;
    LAS float* part = (LAS float*)(F.lds + 36864);
    for (int it = F.vcu; it < 192; it += F.G) {
        const int l = it / 96, n0 = (it % 96) * 64;
        for (int i = F.tid; i < 9 * 1024; i += 512) { const int r = i >> 10, k = i & 1023; const float v = (r < 8) ? F.c[r * 1024 + k] : F.c_ctx[k]; sv[i] = silu_f(v); }
        __syncthreads();
        float acc[9];
#pragma unroll
        for (int r = 0; r < 9; ++r) acc[r] = 0.f;
        const float* wp = F.ada_w + (size_t)l * 1024 * 6144 + n0 + F.lane;
#pragma unroll 8
        for (int k = F.wave * 128; k < F.wave * 128 + 128; ++k) { const float w = NTL(wp + (size_t)k * 6144);
#pragma unroll
            for (int r = 0; r < 9; ++r) acc[r] += sv[r * 1024 + k] * w; }
#pragma unroll
        for (int r = 0; r < 9; ++r) part[(F.wave * 9 + r) * 64 + F.lane] = acc[r];
        __syncthreads();
        for (int i = F.tid; i < 9 * 64; i += 512) { const int r = i >> 6, n = i & 63; float s = 0.f;
#pragma unroll
            for (int w = 0; w < 8; ++w) s += part[(w * 9 + r) * 64 + n];
            F.MOD[(size_t)(l * 9 + r) * 6144 + n0 + n] = s + F.ada_b[l * 6144 + n0 + n]; }
        __syncthreads();
    }
}

__device__ __forceinline__ int cvt_claim(const Frame& F, int word, int n) {
    int it = 0;
    if (F.lane == 0) it = (int)__hip_atomic_fetch_add(F.ctl + word, (unsigned)n, __ATOMIC_RELAXED, __HIP_MEMORY_SCOPE_AGENT);
    return __builtin_amdgcn_readfirstlane(it);
}
__device__ __forceinline__ bool cvt_pull(const Frame& F, int budget, bool allow13) {
    LAS float* scr = (LAS float*)(F.lds + F.wave * 16384);
    constexpr int I_1 = 16 * 112, I_2 = 56 * 32, N2 = NEXP * I_2, N13 = NEXP * 2 * I_1;
    int left = budget;
    { const int b = cvt_claim(F, CW_Q2, budget);
      for (int it = b; it < b + budget && it < N2; ++it) { const int e = it / I_2, r = it % I_2; tr_item(F.moe_w2 + (size_t)e * DFE * 1024, DFE, 1024, F.WM2 + (size_t)e * 1024 * DFE, 0, scr, r, F.lane); --left; } }
    if (left == 0) return true;
    if (!allow13) return false;
    const int b = cvt_claim(F, CW_Q13, left);
    if (b >= N13) return false;
    for (int it = b; it < b + left && it < N13; ++it) { const int e = it / (2 * I_1), r = it % (2 * I_1);
        if (r < I_1) tr_item(F.moe_w1 + (size_t)e * 1024 * DFE, 1024, DFE, F.WM13 + (size_t)e * 7168 * LDHP, 1, scr, r, F.lane, LDHP);
        else tr_item(F.moe_w3 + (size_t)e * 1024 * DFE, 1024, DFE, F.WM13 + (size_t)e * 7168 * LDHP, 2, scr, r - I_1, F.lane, LDHP); }
    return true;
}
__device__ __forceinline__ void cvt_drain(const Frame& F) {
    LAS float* scr = (LAS float*)(F.lds + F.wave * 16384);
    constexpr int I_1 = 16 * 112, I_2 = 56 * 32, N2 = NEXP * I_2, N13 = NEXP * 2 * I_1, CH = 16;
    for (;;) { const int b = cvt_claim(F, CW_Q2, CH); if (b >= N2) break;
        for (int it = b; it < b + CH && it < N2; ++it) { const int e = it / I_2, r = it % I_2; tr_item(F.moe_w2 + (size_t)e * DFE * 1024, DFE, 1024, F.WM2 + (size_t)e * 1024 * DFE, 0, scr, r, F.lane); } }
    for (;;) { const int b = cvt_claim(F, CW_Q13, CH); if (b >= N13) break;
        for (int it = b; it < b + CH && it < N13; ++it) { const int e = it / (2 * I_1), r = it % (2 * I_1);
            if (r < I_1) tr_item(F.moe_w1 + (size_t)e * 1024 * DFE, 1024, DFE, F.WM13 + (size_t)e * 7168 * LDHP, 1, scr, r, F.lane, LDHP);
            else tr_item(F.moe_w3 + (size_t)e * 1024 * DFE, 1024, DFE, F.WM13 + (size_t)e * 7168 * LDHP, 2, scr, r - I_1, F.lane, LDHP); } }
}
__device__ __forceinline__ void ph_cvt_moe(const Frame& F) {
    LAS float* scr = (LAS float*)(F.lds + F.wave * 16640);
    const int gw = F.vcu * NWAVES + F.wave, NGW = F.G * NWAVES;
    constexpr int I_1 = 16 * 56, I_2 = 56 * 16, N2 = NEXP * I_2, N13 = NEXP * 2 * I_1;
    for (int it = gw; it < N2 + N13; it += NGW) {
        if (it < N2) { const int e = it / I_2, r = it % I_2; tr_item64(F.moe_w2 + (size_t)e * DFE * 1024, DFE, 1024, F.WM2 + (size_t)e * 1024 * DFE, 0, scr, r, F.lane); continue; }
        const int q = it - N2, e = q / (2 * I_1), r = q % (2 * I_1);
        if (r < I_1) tr_item64(F.moe_w1 + (size_t)e * 1024 * DFE, 1024, DFE, F.WM13 + (size_t)e * 7168 * LDHP, 1, scr, r, F.lane, LDHP);
        else tr_item64(F.moe_w3 + (size_t)e * 1024 * DFE, 1024, DFE, F.WM13 + (size_t)e * 7168 * LDHP, 2, scr, r - I_1, F.lane, LDHP);
    }
}
__device__ __forceinline__ bool short_round(const Frame& F, int units) { const int rem = units % F.G; return rem != 0 && (int)blockIdx.x >= rem; }

template <int MODE, bool ROUTER, int CTXSUM = 0>
__device__ __forceinline__ void ph_norm(const Frame& F, int layer, int which, int nrows) {
    const int gw = F.vcu * NWAVES + F.wave, NGW = F.G * NWAVES;
    const float* g = (which ? F.norm_ffn_g : F.norm_attn_g) + layer * 1024;
    for (int row0 = gw * 4; row0 < nrows; row0 += NGW * 4) {
        const int bidx = row0 < TL ? (row0 >> 11) : 8;
        const float* mod = F.MOD + (size_t)(layer * 9 + bidx) * 6144 + (which ? 3 : 0) * 1024;
        f32x4 v[4][4];
#pragma unroll
        for (int r = 0; r < 4; ++r) { const int row = row0 + r;
            const float* src = MODE == 0 ? (row < TL ? F.x + (size_t)row * 1024 : F.ctx + (size_t)(row - TL) * 1024) : F.X + (size_t)row * 1024;
#pragma unroll
            for (int j = 0; j < 4; ++j) v[r][j] = __builtin_nontemporal_load((const f32x4*)src + F.lane + 64 * j); }
        if (CTXSUM != 0 && row0 >= TL) {
#pragma unroll
            for (int r = 0; r < 4; ++r) { const int row = row0 + r;
#pragma unroll
                for (int j = 0; j < 4; ++j) { if (CTXSUM == 1) v[r][j] = ((const f32x4*)(F.ctx + (size_t)(row - TL) * 1024))[F.lane + 64 * j];
                    f32x4 sum = (f32x4){0.f, 0.f, 0.f, 0.f};
#pragma unroll
                    for (int sl = 0; sl < 6; ++sl) sum += ((const f32x4*)(F.PART + ((size_t)sl * TC + (row - TL)) * 1024))[F.lane + 64 * j];
                    const f32x4 gq = ((const f32x4*)(F.MOD + (size_t)8 * 6144 + (CTXSUM == 1 ? 2 : 5) * 1024))[F.lane + 64 * j];
                    v[r][j] = v[r][j] + gq * sum; ((f32x4*)(F.X + (size_t)row * 1024))[F.lane + 64 * j] = v[r][j]; } } }
        f32x4 gg[4], sh[4], sc[4];
#pragma unroll
        for (int j = 0; j < 4; ++j) { gg[j] = ((const f32x4*)g)[F.lane + 64 * j]; sh[j] = ((const f32x4*)mod)[F.lane + 64 * j]; sc[j] = ((const f32x4*)(mod + 1024))[F.lane + 64 * j] + 1.0f; gg[j] = gg[j] * sc[j]; }
        float ss[4];
#pragma unroll
        for (int r = 0; r < 4; ++r) { float s = 0.f;
#pragma unroll
            for (int j = 0; j < 4; ++j) s += (v[r][j].x * v[r][j].x + v[r][j].y * v[r][j].y) + (v[r][j].z * v[r][j].z + v[r][j].w * v[r][j].w);
            ss[r] = s; }
#pragma unroll
        for (int o = 1; o < 64; o <<= 1) {
#pragma unroll
            for (int r = 0; r < 4; ++r) ss[r] += __shfl_xor(ss[r], o); }
#pragma unroll
        for (int r = 0; r < 4; ++r) { const float rstd = 1.0f / sqrtf(ss[r] * (1.f / 1024.f) + EPS);
            unsigned long long* o8 = (unsigned long long*)(F.H + (size_t)(row0 + r) * 1024) + F.lane;
#pragma unroll
            for (int j = 0; j < 4; ++j) { const f32x4 hv = (v[r][j] * rstd) * gg[j] + sh[j];
                NTS((unsigned long long)pk2(hv.x, hv.y) | ((unsigned long long)pk2(hv.z, hv.w) << 32), o8 + 64 * j); } }
    }
}

template <class Epi>
__device__ __forceinline__ void gemm_simple(const Frame& F, const bf16* A, const bf16* Bt, int M, int N, int K, const Epi& E) {
    const int nN = N / 128, nU = (M / 256) * nN;
    const int wr = F.wave >> 1, wc = F.wave & 1, fr = F.lane & 15, fq = F.lane >> 4;
    for (int u = F.vcu; u < nU; u += F.G) {
        const int pm = u / nN, pn = u % nN, row0 = pm * 256 + wr * 64, col0 = pn * 128 + wc * 64;
        f32x4 acc[4][4];
#pragma unroll
        for (int i = 0; i < 4; ++i)
#pragma unroll
            for (int j = 0; j < 4; ++j) acc[i][j] = (f32x4){0.f, 0.f, 0.f, 0.f};
        const bf16* ap = A + (size_t)(row0 + fr) * K + fq * 8;
        const bf16* bp0 = Bt + (size_t)(col0 + perm32(fr)) * K + fq * 8;
        const bf16* bp1 = Bt + (size_t)(col0 + perm32(16 + fr)) * K + fq * 8;
#pragma unroll 2
        for (int k0 = 0; k0 < K; k0 += 32) {
            bf16x8 a[4], b[4];
#pragma unroll
            for (int i = 0; i < 4; ++i) a[i] = *(const bf16x8*)(ap + (size_t)(16 * i) * K + k0);
            b[0] = *(const bf16x8*)(bp0 + k0); b[1] = *(const bf16x8*)(bp1 + k0);
            b[2] = *(const bf16x8*)(bp0 + (size_t)32 * K + k0); b[3] = *(const bf16x8*)(bp1 + (size_t)32 * K + k0);
#pragma unroll
            for (int i = 0; i < 4; ++i)
#pragma unroll
                for (int j = 0; j < 4; ++j) acc[i][j] = __builtin_amdgcn_mfma_f32_16x16x32_bf16(b[j], a[i], acc[i][j], 0, 0, 0);
        }
#pragma unroll
        for (int i = 0; i < 4; ++i)
#pragma unroll
            for (int q = 0; q < 2; ++q) E(row0 + 16 * i + fr, col0 + 32 * q + 8 * fq, acc[i][2 * q], acc[i][2 * q + 1]);
    }
}

struct EpiStore {
    bf16* O; int ldc;
    __device__ __forceinline__ void operator()(int row, int col, f32x4 lo, f32x4 hi, int part = 0) const {
        v4u w; w.x = pk2(lo.x, lo.y); w.y = pk2(lo.z, lo.w); w.z = pk2(hi.x, hi.y); w.w = pk2(hi.z, hi.w);
        *(v4u*)(O + (size_t)row * ldc + col) = w; }
};
struct EpiSwiglu {
    bf16* O; int ldc;
    __device__ __forceinline__ void operator()(int row, int col, f32x4 lo, f32x4 hi, int part = 0) const {
        v2u w; w.x = pk2(silu_f(lo.x) * hi.x, silu_f(lo.y) * hi.y); w.y = pk2(silu_f(lo.z) * hi.z, silu_f(lo.w) * hi.w);
        *(v2u*)(O + (size_t)row * ldc + (col >> 1)) = w; }
};
struct EpiResid {
    const float* bl; const float* bc; float* X; const float* gate  ; const float* rs; int rs_ld, rs_off;
    __device__ __forceinline__ void operator()(int row, int col, f32x4 lo, f32x4 hi, int part = 0) const {
        const int bidx = row < TL ? (row >> 11) : 8;
        const float* b = row < TL ? bl + (size_t)row * 1024 + col : bc + (size_t)(row - TL) * 1024 + col;
        const float* gp = gate + (size_t)bidx * 6144 + col;
        float sc = 1.f; if (rs) sc = rs[(size_t)row * rs_ld + rs_off];
        const f32x4 g0 = ((const f32x4*)gp)[0] * sc, g1 = ((const f32x4*)gp)[1] * sc;
        const f32x4 b0 = ((const f32x4*)b)[0], b1 = ((const f32x4*)b)[1];
        float* o = X + (size_t)row * 1024 + col;
        ((f32x4*)o)[0] = b0 + g0 * lo; ((f32x4*)o)[1] = b1 + g1 * hi; }
};

struct EpiRope {
    bf16* O; const LAS float* tab;
    __device__ __forceinline__ void operator()(int row, int col, f32x4 lo, f32x4 hi, int part = 0) const {
        if (col < 640 || (col >= 768 && col < 1792)) {
            const int hb = col & ~63, d0 = (col & 63) >> 1;
            f32x4 c01 = (f32x4){1.f, 0.f, 1.f, 0.f}, c23 = (f32x4){1.f, 0.f, 1.f, 0.f};
            if (row < TL) { const int t = row & 2047, pos = (d0 < 16) ? (t >> 6) : 32 + (t & 63); const LAS float* tp = tab + (pos * 16 + (d0 & 15)) * 2; c01 = ((const LAS f32x4*)tp)[0]; c23 = ((const LAS f32x4*)tp)[1]; }
            v2u a, b;
            a.x = pk2(lo.x * c01.x - hi.x * c01.y, lo.y * c01.z - hi.y * c01.w); a.y = pk2(lo.z * c23.x - hi.z * c23.y, lo.w * c23.z - hi.w * c23.w);
            b.x = pk2(hi.x * c01.x + lo.x * c01.y, hi.y * c01.z + lo.y * c01.w); b.y = pk2(hi.z * c23.x + lo.z * c23.y, hi.w * c23.z + lo.w * c23.w);
            *(v2u*)(O + (size_t)row * LDP1 + hb + d0) = a; *(v2u*)(O + (size_t)row * LDP1 + hb + 32 + d0) = b;
        } else { v4u w; w.x = pk2(lo.x, lo.y); w.y = pk2(lo.z, lo.w); w.z = pk2(hi.x, hi.y); w.w = pk2(hi.z, hi.w); *(v4u*)(O + (size_t)row * LDP1 + col) = w; }
    }
};
struct In1Order {
    int G, c;
    __device__ __forceinline__ bool next(int i, pg8::Unit& u) const {
        const int L0 = i * G + c; if (L0 >= 1016) return false;
        const int L = (L0 & 7) * 127 + (L0 >> 3);
        if (L < 960) { const int grp = L / 120, rem = L % 120; u.pm = grp * 8 + (rem & 7); u.pn = rem >> 3; }
        else { const int q = L - 960, j = q >> 3; u.pm = 64 + (q & 7); u.pn = (j == 0) ? 2 : 4 + j; }
        u.k0 = 0; u.nk = 0; return true; }
    __device__ __forceinline__ void a_ready(const pg8::Unit&) const {}
    __device__ __forceinline__ void done(const pg8::Unit&) const {}
};
struct EpiNull {
    __device__ __forceinline__ void operator()(int row, int col, f32x4 lo, f32x4 hi, int part = 0) const { asm volatile("" :: "v"(lo), "v"(hi), "v"(row), "v"(col)); }
};
template <class F8> struct EpiAdapt {
    static constexpr bool PERM = true, AFTER_DRAIN = false;
    F8 f;
    __device__ __forceinline__ void operator()(const pg8::f32x4 (&acc)[2][2][4][2], const pg8::Unit& u, int wr, int wc, int fr, int fq) const {
#pragma unroll
        for (int ai = 0; ai < 2; ++ai)
#pragma unroll
            for (int m = 0; m < 4; ++m) { const int row = u.pm * 256 + ai * 128 + wr * 64 + m * 16 + fr;
#pragma unroll
                for (int bj = 0; bj < 2; ++bj) f(row, u.pn * 256 + bj * 128 + wc * 32 + 8 * fq, acc[ai][bj][m][0], acc[ai][bj][m][1], u.nk != 0 ? 1 + u.k0 : 0);
                if (m & 1) asm volatile("" ::: "memory"); }
    }
};
#ifndef USE_SIMPLE_GEMM
#define USE_SIMPLE_GEMM 0
#endif
template <class F8>
__device__ __forceinline__ void gemm_pg8(const Frame& F, const bf16* A, const bf16* Bt, int M, int N, int K, const F8& f, int ld = 0) {
#if USE_SIMPLE_GEMM
    gemm_simple(F, A, Bt, M, N, K, f);
#else
    pg8::Gemm g{A, Bt, M, N, K, ld}; pg8::StaticOrder S; S.init(M, N, F.G, (int)blockIdx.x);
    EpiAdapt<F8> E{f};
    pg8::gemm_phase<EpiAdapt<F8>, pg8::StaticOrder, true, true>(F.lds, g, S, E);
#endif
}

struct EpiResidTail {
    EpiResid R; float* part; int kslice;
    __device__ __forceinline__ void operator()(int row, int col, f32x4 lo, f32x4 hi, int p = 0) const {
        if (p == 0) { R(row, col, lo, hi, 0); return; }
        float* o = part + ((size_t)((p - 1) / kslice) * TC + (row - TL)) * 1024 + col; ((f32x4*)o)[0] = lo; ((f32x4*)o)[1] = hi; }
};
struct TailOrder {
    pg8::StaticOrder S0; int G, c, K;
    __device__ __forceinline__ void init(int G_, int c_, int K_) { S0.init(TL, 1024, G_, c_); G = G_; c = c_; K = K_; }
    __device__ __forceinline__ bool next(int i, pg8::Unit& u) const {
        const int r0 = (256 + G - 1) / G;
        if (i < r0) return S0.next(i, u);
        const int q = (i - r0) * G + c; if (q >= 32 * 6) return false;
        const int bu = q & 31, sl = q >> 5; u.pm = 64 + (bu >> 2); u.pn = bu & 3;
        if (K == 1536) { u.k0 = sl * 256; u.nk = 4; } else { u.k0 = sl * 512; u.nk = (sl == 5) ? 4 : 8; }
        return true; }
    __device__ __forceinline__ void a_ready(const pg8::Unit&) const {}
    __device__ __forceinline__ void done(const pg8::Unit&) const {}
};
template <class F8>
__device__ __forceinline__ void gemm_tail(const Frame& F, const bf16* A, const bf16* Bt, int K, const F8& f) {
    pg8::Gemm g{A, Bt, TT, 1024, K, 0}; TailOrder S; S.init(F.G, (int)blockIdx.x, K);
    EpiAdapt<F8> E{f};
    pg8::gemm_phase<EpiAdapt<F8>, TailOrder, true, true>(F.lds, g, S, E);
}

#define DOT64(s, q, kp) do { s = 0.f; _Pragma("unroll") for (int _c = 0; _c < 8; ++_c) { const v4u _w = ((const v4u*)(kp))[_c]; \
    s += q[8*_c+0] * bflo(_w.x) + q[8*_c+1] * bfhi(_w.x) + q[8*_c+2] * bflo(_w.y) + q[8*_c+3] * bfhi(_w.y) + q[8*_c+4] * bflo(_w.z) + q[8*_c+5] * bfhi(_w.z) + q[8*_c+6] * bflo(_w.w) + q[8*_c+7] * bfhi(_w.w); } } while (0)
#define ONLINE_UPD(s, m, l, o, vp) do { if (s > m) { const float _cr = __expf(m - s); l *= _cr; _Pragma("unroll") for (int _d = 0; _d < 64; ++_d) o[_d] *= _cr; m = s; } \
    const float _p = __expf(s - m); l += _p; _Pragma("unroll") for (int _c = 0; _c < 8; ++_c) { const v4u _w = ((const v4u*)(vp))[_c]; \
    o[8*_c+0] += _p * bflo(_w.x); o[8*_c+1] += _p * bfhi(_w.x); o[8*_c+2] += _p * bflo(_w.y); o[8*_c+3] += _p * bfhi(_w.y); o[8*_c+4] += _p * bflo(_w.z); o[8*_c+5] += _p * bfhi(_w.z); o[8*_c+6] += _p * bflo(_w.w); o[8*_c+7] += _p * bfhi(_w.w); } } while (0)
#define LOADQ64(q, qp, scale) do { _Pragma("unroll") for (int _c = 0; _c < 8; ++_c) { const v4u _w = ((const v4u*)(qp))[_c]; \
    q[8*_c+0] = scale * bflo(_w.x); q[8*_c+1] = scale * bfhi(_w.x); q[8*_c+2] = scale * bflo(_w.y); q[8*_c+3] = scale * bfhi(_w.y); q[8*_c+4] = scale * bflo(_w.z); q[8*_c+5] = scale * bfhi(_w.z); q[8*_c+6] = scale * bflo(_w.w); q[8*_c+7] = scale * bfhi(_w.w); } } while (0)
#define STORE_O64(op, o, inv) do { _Pragma("unroll") for (int _c = 0; _c < 8; ++_c) { v4u _w; _w.x = pk2(o[8*_c+0] * inv, o[8*_c+1] * inv); _w.y = pk2(o[8*_c+2] * inv, o[8*_c+3] * inv); \
    _w.z = pk2(o[8*_c+4] * inv, o[8*_c+5] * inv); _w.w = pk2(o[8*_c+6] * inv, o[8*_c+7] * inv); ((v4u*)(op))[_c] = _w; } } while (0)

__device__ __forceinline__ void ph_conv(const Frame& F) {
    const int gt = F.vcu * 512 + F.tid, NGT = F.G * 512;
    for (int idx = gt; idx < (TT / 16) * 192; idx += NGT) {
        const int rb = idx / 192, ch = (idx % 192) * 8, row0 = rb * 16;
        int t0, len; if (row0 < TL) { t0 = row0 & 2047; len = 2048; } else { t0 = (row0 - TL) & 255; len = 256; }
        float wgt[5][8], bias[8];
#pragma unroll
        for (int k = 0; k < 5; ++k) { const f32x4 a = *(const f32x4*)(F.conv_w + k * 1536 + ch), b = *(const f32x4*)(F.conv_w + k * 1536 + ch + 4);
            wgt[k][0] = a.x; wgt[k][1] = a.y; wgt[k][2] = a.z; wgt[k][3] = a.w; wgt[k][4] = b.x; wgt[k][5] = b.y; wgt[k][6] = b.z; wgt[k][7] = b.w; }
        { const f32x4 a = *(const f32x4*)(F.conv_b + ch), b = *(const f32x4*)(F.conv_b + ch + 4); bias[0] = a.x; bias[1] = a.y; bias[2] = a.z; bias[3] = a.w; bias[4] = b.x; bias[5] = b.y; bias[6] = b.z; bias[7] = b.w; }
        const bf16* src = F.P + (size_t)row0 * LDP0 + 2560 + ch;
        const v4u zero = (v4u){0u, 0u, 0u, 0u};
        v4u win[5];
        win[0] = (t0 - 2 >= 0) ? *(const v4u*)(src - 2 * LDP0) : zero; win[1] = (t0 - 1 >= 0) ? *(const v4u*)(src - LDP0) : zero;
        win[2] = *(const v4u*)src; win[3] = *(const v4u*)(src + LDP0);
#pragma unroll
        for (int i = 0; i < 16; ++i) {
            win[4] = (t0 + i + 2 < len) ? NTL((const v4u*)(src + (size_t)(i + 2) * LDP0)) : zero;
            float acc[8];
#pragma unroll
            for (int j = 0; j < 8; ++j) acc[j] = bias[j];
#pragma unroll
            for (int k = 0; k < 5; ++k) { const v4u wv = win[k];
                acc[0] += wgt[k][0] * bflo(wv.x); acc[1] += wgt[k][1] * bfhi(wv.x); acc[2] += wgt[k][2] * bflo(wv.y); acc[3] += wgt[k][3] * bfhi(wv.y);
                acc[4] += wgt[k][4] * bflo(wv.z); acc[5] += wgt[k][5] * bfhi(wv.z); acc[6] += wgt[k][6] * bflo(wv.w); acc[7] += wgt[k][7] * bfhi(wv.w); }
            v4u o; o.x = pk2(silu_f(acc[0]), silu_f(acc[1])); o.y = pk2(silu_f(acc[2]), silu_f(acc[3])); o.z = pk2(silu_f(acc[4]), silu_f(acc[5])); o.w = pk2(silu_f(acc[6]), silu_f(acc[7]));
            NTS(o, (v4u*)(F.XBC + (size_t)(row0 + i) * 1536 + ch));
            win[0] = win[1]; win[1] = win[2]; win[2] = win[3]; win[3] = win[4];
        }
    }
}

__device__ __forceinline__ int scan_row(int b, int d, int s) {
    if (s < 256) return TL + b * 256 + (d ? 255 - s : s);
    const int t = s - 256; return b * 2048 + (d ? 2047 - t : t);
}

typedef short s16x4 __attribute__((ext_vector_type(4)));
__device__ __forceinline__ s16x4 lds_tr(const LAS unsigned char* p) { return __builtin_bit_cast(s16x4, __builtin_amdgcn_ds_read_tr16_b64_v4i16((LAS s16x4*)p)); }
__device__ __forceinline__ bf16x8 cat8(s16x4 a, s16x4 b) { return __builtin_shufflevector(a, b, 0, 1, 2, 3, 4, 5, 6, 7); }
template <int NST, bool RET>
__device__ __forceinline__ void chunk_scan(const Frame& F) {
    constexpr int SC = NST * 2 + 16, SX = 64 * 2 + 16, SH = NST * 2 + 16, NKS = NST / 32, NHT = NST / 32, NP = NST / 32  , PPR = NST / 8  ;
    LAS unsigned char* Cs = F.lds;
    LAS unsigned char* Bs = Cs + 128 * SC;
    LAS unsigned char* Xs = Bs + 128 * SC;
    LAS unsigned char* Xw = Xs + 128 * SX;
    LAS unsigned char* Hs = Xw + 128 * SX;
    LAS float* acs = (LAS float*)(Hs + 64 * SH);
    LAS float* dts = acs + 128;
    const int w = F.wave, lane = F.lane, l15 = lane & 15, g = lane >> 4, q4 = l15 >> 2, p4 = lane & 3;
    for (int u = F.vcu; u < 256; u += F.G) {
        int d, h, b, grp = 0, ph = 0;
        if (RET) { ph = u & 1; d = (u >> 1) & 1; h = (u >> 2) & 7; b = u >> 5; } else { d = u & 1; h = (u >> 1) & 15; b = u >> 5; grp = h >> 3; }
        float dtb = 0.f, Acoef = 0.f, lgam = 0.f;
        if (RET) lgam = log1pf(-expf(F.ret_log_decay[d * 8 + h])); else { dtb = F.dt_bias[d * 16 + h]; Acoef = -expf(F.a_log[d * 16 + h]); }
        const int nt = RET ? (w & 3) : w, pt0 = RET ? 2 * (w >> 2) : 0;
        const int ycol = RET ? h * 128 + ph * 64 : h * 64;
        bf16* Y = RET ? (d ? F.YB1 : F.YF1) : (d ? F.YB0 : F.YF0);
        f32x4 Hacc[NHT];
#pragma unroll
        for (int k = 0; k < NHT; ++k) Hacc[k] = (f32x4){0.f, 0.f, 0.f, 0.f};
        __syncthreads();
        for (int idx = F.tid; idx < 64 * SH / 16; idx += 512) ((LAS v4u*)Hs)[idx] = (v4u){0u, 0u, 0u, 0u};
        v4u rc[NP], rb[NP], rx[2]; unsigned short rdt0 = 0, rdt1 = 0;
#define SCAN_ISSUE(ck_) do { \
            _Pragma("unroll") for (int k = 0; k < NP; ++k) { const int idx = F.tid + 512 * k, i = idx / PPR, c = idx % PPR; const size_t row = scan_row(b, d, (ck_) * 128 + i); \
                if (RET) { const bf16* pr = F.P + row * LDP1 + h * 64 + c * 8; rc[k] = *(const v4u*)(pr + 768); rb[k] = *(const v4u*)(pr + 1280); } \
                else { const bf16* pr = F.XBC + row * 1536 + grp * 128 + c * 8; rc[k] = *(const v4u*)(pr + 1280); rb[k] = *(const v4u*)(pr + 1024); } } \
            _Pragma("unroll") for (int k = 0; k < 2; ++k) { const int idx = F.tid + 512 * k, i = idx >> 3, c = idx & 7; const size_t row = scan_row(b, d, (ck_) * 128 + i); \
                rx[k] = RET ? *(const v4u*)(F.P + row * LDP1 + 1792 + h * 128 + ph * 64 + c * 8) : *(const v4u*)(F.XBC + row * 1536 + h * 64 + c * 8); } \
            if (!RET) { rdt0 = F.P[(size_t)scan_row(b, d, (ck_) * 128 + lane) * LDP0 + 4096 + d * 16 + h]; rdt1 = F.P[(size_t)scan_row(b, d, (ck_) * 128 + 64 + lane) * LDP0 + 4096 + d * 16 + h]; } \
        } while (0)
        SCAN_ISSUE(0);
        for (int ck = 0; ck < 18; ++ck) {
            float atot;
            { float dt0 = 1.f, dt1 = 1.f, a0 = lgam, a1 = lgam;
              if (!RET) { const float x0 = bf2f(rdt0) + dtb, x1 = bf2f(rdt1) + dtb;
                  dt0 = x0 > 20.f ? x0 : log1pf(__expf(x0)); dt1 = x1 > 20.f ? x1 : log1pf(__expf(x1)); a0 = dt0 * Acoef; a1 = dt1 * Acoef; }
              float v0 = a0, v1 = a1;
#pragma unroll
              for (int o = 1; o < 64; o <<= 1) { const float n0 = __shfl_up(v0, o), n1 = __shfl_up(v1, o); if (lane >= o) { v0 += n0; v1 += n1; } }
              v1 += __shfl(v0, 63); atot = __shfl(v1, 63);
              acs[lane] = v0; acs[64 + lane] = v1; dts[lane] = dt0; dts[64 + lane] = dt1; }
            LDS_WAIT(); asm volatile("" ::: "memory");
#pragma unroll
            for (int k = 0; k < NP; ++k) { const int idx = F.tid + 512 * k, i = idx / PPR, c = idx % PPR;
                v4u kv = rb[k];
                if (RET) { kv.x = pk2(0.125f * bflo(kv.x), 0.125f * bfhi(kv.x)); kv.y = pk2(0.125f * bflo(kv.y), 0.125f * bfhi(kv.y)); kv.z = pk2(0.125f * bflo(kv.z), 0.125f * bfhi(kv.z)); kv.w = pk2(0.125f * bflo(kv.w), 0.125f * bfhi(kv.w)); }
                *(LAS v4u*)(Cs + i * SC + c * 16) = rc[k]; *(LAS v4u*)(Bs + i * SC + c * 16) = kv; }
#pragma unroll
            for (int k = 0; k < 2; ++k) { const int idx = F.tid + 512 * k, i = idx >> 3, c = idx & 7; const v4u xv = rx[k];
                const float dtj = dts[i], wj = dtj * __expf(atot - acs[i]);
                v4u a, bq; a.x = pk2(dtj * bflo(xv.x), dtj * bfhi(xv.x)); a.y = pk2(dtj * bflo(xv.y), dtj * bfhi(xv.y)); a.z = pk2(dtj * bflo(xv.z), dtj * bfhi(xv.z)); a.w = pk2(dtj * bflo(xv.w), dtj * bfhi(xv.w));
                bq.x = pk2(wj * bflo(xv.x), wj * bfhi(xv.x)); bq.y = pk2(wj * bflo(xv.y), wj * bfhi(xv.y)); bq.z = pk2(wj * bflo(xv.z), wj * bfhi(xv.z)); bq.w = pk2(wj * bflo(xv.w), wj * bfhi(xv.w));
                *(LAS v4u*)(Xs + i * SX + c * 16) = a; *(LAS v4u*)(Xw + i * SX + c * 16) = bq; }
            if (ck + 1 < 18) SCAN_ISSUE(ck + 1);
            __syncthreads();
            if (!RET || ck >= 2) {
                const float aci = acs[16 * w + l15];
                bf16x8 Cf[NKS];
#pragma unroll
                for (int s = 0; s < NKS; ++s) Cf[s] = *(const LAS bf16x8*)(Cs + (16 * w + l15) * SC + (32 * s + 8 * g) * 2);
                f32x4 Yacc[4];
                const float eaci = __expf(aci);
#pragma unroll
                for (int pt = 0; pt < 4; ++pt) { f32x4 acc = (f32x4){0.f, 0.f, 0.f, 0.f};
#pragma unroll
                    for (int s = 0; s < NKS; ++s) { const bf16x8 hf = *(const LAS bf16x8*)(Hs + (16 * pt + l15) * SH + (32 * s + 8 * g) * 2); acc = __builtin_amdgcn_mfma_f32_16x16x32_bf16(hf, Cf[s], acc, 0, 0, 0); }
                    Yacc[pt] = acc * eaci; }
#pragma unroll
                for (int sp = 0; sp < 4; ++sp) {
                    if (2 * sp <= w) {
                        v2u Lh[2];
#pragma unroll
                        for (int hh = 0; hh < 2; ++hh) { const int jt = 2 * sp + hh;
                            if (jt <= w) { f32x4 cb = (f32x4){0.f, 0.f, 0.f, 0.f};
#pragma unroll
                                for (int s = 0; s < NKS; ++s) { const bf16x8 bf = *(const LAS bf16x8*)(Bs + (16 * jt + l15) * SC + (32 * s + 8 * g) * 2); cb = __builtin_amdgcn_mfma_f32_16x16x32_bf16(bf, Cf[s], cb, 0, 0, 0); }
                                const f32x4 acj = *(const LAS f32x4*)(acs + 16 * jt + 4 * g);
                                float val[4];
#pragma unroll
                                for (int r = 0; r < 4; ++r) { const float arg = fminf(aci - acj[r], 0.f); val[r] = cb[r] * __expf(arg); if (jt == w && (4 * g + r) > l15) val[r] = 0.f; }
                                Lh[hh].x = pk2(val[0], val[1]); Lh[hh].y = pk2(val[2], val[3]); }
                            else { Lh[hh].x = 0u; Lh[hh].y = 0u; } }
                        v4u lw; lw.x = Lh[0].x; lw.y = Lh[0].y; lw.z = Lh[1].x; lw.w = Lh[1].y;
                        const bf16x8 Lf = __builtin_bit_cast(bf16x8, lw);
#pragma unroll
                        for (int pt = 0; pt < 4; ++pt) { const s16x4 x0 = lds_tr(Xs + (32 * sp + 4 * g + q4) * SX + (16 * pt + 4 * p4) * 2), x1 = lds_tr(Xs + (32 * sp + 16 + 4 * g + q4) * SX + (16 * pt + 4 * p4) * 2);
                            Yacc[pt] = __builtin_amdgcn_mfma_f32_16x16x32_bf16(cat8(x0, x1), Lf, Yacc[pt], 0, 0, 0); }
                    }
                }
                const size_t row = scan_row(b, d, ck * 128 + 16 * w + l15);
#pragma unroll
                for (int pt = 0; pt < 4; ++pt) { v2u o; o.x = pk2(Yacc[pt].x, Yacc[pt].y); o.y = pk2(Yacc[pt].z, Yacc[pt].w); NTS(o, (v2u*)(Y + row * 1024 + ycol + 16 * pt + 4 * g)); }
            }
            if (ck < 17) {
                const float eat = __expf(atot);
#pragma unroll
                for (int k = 0; k < NHT; ++k) Hacc[k] = Hacc[k] * eat;
#pragma unroll
                for (int s = 0; s < 4; ++s) {
                    const s16x4 b0 = lds_tr(Bs + (32 * s + 8 * g + q4) * SC + (16 * nt + 4 * p4) * 2), b1 = lds_tr(Bs + (32 * s + 8 * g + 4 + q4) * SC + (16 * nt + 4 * p4) * 2);
                    const bf16x8 Bf = cat8(b0, b1);
#pragma unroll
                    for (int k = 0; k < NHT; ++k) { const int pt = pt0 + k;
                        const s16x4 x0 = lds_tr(Xw + (32 * s + 8 * g + q4) * SX + (16 * pt + 4 * p4) * 2), x1 = lds_tr(Xw + (32 * s + 8 * g + 4 + q4) * SX + (16 * pt + 4 * p4) * 2);
                        Hacc[k] = __builtin_amdgcn_mfma_f32_16x16x32_bf16(cat8(x0, x1), Bf, Hacc[k], 0, 0, 0); }
                }
            }
            __syncthreads();
            if (ck < 17) {
#pragma unroll
                for (int k = 0; k < NHT; ++k)
#pragma unroll
                    for (int r = 0; r < 4; ++r) *(LAS bf16*)(Hs + (16 * (pt0 + k) + 4 * g + r) * SH + (16 * nt + l15) * 2) = (bf16)f2bf(Hacc[k][r]);
            }
        }
#undef SCAN_ISSUE
    }
}

template <int MODE>
__device__ __forceinline__ void attn16(const Frame& F, int u) {
    constexpr int PITCH = MODE == 2 ? LDP1 : LDP0;
    constexpr int SV = 144, VBUF = 4608;
    LAS unsigned char* vb = F.lds + F.wave * 10240;
    LAS float* btab = (LAS float*)(vb + 2 * VBUF);
    const int lane = F.lane, l15 = lane & 15, g = lane >> 4, q4 = l15 >> 2, p4 = lane & 3;
    int b, h, nloc; size_t qrow0, locbase, ctxbase; int kcol, vcol;
    int r = 0, r0 = 0, jq = 0, kstart = 0, t0 = 0, jb_lo = 0;
    if (MODE == 0) { jq = u & 3; h = (u >> 2) & 7; r = (u >> 5) & 31; b = u >> 10; r0 = min(max(r - 4, 0), 24); kstart = min(max(16 * jq - 8, 0), 32);
        qrow0 = (size_t)b * 2048 + r * 64 + 16 * jq; locbase = (size_t)b * 2048 + r0 * 64 + kstart; nloc = 8; kcol = 512 + h * 64; vcol = 1024 + h * 64; }
    else if (MODE == 1) { const int qt = u & 15; h = (u >> 4) & 7; b = u >> 7; qrow0 = (size_t)TL + b * 256 + qt * 16; locbase = 0; nloc = 0; kcol = 512 + h * 64; vcol = 1024 + h * 64; }
    else { const int hq = u & 3, qt = (u >> 2) & 127, kvh = (u >> 9) & 1; b = u >> 10; h = kvh * 4 + hq; t0 = qt * 16; qrow0 = (size_t)b * 2048 + t0;
        jb_lo = max(t0 - 128, 0) >> 5; const int jb_hi = min(t0 + 15 + 128, 2047) >> 5; nloc = jb_hi - jb_lo + 1; locbase = (size_t)b * 2048 + jb_lo * 32; kcol = 512 + kvh * 64; vcol = 640 + kvh * 64; }
    ctxbase = (size_t)TL + b * 256;
    const int nblk = nloc + 8, nit = (nblk + 1) >> 1;
    const bf16* P = F.P;
    if (MODE == 0) {
#pragma unroll
        for (int k = 0; k < 4; ++k) { const int i = lane + 64 * k, kb = i >> 5, c = i & 31; btab[i] = (c < 31) ? F.na_rpb[(h * 15 + (r0 - r + 7 + kb)) * 31 + c] : 0.f; } }
    bf16x8 qf[2];
#pragma unroll
    for (int s = 0; s < 2; ++s) { const v4u w = *(const v4u*)(P + (qrow0 + l15) * PITCH + h * 64 + 32 * s + 8 * g); v4u o;
        o.x = pk2(0.125f * bflo(w.x), 0.125f * bfhi(w.x)); o.y = pk2(0.125f * bflo(w.y), 0.125f * bfhi(w.y)); o.z = pk2(0.125f * bflo(w.z), 0.125f * bfhi(w.z)); o.w = pk2(0.125f * bflo(w.w), 0.125f * bfhi(w.w));
        qf[s] = __builtin_bit_cast(bf16x8, o); }
    int dc[2][4]; bool okc[2][4];
    if (MODE == 0) { const int qc = 16 * jq + l15, c0 = min(max(qc - 8, 0), 48);
#pragma unroll
        for (int t = 0; t < 2; ++t)
#pragma unroll
            for (int rr = 0; rr < 4; ++rr) { const int kc = kstart + 16 * t + 4 * g + rr; okc[t][rr] = (kc >= c0) && (kc < c0 + 16); dc[t][rr] = min(max(kc - qc + 15, 0), 30); } }
    f32x4 oacc[4];
#pragma unroll
    for (int dt = 0; dt < 4; ++dt) oacc[dt] = (f32x4){0.f, 0.f, 0.f, 0.f};
    float m = -INFINITY, lsum = 0.f;
    bf16x8 kf[2][2][2]; v4u vr[2][4];
#define ATT_LOAD(it_) do { _Pragma("unroll") for (int bb = 0; bb < 2; ++bb) { int kb_ = 2 * (it_) + bb; kb_ = kb_ < nblk ? kb_ : nblk - 1; \
        const size_t rb_ = (kb_ < nloc) ? locbase + (MODE == 0 ? kb_ * 64 : kb_ * 32) : ctxbase + (kb_ - nloc) * 32; \
        _Pragma("unroll") for (int t = 0; t < 2; ++t) _Pragma("unroll") for (int s = 0; s < 2; ++s) kf[bb][t][s] = *(const bf16x8*)(P + (rb_ + 16 * t + l15) * PITCH + kcol + 32 * s + 8 * g); \
        _Pragma("unroll") for (int k = 0; k < 4; ++k) { const int idx = lane + 64 * k; vr[bb][k] = *(const v4u*)(P + (rb_ + (idx >> 3)) * PITCH + vcol + (idx & 7) * 8); } } } while (0)
    ATT_LOAD(0);
    for (int it = 0; it < nit; ++it) {
        f32x4 st[2][2];
#pragma unroll
        for (int bb = 0; bb < 2; ++bb)
#pragma unroll
            for (int t = 0; t < 2; ++t) { f32x4 a = (f32x4){0.f, 0.f, 0.f, 0.f}; a = __builtin_amdgcn_mfma_f32_16x16x32_bf16(kf[bb][t][0], qf[0], a, 0, 0, 0); st[bb][t] = __builtin_amdgcn_mfma_f32_16x16x32_bf16(kf[bb][t][1], qf[1], a, 0, 0, 0); }
#pragma unroll
        for (int bb = 0; bb < 2; ++bb)
#pragma unroll
            for (int k = 0; k < 4; ++k) { const int idx = lane + 64 * k; *(LAS v4u*)(vb + bb * VBUF + (idx >> 3) * SV + (idx & 7) * 16) = vr[bb][k]; }
        asm volatile("" ::: "memory");
        if (it + 1 < nit) ATT_LOAD(it + 1);
#pragma unroll
        for (int bb = 0; bb < 2; ++bb) { const int kb = 2 * it + bb;
            if (kb >= nblk) {
#pragma unroll
                for (int t = 0; t < 2; ++t) st[bb][t] = (f32x4){-INFINITY, -INFINITY, -INFINITY, -INFINITY}; }
            else if (kb < nloc) {
                if (MODE == 0) {
#pragma unroll
                    for (int t = 0; t < 2; ++t)
#pragma unroll
                        for (int rr = 0; rr < 4; ++rr) st[bb][t][rr] = okc[t][rr] ? st[bb][t][rr] + btab[kb * 32 + dc[t][rr]] : -INFINITY; }
                if (MODE == 2) { const int tq = t0 + l15;
#pragma unroll
                    for (int t = 0; t < 2; ++t)
#pragma unroll
                        for (int rr = 0; rr < 4; ++rr) { const int dj = tq - ((jb_lo + kb) * 32 + 16 * t + 4 * g + rr); if (dj > 128 || dj < -128) st[bb][t][rr] = -INFINITY; } }
            } }
        float mx = -INFINITY;
#pragma unroll
        for (int bb = 0; bb < 2; ++bb)
#pragma unroll
            for (int t = 0; t < 2; ++t) mx = fmaxf(mx, fmaxf(fmaxf(st[bb][t][0], st[bb][t][1]), fmaxf(st[bb][t][2], st[bb][t][3])));
        mx = fmaxf(mx, __shfl_xor(mx, 16)); mx = fmaxf(mx, __shfl_xor(mx, 32));
        const float mn = fmaxf(m, mx), mu = (mn == -INFINITY) ? 0.f : mn;
        const float corr = __expf(m - mu);
        m = mn;
        float ps = 0.f; bf16x8 pf[2];
#pragma unroll
        for (int bb = 0; bb < 2; ++bb) { float p[8];
#pragma unroll
            for (int t = 0; t < 2; ++t)
#pragma unroll
                for (int rr = 0; rr < 4; ++rr) { p[4 * t + rr] = __expf(st[bb][t][rr] - mu); ps += p[4 * t + rr]; }
            v4u pw; pw.x = pk2(p[0], p[1]); pw.y = pk2(p[2], p[3]); pw.z = pk2(p[4], p[5]); pw.w = pk2(p[6], p[7]); pf[bb] = __builtin_bit_cast(bf16x8, pw); }
        lsum = lsum * corr + ps;
#pragma unroll
        for (int dt = 0; dt < 4; ++dt) { oacc[dt] = oacc[dt] * corr;
#pragma unroll
            for (int bb = 0; bb < 2; ++bb) {
                const s16x4 v0 = lds_tr(vb + bb * VBUF + (4 * g + q4) * SV + (16 * dt + 4 * p4) * 2), v1 = lds_tr(vb + bb * VBUF + (16 + 4 * g + q4) * SV + (16 * dt + 4 * p4) * 2);
                oacc[dt] = __builtin_amdgcn_mfma_f32_16x16x32_bf16(cat8(v0, v1), pf[bb], oacc[dt], 0, 0, 0); } }
        asm volatile("" ::: "memory");
    }
#undef ATT_LOAD
    lsum += __shfl_xor(lsum, 16); lsum += __shfl_xor(lsum, 32);
    if (MODE == 2) { const float sk = F.swa_sink[h]; const float mn = fmaxf(m, sk); const float corr = __expf(m - mn); lsum = lsum * corr + __expf(sk - mn);
#pragma unroll
        for (int dt = 0; dt < 4; ++dt) oacc[dt] = oacc[dt] * corr; }
    const float inv = 1.f / lsum;
    bf16* orow = (MODE == 2 ? F.YA1 + (qrow0 + l15) * LDYA1 : F.YA0 + (qrow0 + l15) * 1536) + h * 64;
#pragma unroll
    for (int dt = 0; dt < 4; ++dt) { v2u o; o.x = pk2(oacc[dt].x * inv, oacc[dt].y * inv); o.y = pk2(oacc[dt].z * inv, oacc[dt].w * inv); NTS(o, (v2u*)(orow + 16 * dt + 4 * g)); }
}
template <int MODE>
__device__ __forceinline__ void attn_wg(const Frame& F, int item) {
    constexpr int PITCH = MODE == 2 ? LDP1 : LDP0;
    constexpr int SK = 144, TILE = 64 * SK, NH = (MODE == 2) ? 1 : 2, BUFB = NH * 2 * TILE, NPC = NH * 2;
    LAS unsigned char* lds = F.lds;
    LAS float* btab = (LAS float*)(F.lds + 2 * BUFB) + F.wave * 256;
    const int w = F.wave, lane = F.lane, l15 = lane & 15, g = lane >> 4, q4 = l15 >> 2, p4 = lane & 3;
    int b, h, hsel = 0, nloc, kcol0, vcol0; size_t qrow0;
    int r = 0, r0 = 0, jq = 0, kstart = 0, t0w = 0, jb_lo = 0;
    if (MODE == 0) { const int hp = item & 3; r = (item >> 2) & 31; b = item >> 7; hsel = w >> 2; jq = w & 3; h = 2 * hp + hsel; r0 = min(max(r - 4, 0), 24); kstart = min(max(16 * jq - 8, 0), 32);
        qrow0 = (size_t)b * 2048 + r * 64 + 16 * jq; nloc = 8; kcol0 = 512 + 2 * hp * 64; vcol0 = 1024 + 2 * hp * 64; }
    else if (MODE == 1) { const int qg = item & 3, hp = (item >> 2) & 3; b = item >> 4; hsel = w >> 2; h = 2 * hp + hsel; qrow0 = (size_t)TL + b * 256 + qg * 64 + (w & 3) * 16; nloc = 0; kcol0 = 512 + 2 * hp * 64; vcol0 = 1024 + 2 * hp * 64; }
    else { const int qg = item & 63, kvh = (item >> 6) & 1; b = item >> 7; h = kvh * 4 + (w & 3); const int t0 = qg * 32; t0w = t0 + 16 * (w >> 2); qrow0 = (size_t)b * 2048 + t0w;
        jb_lo = max(t0 - 128, 0) >> 6; const int jb_hi = min(t0 + 31 + 128, 2047) >> 6; nloc = jb_hi - jb_lo + 1; kcol0 = 512 + kvh * 64; vcol0 = 640 + kvh * 64; }
    const int nst = nloc + 4;
    const bf16* P = F.P;
    __syncthreads();
    if (MODE == 0) {
#pragma unroll
        for (int k = 0; k < 4; ++k) { const int i = lane + 64 * k, kb = i >> 5, c = i & 31; btab[i] = (c < 31) ? F.na_rpb[(h * 15 + (r0 - r + 7 + kb)) * 31 + c] : 0.f; } }
    bf16x8 qf[2];
#pragma unroll
    for (int s = 0; s < 2; ++s) { const v4u wv = *(const v4u*)(P + (qrow0 + l15) * PITCH + h * 64 + 32 * s + 8 * g); v4u o;
        o.x = pk2(0.125f * bflo(wv.x), 0.125f * bfhi(wv.x)); o.y = pk2(0.125f * bflo(wv.y), 0.125f * bfhi(wv.y)); o.z = pk2(0.125f * bflo(wv.z), 0.125f * bfhi(wv.z)); o.w = pk2(0.125f * bflo(wv.w), 0.125f * bfhi(wv.w));
        qf[s] = __builtin_bit_cast(bf16x8, o); }
    int dc[2][4]; bool okc[2][4];
    if (MODE == 0) { const int qc = 16 * jq + l15, c0 = min(max(qc - 8, 0), 48);
#pragma unroll
        for (int t = 0; t < 2; ++t)
#pragma unroll
            for (int rr = 0; rr < 4; ++rr) { const int kc = kstart + 16 * t + 4 * g + rr; okc[t][rr] = (kc >= c0) && (kc < c0 + 16); dc[t][rr] = min(max(kc - qc + 15, 0), 30); } }
    f32x4 oacc[4];
#pragma unroll
    for (int dt = 0; dt < 4; ++dt) oacc[dt] = (f32x4){0.f, 0.f, 0.f, 0.f};
    float m = -INFINITY, lsum = 0.f;
    v4u pre[NPC];
#define AWG_LOAD(st_) do { const size_t rb_ = ((st_) < nloc) ? (size_t)b * 2048 + (MODE == 0 ? (r0 + (st_)) * 64 : (jb_lo + (st_)) * 64) : (size_t)TL + b * 256 + ((st_) - nloc) * 64; \
        _Pragma("unroll") for (int k = 0; k < NPC; ++k) { const int idx = F.tid + 512 * k, which = idx / (NH * 512), rem = idx % (NH * 512), hh = rem >> 9, key = (rem & 511) >> 3, c = rem & 7; \
            pre[k] = *(const v4u*)(P + (rb_ + key) * PITCH + (which ? vcol0 : kcol0) + hh * 64 + c * 8); } } while (0)
#define AWG_STORE(buf_) do { _Pragma("unroll") for (int k = 0; k < NPC; ++k) { const int idx = F.tid + 512 * k, which = idx / (NH * 512), rem = idx % (NH * 512), hh = rem >> 9, key = (rem & 511) >> 3, c = rem & 7; \
            *(LAS v4u*)(lds + (buf_) * BUFB + (which * NH + hh) * TILE + key * SK + c * 16) = pre[k]; } } while (0)
    AWG_LOAD(0); AWG_STORE(0);
    __syncthreads();
    for (int st = 0; st < nst; ++st) {
        if (st + 1 < nst) AWG_LOAD(st + 1);
        const LAS unsigned char* Kt = lds + (st & 1) * BUFB + hsel * TILE;
        const LAS unsigned char* Vt = lds + (st & 1) * BUFB + (NH + hsel) * TILE;
        const bool loc = st < nloc;
        const int nb = (MODE == 0 && loc) ? 1 : 2, koff0 = (MODE == 0 && loc) ? kstart : 0;
        f32x4 sc[2][2];
#pragma unroll
        for (int bb = 0; bb < 2; ++bb) {
            if (bb < nb) {
#pragma unroll
                for (int t = 0; t < 2; ++t) { const LAS unsigned char* kp = Kt + (koff0 + 32 * bb + 16 * t + l15) * SK + 8 * g * 2;
                    f32x4 a = (f32x4){0.f, 0.f, 0.f, 0.f}; a = __builtin_amdgcn_mfma_f32_16x16x32_bf16(*(const LAS bf16x8*)kp, qf[0], a, 0, 0, 0); sc[bb][t] = __builtin_amdgcn_mfma_f32_16x16x32_bf16(*(const LAS bf16x8*)(kp + 64), qf[1], a, 0, 0, 0); }
                if (loc) {
                    if (MODE == 0) {
#pragma unroll
                        for (int t = 0; t < 2; ++t)
#pragma unroll
                            for (int rr = 0; rr < 4; ++rr) sc[bb][t][rr] = okc[t][rr] ? sc[bb][t][rr] + btab[st * 32 + dc[t][rr]] : -INFINITY; }
                    if (MODE == 2) { const int tq = t0w + l15;
#pragma unroll
                        for (int t = 0; t < 2; ++t)
#pragma unroll
                            for (int rr = 0; rr < 4; ++rr) { const int dj = tq - ((jb_lo + st) * 64 + 32 * bb + 16 * t + 4 * g + rr); if (dj > 128 || dj < -128) sc[bb][t][rr] = -INFINITY; } }
                }
            } else {
#pragma unroll
                for (int t = 0; t < 2; ++t) sc[bb][t] = (f32x4){-INFINITY, -INFINITY, -INFINITY, -INFINITY}; }
        }
        float mx = -INFINITY;
#pragma unroll
        for (int bb = 0; bb < 2; ++bb)
#pragma unroll
            for (int t = 0; t < 2; ++t) mx = fmaxf(mx, fmaxf(fmaxf(sc[bb][t][0], sc[bb][t][1]), fmaxf(sc[bb][t][2], sc[bb][t][3])));
        mx = fmaxf(mx, __shfl_xor(mx, 16)); mx = fmaxf(mx, __shfl_xor(mx, 32));
        const float mn = fmaxf(m, mx), mu = (mn == -INFINITY) ? 0.f : mn;
        const float corr = __expf(m - mu);
        m = mn;
        float ps = 0.f; bf16x8 pf[2];
#pragma unroll
        for (int bb = 0; bb < 2; ++bb) { float p[8];
#pragma unroll
            for (int t = 0; t < 2; ++t)
#pragma unroll
                for (int rr = 0; rr < 4; ++rr) { p[4 * t + rr] = __expf(sc[bb][t][rr] - mu); ps += p[4 * t + rr]; }
            v4u pw; pw.x = pk2(p[0], p[1]); pw.y = pk2(p[2], p[3]); pw.z = pk2(p[4], p[5]); pw.w = pk2(p[6], p[7]); pf[bb] = __builtin_bit_cast(bf16x8, pw); }
        lsum = lsum * corr + ps;
#pragma unroll
        for (int dt = 0; dt < 4; ++dt) { oacc[dt] = oacc[dt] * corr;
#pragma unroll
            for (int bb = 0; bb < 2; ++bb) {
                if (bb < nb) { const LAS unsigned char* vp = Vt + (koff0 + 32 * bb) * SK + (16 * dt + 4 * p4) * 2;
                    const s16x4 v0 = lds_tr(vp + (4 * g + q4) * SK), v1 = lds_tr(vp + (16 + 4 * g + q4) * SK);
                    oacc[dt] = __builtin_amdgcn_mfma_f32_16x16x32_bf16(cat8(v0, v1), pf[bb], oacc[dt], 0, 0, 0); } } }
        if (st + 1 < nst) AWG_STORE((st + 1) & 1);
        __syncthreads();
    }
#undef AWG_LOAD
#undef AWG_STORE
    lsum += __shfl_xor(lsum, 16); lsum += __shfl_xor(lsum, 32);
    if (MODE == 2) { const float sk = F.swa_sink[h]; const float mn = fmaxf(m, sk); const float corr = __expf(m - mn); lsum = lsum * corr + __expf(sk - mn);
#pragma unroll
        for (int dt = 0; dt < 4; ++dt) oacc[dt] = oacc[dt] * corr; }
    const float inv = 1.f / lsum;
    bf16* orow = (MODE == 2 ? F.YA1 + (qrow0 + l15) * LDYA1 : F.YA0 + (qrow0 + l15) * 1536) + h * 64;
#pragma unroll
    for (int dt = 0; dt < 4; ++dt) { v2u o; o.x = pk2(oacc[dt].x * inv, oacc[dt].y * inv); o.y = pk2(oacc[dt].z * inv, oacc[dt].w * inv); NTS(o, (v2u*)(orow + 16 * dt + 4 * g)); }
}
__device__ __forceinline__ void ph_attn0_mfma(const Frame& F) {
    for (int it = F.vcu; it < 1024; it += F.G) attn_wg<0>(F, it);
    for (int it = F.vcu; it < 128; it += F.G) attn_wg<1>(F, it);
}
__device__ __forceinline__ void ph_swa_mfma(const Frame& F) {
    for (int it = F.vcu; it < 1024; it += F.G) attn_wg<2>(F, it);
}

__device__ __forceinline__ void ph_ssmout(const Frame& F) {
    const int gw = F.vcu * NWAVES + F.wave, NGW = F.G * NWAVES;
    for (int row = gw; row < TT; row += NGW) {
#pragma unroll
        for (int grp = 0; grp < 2; ++grp) {
            const int ch = grp * 512 + F.lane * 8;
            const v4u yf = NTL((const v4u*)(F.YF0 + (size_t)row * 1024 + ch)), yb = NTL((const v4u*)(F.YB0 + (size_t)row * 1024 + ch));
            const v4u xv = NTL((const v4u*)(F.XBC + (size_t)row * 1536 + ch)), zv = NTL((const v4u*)(F.P + (size_t)row * LDP0 + 1536 + ch));
            const float dsk = F.ssm_d[ch >> 6];
            float yz[8];
            const unsigned yfw[4] = {yf.x, yf.y, yf.z, yf.w}, ybw[4] = {yb.x, yb.y, yb.z, yb.w}, xw[4] = {xv.x, xv.y, xv.z, xv.w}, zw[4] = {zv.x, zv.y, zv.z, zv.w};
            float ss = 0.f;
#pragma unroll
            for (int j = 0; j < 4; ++j) {
                const float y0 = bflo(yfw[j]) + bflo(ybw[j]) + bflo(xw[j]) * dsk, y1 = bfhi(yfw[j]) + bfhi(ybw[j]) + bfhi(xw[j]) * dsk;
                yz[2 * j] = y0 * silu_f(bflo(zw[j])); yz[2 * j + 1] = y1 * silu_f(bfhi(zw[j]));
                ss += yz[2 * j] * yz[2 * j] + yz[2 * j + 1] * yz[2 * j + 1]; }
            const float rstd = 1.0f / sqrtf(wave_sum(ss) * (1.f / 512.f) + EPS);
            const f32x4 g0 = *(const f32x4*)(F.ssm_norm_g + ch), g1 = *(const f32x4*)(F.ssm_norm_g + ch + 4);
            v4u o; o.x = pk2(yz[0] * rstd * g0.x, yz[1] * rstd * g0.y); o.y = pk2(yz[2] * rstd * g0.z, yz[3] * rstd * g0.w);
            o.z = pk2(yz[4] * rstd * g1.x, yz[5] * rstd * g1.y); o.w = pk2(yz[6] * rstd * g1.z, yz[7] * rstd * g1.w);
            NTS(o, (v4u*)(F.YA0 + (size_t)row * 1536 + 512 + ch));
        }
    }
}

__device__ __forceinline__ void ph_retout(const Frame& F) {
    const int gw = F.vcu * NWAVES + F.wave, NGW = F.G * NWAVES;
    for (int row = gw; row < TL; row += NGW) {
#pragma unroll
        for (int half = 0; half < 2; ++half) {
            const int ch = half * 512 + F.lane * 8;
            const v4u yf = NTL((const v4u*)(F.YF1 + (size_t)row * 1024 + ch)), yb = NTL((const v4u*)(F.YB1 + (size_t)row * 1024 + ch)), gv = NTL((const v4u*)(F.P + (size_t)row * LDP1 + 2816 + ch));
            const unsigned yfw[4] = {yf.x, yf.y, yf.z, yf.w}, ybw[4] = {yb.x, yb.y, yb.z, yb.w}, gw4[4] = {gv.x, gv.y, gv.z, gv.w};
            float y[8]; float s = 0.f;
#pragma unroll
            for (int j = 0; j < 4; ++j) { y[2 * j] = bflo(yfw[j]) + bflo(ybw[j]); y[2 * j + 1] = bfhi(yfw[j]) + bfhi(ybw[j]); s += y[2 * j] + y[2 * j + 1]; }
            s += __shfl_xor(s, 1); s += __shfl_xor(s, 2); s += __shfl_xor(s, 4); s += __shfl_xor(s, 8);
            const float mu = s * (1.f / 128.f); float q = 0.f;
#pragma unroll
            for (int j = 0; j < 8; ++j) { y[j] -= mu; q += y[j] * y[j]; }
            q += __shfl_xor(q, 1); q += __shfl_xor(q, 2); q += __shfl_xor(q, 4); q += __shfl_xor(q, 8);
            const float rstd = 1.0f / sqrtf(q * (1.f / 128.f) + EPS);
            float ov[8];
#pragma unroll
            for (int j = 0; j < 8; ++j) { const float gg = (j & 1) ? bfhi(gw4[j >> 1]) : bflo(gw4[j >> 1]); ov[j] = silu_f(gg) * (y[j] * rstd * F.ret_gn_g[ch + j] + F.ret_gn_b[ch + j]); }
            v4u o; o.x = pk2(ov[0], ov[1]); o.y = pk2(ov[2], ov[3]); o.z = pk2(ov[4], ov[5]); o.w = pk2(ov[6], ov[7]);
            NTS(o, (v4u*)(F.YA1 + (size_t)row * LDYA1 + 512 + ch));
        }
    }
}

#define SEL8(arr, idx) (((idx) == 0 ? arr[0] : 0) + ((idx) == 1 ? arr[1] : 0) + ((idx) == 2 ? arr[2] : 0) + ((idx) == 3 ? arr[3] : 0) + ((idx) == 4 ? arr[4] : 0) + ((idx) == 5 ? arr[5] : 0) + ((idx) == 6 ? arr[6] : 0) + ((idx) == 7 ? arr[7] : 0))
__device__ __forceinline__ void ph_norm3_route(const Frame& F) {
    const int gw = F.vcu * NWAVES + F.wave, NGW = F.G * NWAVES;
    const float* g = F.norm_ffn_g + 1024;
    for (int ch = gw; ch < 2048; ch += NGW) {
        int cnt[8];
#pragma unroll
        for (int e = 0; e < 8; ++e) cnt[e] = 0;
        for (int i = 0; i < 8; ++i) {
            const int row = ch * 8 + i, bidx = row >> 11;
            const float* mod = F.MOD + (size_t)(9 + bidx) * 6144 + 3 * 1024;
            const f32x4* xr = (const f32x4*)(F.X + (size_t)row * 1024) + F.lane;
            f32x4 v[4]; float s = 0.f;
#pragma unroll
            for (int j = 0; j < 4; ++j) { v[j] = NTL(xr + 64 * j); s += (v[j].x * v[j].x + v[j].y * v[j].y) + (v[j].z * v[j].z + v[j].w * v[j].w); }
            const float rstd = 1.0f / sqrtf(wave_sum(s) * (1.f / 1024.f) + EPS);
            unsigned long long* o8 = (unsigned long long*)(F.H + (size_t)row * 1024) + F.lane;
#pragma unroll
            for (int j = 0; j < 4; ++j) {
                const f32x4 gg = ((const f32x4*)g)[F.lane + 64 * j], sh = ((const f32x4*)mod)[F.lane + 64 * j], sc = ((const f32x4*)(mod + 1024))[F.lane + 64 * j];
                v[j] = (v[j] * rstd * gg) * (sc + 1.0f) + sh;
                NTS((unsigned long long)pk2(v[j].x, v[j].y) | ((unsigned long long)pk2(v[j].z, v[j].w) << 32), o8 + 64 * j);
            }
            float lg[8];
#pragma unroll
            for (int e = 0; e < 8; ++e) lg[e] = 0.f;
#pragma unroll
            for (int j = 0; j < 4; ++j)
#pragma unroll
                for (int q = 0; q < 4; ++q) { const int k = 4 * (F.lane + 64 * j) + q; const f32x4 r0 = ((const f32x4*)(F.moe_router + (size_t)k * 8))[0], r1 = ((const f32x4*)(F.moe_router + (size_t)k * 8))[1];
                    const float hv = v[j][q];
                    lg[0] += hv * r0.x; lg[1] += hv * r0.y; lg[2] += hv * r0.z; lg[3] += hv * r0.w; lg[4] += hv * r1.x; lg[5] += hv * r1.y; lg[6] += hv * r1.z; lg[7] += hv * r1.w; }
#pragma unroll
            for (int e = 0; e < 8; ++e) lg[e] = wave_sum(lg[e]);
            int i0 = 0; float v0 = lg[0];
#pragma unroll
            for (int e = 1; e < 8; ++e) if (lg[e] > v0) { v0 = lg[e]; i0 = e; }
            int i1 = -1; float v1 = -3.0e38f;
#pragma unroll
            for (int e = 0; e < 8; ++e) if (e != i0 && lg[e] > v1) { v1 = lg[e]; i1 = e; }
            const float e1 = __expf(v1 - v0), g0 = 1.f / (1.f + e1), g1 = e1 / (1.f + e1);
            const int r0 = SEL8(cnt, i0);
#pragma unroll
            for (int e = 0; e < 8; ++e) cnt[e] += (e == i0) ? 1 : 0;
            const int r1 = SEL8(cnt, i1);
#pragma unroll
            for (int e = 0; e < 8; ++e) cnt[e] += (e == i1) ? 1 : 0;
            if (F.lane == 0) { F.TOPK[row] = i0 | (i1 << 4) | (r0 << 8) | (r1 << 16); F.GATE[row * 2] = g0; F.GATE[row * 2 + 1] = g1; }
        }
        if (F.lane < 8) F.CNT[ch * 8 + F.lane] = SEL8(cnt, F.lane);
    }
}

__device__ __forceinline__ void ph_route2(const Frame& F) {
    LAS int* coff = (LAS int*)F.lds;
    LAS int* wtot = coff + 2048 * 8;
    LAS int* meta = wtot + 64;
    const int t = F.tid;
    int loc[4][8], tot[8], incl[8];
#pragma unroll
    for (int i = 0; i < 4; ++i) { const int4 a = ((const int4*)(F.CNT + (4 * t + i) * 8))[0], b = ((const int4*)(F.CNT + (4 * t + i) * 8))[1];
        loc[i][0] = a.x; loc[i][1] = a.y; loc[i][2] = a.z; loc[i][3] = a.w; loc[i][4] = b.x; loc[i][5] = b.y; loc[i][6] = b.z; loc[i][7] = b.w; }
#pragma unroll
    for (int e = 0; e < 8; ++e) { int run = 0;
#pragma unroll
        for (int i = 0; i < 4; ++i) { const int tmp = loc[i][e]; loc[i][e] = run; run += tmp; }
        tot[e] = run; int v = run;
#pragma unroll
        for (int o = 1; o < 64; o <<= 1) { const int n = __shfl_up(v, o); if (F.lane >= o) v += n; }
        incl[e] = v;
        if (F.lane == 63) wtot[F.wave * 8 + e] = v; }
    __syncthreads();
#pragma unroll
    for (int e = 0; e < 8; ++e) { int woff = 0;
        for (int w = 0; w < F.wave; ++w) woff += wtot[w * 8 + e];
        const int excl = woff + incl[e] - tot[e];
#pragma unroll
        for (int i = 0; i < 4; ++i) coff[(4 * t + i) * 8 + e] = excl + loc[i][e]; }
    if (t < 8) { int s = 0; for (int w = 0; w < 8; ++w) s += wtot[w * 8 + t]; meta[8 + t] = s; }
    __syncthreads();
    if (t == 0) { int base = 0; for (int e = 0; e < 8; ++e) { meta[e] = base; base += (meta[8 + e] + 255) & ~255; } meta[16] = base >> 8; }
    __syncthreads();
    if (F.vcu == 0 && t < 144) { int e = 0;
#pragma unroll
        for (int q = 1; q < 8; ++q) if (t * 256 >= meta[q]) e = q;
        F.TILEE[t] = e; if (t == 0) F.MMETA[0] = meta[16]; }
    const int gw = F.vcu * NWAVES + F.wave, NGW = F.G * NWAVES;
    for (int ch = gw; ch < 2048; ch += NGW) {
        for (int i = 0; i < 8; ++i) {
            const int row = ch * 8 + i, tk = F.TOPK[row], e0 = tk & 15, e1 = (tk >> 4) & 15, r0 = (tk >> 8) & 255, r1 = (tk >> 16) & 255;
            const int s0 = meta[e0] + coff[ch * 8 + e0] + r0, s1 = meta[e1] + coff[ch * 8 + e1] + r1;
            const v4u a = NTL((const v4u*)(F.H + (size_t)row * 1024) + F.lane), b = NTL((const v4u*)(F.H + (size_t)row * 1024) + F.lane + 64);
            NTS(a, (v4u*)(F.HP + (size_t)s0 * LDHP) + F.lane); NTS(b, (v4u*)(F.HP + (size_t)s0 * LDHP) + F.lane + 64);
            NTS(a, (v4u*)(F.HP + (size_t)s1 * LDHP) + F.lane); NTS(b, (v4u*)(F.HP + (size_t)s1 * LDHP) + F.lane + 64);
            if (F.lane == 0) { F.SLOT[row * 2] = s0; F.SLOT[row * 2 + 1] = s1; }
        }
    }
    for (int it = gw; it < 2048; it += NGW) { const int e = it >> 8, r = it & 255, row = meta[e] + meta[8 + e] + r;
        if (row < meta[e] + ((meta[8 + e] + 255) & ~255)) { ((v4u*)(F.HP + (size_t)row * LDHP))[F.lane] = (v4u){0u, 0u, 0u, 0u}; ((v4u*)(F.HP + (size_t)row * LDHP))[F.lane + 64] = (v4u){0u, 0u, 0u, 0u}; } }
}

struct MoeOrder {
    const int* tile_e; int t0, t1, nN, G, c;
    __device__ __forceinline__ bool next(int i, pg8::Unit& u) const {
        const int ntiles = t1 - t0; u.k0 = 0; u.nk = 0;
        if ((G & 7) != 0) { const int L = i * G + c; if (L >= ntiles * nN) return false; const int pm = t0 + L / nN; u.pm = pm; u.pn = tile_e[pm] * nN + (L % nN); return true; }
        const int x = c & 7, wpx = G >> 3, s = i * wpx + (c >> 3), nblk = ntiles >> 3, rem = ntiles & 7;
        const int nbx = (nblk > x) ? ((nblk - x + 7) >> 3) : 0, full = nbx * 8 * nN;
        int pm, pl;
        if (s < full) { const int blk = x + 8 * (s / (8 * nN)), w = s % (8 * nN); pm = t0 + 8 * blk + (w & 7); pl = w >> 3; }
        else { const int q = (s - full) * 8 + x; if (rem == 0 || q >= rem * nN) return false; pm = t0 + 8 * nblk + (q % rem); pl = q / rem; }
        u.pm = pm; u.pn = tile_e[pm] * nN + pl; return true; }
    __device__ __forceinline__ void a_ready(const pg8::Unit&) const {}
    __device__ __forceinline__ void done(const pg8::Unit&) const {}
};
struct Moe2BOrder {
    const int* tile_e; int MT, G, c;
    __device__ __forceinline__ bool next(int i, pg8::Unit& u) const {
        const int t1 = MT < 128 ? MT : 128, nfull = (t1 - 64) * 4, L = i * G + c;
        if (L < nfull) { const int pm = 64 + (L >> 2); u.pm = pm; u.pn = tile_e[pm] * 4 + (L & 3); u.k0 = 0; u.nk = 0; return true; }
        const int nb = (MT - t1) * 4; if (nb <= 0) return false;
        const int r0 = (nfull + G - 1) / G; if (i < r0) return false;
        const int NS = 7, q = (i - r0) * G + c; if (q >= nb * NS) return false;
        const int bu = q % nb, sl = q / nb, pm = t1 + (bu >> 2); u.pm = pm; u.pn = tile_e[pm] * 4 + (bu & 3); u.k0 = sl * (DFE / NS); u.nk = DFE / NS / 64; return true; }
    __device__ __forceinline__ void a_ready(const pg8::Unit&) const {}
    __device__ __forceinline__ void done(const pg8::Unit&) const {}
};
struct EpiSwigluMoe {
    bf16* O; int row0;
    __device__ __forceinline__ void operator()(int row, int col, f32x4 lo, f32x4 hi, int part = 0) const {
        v2u w; w.x = pk2(silu_f(lo.x) * hi.x, silu_f(lo.y) * hi.y); w.y = pk2(silu_f(lo.z) * hi.z, silu_f(lo.w) * hi.w);
        *(v2u*)(O + (size_t)(row - row0) * DFE + ((col % 7168) >> 1)) = w; }
};
struct EpiStoreMoe {
    bf16* O; float* T;
    __device__ __forceinline__ void operator()(int row, int col, f32x4 lo, f32x4 hi, int part = 0) const {
        if (part) { float* o = T + ((size_t)((part - 1) / 512) * 2048 + (row - 128 * 256)) * 1024 + (col & 1023); ((f32x4*)o)[0] = lo; ((f32x4*)o)[1] = hi; return; }
        v4u w; w.x = pk2(lo.x, lo.y); w.y = pk2(lo.z, lo.w); w.z = pk2(hi.x, hi.y); w.w = pk2(hi.z, hi.w);
        *(v4u*)(O + (size_t)row * LDHP + (col & 1023)) = w; }
};
template <class F8>
__device__ __forceinline__ void gemm_moe(const Frame& F, const bf16* A, const bf16* Bt, int K, int nN, int t0, int t1, const F8& f, int ld = 0) {
    pg8::Gemm g{A, Bt, 0, 0, K, ld}; MoeOrder S{F.TILEE, t0, t1, nN, F.G, (int)blockIdx.x};
    EpiAdapt<F8> E{f};
    pg8::gemm_phase<EpiAdapt<F8>, MoeOrder, true, true>(F.lds, g, S, E);
}

__device__ __forceinline__ void ph_final(const Frame& F) {
    const int gw = F.vcu * NWAVES + F.wave, NGW = F.G * NWAVES;
    for (int row0 = gw * 2; row0 < TL; row0 += NGW * 2) {
        int sl[2][2]; float gt[2][2];
#pragma unroll
        for (int r = 0; r < 2; ++r) { sl[r][0] = F.SLOT[(row0 + r) * 2]; sl[r][1] = F.SLOT[(row0 + r) * 2 + 1]; gt[r][0] = F.GATE[(row0 + r) * 2]; gt[r][1] = F.GATE[(row0 + r) * 2 + 1]; }
        const float* g2 = F.MOD + (size_t)(9 + (row0 >> 11)) * 6144 + 5 * 1024;
        f32x4 xv[2][4], ya[2][2][4];
#pragma unroll
        for (int r = 0; r < 2; ++r) {
#pragma unroll
            for (int j = 0; j < 4; ++j) xv[r][j] = __builtin_nontemporal_load((const f32x4*)(F.X + (size_t)(row0 + r) * 1024) + F.lane + 64 * j);
#pragma unroll
            for (int k = 0; k < 2; ++k) { const int s = sl[r][k];
                if (s >= 32768) { const f32x4* tp = (const f32x4*)(F.Y2T + (size_t)(s - 32768) * 1024) + F.lane;
#pragma unroll
                    for (int j = 0; j < 4; ++j) { f32x4 a = tp[64 * j];
#pragma unroll
                        for (int q = 1; q < 7; ++q) a += tp[64 * j + (size_t)q * 2048 * 256];
                        ya[r][k][j] = a; } }
                else { const v2u* yp = (const v2u*)(F.HP + (size_t)s * LDHP) + F.lane;
#pragma unroll
                    for (int j = 0; j < 4; ++j) { const v2u a = NTL(yp + 64 * j); ya[r][k][j] = (f32x4){bflo(a.x), bfhi(a.x), bflo(a.y), bfhi(a.y)}; } } } }
        float ss[2];
#pragma unroll
        for (int r = 0; r < 2; ++r) { float s = 0.f;
#pragma unroll
            for (int j = 0; j < 4; ++j) { const f32x4 gg = ((const f32x4*)g2)[F.lane + 64 * j]; const f32x4 y = ya[r][0][j] * gt[r][0] + ya[r][1][j] * gt[r][1];
                xv[r][j] = xv[r][j] + gg * y; s += (xv[r][j].x * xv[r][j].x + xv[r][j].y * xv[r][j].y) + (xv[r][j].z * xv[r][j].z + xv[r][j].w * xv[r][j].w); }
            ss[r] = s; }
#pragma unroll
        for (int o = 1; o < 64; o <<= 1) { ss[0] += __shfl_xor(ss[0], o); ss[1] += __shfl_xor(ss[1], o); }
#pragma unroll
        for (int r = 0; r < 2; ++r) { const float rstd = 1.0f / sqrtf(ss[r] * (1.f / 1024.f) + EPS);
            f32x4* o = (f32x4*)(F.out + (size_t)(row0 + r) * 1024) + F.lane;
#pragma unroll
            for (int j = 0; j < 4; ++j) __builtin_nontemporal_store(xv[r][j] * rstd * ((const f32x4*)F.final_g)[F.lane + 64 * j], o + 64 * j); }
    }
}

enum { PH_CVT = 0, PH_NORM0, PH_IN0, PH_MIX0, PH_SCAN0, PH_SSMOUT, PH_OUT0, PH_NORM1, PH_F13, PH_F2, PH_NORM2, PH_IN1, PH_MIX1, PH_RETOUT, PH_OUT1, PH_NORM3, PH_ROUTE2, PH_MG1A, PH_MG2A, PH_MG1B, PH_MG2B, PH_FINAL, NPHASES };

struct Args { const float* in[31]; float* out; unsigned char* ws; int ph_lo, ph_hi; };

__global__ void __launch_bounds__(NWAVES * 64, 2) fwd(Args args) {
    extern __shared__ __attribute__((aligned(16))) unsigned char lds_raw[];
    Frame F;
    F.lds = (LAS unsigned char*)lds_raw;
    F.tid = threadIdx.x; F.lane = F.tid & 63; F.wave = __builtin_amdgcn_readfirstlane(F.tid >> 6);
    F.G = gridDim.x; { const int bx = blockIdx.x; F.vcu = (F.G % 8 == 0) ? (bx % 8) * (F.G / 8) + bx / 8 : bx; }
    F.x = args.in[0]; F.c = args.in[1]; F.ctx = args.in[2]; F.c_ctx = args.in[3]; F.ada_w = args.in[4]; F.ada_b = args.in[5]; F.norm_attn_g = args.in[6]; F.norm_ffn_g = args.in[7];
    F.ev_w_in = args.in[8]; F.ev_w_out = args.in[9]; F.na_rpb = args.in[10]; F.conv_w = args.in[11]; F.conv_b = args.in[12]; F.dt_bias = args.in[13]; F.a_log = args.in[14]; F.ssm_d = args.in[15];
    F.ssm_norm_g = args.in[16]; F.ffn_w1 = args.in[17]; F.ffn_w3 = args.in[18]; F.ffn_w2 = args.in[19]; F.od_w_in = args.in[20]; F.od_w_out = args.in[21]; F.swa_sink = args.in[22];
    F.ret_log_decay = args.in[23]; F.ret_gn_g = args.in[24]; F.ret_gn_b = args.in[25]; F.moe_router = args.in[26]; F.moe_w1 = args.in[27]; F.moe_w3 = args.in[28]; F.moe_w2 = args.in[29]; F.final_g = args.in[30];
    F.out = args.out;
    unsigned char* ws = args.ws;
    F.MOD = (float*)(ws + WS_MOD); F.GATE = (float*)(ws + WS_GATE); F.ROPE = (float*)(ws + WS_ROPE); F.X = (float*)(ws + WS_X);
    F.WIN0 = (bf16*)(ws + WS_WIN0); F.WOUT0 = (bf16*)(ws + WS_WOUT0); F.WF13 = (bf16*)(ws + WS_WF13); F.WF2 = (bf16*)(ws + WS_WF2); F.WIN1 = (bf16*)(ws + WS_WIN1); F.WOUT1 = (bf16*)(ws + WS_WOUT1);
    F.WM13 = (bf16*)(ws + WS_WM13); F.WM2 = (bf16*)args.out; F.H = (bf16*)(ws + WS_H); F.P = (bf16*)(ws + WS_P); F.YA0 = (bf16*)(ws + WS_YA0); F.YA1 = (bf16*)(ws + WS_YA1); F.XBC = (bf16*)(ws + WS_XBC);
    F.YF0 = (bf16*)(ws + WS_YF0); F.YB0 = (bf16*)(ws + WS_YB0); F.YF1 = (bf16*)(ws + WS_YF1); F.YB1 = (bf16*)(ws + WS_YB1); F.Gh = (bf16*)(ws + WS_G); F.MG = (bf16*)(ws + WS_MG); F.HP = (bf16*)(ws + WS_HP);
    F.ctl = (unsigned*)(ws + WS_CTL); F.Y2T = (float*)(ws + WS_Y2T); F.PART = (float*)(ws + WS_PART);
    F.TOPK = (int*)(ws + WS_TOPK); F.SLOT = (int*)(ws + WS_SLOT); F.CNT = (int*)(ws + WS_CNT); F.TILEE = (int*)(ws + WS_TILEE); F.MMETA = (int*)(ws + WS_MMETA);

    for (int u = F.tid; u < (LDS_BYTES - LDSCTL_OFF) / 4; u += NWAVES * 64) ((LAS unsigned*)(F.lds + LDSCTL_OFF))[u] = 0u;
    __syncthreads();
    volatile LAS unsigned* MISC = (volatile LAS unsigned*)(F.lds + MISC_OFF);
    XcdBarrier bar; bar.bar = (unsigned*)(ws + WS_CTL) + CW_BAR; bar.x = 0; bar.st = nullptr;
    const int lo = args.ph_lo, hi = args.ph_hi;
    if (hi - lo > 1) bar = xcd_barrier_post((unsigned*)(ws + WS_CTL) + CW_BAR, MISC + 8);
#ifndef QB_IN0
#define QB_IN0 0
#define QB_OUT0 0
#define QB_F13 0
#define QB_F2 0
#endif
#ifndef PROBE_PH
#define PROBE_PH -1
#endif
#ifndef PROBE_TAG
#define PROBE_TAG 0
#endif
#define TREP(tag) for (int _tr = 0; _tr < ((tag) == PROBE_TAG ? 2 : 1); ++_tr)
#define REPS(k) for (int _rep = 0; _rep < ((k) == PROBE_PH ? 2 : 1); ++_rep)
#define IN(k) (lo <= (k) && (k) < hi)
#define SEAM(k) do { if (IN(k) && IN((k) + 1)) xcd_barrier(bar); else __syncthreads(); } while (0)

    if (IN(PH_CVT)) { REPS(PH_CVT) { ph_cvt(F); __syncthreads(); } SEAM(PH_CVT); }
    if (IN(PH_NORM0)) { REPS(PH_NORM0) ph_norm<0, false>(F, 0, 0, TT); SEAM(PH_NORM0); }
    if (IN(PH_IN0)) { REPS(PH_IN0) { EpiStore E{F.P, LDP0}; gemm_pg8(F, F.H, F.WIN0, TT, LDP0, 1024, E); } TREP(8) { if (_tr == 1) { EpiNull E0; gemm_pg8(F, F.H, F.WIN0, TT, LDP0, 512, E0, 1024); } } TREP(11) { if (_tr == 1) { EpiNull E0; gemm_pg8(F, F.H, F.WIN0, TT, LDP0, 1024, E0, 1024); } } if (short_round(F, 72 * 17)) cvt_pull(F, QB_IN0, false); SEAM(PH_IN0); }
    if (IN(PH_MIX0)) { REPS(PH_MIX0) { TREP(1) ph_attn0_mfma(F); TREP(2) ph_conv(F); } SEAM(PH_MIX0); }
    if (IN(PH_SCAN0)) { REPS(PH_SCAN0) chunk_scan<128, false>(F); SEAM(PH_SCAN0); }
    if (IN(PH_SSMOUT)) { REPS(PH_SSMOUT) ph_ssmout(F); SEAM(PH_SSMOUT); }
    if (IN(PH_OUT0)) REPS(PH_OUT0) { EpiResidTail E{EpiResid{F.x, F.ctx, F.X, F.MOD + 2 * 1024, nullptr, 0, 0}, F.PART, 256}; gemm_tail(F, F.YA0, F.WOUT0, 1536, E); if (short_round(F, 256 + 192)) cvt_pull(F, QB_OUT0, true); SEAM(PH_OUT0); }
    if (IN(PH_NORM1)) { ph_norm<1, false, 1>(F, 0, 1, TT); SEAM(PH_NORM1); }
    if (IN(PH_F13)) { REPS(PH_F13) { EpiSwiglu E{F.Gh, DFF}; gemm_pg8(F, F.H, F.WF13, TT, 2 * DFF, 1024, E); } if (short_round(F, 72 * 22)) cvt_pull(F, QB_F13, true); SEAM(PH_F13); }
    if (IN(PH_F2)) { EpiResidTail E{EpiResid{F.X, F.X + (size_t)TL * 1024, F.X, F.MOD + 5 * 1024, nullptr, 0, 0}, F.PART, 512}; gemm_tail(F, F.Gh, F.WF2, DFF, E); TREP(9) { if (_tr == 1) { EpiNull E0; gemm_tail(F, F.Gh, F.WF2, DFF, E0); } } if (short_round(F, 256 + 192)) cvt_pull(F, QB_F2, true); SEAM(PH_F2); }
    if (IN(PH_NORM2)) { ph_norm<1, false, 2>(F, 1, 0, TT); SEAM(PH_NORM2); }
    if (IN(PH_IN1)) { LAS float* rtab = (LAS float*)(F.lds + RING_BYTES + 1024);
        for (int i = F.tid; i < 96 * 16; i += 512) { const int pos = i >> 4, f = i & 15; const float* sp = F.ROPE + ((size_t)(pos < 32 ? pos * 64 : (pos - 32)) * 32 + (pos < 32 ? f : 16 + f)) * 2; rtab[2 * i] = sp[0]; rtab[2 * i + 1] = sp[1]; }
        __syncthreads();
        REPS(PH_IN1) { pg8::Gemm g{F.H, F.WIN1, TT, LDP1, 1024, 0}; In1Order S{F.G, (int)blockIdx.x}; EpiAdapt<EpiRope> E{EpiRope{F.P, rtab}};
            pg8::gemm_phase<EpiAdapt<EpiRope>, In1Order, true, true>(F.lds, g, S, E); } SEAM(PH_IN1); }
    if (IN(PH_MIX1)) { REPS(PH_MIX1) { TREP(4) { chunk_scan<64, true>(F); __syncthreads(); } TREP(5) { ph_swa_mfma(F); __syncthreads(); } } SEAM(PH_MIX1); }
    if (IN(PH_RETOUT)) { REPS(PH_RETOUT) { ph_retout(F); } SEAM(PH_RETOUT); }
    if (IN(PH_OUT1)) { EpiResid E{F.X, F.X + (size_t)TL * 1024, F.X, F.MOD + 9 * 6144 + 2 * 1024, nullptr, 0, 0}; gemm_pg8(F, F.YA1, F.WOUT1, TL, 1024, 1536, E, LDYA1); TREP(10) { if (_tr == 1) { EpiNull E0; gemm_pg8(F, F.YA1, F.WOUT1, TL, 1024, 1536, E0, LDYA1); } } SEAM(PH_OUT1); }
    if (IN(PH_NORM3)) { REPS(PH_NORM3) { TREP(6) ph_norm3_route(F); ph_cvt_moe(F); } SEAM(PH_NORM3); }
    if (IN(PH_ROUTE2)) { REPS(PH_ROUTE2) { ph_route2(F); __syncthreads(); } SEAM(PH_ROUTE2); }
    {
        int MT = 0; if (IN(PH_MG1A) || IN(PH_MG2A) || IN(PH_MG1B) || IN(PH_MG2B)) MT = __builtin_amdgcn_readfirstlane(F.MMETA[0]);
        const int ta = MT < 64 ? MT : 64;
        if (IN(PH_MG1A)) { REPS(PH_MG1A) { EpiSwigluMoe E{F.MG, 0}; gemm_moe(F, F.HP, F.WM13, 1024, 28, 0, ta, E, LDHP); } SEAM(PH_MG1A); }
        if (IN(PH_MG2A)) { EpiStoreMoe E{F.HP, F.Y2T}; gemm_moe(F, F.MG, F.WM2, DFE, 4, 0, ta, E); SEAM(PH_MG2A); }
        if (IN(PH_MG1B)) { REPS(PH_MG1B) { EpiSwigluMoe E{F.MG, 64 * 256}; gemm_moe(F, F.HP, F.WM13, 1024, 28, 64, MT, E, LDHP); } SEAM(PH_MG1B); }
        if (IN(PH_MG2B)) REPS(PH_MG2B) { EpiStoreMoe Ef{F.HP, F.Y2T}; pg8::Gemm g{F.MG - (size_t)64 * 256 * DFE, F.WM2, 0, 0, DFE, 0}; Moe2BOrder S{F.TILEE, MT, F.G, (int)blockIdx.x}; EpiAdapt<EpiStoreMoe> E{Ef};
            pg8::gemm_phase<EpiAdapt<EpiStoreMoe>, Moe2BOrder, true, true>(F.lds, g, S, E); SEAM(PH_MG2B); }
    }
    if (IN(PH_FINAL)) { REPS(PH_FINAL) ph_final(F); }
#undef IN
#undef SEAM
}

extern "C" void kernel_launch(void* const* d_in, const int* in_sizes, int n_in, void* d_out, int out_size, void* d_ws, size_t ws_size, hipStream_t stream) {
    static int grid = 0;
    if (grid == 0) {
        if (n_in != 31 || out_size != TL * DM || ws_size < WS_END) { fprintf(stderr, "kernel_launch: unexpected shapes (n_in %d out %d ws %zu need %zu)\n", n_in, out_size, ws_size, (size_t)WS_END); grid = -1; return; }
        int dev = 0, cus = 0, per_cu = 0;
        if (hipGetDevice(&dev) != hipSuccess || hipDeviceGetAttribute(&cus, hipDeviceAttributeMultiprocessorCount, dev) != hipSuccess) { grid = -1; return; }
        if (hipFuncSetAttribute((const void*)fwd, hipFuncAttributeMaxDynamicSharedMemorySize, LDS_BYTES) != hipSuccess) { grid = -1; return; }
        if (hipOccupancyMaxActiveBlocksPerMultiprocessor(&per_cu, (const void*)fwd, NWAVES * 64, LDS_BYTES) != hipSuccess || per_cu < 1) fprintf(stderr, "kernel_launch: occupancy query reports %d\n", per_cu);
        (void)hipGetLastError();
        grid = cus;
    }
    if (grid < 0) return;
    if (hipMemsetAsync((char*)d_ws + WS_CTL, 0, CTL_ZERO_BYTES, stream) != hipSuccess) return;
    Args a{};
    for (int i = 0; i < 31; ++i) a.in[i] = (const float*)d_in[i];
    a.out = (float*)d_out; a.ws = (unsigned char*)d_ws;
#if MK_ONE_LAUNCH
    a.ph_lo = 0; a.ph_hi = NPHASES;
    hipLaunchKernelGGL(fwd, dim3(grid), dim3(NWAVES * 64), LDS_BYTES, stream, a);
#else
    for (int ph = 0; ph < NPHASES; ++ph) { a.ph_lo = ph; a.ph_hi = ph + 1; hipLaunchKernelGGL(fwd, dim3(grid), dim3(NWAVES * 64), LDS_BYTES, stream, a); }
#endif
}
```

```cpp
#include <hip/hip_runtime.h>
#include <cstdio>
#include <cstdint>

#ifndef MK_ONE_LAUNCH
#define MK_ONE_LAUNCH 1
#endif

#ifndef QB_IN0
#define QB_IN0 0
#define QB_OUT0 0
#define QB_F13 3
#define QB_F2 0
#endif
#define LAS __attribute__((address_space(3)))
typedef unsigned short bf16;
typedef short bf16x8 __attribute__((ext_vector_type(8)));
typedef float f32x4 __attribute__((ext_vector_type(4)));
typedef unsigned v4u __attribute__((ext_vector_type(4)));
typedef unsigned v2u __attribute__((ext_vector_type(2)));

constexpr int DM = 1024, NB = 8, SEQ = 2048, CTXL = 256;
constexpr int TL = NB * SEQ, TC = NB * CTXL, TT = TL + TC;
constexpr int LDP0 = 4352;
constexpr int LDP1 = 3840;
constexpr int DFF = 2816, DFE = 3584, NEXP = 8;
constexpr float EPS = 1e-6f;
constexpr int LDHP = 1024;
constexpr int LDYA1 = 1600;

constexpr size_t MiB = 1u << 20;
constexpr size_t WS_CTL = 0, CTL_ZERO_BYTES = 1 * MiB;
constexpr size_t WS_MOD = 1 * MiB;
constexpr size_t WS_GATE = 2 * MiB;
constexpr size_t WS_ROPE = 3 * MiB;
constexpr size_t WS_WIN0 = 4 * MiB;
constexpr size_t WS_WOUT0 = 13 * MiB;
constexpr size_t WS_WF13 = 16 * MiB;
constexpr size_t WS_WF2 = 27 * MiB;
constexpr size_t WS_WIN1 = 33 * MiB;
constexpr size_t WS_WOUT1 = 40 * MiB + MiB / 2;
constexpr size_t WS_X = 44 * MiB;
constexpr size_t WS_H = 116 * MiB;
constexpr size_t WS_R = 152 * MiB;
constexpr size_t WS_P = WS_R;
constexpr size_t WS_YA0 = WS_R + 153 * MiB;
constexpr size_t WS_XBC = WS_R + 207 * MiB;
constexpr size_t WS_YF0 = WS_R + 261 * MiB;
constexpr size_t WS_YB0 = WS_R + 297 * MiB;
constexpr size_t WS_YA1 = WS_R + 135 * MiB;
constexpr size_t WS_YF1 = WS_R + 189 * MiB;
constexpr size_t WS_YB1 = WS_R + 221 * MiB;
constexpr size_t WS_G = WS_R;
constexpr size_t WS_HP = WS_R;
constexpr size_t WS_MG = WS_R + 68 * MiB;
constexpr size_t WS_PART = WS_R + 100 * MiB;
constexpr size_t WS_WM13 = WS_R + 256 * MiB;
constexpr size_t WS_END = WS_R + 368 * MiB;
constexpr size_t WS_TOPK = WS_GATE + 128 * 1024, WS_SLOT = WS_GATE + 192 * 1024, WS_CNT = WS_GATE + 320 * 1024, WS_TILEE = WS_GATE + 384 * 1024, WS_MMETA = WS_GATE + 385 * 1024;
static_assert(WS_P + (size_t)TT * LDP0 * 2 <= WS_YA0 && WS_YA0 + (size_t)TT * 1536 * 2 <= WS_XBC && WS_XBC + (size_t)TT * 1536 * 2 <= WS_YF0 && WS_YF0 + (size_t)TT * 1024 * 2 <= WS_YB0 && WS_YB0 + (size_t)TT * 1024 * 2 <= WS_END, "ws map layer 0");
static_assert(WS_WOUT1 + (size_t)1024 * LDYA1 * 2 <= WS_X && WS_P + (size_t)TT * LDP1 * 2 <= WS_YA1 && WS_YA1 + (size_t)TL * LDYA1 * 2 <= WS_YF1 && WS_YF1 + (size_t)TL * 1024 * 2 <= WS_YB1 && WS_YB1 + (size_t)TL * 1024 * 2 <= WS_WM13, "ws map layer 1");
static_assert(WS_HP + (size_t)34816 * LDHP * 2 <= WS_MG && WS_MG + (size_t)72 * 256 * 3584 * 2 <= WS_WM13 && WS_WM13 + (size_t)8 * 7168 * LDHP * 2 <= WS_END && WS_XBC >= WS_R + 194 * MiB, "ws map moe");
static_assert(WS_G + (size_t)TT * DFF * 2 <= WS_PART && WS_PART + (size_t)6 * TC * 1024 * 4 <= WS_YA0, "partial slabs");
static_assert(WS_X + (size_t)TT * 1024 * 4 <= WS_H && WS_H + (size_t)TT * 1024 * 2 <= WS_R, "ws map 2");
static_assert((size_t)8 * 1024 * 3584 * 2 <= (size_t)TL * DM * 4, "WM2 fits d_out");
constexpr size_t WS_WM2 = WS_R + 194 * MiB;
constexpr size_t WS_Y2T = 80 * MiB;
static_assert(WS_MG + (size_t)72 * 256 * 3584 * 2 <= WS_WM2 && WS_WM2 + (size_t)8 * 1024 * 3584 * 2 <= WS_WM13 && WS_X + (size_t)TT * 1024 * 2 <= WS_Y2T && WS_Y2T + (size_t)7 * 2048 * 1024 * 2 <= WS_H, "WM2 / Y2T slabs");
constexpr int CW_Q2 = 8192, CW_Q13 = 8256;
constexpr int CW_BAR = 4096;

constexpr int RING_BYTES = 131072, LDS_BYTES = 147456, LDSCTL_OFF = LDS_BYTES - 1024, MISC_OFF = LDSCTL_OFF + 320;
constexpr int NWAVES = 8;

#define NTL(p) __builtin_nontemporal_load(p)
#define NTS(v, p) __builtin_nontemporal_store(v, p)
#define LDS_WAIT() asm volatile("s_waitcnt lgkmcnt(0)" ::: "memory")
__device__ __forceinline__ unsigned f2bf(float f) { unsigned u = __builtin_bit_cast(unsigned, f); return (u + 0x7fffu + ((u >> 16) & 1u)) >> 16; }
typedef float f32x2_t __attribute__((ext_vector_type(2))); typedef __bf16 bf16x2_t __attribute__((ext_vector_type(2)));
__device__ __forceinline__ unsigned pk2(float lo, float hi) { f32x2_t v = {lo, hi}; bf16x2_t b = __builtin_convertvector(v, bf16x2_t); return __builtin_bit_cast(unsigned, b); }
__device__ __forceinline__ float bf2f(unsigned short b) { return __builtin_bit_cast(float, ((unsigned)b) << 16); }
__device__ __forceinline__ float bflo(unsigned w) { return __builtin_bit_cast(float, w << 16); }
__device__ __forceinline__ float bfhi(unsigned w) { return __builtin_bit_cast(float, w & 0xffff0000u); }
__device__ __forceinline__ f32x4 bf4(v2u a) { return (f32x4){bflo(a.x), bfhi(a.x), bflo(a.y), bfhi(a.y)}; }
__device__ __forceinline__ v2u pk4(f32x4 v) { v2u o; o.x = pk2(v.x, v.y); o.y = pk2(v.z, v.w); return o; }
__device__ __forceinline__ float silu_f(float x) { return x * __builtin_amdgcn_rcpf(1.f + __expf(-x)); }
__device__ __forceinline__ float wave_sum(float v) {
#pragma unroll
    for (int o = 1; o < 64; o <<= 1) v += __shfl_xor(v, o);
    return v;
}
__host__ __device__ __forceinline__ int perm32(int rho) { const int n = rho >> 4, i = rho & 15; return 8 * (i >> 2) + 4 * n + (i & 3); }

#define XB_TMO      128
#define XB_XCNT(j)  (256  + 64 * (j))
#define XB_XSUB(j)  (1280 + 64 * (j))
#define XB_XGEN(j)  (2304 + 64 * (j))
#define XB_TOP      3328
#define XB_TOPGEN   3392
#define XCD_BAR_WORDS 3456
#define XB_SPIN_CAP (1u << 18)
__device__ __forceinline__ unsigned xb_ld(unsigned* p)              { return __hip_atomic_load(p, __ATOMIC_RELAXED, __HIP_MEMORY_SCOPE_AGENT); }
__device__ __forceinline__ unsigned xb_add(unsigned* p, unsigned v) { return __hip_atomic_fetch_add(p, v, __ATOMIC_RELAXED, __HIP_MEMORY_SCOPE_AGENT); }
__device__ __forceinline__ unsigned xb_xcc_id() { return (unsigned)__builtin_amdgcn_s_getreg((3 << 11) | 20) & 0xFu; }
#define XB_SPIN(cond, bar) do { unsigned _sp = 0; while (cond) { __builtin_amdgcn_s_sleep(1); \
    if ((++_sp & 255u) == 0u) { if (xb_ld(&(bar)[XB_TMO])) break; if (_sp > XB_SPIN_CAP) { atomicAdd(&(bar)[XB_TMO], 1u); break; } } } } while (0)
struct XcdBarrier { unsigned* bar; unsigned x; volatile LAS unsigned* st; };
__device__ __forceinline__ XcdBarrier xcd_barrier_post(unsigned* bar, volatile LAS unsigned* st) {
    XcdBarrier b; b.bar = bar; b.x = xb_xcc_id(); b.st = st;
    if (threadIdx.x == 0) (void)xb_add(&bar[XB_XCNT(b.x)], 1u);
    return b;
}
__device__ __forceinline__ void xcd_barrier_complete(unsigned* bar, unsigned x, unsigned& nloc, unsigned& nx) {
    const unsigned G = gridDim.x * gridDim.y * gridDim.z;
    unsigned sum, cnt, mine, sp = 0u;
    for (;;) {
        sum = 0u; cnt = 0u; mine = 0u;
#pragma unroll
        for (unsigned j = 0; j < 16; ++j) { const unsigned c = xb_ld(&bar[XB_XCNT(j)]); sum += c; cnt += (c > 0u) ? 1u : 0u; mine = (j == x) ? c : mine; }
        if (sum == G) break;
        __builtin_amdgcn_s_sleep(1);
        if ((++sp & 255u) == 0u) { if (xb_ld(&bar[XB_TMO])) break; if (sp > XB_SPIN_CAP) { atomicAdd(&bar[XB_TMO], 1u); break; } }
    }
    nloc = mine > 0u ? mine : 1u; nx = cnt > 0u ? cnt : 1u;
}
__device__ __forceinline__ void xcd_barrier(const XcdBarrier& b) {
    asm volatile("s_waitcnt vmcnt(0)" ::: "memory");
    __syncthreads();
    if (threadIdx.x == 0) {
        unsigned* bar = b.bar;
        __builtin_amdgcn_s_waitcnt(0);
        unsigned nloc = b.st[0], nx = b.st[1];
        if (nloc == 0u) { xcd_barrier_complete(bar, b.x, nloc, nx); b.st[0] = nloc; b.st[1] = nx; }
        const unsigned old = xb_add(&bar[XB_XSUB(b.x)], 1u);
        const unsigned gen = old / nloc;
        if (old + 1u == (gen + 1u) * nloc) {
            __builtin_amdgcn_fence(__ATOMIC_RELEASE, "agent");
            asm volatile("s_waitcnt vmcnt(0)" ::: "memory");
            const unsigned og = xb_add(&bar[XB_TOP], 1u);
            const unsigned tg = og / nx;
            if (og + 1u == (tg + 1u) * nx) xb_add(&bar[XB_TOPGEN], 1u);
            else XB_SPIN(xb_ld(&bar[XB_TOPGEN]) == tg, bar);
            __builtin_amdgcn_fence(__ATOMIC_ACQUIRE, "agent");
            xb_add(&bar[XB_XGEN(b.x)], 1u);
            asm volatile("s_waitcnt vmcnt(0)" ::: "memory");
        } else {
            XB_SPIN(xb_ld(&bar[XB_XGEN(b.x)]) == gen, bar);
            __builtin_amdgcn_fence(__ATOMIC_ACQUIRE, "agent");
            asm volatile("s_waitcnt vmcnt(0)" ::: "memory");
        }
    }
    __syncthreads();
}

namespace pg8 {
#define PG8_LAS __attribute__((address_space(3)))
typedef unsigned short bf16_t;
typedef short bf16x8 __attribute__((ext_vector_type(8)));
typedef float f32x4 __attribute__((ext_vector_type(4)));
typedef unsigned u32x4 __attribute__((ext_vector_type(4)));
constexpr int BM = 256, BK = 64, HALF = 128, HTB = HALF * BK * 2  , STAGE_BYTES = 8 * HTB, NXCD = 8, WGM = 8;

__host__ __device__ __forceinline__ int lds_byte(int r, int c) { const int st = (r >> 4) * 2 + (c >> 5), rr = r & 15, cc = c & 31, ob = rr * 64 + cc * 2; return st * 1024 + (ob ^ (((ob >> 9) & 1) << 5)); }
__host__ __device__ __forceinline__ void stage_rc(int b, int& R, int& C) { const int st = b / 1024, sb = b % 1024, swz = sb ^ (((sb >> 9) & 1) << 5); R = (st >> 1) * 16 + swz / 64; C = (st & 1) * 32 + (swz % 64) / 2; }
__host__ __device__ __forceinline__ int perm32(int rho) { const int n = rho >> 4, i = rho & 15; return 8 * (i >> 2) + 4 * n + (i & 3); }

struct Unit { int pm, pn, k0, nk; };
struct Gemm { const bf16_t* A; const bf16_t* Bt; int M, N, K, ld; };

struct StaticOrder {
    int nM, nN, nwg, G, c;
    __host__ __device__ __forceinline__ void init(int M, int N, int G_, int c_) { nM = M / BM; nN = N / BM; nwg = nM * nN; G = G_; c = c_; }
    __host__ __device__ __forceinline__ bool next(int i, Unit& u) const {
        const long L = (long)i * G + c; if (L >= nwg) return false;
        int wgid = (int)L; { const int q = nwg / NXCD, r = nwg % NXCD, xcd = wgid % NXCD, off = wgid / NXCD; wgid = (xcd < r ? xcd * (q + 1) : r * (q + 1) + (xcd - r) * q) + off; }
        const int nig = WGM * nN, gid = wgid / nig, fm = gid * WGM, gsz = (nM - fm) < WGM ? (nM - fm) : WGM;
        u.pm = fm + ((wgid % nig) % gsz); u.pn = (wgid % nig) / gsz; u.k0 = 0; u.nk = 0; return true;
    }
    __device__ __forceinline__ void a_ready(const Unit&) const {}
    __device__ __forceinline__ void done(const Unit&) const {}
};

__device__ __forceinline__ unsigned cvt_pk_bf16(float lo, float hi) { unsigned r; asm volatile("v_cvt_pk_bf16_f32 %0, %1, %2" : "=v"(r) : "v"(lo), "v"(hi)); return r; }
template <class Epi, class Sched, bool ALIGN_EPI = false, bool SP2 = false>
__device__ __forceinline__ void gemm_phase(PG8_LAS unsigned char* lds, const Gemm g, const Sched& S, const Epi& E) {
    int tid_ = threadIdx.x; asm volatile("" : "+v"(tid_));
    const int tid = tid_, wid = __builtin_amdgcn_readfirstlane(tid >> 6), lane = tid & 63, wr = wid >> 2, wc = wid & 3, fr = lane & 15, fq = lane >> 4;
    const int K = g.K, nt_full = K / BK, LD = g.ld ? g.ld : K;
    unsigned voffA[2], voffB[2];
#pragma unroll
    for (int i = 0; i < 2; ++i) { int R, C; stage_rc(tid * 16 + i * 8192, R, C); const int Rb = Epi::PERM ? ((R & ~31) + perm32(R & 31)) : R;
        voffA[i] = (unsigned)(R * LD + C) * 2u; voffB[i] = (unsigned)(Rb * LD + C) * 2u; }
    const size_t kstep = (size_t)(BK * 2);
    const size_t hstep = (size_t)HALF * LD * 2;
    const size_t tstep = 2 * hstep;
    const unsigned ldsw = (unsigned)wid * 1024u;
    const int aoff = lds_byte(wr * 64 + fr, fq * 8), boff = lds_byte(wc * 32 + fr, fq * 8);
#define PG8_SA(b, h) (((b) * 2 + (h)) * HTB)
#define PG8_SB(b, h) ((4 + (b) * 2 + (h)) * HTB)
#define PG8_STAGE(bufoff, gbase, voff) do { _Pragma("unroll") for (int _i = 0; _i < 2; ++_i) \
        __builtin_amdgcn_global_load_lds((const unsigned*)((const char*)(gbase) + (voff)[_i]), (PG8_LAS unsigned*)(lds + (bufoff) + ldsw + _i * 8192), 16, 0, 0); } while (0)
#define PG8_LDA(dst, b, h) do { _Pragma("unroll") for (int m = 0; m < 4; ++m) _Pragma("unroll") for (int k = 0; k < 2; ++k) dst[m][k] = *(const PG8_LAS bf16x8*)(lds + PG8_SA(b, h) + aoff + m * 2048 + k * 1024); } while (0)
#define PG8_LDB(dst, b, h) do { _Pragma("unroll") for (int n = 0; n < 2; ++n) _Pragma("unroll") for (int k = 0; k < 2; ++k) dst[n][k] = *(const PG8_LAS bf16x8*)(lds + PG8_SB(b, h) + boff + n * 2048 + k * 1024); } while (0)
#define PG8_MMA(ai, bj, At, Bt) do { __builtin_amdgcn_s_setprio(1); _Pragma("unroll") for (int m = 0; m < 4; ++m) _Pragma("unroll") for (int n = 0; n < 2; ++n) _Pragma("unroll") for (int k = 0; k < 2; ++k) \
        acc[ai][bj][m][n] = __builtin_amdgcn_mfma_f32_16x16x32_bf16(Bt[n][k], At[m][k], acc[ai][bj][m][n], 0, 0, 0); __builtin_amdgcn_s_setprio(0); } while (0)
#define PG8_WAIT_V(n) asm volatile("s_waitcnt vmcnt(" #n ")" ::: "memory")
#define PG8_WAIT_L(n) asm volatile("s_waitcnt lgkmcnt(" #n ")" ::: "memory")
#define PG8_BAR __builtin_amdgcn_s_barrier()
#define PG8_SCHED __builtin_amdgcn_sched_barrier(0)
    Unit cur{0, 0, 0, 0}, nxt{0, 0, 0, 0}; int ui = 0;
    if (!S.next(0, cur)) return;
    f32x4 acc[2][2][4][2];
#pragma unroll
    for (int a = 0; a < 2; ++a)
#pragma unroll
        for (int b = 0; b < 2; ++b)
#pragma unroll
            for (int m = 0; m < 4; ++m)
#pragma unroll
                for (int n = 0; n < 2; ++n) acc[a][b][m][n] = (f32x4){0.f, 0.f, 0.f, 0.f};
    bf16x8 At[4][2], B0[2][2], B1[2][2];
    const char* cA = (const char*)g.A + (size_t)cur.pm * tstep + (size_t)cur.k0 * 2; const char* cB = (const char*)g.Bt + (size_t)cur.pn * tstep + (size_t)cur.k0 * 2;
    S.a_ready(cur);
    if constexpr (SP2) {
        PG8_STAGE(PG8_SB(0, 0), cB, voffB); PG8_STAGE(PG8_SB(0, 1), cB + hstep, voffB); PG8_STAGE(PG8_SA(0, 0), cA, voffA); PG8_STAGE(PG8_SA(0, 1), cA + hstep, voffA);
        if (wr == 1) PG8_BAR;
        PG8_WAIT_V(2); PG8_BAR;
        PG8_STAGE(PG8_SB(1, 0), cB + kstep, voffB); PG8_STAGE(PG8_SA(1, 0), cA + kstep, voffA); PG8_STAGE(PG8_SB(1, 1), cB + hstep + kstep, voffB);
        PG8_WAIT_V(6); PG8_BAR;
    } else {
        PG8_STAGE(PG8_SB(0, 0), cB, voffB); PG8_STAGE(PG8_SA(0, 0), cA, voffA); PG8_STAGE(PG8_SB(0, 1), cB + hstep, voffB); PG8_STAGE(PG8_SA(0, 1), cA + hstep, voffA);
        if (wr == 1) PG8_BAR;
        PG8_WAIT_V(4); PG8_BAR;
        PG8_STAGE(PG8_SB(1, 0), cB + kstep, voffB); PG8_STAGE(PG8_SA(1, 0), cA + kstep, voffA); PG8_STAGE(PG8_SB(1, 1), cB + hstep + kstep, voffB);
        PG8_WAIT_V(6); PG8_BAR;
    }
    for (;;) {
        const bool has_next = S.next(ui + 1, nxt);
        const char* nA = has_next ? (const char*)g.A + (size_t)nxt.pm * tstep + (size_t)nxt.k0 * 2 : cA; const char* nB = has_next ? (const char*)g.Bt + (size_t)nxt.pn * tstep + (size_t)nxt.k0 * 2 : cB;
        const int nt = cur.nk ? cur.nk : nt_full;
        for (int t = 0; t < nt; t += 2) {
            const bool last = (t == nt - 2);
            const char* a1 = cA + (size_t)(t + 1) * kstep;
            const char* a2 = last ? nA : cA + (size_t)(t + 2) * kstep; const char* b2 = last ? nB : cB + (size_t)(t + 2) * kstep;
            const char* a3 = a2 + kstep; const char* b3 = b2 + kstep;
            if (last && has_next) S.a_ready(nxt);
            if constexpr (SP2) {
            PG8_LDB(B0, 0, 0); PG8_LDB(B1, 0, 1); PG8_SCHED; PG8_LDA(At, 0, 0); PG8_STAGE(PG8_SA(1, 1), a1 + hstep, voffA);
            PG8_WAIT_V(8); PG8_WAIT_L(0); PG8_BAR; PG8_MMA(0, 0, At, B0); PG8_MMA(0, 1, At, B1); PG8_BAR; PG8_SCHED;
            PG8_LDA(At, 0, 1); PG8_STAGE(PG8_SB(0, 0), b2, voffB); PG8_STAGE(PG8_SB(0, 1), b2 + hstep, voffB); PG8_STAGE(PG8_SA(0, 0), a2, voffA);
            PG8_WAIT_V(8); PG8_WAIT_L(0); PG8_BAR; PG8_MMA(1, 0, At, B0); PG8_MMA(1, 1, At, B1); PG8_BAR; PG8_SCHED;
            PG8_LDB(B0, 1, 0); PG8_LDB(B1, 1, 1); PG8_SCHED; PG8_LDA(At, 1, 0); PG8_STAGE(PG8_SA(0, 1), a2 + hstep, voffA);
            PG8_WAIT_V(8); PG8_WAIT_L(0); PG8_BAR; PG8_MMA(0, 0, At, B0); PG8_MMA(0, 1, At, B1); PG8_BAR; PG8_SCHED;
            PG8_LDA(At, 1, 1); PG8_STAGE(PG8_SB(1, 0), b3, voffB); PG8_STAGE(PG8_SB(1, 1), b3 + hstep, voffB); PG8_STAGE(PG8_SA(1, 0), a3, voffA);
            PG8_WAIT_V(8); PG8_WAIT_L(0); PG8_BAR; PG8_MMA(1, 0, At, B0); PG8_MMA(1, 1, At, B1); PG8_BAR; PG8_SCHED;
            } else {
            PG8_LDB(B0, 0, 0); PG8_SCHED; PG8_LDA(At, 0, 0); PG8_STAGE(PG8_SA(1, 1), a1 + hstep, voffA);
            PG8_WAIT_L(8); PG8_BAR; PG8_WAIT_L(0); PG8_MMA(0, 0, At, B0); PG8_BAR; PG8_SCHED;
            PG8_LDB(B1, 0, 1); PG8_STAGE(PG8_SB(0, 0), b2, voffB);
            PG8_BAR; PG8_WAIT_L(0); PG8_MMA(0, 1, At, B1); PG8_BAR;
            PG8_LDA(At, 0, 1); PG8_STAGE(PG8_SA(0, 0), a2, voffA);
            PG8_BAR; PG8_WAIT_L(0); PG8_MMA(1, 0, At, B0); PG8_BAR; PG8_SCHED;
            PG8_STAGE(PG8_SB(0, 1), b2 + hstep, voffB);
            PG8_WAIT_V(6); PG8_BAR; PG8_MMA(1, 1, At, B1); PG8_BAR;
            PG8_LDB(B0, 1, 0); PG8_SCHED; PG8_LDA(At, 1, 0); PG8_STAGE(PG8_SA(0, 1), a2 + hstep, voffA);
            PG8_WAIT_L(8); PG8_BAR; PG8_WAIT_L(0); PG8_MMA(0, 0, At, B0); PG8_BAR; PG8_SCHED;
            PG8_LDB(B1, 1, 1); PG8_STAGE(PG8_SB(1, 0), b3, voffB);
            PG8_BAR; PG8_WAIT_L(0); PG8_MMA(0, 1, At, B1); PG8_BAR;
            PG8_LDA(At, 1, 1); PG8_STAGE(PG8_SA(1, 0), a3, voffA);
            PG8_BAR; PG8_WAIT_L(0); PG8_MMA(1, 0, At, B0); PG8_BAR; PG8_SCHED;
            PG8_STAGE(PG8_SB(1, 1), b3 + hstep, voffB);
            PG8_WAIT_V(6); PG8_BAR; PG8_MMA(1, 1, At, B1); PG8_BAR;
            }
        }
        if constexpr (ALIGN_EPI) { if (wr == 0) PG8_BAR; }
        if constexpr (!Epi::AFTER_DRAIN) { E(acc, cur, wr, wc, fr, fq); S.done(cur); }
        if (!has_next) break;
#pragma unroll
        for (int a = 0; a < 2; ++a)
#pragma unroll
            for (int b = 0; b < 2; ++b)
#pragma unroll
                for (int m = 0; m < 4; ++m)
#pragma unroll
                    for (int n = 0; n < 2; ++n) acc[a][b][m][n] = (f32x4){0.f, 0.f, 0.f, 0.f};
        cur = nxt; cA = nA; cB = nB; ++ui;
        if constexpr (ALIGN_EPI) { if (wr == 1) PG8_BAR; }
    }
    PG8_WAIT_V(0);
    if constexpr (!ALIGN_EPI) { if (wr == 0) PG8_BAR; }
    PG8_BAR;
    if constexpr (Epi::AFTER_DRAIN) { E.fused(acc, cur, wr, wc, fr, fq, lds, wid, lane); S.done(cur); }
#undef PG8_SA
#undef PG8_SB
#undef PG8_STAGE
#undef PG8_LDA
#undef PG8_LDB
#undef PG8_MMA
#undef PG8_WAIT_V
#undef PG8_WAIT_L
#undef PG8_BAR
#undef PG8_SCHED
}
}

struct Frame {
    LAS unsigned char* lds;
    int tid, lane, wave, vcu, G;
    const float *x, *c, *ctx, *c_ctx, *ada_w, *ada_b, *norm_attn_g, *norm_ffn_g, *ev_w_in, *ev_w_out, *na_rpb, *conv_w, *conv_b, *dt_bias, *a_log, *ssm_d, *ssm_norm_g,
        *ffn_w1, *ffn_w3, *ffn_w2, *od_w_in, *od_w_out, *swa_sink, *ret_log_decay, *ret_gn_g, *ret_gn_b, *moe_router, *moe_w1, *moe_w3, *moe_w2, *final_g;
    float* out;
    float *MOD, *GATE, *ROPE; bf16* X;
    bf16 *WIN0, *WOUT0, *WF13, *WF2, *WIN1, *WOUT1, *WM13, *WM2, *H, *P, *YA0, *YA1, *XBC, *YF0, *YB0, *YF1, *YB1, *Gh, *MG, *HP;
    unsigned* ctl;
    int *TOPK, *SLOT, *CNT, *TILEE, *MMETA; float* PART; bf16* Y2T;
};

__device__ __forceinline__ void tr_item(const float* W, int K, int N, bf16* WT, int ilv, LAS float* scr, int item, int lane, int ldk = 0) {
    if (ldk == 0) ldk = K;
    const int nblk = N / 32, kb = item / nblk, nb = item % nblk, k0 = 64 * kb, n0 = 32 * nb;
#pragma unroll 8
    for (int i = 0; i < 32; ++i) { const int kk = 2 * i + (lane >> 5); scr[kk * 33 + (lane & 31)] = __builtin_nontemporal_load(W + (size_t)(k0 + kk) * N + n0 + (lane & 31)); }
    LDS_WAIT(); asm volatile("" ::: "memory");
    const int c = lane & 7;
#pragma unroll
    for (int j = 0; j < 4; ++j) { const int n = (lane >> 3) + 8 * j; const LAS float* s = scr + (8 * c) * 33 + n;
        v4u o; o.x = pk2(s[0 * 33], s[1 * 33]); o.y = pk2(s[2 * 33], s[3 * 33]); o.z = pk2(s[4 * 33], s[5 * 33]); o.w = pk2(s[6 * 33], s[7 * 33]);
        const int nn = n0 + n; int row = nn;
        if (ilv == 1 || ilv == 2) row = 8 * (nn >> 2) + (nn & 3) + (ilv == 2 ? 4 : 0);
        if (ilv == 3 && (nn < 640 || (nn >= 768 && nn < 1792))) row = (nn & ~63) + 8 * ((nn & 31) >> 2) + 4 * ((nn >> 5) & 1) + (nn & 3);
        __builtin_nontemporal_store(o, (v4u*)(WT + (size_t)row * ldk + k0 + 8 * c)); }
    LDS_WAIT(); asm volatile("" ::: "memory");
}

__device__ __forceinline__ void tr_item64(const float* W, int K, int N, bf16* WT, int ilv, LAS float* scr, int item, int lane, int ldk = 0) {
    if (ldk == 0) ldk = K;
    const int nblk = N / 64, kb = item / nblk, nb = item % nblk, k0 = 64 * kb, n0 = 64 * nb, c4 = (lane & 15) * 4;
    f32x4 v[16];
#pragma unroll
    for (int i = 0; i < 16; ++i) v[i] = NTL((const f32x4*)(W + (size_t)(k0 + 4 * i + (lane >> 4)) * N + n0 + c4));
#pragma unroll
    for (int i = 0; i < 16; ++i) { LAS float* d = scr + (4 * i + (lane >> 4)) * 65 + c4; d[0] = v[i].x; d[1] = v[i].y; d[2] = v[i].z; d[3] = v[i].w; }
    LDS_WAIT(); asm volatile("" ::: "memory");
    const int c = lane & 7;
#pragma unroll
    for (int j = 0; j < 8; ++j) { const int n = (lane >> 3) + 8 * j; const LAS float* s = scr + (8 * c) * 65 + n;
        v4u o; o.x = pk2(s[0 * 65], s[1 * 65]); o.y = pk2(s[2 * 65], s[3 * 65]); o.z = pk2(s[4 * 65], s[5 * 65]); o.w = pk2(s[6 * 65], s[7 * 65]);
        const int nn = n0 + n; int row = nn;
        if (ilv == 1 || ilv == 2) row = 8 * (nn >> 2) + (nn & 3) + (ilv == 2 ? 4 : 0);
        if (ilv == 3 && (nn < 640 || (nn >= 768 && nn < 1792))) row = (nn & ~63) + 8 * ((nn & 31) >> 2) + 4 * ((nn >> 5) & 1) + (nn & 3);
        NTS(o, (v4u*)(WT + (size_t)row * ldk + k0 + 8 * c)); }
    LDS_WAIT(); asm volatile("" ::: "memory");
}

__device__ __forceinline__ void ph_cvt(const Frame& F) {
    LAS float* scr = (LAS float*)(F.lds + F.wave * 16640);
    const int gw = F.vcu * NWAVES + F.wave, NGW = F.G * NWAVES;
    constexpr int I_IN0 = 16 * 129, I_OUT = 24 * 16, I_F1 = 16 * 44, I_F2 = 44 * 16, I_IN1 = 16 * 60;
    constexpr int NITEMS = I_IN0 + I_OUT + 2 * I_F1 + I_F2 + I_IN1 + I_OUT;
    for (int it = gw; it < NITEMS; it += NGW) {
        int r = it;
        if (r < I_IN0) { tr_item(F.ev_w_in, 1024, 4128, F.WIN0, 0, scr, r, F.lane); continue; } r -= I_IN0;
        if (r < I_OUT) { tr_item64(F.ev_w_out, 1536, 1024, F.WOUT0, 0, scr, r, F.lane); continue; } r -= I_OUT;
        if (r < I_F1) { tr_item64(F.ffn_w1, 1024, DFF, F.WF13, 1, scr, r, F.lane); continue; } r -= I_F1;
        if (r < I_F1) { tr_item64(F.ffn_w3, 1024, DFF, F.WF13, 2, scr, r, F.lane); continue; } r -= I_F1;
        if (r < I_F2) { tr_item64(F.ffn_w2, DFF, 1024, F.WF2, 0, scr, r, F.lane); continue; } r -= I_F2;
        if (r < I_IN1) { tr_item64(F.od_w_in, 1024, LDP1, F.WIN1, 3, scr, r, F.lane); continue; } r -= I_IN1;
        tr_item64(F.od_w_out, 1536, 1024, F.WOUT1, 0, scr, r, F.lane, LDYA1);
    }
    { const int gt = F.vcu * 512 + F.tid, NGT = F.G * 512; v4u* z = (v4u*)(F.WIN0 + (size_t)4128 * 1024);
      for (int i = gt; i < 224 * 1024 / 8; i += NGT) z[i] = (v4u){0u, 0u, 0u, 0u}; }
    { const int gt = F.vcu * 512 + F.tid, NGT = F.G * 512;
      for (int i = gt; i < 2048 * 32; i += NGT) { const int t = i >> 5, f = i & 31; const float inv = powf(10000.f, -(float)(f & 15) / 16.f);
          const float ang = (float)((f < 16) ? (t >> 6) : (t & 63)) * inv; float sn, cs; sincosf(ang, &sn, &cs); F.ROPE[2 * i] = cs; F.ROPE[2 * i + 1] = sn; } }
    __syncthreads();
    LAS float* sv = (LAS float*)F.lds;
    LAS float* part = (LAS float*)(F.lds + 36864);
    for (int it = F.vcu; it < 192; it += F.G) {
        const int l = it / 96, n0 = (it % 96) * 64;
        for (int i = F.tid; i < 9 * 1024; i += 512) { const int r = i >> 10, k = i & 1023; const float v = (r < 8) ? F.c[r * 1024 + k] : F.c_ctx[k]; sv[i] = silu_f(v); }
        __syncthreads();
        float acc[9];
#pragma unroll
        for (int r = 0; r < 9; ++r) acc[r] = 0.f;
        const float* wp = F.ada_w + (size_t)l * 1024 * 6144 + n0 + F.lane;
#pragma unroll 8
        for (int k = F.wave * 128; k < F.wave * 128 + 128; ++k) { const float w = NTL(wp + (size_t)k * 6144);
#pragma unroll
            for (int r = 0; r < 9; ++r) acc[r] += sv[r * 1024 + k] * w; }
#pragma unroll
        for (int r = 0; r < 9; ++r) part[(F.wave * 9 + r) * 64 + F.lane] = acc[r];
        __syncthreads();
        for (int i = F.tid; i < 9 * 64; i += 512) { const int r = i >> 6, n = i & 63; float s = 0.f;
#pragma unroll
            for (int w = 0; w < 8; ++w) s += part[(w * 9 + r) * 64 + n];
            F.MOD[(size_t)(l * 9 + r) * 6144 + n0 + n] = s + F.ada_b[l * 6144 + n0 + n]; }
        __syncthreads();
    }
}

__device__ __forceinline__ int cvt_claim(const Frame& F, int word, int n) {
    int it = 0;
    if (F.lane == 0) it = (int)__hip_atomic_fetch_add(F.ctl + word, (unsigned)n, __ATOMIC_RELAXED, __HIP_MEMORY_SCOPE_AGENT);
    return __builtin_amdgcn_readfirstlane(it);
}
__device__ __forceinline__ void cvt_item2(const Frame& F, LAS float* scr, int it) { constexpr int I_2 = 56 * 16; const int e = it / I_2, r = it % I_2;
    tr_item64(F.moe_w2 + (size_t)e * DFE * 1024, DFE, 1024, F.WM2 + (size_t)e * 1024 * DFE, 0, scr, r, F.lane); }
__device__ __forceinline__ void cvt_item13(const Frame& F, LAS float* scr, int it) { constexpr int I_1 = 16 * 56; const int e = it / (2 * I_1), r = it % (2 * I_1);
    if (r < I_1) tr_item64(F.moe_w1 + (size_t)e * 1024 * DFE, 1024, DFE, F.WM13 + (size_t)e * 7168 * LDHP, 1, scr, r, F.lane, LDHP);
    else tr_item64(F.moe_w3 + (size_t)e * 1024 * DFE, 1024, DFE, F.WM13 + (size_t)e * 7168 * LDHP, 2, scr, r - I_1, F.lane, LDHP); }
constexpr int CVT_N2 = NEXP * 56 * 16, CVT_N13 = NEXP * 2 * 16 * 56;
__device__ __forceinline__ bool cvt_pull(const Frame& F, int budget, bool allow13) {
    LAS float* scr = (LAS float*)(F.lds + F.wave * 16640);
    if (!allow13) return false;
    const int b = cvt_claim(F, CW_Q13, budget);
    if (b >= CVT_N13) return false;
    for (int it = b; it < b + budget && it < CVT_N13; ++it) cvt_item13(F, scr, it);
    return true;
}
__device__ __forceinline__ void cvt_drain(const Frame& F) {
    LAS float* scr = (LAS float*)(F.lds + F.wave * 16640);
    for (;;) { const int b = cvt_claim(F, CW_Q2, 2); if (b >= CVT_N2) break; for (int it = b; it < b + 2 && it < CVT_N2; ++it) cvt_item2(F, scr, it); }
    for (;;) { const int b = cvt_claim(F, CW_Q13, 2); if (b >= CVT_N13) break; for (int it = b; it < b + 2 && it < CVT_N13; ++it) cvt_item13(F, scr, it); }
}
__device__ __forceinline__ int cvt_nt(const Frame& F) { const int rem = (72 * 22) % F.G; return rem ? (F.G - rem) * NWAVES * QB_F13 : 0; }
__device__ __forceinline__ void cvt_tail_f13(const Frame& F) {
    const int rem = (72 * 22) % F.G; if (rem == 0 || (int)blockIdx.x < rem || QB_F13 == 0) return;
    LAS float* scr = (LAS float*)(F.lds + F.wave * 16640);
    const int w = ((int)blockIdx.x - rem) * NWAVES + F.wave, nw = (F.G - rem) * NWAVES;
    for (int k = 0; k < QB_F13; ++k) { const int it = k * nw + w; if (it < CVT_N13) cvt_item13(F, scr, it); }
}
__device__ __forceinline__ void ph_cvt_moe(const Frame& F) {
    LAS float* scr = (LAS float*)(F.lds + F.wave * 16640);
    const int gw = F.vcu * NWAVES + F.wave, NGW = F.G * NWAVES;
    const int nt = min(cvt_nt(F), CVT_N13), n13 = CVT_N13 - nt;
    for (int it = gw; it < CVT_N2 + n13; it += NGW) { if (it < CVT_N2) cvt_item2(F, scr, it); else cvt_item13(F, scr, nt + (it - CVT_N2)); }
}
__device__ __forceinline__ bool short_round(const Frame& F, int units) { const int rem = units % F.G; return rem != 0 && (int)blockIdx.x >= rem; }

template <int MODE, bool ROUTER, int CTXSUM = 0>
__device__ __forceinline__ void ph_norm(const Frame& F, int layer, int which, int nrows) {
    const int gw = F.vcu * NWAVES + F.wave, NGW = F.G * NWAVES;
    const float* g = (which ? F.norm_ffn_g : F.norm_attn_g) + layer * 1024;
    for (int row0 = gw * 4; row0 < nrows; row0 += NGW * 4) {
        const int bidx = row0 < TL ? (row0 >> 11) : 8;
        const float* mod = F.MOD + (size_t)(layer * 9 + bidx) * 6144 + (which ? 3 : 0) * 1024;
        f32x4 v[4][4];
#pragma unroll
        for (int r = 0; r < 4; ++r) { const int row = row0 + r;
            if (MODE == 0) { const float* src = row < TL ? F.x + (size_t)row * 1024 : F.ctx + (size_t)(row - TL) * 1024;
#pragma unroll
                for (int j = 0; j < 4; ++j) v[r][j] = __builtin_nontemporal_load((const f32x4*)src + F.lane + 64 * j); }
            else { const v2u* src = (const v2u*)(F.X + (size_t)row * 1024);
#pragma unroll
                for (int j = 0; j < 4; ++j) v[r][j] = bf4(NTL(src + F.lane + 64 * j)); } }
        if (CTXSUM != 0 && row0 >= TL) {
#pragma unroll
            for (int r = 0; r < 4; ++r) { const int row = row0 + r;
#pragma unroll
                for (int j = 0; j < 4; ++j) { if (CTXSUM == 1) v[r][j] = ((const f32x4*)(F.ctx + (size_t)(row - TL) * 1024))[F.lane + 64 * j];
                    f32x4 sum = (f32x4){0.f, 0.f, 0.f, 0.f};
#pragma unroll
                    for (int sl = 0; sl < 6; ++sl) sum += ((const f32x4*)(F.PART + ((size_t)sl * TC + (row - TL)) * 1024))[F.lane + 64 * j];
                    const f32x4 gq = ((const f32x4*)(F.MOD + (size_t)8 * 6144 + (CTXSUM == 1 ? 2 : 5) * 1024))[F.lane + 64 * j];
                    v[r][j] = v[r][j] + gq * sum; ((v2u*)(F.X + (size_t)row * 1024))[F.lane + 64 * j] = pk4(v[r][j]); v[r][j] = bf4(pk4(v[r][j])); } } }
        f32x4 gg[4], sh[4], sc[4];
#pragma unroll
        for (int j = 0; j < 4; ++j) { gg[j] = ((const f32x4*)g)[F.lane + 64 * j]; sh[j] = ((const f32x4*)mod)[F.lane + 64 * j]; sc[j] = ((const f32x4*)(mod + 1024))[F.lane + 64 * j] + 1.0f; gg[j] = gg[j] * sc[j]; }
        float ss[4];
#pragma unroll
        for (int r = 0; r < 4; ++r) { float s = 0.f;
#pragma unroll
            for (int j = 0; j < 4; ++j) s += (v[r][j].x * v[r][j].x + v[r][j].y * v[r][j].y) + (v[r][j].z * v[r][j].z + v[r][j].w * v[r][j].w);
            ss[r] = s; }
#pragma unroll
        for (int o = 1; o < 64; o <<= 1) {
#pragma unroll
            for (int r = 0; r < 4; ++r) ss[r] += __shfl_xor(ss[r], o); }
#pragma unroll
        for (int r = 0; r < 4; ++r) { const float rstd = 1.0f / sqrtf(ss[r] * (1.f / 1024.f) + EPS);
            unsigned long long* o8 = (unsigned long long*)(F.H + (size_t)(row0 + r) * 1024) + F.lane;
#pragma unroll
            for (int j = 0; j < 4; ++j) { const f32x4 hv = (v[r][j] * rstd) * gg[j] + sh[j];
                NTS((unsigned long long)pk2(hv.x, hv.y) | ((unsigned long long)pk2(hv.z, hv.w) << 32), o8 + 64 * j); } }
    }
}

template <class Epi>
__device__ __forceinline__ void gemm_simple(const Frame& F, const bf16* A, const bf16* Bt, int M, int N, int K, const Epi& E) {
    const int nN = N / 128, nU = (M / 256) * nN;
    const int wr = F.wave >> 1, wc = F.wave & 1, fr = F.lane & 15, fq = F.lane >> 4;
    for (int u = F.vcu; u < nU; u += F.G) {
        const int pm = u / nN, pn = u % nN, row0 = pm * 256 + wr * 64, col0 = pn * 128 + wc * 64;
        f32x4 acc[4][4];
#pragma unroll
        for (int i = 0; i < 4; ++i)
#pragma unroll
            for (int j = 0; j < 4; ++j) acc[i][j] = (f32x4){0.f, 0.f, 0.f, 0.f};
        const bf16* ap = A + (size_t)(row0 + fr) * K + fq * 8;
        const bf16* bp0 = Bt + (size_t)(col0 + perm32(fr)) * K + fq * 8;
        const bf16* bp1 = Bt + (size_t)(col0 + perm32(16 + fr)) * K + fq * 8;
#pragma unroll 2
        for (int k0 = 0; k0 < K; k0 += 32) {
            bf16x8 a[4], b[4];
#pragma unroll
            for (int i = 0; i < 4; ++i) a[i] = *(const bf16x8*)(ap + (size_t)(16 * i) * K + k0);
            b[0] = *(const bf16x8*)(bp0 + k0); b[1] = *(const bf16x8*)(bp1 + k0);
            b[2] = *(const bf16x8*)(bp0 + (size_t)32 * K + k0); b[3] = *(const bf16x8*)(bp1 + (size_t)32 * K + k0);
#pragma unroll
            for (int i = 0; i < 4; ++i)
#pragma unroll
                for (int j = 0; j < 4; ++j) acc[i][j] = __builtin_amdgcn_mfma_f32_16x16x32_bf16(b[j], a[i], acc[i][j], 0, 0, 0);
        }
#pragma unroll
        for (int i = 0; i < 4; ++i)
#pragma unroll
            for (int q = 0; q < 2; ++q) E(row0 + 16 * i + fr, col0 + 32 * q + 8 * fq, acc[i][2 * q], acc[i][2 * q + 1]);
    }
}

struct EpiStore {
    bf16* O; int ldc;
    __device__ __forceinline__ void operator()(int row, int col, f32x4 lo, f32x4 hi, int part = 0) const {
        v4u w; w.x = pk2(lo.x, lo.y); w.y = pk2(lo.z, lo.w); w.z = pk2(hi.x, hi.y); w.w = pk2(hi.z, hi.w);
        *(v4u*)(O + (size_t)row * ldc + col) = w; }
};
struct EpiSwiglu {
    bf16* O; int ldc;
    __device__ __forceinline__ void operator()(int row, int col, f32x4 lo, f32x4 hi, int part = 0) const {
        v2u w; w.x = pk2(silu_f(lo.x) * hi.x, silu_f(lo.y) * hi.y); w.y = pk2(silu_f(lo.z) * hi.z, silu_f(lo.w) * hi.w);
        *(v2u*)(O + (size_t)row * ldc + (col >> 1)) = w; }
};
template <bool BASEF32>
struct EpiResidT {
    const float* bl; const float* bc; bf16* X; const float* gate  ; const float* rs; int rs_ld, rs_off;
    __device__ __forceinline__ void operator()(int row, int col, f32x4 lo, f32x4 hi, int part = 0) const {
        const int bidx = row < TL ? (row >> 11) : 8;
        const float* gp = gate + (size_t)bidx * 6144 + col;
        float sc = 1.f; if (rs) sc = rs[(size_t)row * rs_ld + rs_off];
        const f32x4 g0 = ((const f32x4*)gp)[0] * sc, g1 = ((const f32x4*)gp)[1] * sc;
        bf16* o = X + (size_t)row * 1024 + col;
        f32x4 b0, b1;
        if (BASEF32) { const float* b = row < TL ? bl + (size_t)row * 1024 + col : bc + (size_t)(row - TL) * 1024 + col; b0 = ((const f32x4*)b)[0]; b1 = ((const f32x4*)b)[1]; }
        else { const v4u w = *(const v4u*)o; b0 = (f32x4){bflo(w.x), bfhi(w.x), bflo(w.y), bfhi(w.y)}; b1 = (f32x4){bflo(w.z), bfhi(w.z), bflo(w.w), bfhi(w.w)}; }
        const f32x4 r0 = b0 + g0 * lo, r1 = b1 + g1 * hi;
        v4u w; w.x = pk2(r0.x, r0.y); w.y = pk2(r0.z, r0.w); w.z = pk2(r1.x, r1.y); w.w = pk2(r1.z, r1.w);
        *(v4u*)o = w; }
};
typedef EpiResidT<false> EpiResid;

struct EpiRope {
    bf16* O; const LAS float* tab;
    __device__ __forceinline__ void operator()(int row, int col, f32x4 lo, f32x4 hi, int part = 0) const {
        if (col < 640 || (col >= 768 && col < 1792)) {
            const int hb = col & ~63, d0 = (col & 63) >> 1;
            f32x4 c01 = (f32x4){1.f, 0.f, 1.f, 0.f}, c23 = (f32x4){1.f, 0.f, 1.f, 0.f};
            if (row < TL) { const int t = row & 2047, pos = (d0 < 16) ? (t >> 6) : 32 + (t & 63); const LAS float* tp = tab + (pos * 16 + (d0 & 15)) * 2; c01 = ((const LAS f32x4*)tp)[0]; c23 = ((const LAS f32x4*)tp)[1]; }
            v2u a, b;
            a.x = pk2(lo.x * c01.x - hi.x * c01.y, lo.y * c01.z - hi.y * c01.w); a.y = pk2(lo.z * c23.x - hi.z * c23.y, lo.w * c23.z - hi.w * c23.w);
            b.x = pk2(hi.x * c01.x + lo.x * c01.y, hi.y * c01.z + lo.y * c01.w); b.y = pk2(hi.z * c23.x + lo.z * c23.y, hi.w * c23.z + lo.w * c23.w);
            *(v2u*)(O + (size_t)row * LDP1 + hb + d0) = a; *(v2u*)(O + (size_t)row * LDP1 + hb + 32 + d0) = b;
        } else { v4u w; w.x = pk2(lo.x, lo.y); w.y = pk2(lo.z, lo.w); w.z = pk2(hi.x, hi.y); w.w = pk2(hi.z, hi.w); *(v4u*)(O + (size_t)row * LDP1 + col) = w; }
    }
};
struct In1Order {
    int G, c;
    __device__ __forceinline__ bool next(int i, pg8::Unit& u) const {
        const int L0 = i * G + c; if (L0 >= 1016) return false;
        const int L = (L0 & 7) * 127 + (L0 >> 3);
        if (L < 960) { const int grp = L / 120, rem = L % 120; u.pm = grp * 8 + (rem & 7); u.pn = rem >> 3; }
        else { const int q = L - 960, j = q >> 3; u.pm = 64 + (q & 7); u.pn = (j == 0) ? 2 : 4 + j; }
        u.k0 = 0; u.nk = 0; return true; }
    __device__ __forceinline__ void a_ready(const pg8::Unit&) const {}
    __device__ __forceinline__ void done(const pg8::Unit&) const {}
};
struct EpiNull {
    __device__ __forceinline__ void operator()(int row, int col, f32x4 lo, f32x4 hi, int part = 0) const { asm volatile("" :: "v"(lo), "v"(hi), "v"(row), "v"(col)); }
};
template <class F8> struct EpiAdapt {
    static constexpr bool PERM = true, AFTER_DRAIN = false;
    F8 f;
    __device__ __forceinline__ void operator()(const pg8::f32x4 (&acc)[2][2][4][2], const pg8::Unit& u, int wr, int wc, int fr, int fq) const {
#pragma unroll
        for (int ai = 0; ai < 2; ++ai)
#pragma unroll
            for (int m = 0; m < 4; ++m) { const int row = u.pm * 256 + ai * 128 + wr * 64 + m * 16 + fr;
#pragma unroll
                for (int bj = 0; bj < 2; ++bj) f(row, u.pn * 256 + bj * 128 + wc * 32 + 8 * fq, acc[ai][bj][m][0], acc[ai][bj][m][1], u.nk != 0 ? 1 + u.k0 : 0);
                if (m & 1) asm volatile("" ::: "memory"); }
    }
};
#ifndef USE_SIMPLE_GEMM
#define USE_SIMPLE_GEMM 0
#endif
template <class F8>
__device__ __forceinline__ void gemm_pg8(const Frame& F, const bf16* A, const bf16* Bt, int M, int N, int K, const F8& f, int ld = 0) {
#if USE_SIMPLE_GEMM
    gemm_simple(F, A, Bt, M, N, K, f);
#else
    pg8::Gemm g{A, Bt, M, N, K, ld}; pg8::StaticOrder S; S.init(M, N, F.G, (int)blockIdx.x);
    EpiAdapt<F8> E{f};
    pg8::gemm_phase<EpiAdapt<F8>, pg8::StaticOrder, true, true>(F.lds, g, S, E);
#endif
}

template <class RT>
struct EpiResidTail {
    RT R; float* part; int kslice;
    __device__ __forceinline__ void operator()(int row, int col, f32x4 lo, f32x4 hi, int p = 0) const {
        if (p == 0) { R(row, col, lo, hi, 0); return; }
        float* o = part + ((size_t)((p - 1) / kslice) * TC + (row - TL)) * 1024 + col; ((f32x4*)o)[0] = lo; ((f32x4*)o)[1] = hi; }
};
struct TailOrder {
    pg8::StaticOrder S0; int G, c, K;
    __device__ __forceinline__ void init(int G_, int c_, int K_) { S0.init(TL, 1024, G_, c_); G = G_; c = c_; K = K_; }
    __device__ __forceinline__ bool next(int i, pg8::Unit& u) const {
        const int r0 = (256 + G - 1) / G;
        if (i < r0) return S0.next(i, u);
        const int q = (i - r0) * G + c; if (q >= 32 * 6) return false;
        const int bu = q & 31, sl = q >> 5; u.pm = 64 + (bu >> 2); u.pn = bu & 3;
        if (K == 1536) { u.k0 = sl * 256; u.nk = 4; } else { u.k0 = sl * 512; u.nk = (sl == 5) ? 4 : 8; }
        return true; }
    __device__ __forceinline__ void a_ready(const pg8::Unit&) const {}
    __device__ __forceinline__ void done(const pg8::Unit&) const {}
};
template <class F8>
__device__ __forceinline__ void gemm_tail(const Frame& F, const bf16* A, const bf16* Bt, int K, const F8& f) {
    pg8::Gemm g{A, Bt, TT, 1024, K, 0}; TailOrder S; S.init(F.G, (int)blockIdx.x, K);
    EpiAdapt<F8> E{f};
    pg8::gemm_phase<EpiAdapt<F8>, TailOrder, true, true>(F.lds, g, S, E);
}

#define DOT64(s, q, kp) do { s = 0.f; _Pragma("unroll") for (int _c = 0; _c < 8; ++_c) { const v4u _w = ((const v4u*)(kp))[_c]; \
    s += q[8*_c+0] * bflo(_w.x) + q[8*_c+1] * bfhi(_w.x) + q[8*_c+2] * bflo(_w.y) + q[8*_c+3] * bfhi(_w.y) + q[8*_c+4] * bflo(_w.z) + q[8*_c+5] * bfhi(_w.z) + q[8*_c+6] * bflo(_w.w) + q[8*_c+7] * bfhi(_w.w); } } while (0)
#define ONLINE_UPD(s, m, l, o, vp) do { if (s > m) { const float _cr = __expf(m - s); l *= _cr; _Pragma("unroll") for (int _d = 0; _d < 64; ++_d) o[_d] *= _cr; m = s; } \
    const float _p = __expf(s - m); l += _p; _Pragma("unroll") for (int _c = 0; _c < 8; ++_c) { const v4u _w = ((const v4u*)(vp))[_c]; \
    o[8*_c+0] += _p * bflo(_w.x); o[8*_c+1] += _p * bfhi(_w.x); o[8*_c+2] += _p * bflo(_w.y); o[8*_c+3] += _p * bfhi(_w.y); o[8*_c+4] += _p * bflo(_w.z); o[8*_c+5] += _p * bfhi(_w.z); o[8*_c+6] += _p * bflo(_w.w); o[8*_c+7] += _p * bfhi(_w.w); } } while (0)
#define LOADQ64(q, qp, scale) do { _Pragma("unroll") for (int _c = 0; _c < 8; ++_c) { const v4u _w = ((const v4u*)(qp))[_c]; \
    q[8*_c+0] = scale * bflo(_w.x); q[8*_c+1] = scale * bfhi(_w.x); q[8*_c+2] = scale * bflo(_w.y); q[8*_c+3] = scale * bfhi(_w.y); q[8*_c+4] = scale * bflo(_w.z); q[8*_c+5] = scale * bfhi(_w.z); q[8*_c+6] = scale * bflo(_w.w); q[8*_c+7] = scale * bfhi(_w.w); } } while (0)
#define STORE_O64(op, o, inv) do { _Pragma("unroll") for (int _c = 0; _c < 8; ++_c) { v4u _w; _w.x = pk2(o[8*_c+0] * inv, o[8*_c+1] * inv); _w.y = pk2(o[8*_c+2] * inv, o[8*_c+3] * inv); \
    _w.z = pk2(o[8*_c+4] * inv, o[8*_c+5] * inv); _w.w = pk2(o[8*_c+6] * inv, o[8*_c+7] * inv); ((v4u*)(op))[_c] = _w; } } while (0)

__device__ __forceinline__ void ph_conv(const Frame& F) {
    const int gt = F.vcu * 512 + F.tid, NGT = F.G * 512;
    for (int idx = gt; idx < (TT / 16) * 192; idx += NGT) {
        const int rb = idx / 192, ch = (idx % 192) * 8, row0 = rb * 16;
        int t0, len; if (row0 < TL) { t0 = row0 & 2047; len = 2048; } else { t0 = (row0 - TL) & 255; len = 256; }
        float wgt[5][8], bias[8];
#pragma unroll
        for (int k = 0; k < 5; ++k) { const f32x4 a = *(const f32x4*)(F.conv_w + k * 1536 + ch), b = *(const f32x4*)(F.conv_w + k * 1536 + ch + 4);
            wgt[k][0] = a.x; wgt[k][1] = a.y; wgt[k][2] = a.z; wgt[k][3] = a.w; wgt[k][4] = b.x; wgt[k][5] = b.y; wgt[k][6] = b.z; wgt[k][7] = b.w; }
        { const f32x4 a = *(const f32x4*)(F.conv_b + ch), b = *(const f32x4*)(F.conv_b + ch + 4); bias[0] = a.x; bias[1] = a.y; bias[2] = a.z; bias[3] = a.w; bias[4] = b.x; bias[5] = b.y; bias[6] = b.z; bias[7] = b.w; }
        const bf16* src = F.P + (size_t)row0 * LDP0 + 2560 + ch;
        const v4u zero = (v4u){0u, 0u, 0u, 0u};
        v4u win[5];
        win[0] = (t0 - 2 >= 0) ? *(const v4u*)(src - 2 * LDP0) : zero; win[1] = (t0 - 1 >= 0) ? *(const v4u*)(src - LDP0) : zero;
        win[2] = *(const v4u*)src; win[3] = *(const v4u*)(src + LDP0);
#pragma unroll
        for (int i = 0; i < 16; ++i) {
            win[4] = (t0 + i + 2 < len) ? NTL((const v4u*)(src + (size_t)(i + 2) * LDP0)) : zero;
            float acc[8];
#pragma unroll
            for (int j = 0; j < 8; ++j) acc[j] = bias[j];
#pragma unroll
            for (int k = 0; k < 5; ++k) { const v4u wv = win[k];
                acc[0] += wgt[k][0] * bflo(wv.x); acc[1] += wgt[k][1] * bfhi(wv.x); acc[2] += wgt[k][2] * bflo(wv.y); acc[3] += wgt[k][3] * bfhi(wv.y);
                acc[4] += wgt[k][4] * bflo(wv.z); acc[5] += wgt[k][5] * bfhi(wv.z); acc[6] += wgt[k][6] * bflo(wv.w); acc[7] += wgt[k][7] * bfhi(wv.w); }
            v4u o; o.x = pk2(silu_f(acc[0]), silu_f(acc[1])); o.y = pk2(silu_f(acc[2]), silu_f(acc[3])); o.z = pk2(silu_f(acc[4]), silu_f(acc[5])); o.w = pk2(silu_f(acc[6]), silu_f(acc[7]));
            NTS(o, (v4u*)(F.XBC + (size_t)(row0 + i) * 1536 + ch));
            win[0] = win[1]; win[1] = win[2]; win[2] = win[3]; win[3] = win[4];
        }
    }
}

__device__ __forceinline__ int scan_row(int b, int d, int s) {
    if (s < 256) return TL + b * 256 + (d ? 255 - s : s);
    const int t = s - 256; return b * 2048 + (d ? 2047 - t : t);
}

typedef short s16x4 __attribute__((ext_vector_type(4)));
__device__ __forceinline__ s16x4 lds_tr(const LAS unsigned char* p) { return __builtin_bit_cast(s16x4, __builtin_amdgcn_ds_read_tr16_b64_v4i16((LAS s16x4*)p)); }
__device__ __forceinline__ bf16x8 cat8(s16x4 a, s16x4 b) { return __builtin_shufflevector(a, b, 0, 1, 2, 3, 4, 5, 6, 7); }
template <int NST, bool RET>
__device__ __forceinline__ void chunk_scan(const Frame& F) {
    constexpr int SC = NST * 2 + 16, SX = 64 * 2 + 16, SH = NST * 2 + 16, NKS = NST / 32, NHT = NST / 32, NP = NST / 32  , PPR = NST / 8  ;
    LAS unsigned char* Cs = F.lds;
    LAS unsigned char* Bs = Cs + 128 * SC;
    LAS unsigned char* Xs = Bs + 128 * SC;
    LAS unsigned char* Xw = Xs + 128 * SX;
    LAS unsigned char* Hs = Xw + 128 * SX;
    LAS float* acs = (LAS float*)(Hs + 64 * SH);
    LAS float* dts = acs + 128;
    const int w = F.wave, lane = F.lane, l15 = lane & 15, g = lane >> 4, q4 = l15 >> 2, p4 = lane & 3;
    for (int u = F.vcu; u < 256; u += F.G) {
        int d, h, b, grp = 0, ph = 0;
        if (RET) { ph = u & 1; d = (u >> 1) & 1; h = (u >> 2) & 7; b = u >> 5; } else { d = u & 1; h = (u >> 1) & 15; b = u >> 5; grp = h >> 3; }
        float dtb = 0.f, Acoef = 0.f, lgam = 0.f;
        if (RET) lgam = log1pf(-expf(F.ret_log_decay[d * 8 + h])); else { dtb = F.dt_bias[d * 16 + h]; Acoef = -expf(F.a_log[d * 16 + h]); }
        const int nt = RET ? (w & 3) : w, pt0 = RET ? 2 * (w >> 2) : 0;
        const int ycol = RET ? h * 128 + ph * 64 : h * 64;
        bf16* Y = RET ? (d ? F.YB1 : F.YF1) : (d ? F.YB0 : F.YF0);
        f32x4 Hacc[NHT];
#pragma unroll
        for (int k = 0; k < NHT; ++k) Hacc[k] = (f32x4){0.f, 0.f, 0.f, 0.f};
        __syncthreads();
        for (int idx = F.tid; idx < 64 * SH / 16; idx += 512) ((LAS v4u*)Hs)[idx] = (v4u){0u, 0u, 0u, 0u};
        v4u rc[NP], rb[NP], rx[2]; unsigned short rdt0 = 0, rdt1 = 0;
#define SCAN_ISSUE(ck_) do { \
            _Pragma("unroll") for (int k = 0; k < NP; ++k) { const int idx = F.tid + 512 * k, i = idx / PPR, c = idx % PPR; const size_t row = scan_row(b, d, (ck_) * 128 + i); \
                if (RET) { const bf16* pr = F.P + row * LDP1 + h * 64 + c * 8; rc[k] = *(const v4u*)(pr + 768); rb[k] = *(const v4u*)(pr + 1280); } \
                else { const bf16* pr = F.XBC + row * 1536 + grp * 128 + c * 8; rc[k] = *(const v4u*)(pr + 1280); rb[k] = *(const v4u*)(pr + 1024); } } \
            _Pragma("unroll") for (int k = 0; k < 2; ++k) { const int idx = F.tid + 512 * k, i = idx >> 3, c = idx & 7; const size_t row = scan_row(b, d, (ck_) * 128 + i); \
                rx[k] = RET ? *(const v4u*)(F.P + row * LDP1 + 1792 + h * 128 + ph * 64 + c * 8) : *(const v4u*)(F.XBC + row * 1536 + h * 64 + c * 8); } \
            if (!RET) { rdt0 = F.P[(size_t)scan_row(b, d, (ck_) * 128 + lane) * LDP0 + 4096 + d * 16 + h]; rdt1 = F.P[(size_t)scan_row(b, d, (ck_) * 128 + 64 + lane) * LDP0 + 4096 + d * 16 + h]; } \
        } while (0)
        SCAN_ISSUE(0);
        for (int ck = 0; ck < 18; ++ck) {
            float atot;
            { float dt0 = 1.f, dt1 = 1.f, a0 = lgam, a1 = lgam;
              if (!RET) { const float x0 = bf2f(rdt0) + dtb, x1 = bf2f(rdt1) + dtb;
                  dt0 = x0 > 20.f ? x0 : log1pf(__expf(x0)); dt1 = x1 > 20.f ? x1 : log1pf(__expf(x1)); a0 = dt0 * Acoef; a1 = dt1 * Acoef; }
              float v0 = a0, v1 = a1;
#pragma unroll
              for (int o = 1; o < 64; o <<= 1) { const float n0 = __shfl_up(v0, o), n1 = __shfl_up(v1, o); if (lane >= o) { v0 += n0; v1 += n1; } }
              v1 += __shfl(v0, 63); atot = __shfl(v1, 63);
              acs[lane] = v0; acs[64 + lane] = v1; dts[lane] = dt0; dts[64 + lane] = dt1; }
            LDS_WAIT(); asm volatile("" ::: "memory");
#pragma unroll
            for (int k = 0; k < NP; ++k) { const int idx = F.tid + 512 * k, i = idx / PPR, c = idx % PPR;
                v4u kv = rb[k];
                if (RET) { kv.x = pk2(0.125f * bflo(kv.x), 0.125f * bfhi(kv.x)); kv.y = pk2(0.125f * bflo(kv.y), 0.125f * bfhi(kv.y)); kv.z = pk2(0.125f * bflo(kv.z), 0.125f * bfhi(kv.z)); kv.w = pk2(0.125f * bflo(kv.w), 0.125f * bfhi(kv.w)); }
                *(LAS v4u*)(Cs + i * SC + c * 16) = rc[k]; *(LAS v4u*)(Bs + i * SC + c * 16) = kv; }
#pragma unroll
            for (int k = 0; k < 2; ++k) { const int idx = F.tid + 512 * k, i = idx >> 3, c = idx & 7; const v4u xv = rx[k];
                const float dtj = dts[i], wj = dtj * __expf(atot - acs[i]);
                v4u a, bq; a.x = pk2(dtj * bflo(xv.x), dtj * bfhi(xv.x)); a.y = pk2(dtj * bflo(xv.y), dtj * bfhi(xv.y)); a.z = pk2(dtj * bflo(xv.z), dtj * bfhi(xv.z)); a.w = pk2(dtj * bflo(xv.w), dtj * bfhi(xv.w));
                bq.x = pk2(wj * bflo(xv.x), wj * bfhi(xv.x)); bq.y = pk2(wj * bflo(xv.y), wj * bfhi(xv.y)); bq.z = pk2(wj * bflo(xv.z), wj * bfhi(xv.z)); bq.w = pk2(wj * bflo(xv.w), wj * bfhi(xv.w));
                *(LAS v4u*)(Xs + i * SX + c * 16) = a; *(LAS v4u*)(Xw + i * SX + c * 16) = bq; }
            if (ck + 1 < 18) SCAN_ISSUE(ck + 1);
            __syncthreads();
            if (!RET || ck >= 2) {
                const float aci = acs[16 * w + l15];
                bf16x8 Cf[NKS];
#pragma unroll
                for (int s = 0; s < NKS; ++s) Cf[s] = *(const LAS bf16x8*)(Cs + (16 * w + l15) * SC + (32 * s + 8 * g) * 2);
                f32x4 Yacc[4];
                const float eaci = __expf(aci);
#pragma unroll
                for (int pt = 0; pt < 4; ++pt) { f32x4 acc = (f32x4){0.f, 0.f, 0.f, 0.f};
#pragma unroll
                    for (int s = 0; s < NKS; ++s) { const bf16x8 hf = *(const LAS bf16x8*)(Hs + (16 * pt + l15) * SH + (32 * s + 8 * g) * 2); acc = __builtin_amdgcn_mfma_f32_16x16x32_bf16(hf, Cf[s], acc, 0, 0, 0); }
                    Yacc[pt] = acc * eaci; }
#pragma unroll
                for (int sp = 0; sp < 4; ++sp) {
                    if (2 * sp <= w) {
                        v2u Lh[2];
#pragma unroll
                        for (int hh = 0; hh < 2; ++hh) { const int jt = 2 * sp + hh;
                            if (jt <= w) { f32x4 cb = (f32x4){0.f, 0.f, 0.f, 0.f};
#pragma unroll
                                for (int s = 0; s < NKS; ++s) { const bf16x8 bf = *(const LAS bf16x8*)(Bs + (16 * jt + l15) * SC + (32 * s + 8 * g) * 2); cb = __builtin_amdgcn_mfma_f32_16x16x32_bf16(bf, Cf[s], cb, 0, 0, 0); }
                                const f32x4 acj = *(const LAS f32x4*)(acs + 16 * jt + 4 * g);
                                float val[4];
#pragma unroll
                                for (int r = 0; r < 4; ++r) { const float arg = fminf(aci - acj[r], 0.f); val[r] = cb[r] * __expf(arg); if (jt == w && (4 * g + r) > l15) val[r] = 0.f; }
                                Lh[hh].x = pk2(val[0], val[1]); Lh[hh].y = pk2(val[2], val[3]); }
                            else { Lh[hh].x = 0u; Lh[hh].y = 0u; } }
                        v4u lw; lw.x = Lh[0].x; lw.y = Lh[0].y; lw.z = Lh[1].x; lw.w = Lh[1].y;
                        const bf16x8 Lf = __builtin_bit_cast(bf16x8, lw);
#pragma unroll
                        for (int pt = 0; pt < 4; ++pt) { const s16x4 x0 = lds_tr(Xs + (32 * sp + 4 * g + q4) * SX + (16 * pt + 4 * p4) * 2), x1 = lds_tr(Xs + (32 * sp + 16 + 4 * g + q4) * SX + (16 * pt + 4 * p4) * 2);
                            Yacc[pt] = __builtin_amdgcn_mfma_f32_16x16x32_bf16(cat8(x0, x1), Lf, Yacc[pt], 0, 0, 0); }
                    }
                }
                const size_t row = scan_row(b, d, ck * 128 + 16 * w + l15);
#pragma unroll
                for (int pt = 0; pt < 4; ++pt) { v2u o; o.x = pk2(Yacc[pt].x, Yacc[pt].y); o.y = pk2(Yacc[pt].z, Yacc[pt].w); NTS(o, (v2u*)(Y + row * 1024 + ycol + 16 * pt + 4 * g)); }
            }
            if (ck < 17) {
                const float eat = __expf(atot);
#pragma unroll
                for (int k = 0; k < NHT; ++k) Hacc[k] = Hacc[k] * eat;
#pragma unroll
                for (int s = 0; s < 4; ++s) {
                    const s16x4 b0 = lds_tr(Bs + (32 * s + 8 * g + q4) * SC + (16 * nt + 4 * p4) * 2), b1 = lds_tr(Bs + (32 * s + 8 * g + 4 + q4) * SC + (16 * nt + 4 * p4) * 2);
                    const bf16x8 Bf = cat8(b0, b1);
#pragma unroll
                    for (int k = 0; k < NHT; ++k) { const int pt = pt0 + k;
                        const s16x4 x0 = lds_tr(Xw + (32 * s + 8 * g + q4) * SX + (16 * pt + 4 * p4) * 2), x1 = lds_tr(Xw + (32 * s + 8 * g + 4 + q4) * SX + (16 * pt + 4 * p4) * 2);
                        Hacc[k] = __builtin_amdgcn_mfma_f32_16x16x32_bf16(cat8(x0, x1), Bf, Hacc[k], 0, 0, 0); }
                }
            }
            __syncthreads();
            if (ck < 17) {
#pragma unroll
                for (int k = 0; k < NHT; ++k)
#pragma unroll
                    for (int r = 0; r < 4; ++r) *(LAS bf16*)(Hs + (16 * (pt0 + k) + 4 * g + r) * SH + (16 * nt + l15) * 2) = (bf16)f2bf(Hacc[k][r]);
            }
        }
#undef SCAN_ISSUE
    }
}

template <int MODE>
__device__ __forceinline__ void attn16(const Frame& F, int u) {
    constexpr int PITCH = MODE == 2 ? LDP1 : LDP0;
    constexpr int SV = 144, VBUF = 4608;
    LAS unsigned char* vb = F.lds + F.wave * 10240;
    LAS float* btab = (LAS float*)(vb + 2 * VBUF);
    const int lane = F.lane, l15 = lane & 15, g = lane >> 4, q4 = l15 >> 2, p4 = lane & 3;
    int b, h, nloc; size_t qrow0, locbase, ctxbase; int kcol, vcol;
    int r = 0, r0 = 0, jq = 0, kstart = 0, t0 = 0, jb_lo = 0;
    if (MODE == 0) { jq = u & 3; h = (u >> 2) & 7; r = (u >> 5) & 31; b = u >> 10; r0 = min(max(r - 4, 0), 24); kstart = min(max(16 * jq - 8, 0), 32);
        qrow0 = (size_t)b * 2048 + r * 64 + 16 * jq; locbase = (size_t)b * 2048 + r0 * 64 + kstart; nloc = 8; kcol = 512 + h * 64; vcol = 1024 + h * 64; }
    else if (MODE == 1) { const int qt = u & 15; h = (u >> 4) & 7; b = u >> 7; qrow0 = (size_t)TL + b * 256 + qt * 16; locbase = 0; nloc = 0; kcol = 512 + h * 64; vcol = 1024 + h * 64; }
    else { const int hq = u & 3, qt = (u >> 2) & 127, kvh = (u >> 9) & 1; b = u >> 10; h = kvh * 4 + hq; t0 = qt * 16; qrow0 = (size_t)b * 2048 + t0;
        jb_lo = max(t0 - 128, 0) >> 5; const int jb_hi = min(t0 + 15 + 128, 2047) >> 5; nloc = jb_hi - jb_lo + 1; locbase = (size_t)b * 2048 + jb_lo * 32; kcol = 512 + kvh * 64; vcol = 640 + kvh * 64; }
    ctxbase = (size_t)TL + b * 256;
    const int nblk = nloc + 8, nit = (nblk + 1) >> 1;
    const bf16* P = F.P;
    if (MODE == 0) {
#pragma unroll
        for (int k = 0; k < 4; ++k) { const int i = lane + 64 * k, kb = i >> 5, c = i & 31; btab[i] = (c < 31) ? F.na_rpb[(h * 15 + (r0 - r + 7 + kb)) * 31 + c] : 0.f; } }
    bf16x8 qf[2];
#pragma unroll
    for (int s = 0; s < 2; ++s) { const v4u w = *(const v4u*)(P + (qrow0 + l15) * PITCH + h * 64 + 32 * s + 8 * g); v4u o;
        o.x = pk2(0.125f * bflo(w.x), 0.125f * bfhi(w.x)); o.y = pk2(0.125f * bflo(w.y), 0.125f * bfhi(w.y)); o.z = pk2(0.125f * bflo(w.z), 0.125f * bfhi(w.z)); o.w = pk2(0.125f * bflo(w.w), 0.125f * bfhi(w.w));
        qf[s] = __builtin_bit_cast(bf16x8, o); }
    int dc[2][4]; bool okc[2][4];
    if (MODE == 0) { const int qc = 16 * jq + l15, c0 = min(max(qc - 8, 0), 48);
#pragma unroll
        for (int t = 0; t < 2; ++t)
#pragma unroll
            for (int rr = 0; rr < 4; ++rr) { const int kc = kstart + 16 * t + 4 * g + rr; okc[t][rr] = (kc >= c0) && (kc < c0 + 16); dc[t][rr] = min(max(kc - qc + 15, 0), 30); } }
    f32x4 oacc[4];
#pragma unroll
    for (int dt = 0; dt < 4; ++dt) oacc[dt] = (f32x4){0.f, 0.f, 0.f, 0.f};
    float m = -INFINITY, lsum = 0.f;
    bf16x8 kf[2][2][2]; v4u vr[2][4];
#define ATT_LOAD(it_) do { _Pragma("unroll") for (int bb = 0; bb < 2; ++bb) { int kb_ = 2 * (it_) + bb; kb_ = kb_ < nblk ? kb_ : nblk - 1; \
        const size_t rb_ = (kb_ < nloc) ? locbase + (MODE == 0 ? kb_ * 64 : kb_ * 32) : ctxbase + (kb_ - nloc) * 32; \
        _Pragma("unroll") for (int t = 0; t < 2; ++t) _Pragma("unroll") for (int s = 0; s < 2; ++s) kf[bb][t][s] = *(const bf16x8*)(P + (rb_ + 16 * t + l15) * PITCH + kcol + 32 * s + 8 * g); \
        _Pragma("unroll") for (int k = 0; k < 4; ++k) { const int idx = lane + 64 * k; vr[bb][k] = *(const v4u*)(P + (rb_ + (idx >> 3)) * PITCH + vcol + (idx & 7) * 8); } } } while (0)
    ATT_LOAD(0);
    for (int it = 0; it < nit; ++it) {
        f32x4 st[2][2];
#pragma unroll
        for (int bb = 0; bb < 2; ++bb)
#pragma unroll
            for (int t = 0; t < 2; ++t) { f32x4 a = (f32x4){0.f, 0.f, 0.f, 0.f}; a = __builtin_amdgcn_mfma_f32_16x16x32_bf16(kf[bb][t][0], qf[0], a, 0, 0, 0); st[bb][t] = __builtin_amdgcn_mfma_f32_16x16x32_bf16(kf[bb][t][1], qf[1], a, 0, 0, 0); }
#pragma unroll
        for (int bb = 0; bb < 2; ++bb)
#pragma unroll
            for (int k = 0; k < 4; ++k) { const int idx = lane + 64 * k; *(LAS v4u*)(vb + bb * VBUF + (idx >> 3) * SV + (idx & 7) * 16) = vr[bb][k]; }
        asm volatile("" ::: "memory");
        if (it + 1 < nit) ATT_LOAD(it + 1);
#pragma unroll
        for (int bb = 0; bb < 2; ++bb) { const int kb = 2 * it + bb;
            if (kb >= nblk) {
#pragma unroll
                for (int t = 0; t < 2; ++t) st[bb][t] = (f32x4){-INFINITY, -INFINITY, -INFINITY, -INFINITY}; }
            else if (kb < nloc) {
                if (MODE == 0) {
#pragma unroll
                    for (int t = 0; t < 2; ++t)
#pragma unroll
                        for (int rr = 0; rr < 4; ++rr) st[bb][t][rr] = okc[t][rr] ? st[bb][t][rr] + btab[kb * 32 + dc[t][rr]] : -INFINITY; }
                if (MODE == 2) { const int tq = t0 + l15;
#pragma unroll
                    for (int t = 0; t < 2; ++t)
#pragma unroll
                        for (int rr = 0; rr < 4; ++rr) { const int dj = tq - ((jb_lo + kb) * 32 + 16 * t + 4 * g + rr); if (dj > 128 || dj < -128) st[bb][t][rr] = -INFINITY; } }
            } }
        float mx = -INFINITY;
#pragma unroll
        for (int bb = 0; bb < 2; ++bb)
#pragma unroll
            for (int t = 0; t < 2; ++t) mx = fmaxf(mx, fmaxf(fmaxf(st[bb][t][0], st[bb][t][1]), fmaxf(st[bb][t][2], st[bb][t][3])));
        mx = fmaxf(mx, __shfl_xor(mx, 16)); mx = fmaxf(mx, __shfl_xor(mx, 32));
        const float mn = fmaxf(m, mx), mu = (mn == -INFINITY) ? 0.f : mn;
        const float corr = __expf(m - mu);
        m = mn;
        float ps = 0.f; bf16x8 pf[2];
#pragma unroll
        for (int bb = 0; bb < 2; ++bb) { float p[8];
#pragma unroll
            for (int t = 0; t < 2; ++t)
#pragma unroll
                for (int rr = 0; rr < 4; ++rr) { p[4 * t + rr] = __expf(st[bb][t][rr] - mu); ps += p[4 * t + rr]; }
            v4u pw; pw.x = pk2(p[0], p[1]); pw.y = pk2(p[2], p[3]); pw.z = pk2(p[4], p[5]); pw.w = pk2(p[6], p[7]); pf[bb] = __builtin_bit_cast(bf16x8, pw); }
        lsum = lsum * corr + ps;
#pragma unroll
        for (int dt = 0; dt < 4; ++dt) { oacc[dt] = oacc[dt] * corr;
#pragma unroll
            for (int bb = 0; bb < 2; ++bb) {
                const s16x4 v0 = lds_tr(vb + bb * VBUF + (4 * g + q4) * SV + (16 * dt + 4 * p4) * 2), v1 = lds_tr(vb + bb * VBUF + (16 + 4 * g + q4) * SV + (16 * dt + 4 * p4) * 2);
                oacc[dt] = __builtin_amdgcn_mfma_f32_16x16x32_bf16(cat8(v0, v1), pf[bb], oacc[dt], 0, 0, 0); } }
        asm volatile("" ::: "memory");
    }
#undef ATT_LOAD
    lsum += __shfl_xor(lsum, 16); lsum += __shfl_xor(lsum, 32);
    if (MODE == 2) { const float sk = F.swa_sink[h]; const float mn = fmaxf(m, sk); const float corr = __expf(m - mn); lsum = lsum * corr + __expf(sk - mn);
#pragma unroll
        for (int dt = 0; dt < 4; ++dt) oacc[dt] = oacc[dt] * corr; }
    const float inv = 1.f / lsum;
    bf16* orow = (MODE == 2 ? F.YA1 + (qrow0 + l15) * LDYA1 : F.YA0 + (qrow0 + l15) * 1536) + h * 64;
#pragma unroll
    for (int dt = 0; dt < 4; ++dt) { v2u o; o.x = pk2(oacc[dt].x * inv, oacc[dt].y * inv); o.y = pk2(oacc[dt].z * inv, oacc[dt].w * inv); NTS(o, (v2u*)(orow + 16 * dt + 4 * g)); }
}
template <int MODE>
__device__ __forceinline__ void attn_wg(const Frame& F, int item) {
    constexpr int PITCH = MODE == 2 ? LDP1 : LDP0;
    constexpr int SK = 144, TILE = 64 * SK, NH = (MODE == 2) ? 1 : 2, BUFB = NH * 2 * TILE, NPC = NH * 2;
    LAS unsigned char* lds = F.lds;
    LAS float* btab = (LAS float*)(F.lds + 2 * BUFB) + F.wave * 256;
    const int w = F.wave, lane = F.lane, l15 = lane & 15, g = lane >> 4, q4 = l15 >> 2, p4 = lane & 3;
    int b, h, hsel = 0, nloc, kcol0, vcol0; size_t qrow0;
    int r = 0, r0 = 0, jq = 0, kstart = 0, t0w = 0, jb_lo = 0;
    if (MODE == 0) { const int hp = item & 3; r = (item >> 2) & 31; b = item >> 7; hsel = w >> 2; jq = w & 3; h = 2 * hp + hsel; r0 = min(max(r - 4, 0), 24); kstart = min(max(16 * jq - 8, 0), 32);
        qrow0 = (size_t)b * 2048 + r * 64 + 16 * jq; nloc = 8; kcol0 = 512 + 2 * hp * 64; vcol0 = 1024 + 2 * hp * 64; }
    else if (MODE == 1) { const int qg = item & 3, hp = (item >> 2) & 3; b = item >> 4; hsel = w >> 2; h = 2 * hp + hsel; qrow0 = (size_t)TL + b * 256 + qg * 64 + (w & 3) * 16; nloc = 0; kcol0 = 512 + 2 * hp * 64; vcol0 = 1024 + 2 * hp * 64; }
    else { const int qg = item & 63, kvh = (item >> 6) & 1; b = item >> 7; h = kvh * 4 + (w & 3); const int t0 = qg * 32; t0w = t0 + 16 * (w >> 2); qrow0 = (size_t)b * 2048 + t0w;
        jb_lo = max(t0 - 128, 0) >> 6; const int jb_hi = min(t0 + 31 + 128, 2047) >> 6; nloc = jb_hi - jb_lo + 1; kcol0 = 512 + kvh * 64; vcol0 = 640 + kvh * 64; }
    const int nst = nloc + 4;
    const bf16* P = F.P;
    __syncthreads();
    if (MODE == 0) {
#pragma unroll
        for (int k = 0; k < 4; ++k) { const int i = lane + 64 * k, kb = i >> 5, c = i & 31; btab[i] = (c < 31) ? F.na_rpb[(h * 15 + (r0 - r + 7 + kb)) * 31 + c] : 0.f; } }
    bf16x8 qf[2];
#pragma unroll
    for (int s = 0; s < 2; ++s) { const v4u wv = *(const v4u*)(P + (qrow0 + l15) * PITCH + h * 64 + 32 * s + 8 * g); v4u o;
        o.x = pk2(0.125f * bflo(wv.x), 0.125f * bfhi(wv.x)); o.y = pk2(0.125f * bflo(wv.y), 0.125f * bfhi(wv.y)); o.z = pk2(0.125f * bflo(wv.z), 0.125f * bfhi(wv.z)); o.w = pk2(0.125f * bflo(wv.w), 0.125f * bfhi(wv.w));
        qf[s] = __builtin_bit_cast(bf16x8, o); }
    int dc[2][4]; bool okc[2][4];
    if (MODE == 0) { const int qc = 16 * jq + l15, c0 = min(max(qc - 8, 0), 48);
#pragma unroll
        for (int t = 0; t < 2; ++t)
#pragma unroll
            for (int rr = 0; rr < 4; ++rr) { const int kc = kstart + 16 * t + 4 * g + rr; okc[t][rr] = (kc >= c0) && (kc < c0 + 16); dc[t][rr] = min(max(kc - qc + 15, 0), 30); } }
    f32x4 oacc[4];
#pragma unroll
    for (int dt = 0; dt < 4; ++dt) oacc[dt] = (f32x4){0.f, 0.f, 0.f, 0.f};
    float m = -INFINITY, lsum = 0.f;
    v4u pre[NPC], pre2[NPC];
#define AWG_LOAD(dst_, st_) do { const size_t rb_ = ((st_) < nloc) ? (size_t)b * 2048 + (MODE == 0 ? (r0 + (st_)) * 64 : (jb_lo + (st_)) * 64) : (size_t)TL + b * 256 + ((st_) - nloc) * 64; \
        _Pragma("unroll") for (int k = 0; k < NPC; ++k) { const int idx = F.tid + 512 * k, which = idx / (NH * 512), rem = idx % (NH * 512), hh = rem >> 9, key = (rem & 511) >> 3, c = rem & 7; \
            dst_[k] = *(const v4u*)(P + (rb_ + key) * PITCH + (which ? vcol0 : kcol0) + hh * 64 + c * 8); } } while (0)
#define AWG_STORE(buf_) do { _Pragma("unroll") for (int k = 0; k < NPC; ++k) { const int idx = F.tid + 512 * k, which = idx / (NH * 512), rem = idx % (NH * 512), hh = rem >> 9, key = (rem & 511) >> 3, c = rem & 7; \
            *(LAS v4u*)(lds + (buf_) * BUFB + (which * NH + hh) * TILE + key * SK + c * 16) = pre[k]; } } while (0)
    AWG_LOAD(pre, 0); AWG_STORE(0);
    if (nst > 1) AWG_LOAD(pre, 1);
    __syncthreads();
    for (int st = 0; st < nst; ++st) {
        if (st + 2 < nst) AWG_LOAD(pre2, st + 2);
        const LAS unsigned char* Kt = lds + (st & 1) * BUFB + hsel * TILE;
        const LAS unsigned char* Vt = lds + (st & 1) * BUFB + (NH + hsel) * TILE;
        const bool loc = st < nloc;
        const int nb = (MODE == 0 && loc) ? 1 : 2, koff0 = (MODE == 0 && loc) ? kstart : 0;
        f32x4 sc[2][2];
#pragma unroll
        for (int bb = 0; bb < 2; ++bb) {
            if (bb < nb) {
#pragma unroll
                for (int t = 0; t < 2; ++t) { const LAS unsigned char* kp = Kt + (koff0 + 32 * bb + 16 * t + l15) * SK + 8 * g * 2;
                    f32x4 a = (f32x4){0.f, 0.f, 0.f, 0.f}; a = __builtin_amdgcn_mfma_f32_16x16x32_bf16(*(const LAS bf16x8*)kp, qf[0], a, 0, 0, 0); sc[bb][t] = __builtin_amdgcn_mfma_f32_16x16x32_bf16(*(const LAS bf16x8*)(kp + 64), qf[1], a, 0, 0, 0); }
                if (loc) {
                    if (MODE == 0) {
#pragma unroll
                        for (int t = 0; t < 2; ++t)
#pragma unroll
                            for (int rr = 0; rr < 4; ++rr) sc[bb][t][rr] = okc[t][rr] ? sc[bb][t][rr] + btab[st * 32 + dc[t][rr]] : -INFINITY; }
                    if (MODE == 2) { const int tq = t0w + l15;
#pragma unroll
                        for (int t = 0; t < 2; ++t)
#pragma unroll
                            for (int rr = 0; rr < 4; ++rr) { const int dj = tq - ((jb_lo + st) * 64 + 32 * bb + 16 * t + 4 * g + rr); if (dj > 128 || dj < -128) sc[bb][t][rr] = -INFINITY; } }
                }
            } else {
#pragma unroll
                for (int t = 0; t < 2; ++t) sc[bb][t] = (f32x4){-INFINITY, -INFINITY, -INFINITY, -INFINITY}; }
        }
        float mx = -INFINITY;
#pragma unroll
        for (int bb = 0; bb < 2; ++bb)
#pragma unroll
            for (int t = 0; t < 2; ++t) mx = fmaxf(mx, fmaxf(fmaxf(sc[bb][t][0], sc[bb][t][1]), fmaxf(sc[bb][t][2], sc[bb][t][3])));
        mx = fmaxf(mx, __shfl_xor(mx, 16)); mx = fmaxf(mx, __shfl_xor(mx, 32));
        const float mn = fmaxf(m, mx), mu = (mn == -INFINITY) ? 0.f : mn;
        const float corr = __expf(m - mu);
        m = mn;
        float ps = 0.f; bf16x8 pf[2];
#pragma unroll
        for (int bb = 0; bb < 2; ++bb) { float p[8];
#pragma unroll
            for (int t = 0; t < 2; ++t)
#pragma unroll
                for (int rr = 0; rr < 4; ++rr) { p[4 * t + rr] = __expf(sc[bb][t][rr] - mu); ps += p[4 * t + rr]; }
            v4u pw; pw.x = pk2(p[0], p[1]); pw.y = pk2(p[2], p[3]); pw.z = pk2(p[4], p[5]); pw.w = pk2(p[6], p[7]); pf[bb] = __builtin_bit_cast(bf16x8, pw); }
        lsum = lsum * corr + ps;
#pragma unroll
        for (int dt = 0; dt < 4; ++dt) { oacc[dt] = oacc[dt] * corr;
#pragma unroll
            for (int bb = 0; bb < 2; ++bb) {
                if (bb < nb) { const LAS unsigned char* vp = Vt + (koff0 + 32 * bb) * SK + (16 * dt + 4 * p4) * 2;
                    const s16x4 v0 = lds_tr(vp + (4 * g + q4) * SK), v1 = lds_tr(vp + (16 + 4 * g + q4) * SK);
                    oacc[dt] = __builtin_amdgcn_mfma_f32_16x16x32_bf16(cat8(v0, v1), pf[bb], oacc[dt], 0, 0, 0); } } }
        if (st + 1 < nst) AWG_STORE((st + 1) & 1);
#pragma unroll
        for (int k = 0; k < NPC; ++k) pre[k] = pre2[k];
        __syncthreads();
    }
#undef AWG_LOAD
#undef AWG_STORE
    lsum += __shfl_xor(lsum, 16); lsum += __shfl_xor(lsum, 32);
    if (MODE == 2) { const float sk = F.swa_sink[h]; const float mn = fmaxf(m, sk); const float corr = __expf(m - mn); lsum = lsum * corr + __expf(sk - mn);
#pragma unroll
        for (int dt = 0; dt < 4; ++dt) oacc[dt] = oacc[dt] * corr; }
    const float inv = 1.f / lsum;
    bf16* orow = (MODE == 2 ? F.YA1 + (qrow0 + l15) * LDYA1 : F.YA0 + (qrow0 + l15) * 1536) + h * 64;
#pragma unroll
    for (int dt = 0; dt < 4; ++dt) { v2u o; o.x = pk2(oacc[dt].x * inv, oacc[dt].y * inv); o.y = pk2(oacc[dt].z * inv, oacc[dt].w * inv); NTS(o, (v2u*)(orow + 16 * dt + 4 * g)); }
}
__device__ __forceinline__ void ph_attn0_mfma(const Frame& F) {
    for (int it = F.vcu; it < 1024; it += F.G) attn_wg<0>(F, it);
    for (int it = F.vcu; it < 128; it += F.G) attn_wg<1>(F, it);
}
__device__ __forceinline__ void ph_swa_mfma(const Frame& F) {
    for (int it = F.vcu; it < 1024; it += F.G) attn_wg<2>(F, it);
}

__device__ __forceinline__ void ph_ssmout(const Frame& F) {
    const int gw = F.vcu * NWAVES + F.wave, NGW = F.G * NWAVES;
    f32x4 gn[2][2]; float dsk[2];
#pragma unroll
    for (int grp = 0; grp < 2; ++grp) { const int ch = grp * 512 + F.lane * 8; gn[grp][0] = *(const f32x4*)(F.ssm_norm_g + ch); gn[grp][1] = *(const f32x4*)(F.ssm_norm_g + ch + 4); dsk[grp] = F.ssm_d[ch >> 6]; }
    for (int row0 = gw * 2; row0 < TT; row0 += NGW * 2) {
        v4u yf[2][2], yb[2][2], xv[2][2], zv[2][2];
#pragma unroll
        for (int r = 0; r < 2; ++r)
#pragma unroll
            for (int grp = 0; grp < 2; ++grp) { const int ch = grp * 512 + F.lane * 8; const size_t row = row0 + r;
                yf[r][grp] = NTL((const v4u*)(F.YF0 + row * 1024 + ch)); yb[r][grp] = NTL((const v4u*)(F.YB0 + row * 1024 + ch));
                xv[r][grp] = NTL((const v4u*)(F.XBC + row * 1536 + ch)); zv[r][grp] = NTL((const v4u*)(F.P + row * LDP0 + 1536 + ch)); }
#pragma unroll
        for (int r = 0; r < 2; ++r)
#pragma unroll
            for (int grp = 0; grp < 2; ++grp) { const int ch = grp * 512 + F.lane * 8;
                const unsigned yfw[4] = {yf[r][grp].x, yf[r][grp].y, yf[r][grp].z, yf[r][grp].w}, ybw[4] = {yb[r][grp].x, yb[r][grp].y, yb[r][grp].z, yb[r][grp].w};
                const unsigned xw[4] = {xv[r][grp].x, xv[r][grp].y, xv[r][grp].z, xv[r][grp].w}, zw[4] = {zv[r][grp].x, zv[r][grp].y, zv[r][grp].z, zv[r][grp].w};
                float yz[8]; float ss = 0.f;
#pragma unroll
                for (int j = 0; j < 4; ++j) {
                    const float y0 = bflo(yfw[j]) + bflo(ybw[j]) + bflo(xw[j]) * dsk[grp], y1 = bfhi(yfw[j]) + bfhi(ybw[j]) + bfhi(xw[j]) * dsk[grp];
                    yz[2 * j] = y0 * silu_f(bflo(zw[j])); yz[2 * j + 1] = y1 * silu_f(bfhi(zw[j]));
                    ss += yz[2 * j] * yz[2 * j] + yz[2 * j + 1] * yz[2 * j + 1]; }
                const float rstd = 1.0f / sqrtf(wave_sum(ss) * (1.f / 512.f) + EPS);
                const f32x4 g0 = gn[grp][0], g1 = gn[grp][1];
                v4u o; o.x = pk2(yz[0] * rstd * g0.x, yz[1] * rstd * g0.y); o.y = pk2(yz[2] * rstd * g0.z, yz[3] * rstd * g0.w);
                o.z = pk2(yz[4] * rstd * g1.x, yz[5] * rstd * g1.y); o.w = pk2(yz[6] * rstd * g1.z, yz[7] * rstd * g1.w);
                NTS(o, (v4u*)(F.YA0 + (size_t)(row0 + r) * 1536 + 512 + ch)); }
    }
}

__device__ __forceinline__ void ph_retout(const Frame& F) {
    const int gw = F.vcu * NWAVES + F.wave, NGW = F.G * NWAVES;
    f32x4 gg[2][2], gb[2][2];
#pragma unroll
    for (int half = 0; half < 2; ++half) { const int ch = half * 512 + F.lane * 8; gg[half][0] = *(const f32x4*)(F.ret_gn_g + ch); gg[half][1] = *(const f32x4*)(F.ret_gn_g + ch + 4); gb[half][0] = *(const f32x4*)(F.ret_gn_b + ch); gb[half][1] = *(const f32x4*)(F.ret_gn_b + ch + 4); }
    for (int row0 = gw * 2; row0 < TL; row0 += NGW * 2) {
        v4u yf[2][2], yb[2][2], gv[2][2];
#pragma unroll
        for (int r = 0; r < 2; ++r)
#pragma unroll
            for (int half = 0; half < 2; ++half) { const int ch = half * 512 + F.lane * 8; const size_t row = row0 + r;
                yf[r][half] = NTL((const v4u*)(F.YF1 + row * 1024 + ch)); yb[r][half] = NTL((const v4u*)(F.YB1 + row * 1024 + ch)); gv[r][half] = NTL((const v4u*)(F.P + row * LDP1 + 2816 + ch)); }
#pragma unroll
        for (int r = 0; r < 2; ++r)
#pragma unroll
            for (int half = 0; half < 2; ++half) { const int ch = half * 512 + F.lane * 8;
                const unsigned yfw[4] = {yf[r][half].x, yf[r][half].y, yf[r][half].z, yf[r][half].w}, ybw[4] = {yb[r][half].x, yb[r][half].y, yb[r][half].z, yb[r][half].w}, gw4[4] = {gv[r][half].x, gv[r][half].y, gv[r][half].z, gv[r][half].w};
                float y[8]; float s = 0.f;
#pragma unroll
                for (int j = 0; j < 4; ++j) { y[2 * j] = bflo(yfw[j]) + bflo(ybw[j]); y[2 * j + 1] = bfhi(yfw[j]) + bfhi(ybw[j]); s += y[2 * j] + y[2 * j + 1]; }
                s += __shfl_xor(s, 1); s += __shfl_xor(s, 2); s += __shfl_xor(s, 4); s += __shfl_xor(s, 8);
                const float mu = s * (1.f / 128.f); float q = 0.f;
#pragma unroll
                for (int j = 0; j < 8; ++j) { y[j] -= mu; q += y[j] * y[j]; }
                q += __shfl_xor(q, 1); q += __shfl_xor(q, 2); q += __shfl_xor(q, 4); q += __shfl_xor(q, 8);
                const float rstd = 1.0f / sqrtf(q * (1.f / 128.f) + EPS);
                float ov[8];
#pragma unroll
                for (int j = 0; j < 8; ++j) { const float gt = (j & 1) ? bfhi(gw4[j >> 1]) : bflo(gw4[j >> 1]); ov[j] = silu_f(gt) * (y[j] * rstd * gg[half][j >> 2][j & 3] + gb[half][j >> 2][j & 3]); }
                v4u o; o.x = pk2(ov[0], ov[1]); o.y = pk2(ov[2], ov[3]); o.z = pk2(ov[4], ov[5]); o.w = pk2(ov[6], ov[7]);
                NTS(o, (v4u*)(F.YA1 + (size_t)(row0 + r) * LDYA1 + 512 + ch)); }
    }
}

#define SEL8(arr, idx) (((idx) == 0 ? arr[0] : 0) + ((idx) == 1 ? arr[1] : 0) + ((idx) == 2 ? arr[2] : 0) + ((idx) == 3 ? arr[3] : 0) + ((idx) == 4 ? arr[4] : 0) + ((idx) == 5 ? arr[5] : 0) + ((idx) == 6 ? arr[6] : 0) + ((idx) == 7 ? arr[7] : 0))
__device__ __forceinline__ void ph_norm3_route(const Frame& F) {
    LAS float* rt = (LAS float*)F.lds;
    for (int i = F.tid; i < 1024 * 8 / 4; i += 512) ((LAS f32x4*)rt)[i] = ((const f32x4*)F.moe_router)[i];
    __syncthreads();
    const int gw = F.vcu * NWAVES + F.wave, NGW = F.G * NWAVES;
    const float* g = F.norm_ffn_g + 1024;
    for (int ch = gw; ch < 2048; ch += NGW) {
        int cnt[8];
#pragma unroll
        for (int e = 0; e < 8; ++e) cnt[e] = 0;
        const int bidx = (ch * 8) >> 11;
        const float* mod = F.MOD + (size_t)(9 + bidx) * 6144 + 3 * 1024;
        f32x4 gg[4], sh[4];
#pragma unroll
        for (int j = 0; j < 4; ++j) { gg[j] = ((const f32x4*)g)[F.lane + 64 * j] * (((const f32x4*)(mod + 1024))[F.lane + 64 * j] + 1.0f); sh[j] = ((const f32x4*)mod)[F.lane + 64 * j]; }
        for (int i2 = 0; i2 < 8; i2 += 2) {
            f32x4 v[2][4]; float ss[2];
#pragma unroll
            for (int r = 0; r < 2; ++r) { const v2u* xr = (const v2u*)(F.X + (size_t)(ch * 8 + i2 + r) * 1024) + F.lane;
#pragma unroll
                for (int j = 0; j < 4; ++j) v[r][j] = bf4(NTL(xr + 64 * j)); }
#pragma unroll
            for (int r = 0; r < 2; ++r) { float s = 0.f;
#pragma unroll
                for (int j = 0; j < 4; ++j) s += (v[r][j].x * v[r][j].x + v[r][j].y * v[r][j].y) + (v[r][j].z * v[r][j].z + v[r][j].w * v[r][j].w);
                ss[r] = s; }
#pragma unroll
            for (int o = 1; o < 64; o <<= 1) { ss[0] += __shfl_xor(ss[0], o); ss[1] += __shfl_xor(ss[1], o); }
#pragma unroll
            for (int r = 0; r < 2; ++r) { const float rstd = 1.0f / sqrtf(ss[r] * (1.f / 1024.f) + EPS);
                unsigned long long* o8 = (unsigned long long*)(F.H + (size_t)(ch * 8 + i2 + r) * 1024) + F.lane;
#pragma unroll
                for (int j = 0; j < 4; ++j) { v[r][j] = (v[r][j] * rstd) * gg[j] + sh[j]; NTS((unsigned long long)pk2(v[r][j].x, v[r][j].y) | ((unsigned long long)pk2(v[r][j].z, v[r][j].w) << 32), o8 + 64 * j); } }
#pragma unroll
            for (int r = 0; r < 2; ++r) { const int row = ch * 8 + i2 + r;
                float lg[8];
#pragma unroll
                for (int e = 0; e < 8; ++e) lg[e] = 0.f;
#pragma unroll
                for (int j = 0; j < 4; ++j)
#pragma unroll
                    for (int q = 0; q < 4; ++q) { const int k = 4 * (F.lane + 64 * j) + q; const f32x4 r0 = ((const LAS f32x4*)(rt + k * 8))[0], r1 = ((const LAS f32x4*)(rt + k * 8))[1];
                        const float hv = v[r][j][q];
                        lg[0] += hv * r0.x; lg[1] += hv * r0.y; lg[2] += hv * r0.z; lg[3] += hv * r0.w; lg[4] += hv * r1.x; lg[5] += hv * r1.y; lg[6] += hv * r1.z; lg[7] += hv * r1.w; }
#pragma unroll
                for (int o = 1; o < 64; o <<= 1) {
#pragma unroll
                    for (int e = 0; e < 8; ++e) lg[e] += __shfl_xor(lg[e], o); }
                int i0 = 0; float v0 = lg[0];
#pragma unroll
                for (int e = 1; e < 8; ++e) if (lg[e] > v0) { v0 = lg[e]; i0 = e; }
                int i1 = -1; float v1 = -3.0e38f;
#pragma unroll
                for (int e = 0; e < 8; ++e) if (e != i0 && lg[e] > v1) { v1 = lg[e]; i1 = e; }
                const float e1 = __expf(v1 - v0), g0 = 1.f / (1.f + e1), g1 = e1 / (1.f + e1);
                const int r0 = SEL8(cnt, i0);
#pragma unroll
                for (int e = 0; e < 8; ++e) cnt[e] += (e == i0) ? 1 : 0;
                const int r1 = SEL8(cnt, i1);
#pragma unroll
                for (int e = 0; e < 8; ++e) cnt[e] += (e == i1) ? 1 : 0;
                if (F.lane == 0) { F.TOPK[row] = i0 | (i1 << 4) | (r0 << 8) | (r1 << 16); F.GATE[row * 2] = g0; F.GATE[row * 2 + 1] = g1; } }
        }
        if (F.lane < 8) F.CNT[ch * 8 + F.lane] = SEL8(cnt, F.lane);
    }
}

__device__ __forceinline__ void ph_route2(const Frame& F) {
    LAS int* coff = (LAS int*)F.lds;
    LAS int* wtot = coff + 2048 * 8;
    LAS int* meta = wtot + 64;
    const int t = F.tid;
    int loc[4][8], tot[8], incl[8];
#pragma unroll
    for (int i = 0; i < 4; ++i) { const int4 a = ((const int4*)(F.CNT + (4 * t + i) * 8))[0], b = ((const int4*)(F.CNT + (4 * t + i) * 8))[1];
        loc[i][0] = a.x; loc[i][1] = a.y; loc[i][2] = a.z; loc[i][3] = a.w; loc[i][4] = b.x; loc[i][5] = b.y; loc[i][6] = b.z; loc[i][7] = b.w; }
#pragma unroll
    for (int e = 0; e < 8; ++e) { int run = 0;
#pragma unroll
        for (int i = 0; i < 4; ++i) { const int tmp = loc[i][e]; loc[i][e] = run; run += tmp; }
        tot[e] = run; int v = run;
#pragma unroll
        for (int o = 1; o < 64; o <<= 1) { const int n = __shfl_up(v, o); if (F.lane >= o) v += n; }
        incl[e] = v;
        if (F.lane == 63) wtot[F.wave * 8 + e] = v; }
    __syncthreads();
#pragma unroll
    for (int e = 0; e < 8; ++e) { int woff = 0;
        for (int w = 0; w < F.wave; ++w) woff += wtot[w * 8 + e];
        const int excl = woff + incl[e] - tot[e];
#pragma unroll
        for (int i = 0; i < 4; ++i) coff[(4 * t + i) * 8 + e] = excl + loc[i][e]; }
    if (t < 8) { int s = 0; for (int w = 0; w < 8; ++w) s += wtot[w * 8 + t]; meta[8 + t] = s; }
    __syncthreads();
    if (t == 0) { int base = 0; for (int e = 0; e < 8; ++e) { meta[e] = base; base += (meta[8 + e] + 255) & ~255; } meta[16] = base >> 8; }
    __syncthreads();
    if (F.vcu == 0 && t < 144) { int e = 0;
#pragma unroll
        for (int q = 1; q < 8; ++q) if (t * 256 >= meta[q]) e = q;
        F.TILEE[t] = e; if (t == 0) F.MMETA[0] = meta[16]; }
    const int gw = F.vcu * NWAVES + F.wave, NGW = F.G * NWAVES;
    for (int ch = gw; ch < 2048; ch += NGW) {
        for (int i = 0; i < 8; ++i) {
            const int row = ch * 8 + i, tk = F.TOPK[row], e0 = tk & 15, e1 = (tk >> 4) & 15, r0 = (tk >> 8) & 255, r1 = (tk >> 16) & 255;
            const int s0 = meta[e0] + coff[ch * 8 + e0] + r0, s1 = meta[e1] + coff[ch * 8 + e1] + r1;
            const v4u a = NTL((const v4u*)(F.H + (size_t)row * 1024) + F.lane), b = NTL((const v4u*)(F.H + (size_t)row * 1024) + F.lane + 64);
            NTS(a, (v4u*)(F.HP + (size_t)s0 * LDHP) + F.lane); NTS(b, (v4u*)(F.HP + (size_t)s0 * LDHP) + F.lane + 64);
            NTS(a, (v4u*)(F.HP + (size_t)s1 * LDHP) + F.lane); NTS(b, (v4u*)(F.HP + (size_t)s1 * LDHP) + F.lane + 64);
            if (F.lane == 0) { F.SLOT[row * 2] = s0; F.SLOT[row * 2 + 1] = s1; }
        }
    }
    for (int it = gw; it < 2048; it += NGW) { const int e = it >> 8, r = it & 255, row = meta[e] + meta[8 + e] + r;
        if (row < meta[e] + ((meta[8 + e] + 255) & ~255)) { ((v4u*)(F.HP + (size_t)row * LDHP))[F.lane] = (v4u){0u, 0u, 0u, 0u}; ((v4u*)(F.HP + (size_t)row * LDHP))[F.lane + 64] = (v4u){0u, 0u, 0u, 0u}; } }
}

struct MoeOrder {
    const int* tile_e; int t0, t1, nN, G, c;
    __device__ __forceinline__ bool next(int i, pg8::Unit& u) const {
        const int ntiles = t1 - t0; u.k0 = 0; u.nk = 0;
        if ((G & 7) != 0) { const int L = i * G + c; if (L >= ntiles * nN) return false; const int pm = t0 + L / nN; u.pm = pm; u.pn = tile_e[pm] * nN + (L % nN); return true; }
        const int x = c & 7, wpx = G >> 3, s = i * wpx + (c >> 3), nblk = ntiles >> 3, rem = ntiles & 7;
        const int nbx = (nblk > x) ? ((nblk - x + 7) >> 3) : 0, full = nbx * 8 * nN;
        int pm, pl;
        if (s < full) { const int blk = x + 8 * (s / (8 * nN)), w = s % (8 * nN); pm = t0 + 8 * blk + (w & 7); pl = w >> 3; }
        else { const int q = (s - full) * 8 + x; if (rem == 0 || q >= rem * nN) return false; pm = t0 + 8 * nblk + (q % rem); pl = q / rem; }
        u.pm = pm; u.pn = tile_e[pm] * nN + pl; return true; }
    __device__ __forceinline__ void a_ready(const pg8::Unit&) const {}
    __device__ __forceinline__ void done(const pg8::Unit&) const {}
};
struct Moe2BOrder {
    const int* tile_e; int MT, G, c;
    __device__ __forceinline__ bool next(int i, pg8::Unit& u) const {
        const int t1 = MT < 128 ? MT : 128, nfull = (t1 - 64) * 4, L = i * G + c;
        if (L < nfull) { const int pm = 64 + (L >> 2); u.pm = pm; u.pn = tile_e[pm] * 4 + (L & 3); u.k0 = 0; u.nk = 0; return true; }
        const int nb = (MT - t1) * 4; if (nb <= 0) return false;
        const int r0 = (nfull + G - 1) / G; if (i < r0) return false;
        const int NS = 7, q = (i - r0) * G + c; if (q >= nb * NS) return false;
        const int bu = q % nb, sl = q / nb, pm = t1 + (bu >> 2); u.pm = pm; u.pn = tile_e[pm] * 4 + (bu & 3); u.k0 = sl * (DFE / NS); u.nk = DFE / NS / 64; return true; }
    __device__ __forceinline__ void a_ready(const pg8::Unit&) const {}
    __device__ __forceinline__ void done(const pg8::Unit&) const {}
};
struct EpiSwigluMoe {
    bf16* O; int row0;
    __device__ __forceinline__ void operator()(int row, int col, f32x4 lo, f32x4 hi, int part = 0) const {
        v2u w; w.x = pk2(silu_f(lo.x) * hi.x, silu_f(lo.y) * hi.y); w.y = pk2(silu_f(lo.z) * hi.z, silu_f(lo.w) * hi.w);
        *(v2u*)(O + (size_t)(row - row0) * DFE + ((col % 7168) >> 1)) = w; }
};
struct EpiStoreMoe {
    bf16* O; bf16* T;
    __device__ __forceinline__ void operator()(int row, int col, f32x4 lo, f32x4 hi, int part = 0) const {
        if (part) { bf16* o = T + ((size_t)((part - 1) / 512) * 2048 + (row - 128 * 256)) * 1024 + (col & 1023); v4u q; q.x = pk2(lo.x, lo.y); q.y = pk2(lo.z, lo.w); q.z = pk2(hi.x, hi.y); q.w = pk2(hi.z, hi.w); *(v4u*)o = q; return; }
        v4u w; w.x = pk2(lo.x, lo.y); w.y = pk2(lo.z, lo.w); w.z = pk2(hi.x, hi.y); w.w = pk2(hi.z, hi.w);
        *(v4u*)(O + (size_t)row * LDHP + (col & 1023)) = w; }
};
template <class F8>
__device__ __forceinline__ void gemm_moe(const Frame& F, const bf16* A, const bf16* Bt, int K, int nN, int t0, int t1, const F8& f, int ld = 0) {
    pg8::Gemm g{A, Bt, 0, 0, K, ld}; MoeOrder S{F.TILEE, t0, t1, nN, F.G, (int)blockIdx.x};
    EpiAdapt<F8> E{f};
    pg8::gemm_phase<EpiAdapt<F8>, MoeOrder, true, true>(F.lds, g, S, E);
}

__device__ __forceinline__ void ph_final(const Frame& F) {
    const int gw = F.vcu * NWAVES + F.wave, NGW = F.G * NWAVES;
    for (int row0 = gw * 2; row0 < TL; row0 += NGW * 2) {
        int sl[2][2]; float gt[2][2];
#pragma unroll
        for (int r = 0; r < 2; ++r) { sl[r][0] = F.SLOT[(row0 + r) * 2]; sl[r][1] = F.SLOT[(row0 + r) * 2 + 1]; gt[r][0] = F.GATE[(row0 + r) * 2]; gt[r][1] = F.GATE[(row0 + r) * 2 + 1]; }
        const float* g2 = F.MOD + (size_t)(9 + (row0 >> 11)) * 6144 + 5 * 1024;
        f32x4 xv[2][4], ya[2][2][4];
#pragma unroll
        for (int r = 0; r < 2; ++r) {
#pragma unroll
            for (int j = 0; j < 4; ++j) xv[r][j] = bf4(NTL((const v2u*)(F.X + (size_t)(row0 + r) * 1024) + F.lane + 64 * j));
#pragma unroll
            for (int k = 0; k < 2; ++k) { const int s = sl[r][k];
                if (s >= 32768) { const v2u* tp = (const v2u*)(F.Y2T + (size_t)(s - 32768) * 1024) + F.lane;
#pragma unroll
                    for (int j = 0; j < 4; ++j) { f32x4 a = bf4(tp[64 * j]);
#pragma unroll
                        for (int q = 1; q < 7; ++q) a += bf4(tp[64 * j + (size_t)q * 2048 * 256]);
                        ya[r][k][j] = a; } }
                else { const v2u* yp = (const v2u*)(F.HP + (size_t)s * LDHP) + F.lane;
#pragma unroll
                    for (int j = 0; j < 4; ++j) { const v2u a = NTL(yp + 64 * j); ya[r][k][j] = (f32x4){bflo(a.x), bfhi(a.x), bflo(a.y), bfhi(a.y)}; } } } }
        float ss[2];
#pragma unroll
        for (int r = 0; r < 2; ++r) { float s = 0.f;
#pragma unroll
            for (int j = 0; j < 4; ++j) { const f32x4 gg = ((const f32x4*)g2)[F.lane + 64 * j]; const f32x4 y = ya[r][0][j] * gt[r][0] + ya[r][1][j] * gt[r][1];
                xv[r][j] = xv[r][j] + gg * y; s += (xv[r][j].x * xv[r][j].x + xv[r][j].y * xv[r][j].y) + (xv[r][j].z * xv[r][j].z + xv[r][j].w * xv[r][j].w); }
            ss[r] = s; }
#pragma unroll
        for (int o = 1; o < 64; o <<= 1) { ss[0] += __shfl_xor(ss[0], o); ss[1] += __shfl_xor(ss[1], o); }
#pragma unroll
        for (int r = 0; r < 2; ++r) { const float rstd = 1.0f / sqrtf(ss[r] * (1.f / 1024.f) + EPS);
            f32x4* o = (f32x4*)(F.out + (size_t)(row0 + r) * 1024) + F.lane;
#pragma unroll
            for (int j = 0; j < 4; ++j) __builtin_nontemporal_store(xv[r][j] * rstd * ((const f32x4*)F.final_g)[F.lane + 64 * j], o + 64 * j); }
    }
}

enum { PH_CVT = 0, PH_NORM0, PH_IN0, PH_MIX0, PH_SCAN0, PH_SSMOUT, PH_OUT0, PH_NORM1, PH_F13, PH_F2, PH_NORM2, PH_IN1, PH_MIX1, PH_RETOUT, PH_OUT1, PH_NORM3, PH_ROUTE2, PH_MG1A, PH_MG2A, PH_MG1B, PH_MG2B, PH_FINAL, NPHASES };

struct Args { const float* in[31]; float* out; unsigned char* ws; int ph_lo, ph_hi; };

__global__ void __launch_bounds__(NWAVES * 64, 2) fwd(Args args) {
    extern __shared__ __attribute__((aligned(16))) unsigned char lds_raw[];
    Frame F;
    F.lds = (LAS unsigned char*)lds_raw;
    F.tid = threadIdx.x; F.lane = F.tid & 63; F.wave = __builtin_amdgcn_readfirstlane(F.tid >> 6);
    F.G = gridDim.x; { const int bx = blockIdx.x; F.vcu = (F.G % 8 == 0) ? (bx % 8) * (F.G / 8) + bx / 8 : bx; }
    F.x = args.in[0]; F.c = args.in[1]; F.ctx = args.in[2]; F.c_ctx = args.in[3]; F.ada_w = args.in[4]; F.ada_b = args.in[5]; F.norm_attn_g = args.in[6]; F.norm_ffn_g = args.in[7];
    F.ev_w_in = args.in[8]; F.ev_w_out = args.in[9]; F.na_rpb = args.in[10]; F.conv_w = args.in[11]; F.conv_b = args.in[12]; F.dt_bias = args.in[13]; F.a_log = args.in[14]; F.ssm_d = args.in[15];
    F.ssm_norm_g = args.in[16]; F.ffn_w1 = args.in[17]; F.ffn_w3 = args.in[18]; F.ffn_w2 = args.in[19]; F.od_w_in = args.in[20]; F.od_w_out = args.in[21]; F.swa_sink = args.in[22];
    F.ret_log_decay = args.in[23]; F.ret_gn_g = args.in[24]; F.ret_gn_b = args.in[25]; F.moe_router = args.in[26]; F.moe_w1 = args.in[27]; F.moe_w3 = args.in[28]; F.moe_w2 = args.in[29]; F.final_g = args.in[30];
    F.out = args.out;
    unsigned char* ws = args.ws;
    F.MOD = (float*)(ws + WS_MOD); F.GATE = (float*)(ws + WS_GATE); F.ROPE = (float*)(ws + WS_ROPE); F.X = (bf16*)(ws + WS_X);
    F.WIN0 = (bf16*)(ws + WS_WIN0); F.WOUT0 = (bf16*)(ws + WS_WOUT0); F.WF13 = (bf16*)(ws + WS_WF13); F.WF2 = (bf16*)(ws + WS_WF2); F.WIN1 = (bf16*)(ws + WS_WIN1); F.WOUT1 = (bf16*)(ws + WS_WOUT1);
    F.WM13 = (bf16*)(ws + WS_WM13); F.WM2 = (bf16*)(ws + WS_WM2); F.H = (bf16*)(ws + WS_H); F.P = (bf16*)(ws + WS_P); F.YA0 = (bf16*)(ws + WS_YA0); F.YA1 = (bf16*)(ws + WS_YA1); F.XBC = (bf16*)(ws + WS_XBC);
    F.YF0 = (bf16*)(ws + WS_YF0); F.YB0 = (bf16*)(ws + WS_YB0); F.YF1 = (bf16*)(ws + WS_YF1); F.YB1 = (bf16*)(ws + WS_YB1); F.Gh = (bf16*)(ws + WS_G); F.MG = (bf16*)(ws + WS_MG); F.HP = (bf16*)(ws + WS_HP);
    F.ctl = (unsigned*)(ws + WS_CTL); F.Y2T = (bf16*)(ws + WS_Y2T); F.PART = (float*)(ws + WS_PART);
    F.TOPK = (int*)(ws + WS_TOPK); F.SLOT = (int*)(ws + WS_SLOT); F.CNT = (int*)(ws + WS_CNT); F.TILEE = (int*)(ws + WS_TILEE); F.MMETA = (int*)(ws + WS_MMETA);

    for (int u = F.tid; u < (LDS_BYTES - LDSCTL_OFF) / 4; u += NWAVES * 64) ((LAS unsigned*)(F.lds + LDSCTL_OFF))[u] = 0u;
    __syncthreads();
    volatile LAS unsigned* MISC = (volatile LAS unsigned*)(F.lds + MISC_OFF);
    XcdBarrier bar; bar.bar = (unsigned*)(ws + WS_CTL) + CW_BAR; bar.x = 0; bar.st = nullptr;
    const int lo = args.ph_lo, hi = args.ph_hi;
    if (hi - lo > 1) bar = xcd_barrier_post((unsigned*)(ws + WS_CTL) + CW_BAR, MISC + 8);
#ifndef PROBE_PH
#define PROBE_PH -1
#endif
#ifndef PROBE_TAG
#define PROBE_TAG 0
#endif
#define TREP(tag) for (int _tr = 0; _tr < ((tag) == PROBE_TAG ? 2 : 1); ++_tr)
#define REPS(k) for (int _rep = 0; _rep < ((k) == PROBE_PH ? 2 : 1); ++_rep)
#define IN(k) (lo <= (k) && (k) < hi)
#define SEAM(k) do { if (IN(k) && IN((k) + 1)) xcd_barrier(bar); else __syncthreads(); } while (0)

    if (IN(PH_CVT)) { REPS(PH_CVT) { ph_cvt(F); __syncthreads(); } SEAM(PH_CVT); }
    if (IN(PH_NORM0)) { REPS(PH_NORM0) ph_norm<0, false>(F, 0, 0, TT); SEAM(PH_NORM0); }
    if (IN(PH_IN0)) { REPS(PH_IN0) { EpiStore E{F.P, LDP0}; gemm_pg8(F, F.H, F.WIN0, TT, LDP0, 1024, E); } TREP(8) { if (_tr == 1) { EpiNull E0; gemm_pg8(F, F.H, F.WIN0, TT, LDP0, 512, E0, 1024); } } TREP(11) { if (_tr == 1) { EpiNull E0; gemm_pg8(F, F.H, F.WIN0, TT, LDP0, 1024, E0, 1024); } } if (short_round(F, 72 * 17)) cvt_pull(F, QB_IN0, false); SEAM(PH_IN0); }
    if (IN(PH_MIX0)) { REPS(PH_MIX0) { TREP(1) ph_attn0_mfma(F); TREP(2) ph_conv(F); } SEAM(PH_MIX0); }
    if (IN(PH_SCAN0)) { REPS(PH_SCAN0) chunk_scan<128, false>(F); SEAM(PH_SCAN0); }
    if (IN(PH_SSMOUT)) { REPS(PH_SSMOUT) ph_ssmout(F); SEAM(PH_SSMOUT); }
    if (IN(PH_OUT0)) REPS(PH_OUT0) { EpiResidTail<EpiResidT<true>> E{EpiResidT<true>{F.x, F.ctx, F.X, F.MOD + 2 * 1024, nullptr, 0, 0}, F.PART, 256}; gemm_tail(F, F.YA0, F.WOUT0, 1536, E); if (short_round(F, 256 + 192)) cvt_pull(F, QB_OUT0, true); SEAM(PH_OUT0); }
    if (IN(PH_NORM1)) { ph_norm<1, false, 1>(F, 0, 1, TT); SEAM(PH_NORM1); }
    if (IN(PH_F13)) { REPS(PH_F13) { EpiSwiglu E{F.Gh, DFF}; gemm_pg8(F, F.H, F.WF13, TT, 2 * DFF, 1024, E); } cvt_tail_f13(F); SEAM(PH_F13); }
    if (IN(PH_F2)) { EpiResidTail<EpiResid> E{EpiResid{nullptr, nullptr, F.X, F.MOD + 5 * 1024, nullptr, 0, 0}, F.PART, 512}; gemm_tail(F, F.Gh, F.WF2, DFF, E); TREP(9) { if (_tr == 1) { EpiNull E0; gemm_tail(F, F.Gh, F.WF2, DFF, E0); } } if (short_round(F, 256 + 192)) cvt_pull(F, QB_F2, true); SEAM(PH_F2); }
    if (IN(PH_NORM2)) { ph_norm<1, false, 2>(F, 1, 0, TT); SEAM(PH_NORM2); }
    if (IN(PH_IN1)) { LAS float* rtab = (LAS float*)(F.lds + RING_BYTES + 1024);
        for (int i = F.tid; i < 96 * 16; i += 512) { const int pos = i >> 4, f = i & 15; const float* sp = F.ROPE + ((size_t)(pos < 32 ? pos * 64 : (pos - 32)) * 32 + (pos < 32 ? f : 16 + f)) * 2; rtab[2 * i] = sp[0]; rtab[2 * i + 1] = sp[1]; }
        __syncthreads();
        REPS(PH_IN1) { pg8::Gemm g{F.H, F.WIN1, TT, LDP1, 1024, 0}; In1Order S{F.G, (int)blockIdx.x}; EpiAdapt<EpiRope> E{EpiRope{F.P, rtab}};
            pg8::gemm_phase<EpiAdapt<EpiRope>, In1Order, true, true>(F.lds, g, S, E); } SEAM(PH_IN1); }
    if (IN(PH_MIX1)) { REPS(PH_MIX1) { TREP(4) { chunk_scan<64, true>(F); __syncthreads(); } TREP(5) { ph_swa_mfma(F); __syncthreads(); } } SEAM(PH_MIX1); }
    if (IN(PH_RETOUT)) { REPS(PH_RETOUT) { ph_retout(F); } SEAM(PH_RETOUT); }
    if (IN(PH_OUT1)) { EpiResid E{nullptr, nullptr, F.X, F.MOD + 9 * 6144 + 2 * 1024, nullptr, 0, 0}; gemm_pg8(F, F.YA1, F.WOUT1, TL, 1024, 1536, E, LDYA1); TREP(10) { if (_tr == 1) { EpiNull E0; gemm_pg8(F, F.YA1, F.WOUT1, TL, 1024, 1536, E0, LDYA1); } } SEAM(PH_OUT1); }
    if (IN(PH_NORM3)) { REPS(PH_NORM3) { TREP(6) ph_norm3_route(F); __syncthreads(); ph_cvt_moe(F); } SEAM(PH_NORM3); }
    if (IN(PH_ROUTE2)) { REPS(PH_ROUTE2) { ph_route2(F); __syncthreads(); } SEAM(PH_ROUTE2); }
    {
        int MT = 0; if (IN(PH_MG1A) || IN(PH_MG2A) || IN(PH_MG1B) || IN(PH_MG2B)) MT = __builtin_amdgcn_readfirstlane(F.MMETA[0]);
        const int ta = MT < 64 ? MT : 64;
        if (IN(PH_MG1A)) { REPS(PH_MG1A) { EpiSwigluMoe E{F.MG, 0}; gemm_moe(F, F.HP, F.WM13, 1024, 28, 0, ta, E, LDHP); } SEAM(PH_MG1A); }
        if (IN(PH_MG2A)) { EpiStoreMoe E{F.HP, F.Y2T}; gemm_moe(F, F.MG, F.WM2, DFE, 4, 0, ta, E); SEAM(PH_MG2A); }
        if (IN(PH_MG1B)) { REPS(PH_MG1B) { EpiSwigluMoe E{F.MG, 64 * 256}; gemm_moe(F, F.HP, F.WM13, 1024, 28, 64, MT, E, LDHP); } SEAM(PH_MG1B); }
        if (IN(PH_MG2B)) REPS(PH_MG2B) { EpiStoreMoe Ef{F.HP, F.Y2T}; pg8::Gemm g{F.MG - (size_t)64 * 256 * DFE, F.WM2, 0, 0, DFE, 0}; Moe2BOrder S{F.TILEE, MT, F.G, (int)blockIdx.x}; EpiAdapt<EpiStoreMoe> E{Ef};
            pg8::gemm_phase<EpiAdapt<EpiStoreMoe>, Moe2BOrder, true, true>(F.lds, g, S, E); SEAM(PH_MG2B); }
    }
    if (IN(PH_FINAL)) { REPS(PH_FINAL) ph_final(F); }
#undef IN
#undef SEAM
}

extern "C" void kernel_launch(void* const* d_in, const int* in_sizes, int n_in, void* d_out, int out_size, void* d_ws, size_t ws_size, hipStream_t stream) {
    static int grid = 0;
    if (grid == 0) {
        if (n_in != 31 || out_size != TL * DM || ws_size < WS_END) { fprintf(stderr, "kernel_launch: unexpected shapes (n_in %d out %d ws %zu need %zu)\n", n_in, out_size, ws_size, (size_t)WS_END); grid = -1; return; }
        int dev = 0, cus = 0, per_cu = 0;
        if (hipGetDevice(&dev) != hipSuccess || hipDeviceGetAttribute(&cus, hipDeviceAttributeMultiprocessorCount, dev) != hipSuccess) { grid = -1; return; }
        if (hipFuncSetAttribute((const void*)fwd, hipFuncAttributeMaxDynamicSharedMemorySize, LDS_BYTES) != hipSuccess) { grid = -1; return; }
        if (hipOccupancyMaxActiveBlocksPerMultiprocessor(&per_cu, (const void*)fwd, NWAVES * 64, LDS_BYTES) != hipSuccess || per_cu < 1) fprintf(stderr, "kernel_launch: occupancy query reports %d\n", per_cu);
        (void)hipGetLastError();
        grid = cus;
    }
    if (grid < 0) return;
    if (hipMemsetAsync((char*)d_ws + WS_CTL, 0, CTL_ZERO_BYTES, stream) != hipSuccess) return;
    Args a{};
    for (int i = 0; i < 31; ++i) a.in[i] = (const float*)d_in[i];
    a.out = (float*)d_out; a.ws = (unsigned char*)d_ws;
#if MK_ONE_LAUNCH
    a.ph_lo = 0; a.ph_hi = NPHASES;
    hipLaunchKernelGGL(fwd, dim3(grid), dim3(NWAVES * 64), LDS_BYTES, stream, a);
#else
    for (int ph = 0; ph < NPHASES; ++ph) { a.ph_lo = ph; a.ph_hi = ph + 1; hipLaunchKernelGGL(fwd, dim3(grid), dim3(NWAVES * 64), LDS_BYTES, stream, a); }
#endif
}
```

```cpp
#include <hip/hip_runtime.h>
#include <cstdio>
#include <cstdint>

#ifndef MK_ONE_LAUNCH
#define MK_ONE_LAUNCH 1
#endif

#ifndef QB_IN0
#define QB_IN0 0
#define QB_OUT0 0
#define QB_F13 3
#define QB_F2 0
#endif
#define LAS __attribute__((address_space(3)))
typedef unsigned short bf16;
typedef short bf16x8 __attribute__((ext_vector_type(8)));
typedef float f32x4 __attribute__((ext_vector_type(4)));
typedef unsigned v4u __attribute__((ext_vector_type(4)));
typedef unsigned v2u __attribute__((ext_vector_type(2)));

constexpr int DM = 1024, NB = 8, SEQ = 2048, CTXL = 256;
constexpr int TL = NB * SEQ, TC = NB * CTXL, TT = TL + TC;
constexpr int LDP0 = 4352;
constexpr int LDP1 = 3840;
constexpr int DFF = 2816, DFE = 3584, NEXP = 8;
constexpr float EPS = 1e-6f;
constexpr int LDHP = 1024;
constexpr int LDYA1 = 1600;

constexpr size_t MiB = 1u << 20;
constexpr size_t WS_CTL = 0, CTL_ZERO_BYTES = 64 * 1024;
constexpr size_t WS_MOD = 1 * MiB;
constexpr size_t WS_GATE = 2 * MiB;
constexpr size_t WS_ROPE = 3 * MiB;
constexpr size_t WS_WIN0 = 4 * MiB;
constexpr size_t WS_WOUT0 = 13 * MiB;
constexpr size_t WS_WF13 = 16 * MiB;
constexpr size_t WS_WF2 = 27 * MiB;
constexpr size_t WS_WIN1 = 33 * MiB;
constexpr size_t WS_WOUT1 = 40 * MiB + MiB / 2;
constexpr size_t WS_X = 44 * MiB;
constexpr size_t WS_H = 116 * MiB;
constexpr size_t WS_R = 152 * MiB;
constexpr size_t WS_P = WS_R;
constexpr size_t WS_YA0 = WS_R + 153 * MiB;
constexpr size_t WS_XBC = WS_R + 207 * MiB;
constexpr size_t WS_YF0 = WS_R + 261 * MiB;
constexpr size_t WS_YB0 = WS_R + 297 * MiB;
constexpr size_t WS_YA1 = WS_R + 135 * MiB;
constexpr size_t WS_YF1 = WS_R + 189 * MiB;
constexpr size_t WS_YB1 = WS_R + 221 * MiB;
constexpr size_t WS_G = WS_R;
constexpr size_t WS_HP = WS_R;
constexpr size_t WS_MG = WS_R + 68 * MiB;
constexpr size_t WS_PART = WS_R + 100 * MiB;
constexpr size_t WS_WM13 = WS_R + 256 * MiB;
constexpr size_t WS_END = WS_R + 368 * MiB;
constexpr size_t WS_TOPK = WS_GATE + 128 * 1024, WS_SLOT = WS_GATE + 192 * 1024, WS_CNT = WS_GATE + 320 * 1024, WS_TILEE = WS_GATE + 384 * 1024, WS_MMETA = WS_GATE + 385 * 1024;
constexpr size_t WS_ROWIDX = WS_GATE + 512 * 1024;
static_assert(WS_ROWIDX + 34816 * 4 <= WS_ROPE, "rowidx");
static_assert(WS_P + (size_t)TT * LDP0 * 2 <= WS_YA0 && WS_YA0 + (size_t)TT * 1536 * 2 <= WS_XBC && WS_XBC + (size_t)TT * 1536 * 2 <= WS_YF0 && WS_YF0 + (size_t)TT * 1024 * 2 <= WS_YB0 && WS_YB0 + (size_t)TT * 1024 * 2 <= WS_END, "ws map layer 0");
static_assert(WS_WOUT1 + (size_t)1024 * LDYA1 * 2 <= WS_X && WS_P + (size_t)TT * LDP1 * 2 <= WS_YA1 && WS_YA1 + (size_t)TL * LDYA1 * 2 <= WS_YF1 && WS_YF1 + (size_t)TL * 1024 * 2 <= WS_YB1 && WS_YB1 + (size_t)TL * 1024 * 2 <= WS_WM13, "ws map layer 1");
static_assert(WS_HP + (size_t)34816 * LDHP * 2 <= WS_MG && WS_MG + (size_t)72 * 256 * 3584 * 2 <= WS_WM13 && WS_WM13 + (size_t)8 * 7168 * LDHP * 2 <= WS_END && WS_XBC >= WS_R + 194 * MiB, "ws map moe");
static_assert(WS_G + (size_t)TT * DFF * 2 <= WS_PART && WS_PART + (size_t)6 * TC * 1024 * 4 <= WS_YA0, "partial slabs");
static_assert(WS_X + (size_t)TT * 1024 * 4 <= WS_H && WS_H + (size_t)TT * 1024 * 2 <= WS_R, "ws map 2");
static_assert((size_t)8 * 1024 * 3584 * 2 <= (size_t)TL * DM * 4, "WM2 fits d_out");
constexpr size_t WS_WM2 = WS_R + 194 * MiB;
constexpr size_t WS_Y2T = 80 * MiB;
static_assert(WS_MG + (size_t)72 * 256 * 3584 * 2 <= WS_WM2 && WS_WM2 + (size_t)8 * 1024 * 3584 * 2 <= WS_WM13 && WS_X + (size_t)TT * 1024 * 2 <= WS_Y2T && WS_Y2T + (size_t)7 * 2048 * 1024 * 2 <= WS_H, "WM2 / Y2T slabs");
constexpr int CW_Q2 = 8192, CW_Q13 = 8256;
constexpr int CW_BAR = 4096;

constexpr int RING_BYTES = 131072, LDS_BYTES = 147456, LDSCTL_OFF = LDS_BYTES - 1024, MISC_OFF = LDSCTL_OFF + 320;
constexpr int NWAVES = 8;

#define NTL(p) __builtin_nontemporal_load(p)
#define NTS(v, p) __builtin_nontemporal_store(v, p)
#define LDS_WAIT() asm volatile("s_waitcnt lgkmcnt(0)" ::: "memory")
__device__ __forceinline__ unsigned f2bf(float f) { unsigned u = __builtin_bit_cast(unsigned, f); return (u + 0x7fffu + ((u >> 16) & 1u)) >> 16; }
typedef float f32x2_t __attribute__((ext_vector_type(2))); typedef __bf16 bf16x2_t __attribute__((ext_vector_type(2)));
__device__ __forceinline__ unsigned pk2(float lo, float hi) { f32x2_t v = {lo, hi}; bf16x2_t b = __builtin_convertvector(v, bf16x2_t); return __builtin_bit_cast(unsigned, b); }
__device__ __forceinline__ float bf2f(unsigned short b) { return __builtin_bit_cast(float, ((unsigned)b) << 16); }
__device__ __forceinline__ float bflo(unsigned w) { return __builtin_bit_cast(float, w << 16); }
__device__ __forceinline__ float bfhi(unsigned w) { return __builtin_bit_cast(float, w & 0xffff0000u); }
__device__ __forceinline__ f32x4 bf4(v2u a) { return (f32x4){bflo(a.x), bfhi(a.x), bflo(a.y), bfhi(a.y)}; }
__device__ __forceinline__ v2u pk4(f32x4 v) { v2u o; o.x = pk2(v.x, v.y); o.y = pk2(v.z, v.w); return o; }
__device__ __forceinline__ float silu_f(float x) { return x * __builtin_amdgcn_rcpf(1.f + __expf(-x)); }
__device__ __forceinline__ float wave_sum(float v) {
#pragma unroll
    for (int o = 1; o < 64; o <<= 1) v += __shfl_xor(v, o);
    return v;
}
__host__ __device__ __forceinline__ int perm32(int rho) { const int n = rho >> 4, i = rho & 15; return 8 * (i >> 2) + 4 * n + (i & 3); }

#define XB_TMO      128
#define XB_XCNT(j)  (256  + 64 * (j))
#define XB_XSUB(j)  (1280 + 64 * (j))
#define XB_XGEN(j)  (2304 + 64 * (j))
#define XB_TOP      3328
#define XB_TOPGEN   3392
#define XCD_BAR_WORDS 3456
#define XB_SPIN_CAP (1u << 18)
__device__ __forceinline__ unsigned xb_ld(unsigned* p)              { return __hip_atomic_load(p, __ATOMIC_RELAXED, __HIP_MEMORY_SCOPE_AGENT); }
__device__ __forceinline__ unsigned xb_add(unsigned* p, unsigned v) { return __hip_atomic_fetch_add(p, v, __ATOMIC_RELAXED, __HIP_MEMORY_SCOPE_AGENT); }
__device__ __forceinline__ unsigned xb_xcc_id() { return (unsigned)__builtin_amdgcn_s_getreg((3 << 11) | 20) & 0xFu; }
#define XB_SPIN(cond, bar) do { unsigned _sp = 0; while (cond) { __builtin_amdgcn_s_sleep(1); \
    if ((++_sp & 255u) == 0u) { if (xb_ld(&(bar)[XB_TMO])) break; if (_sp > XB_SPIN_CAP) { atomicAdd(&(bar)[XB_TMO], 1u); break; } } } } while (0)
struct XcdBarrier { unsigned* bar; unsigned x; volatile LAS unsigned* st; };
__device__ __forceinline__ XcdBarrier xcd_barrier_post(unsigned* bar, volatile LAS unsigned* st) {
    XcdBarrier b; b.bar = bar; b.x = xb_xcc_id(); b.st = st;
    if (threadIdx.x == 0) (void)xb_add(&bar[XB_XCNT(b.x)], 1u);
    return b;
}
__device__ __forceinline__ void xcd_barrier_complete(unsigned* bar, unsigned x, unsigned& nloc, unsigned& nx) {
    const unsigned G = gridDim.x * gridDim.y * gridDim.z;
    unsigned sum, cnt, mine, sp = 0u;
    for (;;) {
        sum = 0u; cnt = 0u; mine = 0u;
#pragma unroll
        for (unsigned j = 0; j < 16; ++j) { const unsigned c = xb_ld(&bar[XB_XCNT(j)]); sum += c; cnt += (c > 0u) ? 1u : 0u; mine = (j == x) ? c : mine; }
        if (sum == G) break;
        __builtin_amdgcn_s_sleep(1);
        if ((++sp & 255u) == 0u) { if (xb_ld(&bar[XB_TMO])) break; if (sp > XB_SPIN_CAP) { atomicAdd(&bar[XB_TMO], 1u); break; } }
    }
    nloc = mine > 0u ? mine : 1u; nx = cnt > 0u ? cnt : 1u;
}
__device__ __forceinline__ void xcd_barrier_thread0(const XcdBarrier& b) {
    if (threadIdx.x == 0) {
        unsigned* bar = b.bar;
        __builtin_amdgcn_s_waitcnt(0);
        unsigned nloc = b.st[0], nx = b.st[1];
        if (nloc == 0u) { xcd_barrier_complete(bar, b.x, nloc, nx); b.st[0] = nloc; b.st[1] = nx; }
        const unsigned old = xb_add(&bar[XB_XSUB(b.x)], 1u);
        const unsigned gen = old / nloc;
        if (old + 1u == (gen + 1u) * nloc) {
            __builtin_amdgcn_fence(__ATOMIC_RELEASE, "agent");
            asm volatile("s_waitcnt vmcnt(0)" ::: "memory");
            const unsigned og = xb_add(&bar[XB_TOP], 1u);
            const unsigned tg = og / nx;
            if (og + 1u == (tg + 1u) * nx) xb_add(&bar[XB_TOPGEN], 1u);
            else XB_SPIN(xb_ld(&bar[XB_TOPGEN]) == tg, bar);
            __builtin_amdgcn_fence(__ATOMIC_ACQUIRE, "agent");
            xb_add(&bar[XB_XGEN(b.x)], 1u);
            asm volatile("s_waitcnt vmcnt(0)" ::: "memory");
        } else {
            XB_SPIN(xb_ld(&bar[XB_XGEN(b.x)]) == gen, bar);
            __builtin_amdgcn_fence(__ATOMIC_ACQUIRE, "agent");
            asm volatile("s_waitcnt vmcnt(0)" ::: "memory");
        }
    }
}
__device__ __forceinline__ void xcd_barrier(const XcdBarrier& b) {
    asm volatile("s_waitcnt vmcnt(0)" ::: "memory");
    __syncthreads();
    xcd_barrier_thread0(b);
    __syncthreads();
}

namespace pg8 {
#define PG8_LAS __attribute__((address_space(3)))
typedef unsigned short bf16_t;
typedef short bf16x8 __attribute__((ext_vector_type(8)));
typedef float f32x4 __attribute__((ext_vector_type(4)));
typedef unsigned u32x4 __attribute__((ext_vector_type(4)));
constexpr int BM = 256, BK = 64, HALF = 128, HTB = HALF * BK * 2  , STAGE_BYTES = 8 * HTB, NXCD = 8, WGM = 8;

__host__ __device__ __forceinline__ int lds_byte(int r, int c) { const int st = (r >> 4) * 2 + (c >> 5), rr = r & 15, cc = c & 31, ob = rr * 64 + cc * 2; return st * 1024 + (ob ^ (((ob >> 9) & 1) << 5)); }
__host__ __device__ __forceinline__ void stage_rc(int b, int& R, int& C) { const int st = b / 1024, sb = b % 1024, swz = sb ^ (((sb >> 9) & 1) << 5); R = (st >> 1) * 16 + swz / 64; C = (st & 1) * 32 + (swz % 64) / 2; }
__host__ __device__ __forceinline__ int perm32(int rho) { const int n = rho >> 4, i = rho & 15; return 8 * (i >> 2) + 4 * n + (i & 3); }

struct Unit { int pm, pn, k0, nk; };
struct Gemm { const bf16_t* A; const bf16_t* Bt; int M, N, K, ld; };

struct StaticOrder {
    static constexpr bool GATHER = false;
    int nM, nN, nwg, G, c;
    __host__ __device__ __forceinline__ void init(int M, int N, int G_, int c_) { nM = M / BM; nN = N / BM; nwg = nM * nN; G = G_; c = c_; }
    __host__ __device__ __forceinline__ bool next(int i, Unit& u) const {
        const long L = (long)i * G + c; if (L >= nwg) return false;
        int wgid = (int)L; { const int q = nwg / NXCD, r = nwg % NXCD, xcd = wgid % NXCD, off = wgid / NXCD; wgid = (xcd < r ? xcd * (q + 1) : r * (q + 1) + (xcd - r) * q) + off; }
        const int nig = WGM * nN, gid = wgid / nig, fm = gid * WGM, gsz = (nM - fm) < WGM ? (nM - fm) : WGM;
        u.pm = fm + ((wgid % nig) % gsz); u.pn = (wgid % nig) / gsz; u.k0 = 0; u.nk = 0; return true;
    }
    __device__ __forceinline__ void a_ready(const Unit&) const {}
    __device__ __forceinline__ void done(const Unit&) const {}
};

__device__ __forceinline__ unsigned cvt_pk_bf16(float lo, float hi) { unsigned r; asm volatile("v_cvt_pk_bf16_f32 %0, %1, %2" : "=v"(r) : "v"(lo), "v"(hi)); return r; }
template <class Epi, class Sched, bool ALIGN_EPI = false, bool SP2 = false>
__device__ __forceinline__ void gemm_phase(PG8_LAS unsigned char* lds, const Gemm g, const Sched& S, const Epi& E) {
    int tid_ = threadIdx.x; asm volatile("" : "+v"(tid_));
    const int tid = tid_, wid = __builtin_amdgcn_readfirstlane(tid >> 6), lane = tid & 63, wr = wid >> 2, wc = wid & 3, fr = lane & 15, fq = lane >> 4;
    const int K = g.K, nt_full = K / BK, LD = g.ld ? g.ld : K;
    unsigned voffA[2], voffB[2];
#pragma unroll
    for (int i = 0; i < 2; ++i) { int R, C; stage_rc(tid * 16 + i * 8192, R, C); const int Rb = Epi::PERM ? ((R >> 5) * 64 + perm32(R & 31)) : R;
        voffA[i] = (unsigned)(R * LD + C) * 2u; voffB[i] = (unsigned)(Rb * LD + C) * 2u; }
    constexpr bool GA = Sched::GATHER;
    static_assert(!GA || SP2, "the gather path is written for the SP2 loop");
    int gR[2] = {0, 0}, gC[2] = {0, 0}; unsigned cv0[2] = {0u, 0u}, cv1[2] = {0u, 0u}, nv0[2] = {0u, 0u}, nv1[2] = {0u, 0u}, ti[4] = {0u, 0u, 0u, 0u};
    if constexpr (GA) {
#pragma unroll
        for (int i = 0; i < 2; ++i) { int R, C; stage_rc(tid * 16 + i * 8192, R, C); gR[i] = R; gC[i] = C; } }
    const size_t kstep = (size_t)(BK * 2);
    const size_t hstep = (size_t)HALF * LD * 2;
    const size_t hstepB = Epi::PERM ? (size_t)32 * LD * 2 : hstep;
    const size_t tstep = 2 * hstep;
    const unsigned ldsw = (unsigned)wid * 1024u;
    const int aoff = lds_byte(wr * 64 + fr, fq * 8), boff = lds_byte(wc * 32 + fr, fq * 8);
#define PG8_SA(b, h) (((b) * 2 + (h)) * HTB)
#define PG8_SB(b, h) ((4 + (b) * 2 + (h)) * HTB)
#define PG8_STAGE(bufoff, gbase, voff) do { _Pragma("unroll") for (int _i = 0; _i < 2; ++_i) \
        __builtin_amdgcn_global_load_lds((const unsigned*)((const char*)(gbase) + (voff)[_i]), (PG8_LAS unsigned*)(lds + (bufoff) + ldsw + _i * 8192), 16, 0, 0); } while (0)
#define PG8_STA0(bufoff, base, sel) do { if constexpr (GA) { unsigned so_[2] = {(sel) ? nv0[0] : cv0[0], (sel) ? nv0[1] : cv0[1]}; PG8_STAGE(bufoff, base, so_); } else PG8_STAGE(bufoff, base, voffA); } while (0)
#define PG8_STA1(bufoff, base, sel) do { if constexpr (GA) { unsigned so_[2] = {(sel) ? nv1[0] : cv1[0], (sel) ? nv1[1] : cv1[1]}; PG8_STAGE(bufoff, base, so_); } else PG8_STAGE(bufoff, (base) + hstep, voffA); } while (0)
#define PG8_LDA(dst, b, h) do { _Pragma("unroll") for (int m = 0; m < 4; ++m) _Pragma("unroll") for (int k = 0; k < 2; ++k) dst[m][k] = *(const PG8_LAS bf16x8*)(lds + PG8_SA(b, h) + aoff + m * 2048 + k * 1024); } while (0)
#define PG8_LDB(dst, b, h) do { _Pragma("unroll") for (int n = 0; n < 2; ++n) _Pragma("unroll") for (int k = 0; k < 2; ++k) dst[n][k] = *(const PG8_LAS bf16x8*)(lds + PG8_SB(b, h) + boff + n * 2048 + k * 1024); } while (0)
#define PG8_MMA(ai, bj, At, Bt) do { __builtin_amdgcn_s_setprio(1); _Pragma("unroll") for (int m = 0; m < 4; ++m) _Pragma("unroll") for (int n = 0; n < 2; ++n) _Pragma("unroll") for (int k = 0; k < 2; ++k) \
        acc[ai][bj][m][n] = __builtin_amdgcn_mfma_f32_16x16x32_bf16(Bt[n][k], At[m][k], acc[ai][bj][m][n], 0, 0, 0); __builtin_amdgcn_s_setprio(0); } while (0)
#define PG8_WAIT_V(n) asm volatile("s_waitcnt vmcnt(" #n ")" ::: "memory")
#define PG8_WAIT_L(n) asm volatile("s_waitcnt lgkmcnt(" #n ")" ::: "memory")
#define PG8_BAR __builtin_amdgcn_s_barrier()
#define PG8_SCHED __builtin_amdgcn_sched_barrier(0)
    Unit cur{0, 0, 0, 0}, nxt{0, 0, 0, 0}; int ui = 0;
    if (!S.next(0, cur)) return;
    f32x4 acc[2][2][4][2];
#pragma unroll
    for (int a = 0; a < 2; ++a)
#pragma unroll
        for (int b = 0; b < 2; ++b)
#pragma unroll
            for (int m = 0; m < 4; ++m)
#pragma unroll
                for (int n = 0; n < 2; ++n) acc[a][b][m][n] = (f32x4){0.f, 0.f, 0.f, 0.f};
    bf16x8 At[4][2], B0[2][2], B1[2][2];
    const char* cA = (const char*)g.A + (GA ? (size_t)0 : (size_t)cur.pm * tstep) + (size_t)cur.k0 * 2; const char* cB = (const char*)g.Bt + (size_t)cur.pn * tstep + (size_t)cur.k0 * 2;
    if constexpr (GA) { const int* tab = S.rowidx + cur.pm * 256;
#pragma unroll
        for (int i = 0; i < 2; ++i) { cv0[i] = (unsigned)(tab[gR[i]] * LD + gC[i]) * 2u; cv1[i] = (unsigned)(tab[128 + gR[i]] * LD + gC[i]) * 2u; } }
    S.a_ready(cur);
    if constexpr (SP2) {
        PG8_STAGE(PG8_SB(0, 0), cB, voffB); PG8_STAGE(PG8_SB(0, 1), cB + hstepB, voffB); PG8_STA0(PG8_SA(0, 0), cA, false); PG8_STA1(PG8_SA(0, 1), cA, false);
        if (wr == 1) PG8_BAR;
        PG8_WAIT_V(2); PG8_BAR;
        PG8_STAGE(PG8_SB(1, 0), cB + kstep, voffB); PG8_STA0(PG8_SA(1, 0), cA + kstep, false); PG8_STAGE(PG8_SB(1, 1), cB + hstepB + kstep, voffB);
        PG8_WAIT_V(6); PG8_BAR;
    } else {
        PG8_STAGE(PG8_SB(0, 0), cB, voffB); PG8_STAGE(PG8_SA(0, 0), cA, voffA); PG8_STAGE(PG8_SB(0, 1), cB + hstepB, voffB); PG8_STAGE(PG8_SA(0, 1), cA + hstep, voffA);
        if (wr == 1) PG8_BAR;
        PG8_WAIT_V(4); PG8_BAR;
        PG8_STAGE(PG8_SB(1, 0), cB + kstep, voffB); PG8_STAGE(PG8_SA(1, 0), cA + kstep, voffA); PG8_STAGE(PG8_SB(1, 1), cB + hstepB + kstep, voffB);
        PG8_WAIT_V(6); PG8_BAR;
    }
    for (;;) {
        const bool has_next = S.next(ui + 1, nxt);
        const char* nA = has_next ? (const char*)g.A + (GA ? (size_t)0 : (size_t)nxt.pm * tstep) + (size_t)nxt.k0 * 2 : cA; const char* nB = has_next ? (const char*)g.Bt + (size_t)nxt.pn * tstep + (size_t)nxt.k0 * 2 : cB;
        const int nt = cur.nk ? cur.nk : nt_full;
        if constexpr (GA) { if (has_next) { const unsigned tb = (unsigned)nxt.pm * 1024u;
            const unsigned o0 = tb + (unsigned)gR[0] * 4u, o1 = tb + (unsigned)gR[1] * 4u, o2 = o0 + 512u, o3 = o1 + 512u;
            asm volatile("global_load_dword %0, %1, %2" : "=v"(ti[0]) : "v"(o0), "s"(S.rowidx) : "memory"); asm volatile("global_load_dword %0, %1, %2" : "=v"(ti[1]) : "v"(o1), "s"(S.rowidx) : "memory");
            asm volatile("global_load_dword %0, %1, %2" : "=v"(ti[2]) : "v"(o2), "s"(S.rowidx) : "memory"); asm volatile("global_load_dword %0, %1, %2" : "=v"(ti[3]) : "v"(o3), "s"(S.rowidx) : "memory"); } }
        for (int t = 0; t < nt; t += 2) {
            const bool last = (t == nt - 2);
            const char* a1 = cA + (size_t)(t + 1) * kstep;
            const char* a2 = last ? nA : cA + (size_t)(t + 2) * kstep; const char* b2 = last ? nB : cB + (size_t)(t + 2) * kstep;
            const char* a3 = a2 + kstep; const char* b3 = b2 + kstep;
            if (last && has_next) S.a_ready(nxt);
            if constexpr (GA) { if (last) {
                if (has_next) { unsigned t0 = ti[0], t1 = ti[1], t2 = ti[2], t3 = ti[3]; asm volatile("" : "+v"(t0), "+v"(t1), "+v"(t2), "+v"(t3));
                    nv0[0] = (t0 * (unsigned)LD + (unsigned)gC[0]) * 2u; nv0[1] = (t1 * (unsigned)LD + (unsigned)gC[1]) * 2u; nv1[0] = (t2 * (unsigned)LD + (unsigned)gC[0]) * 2u; nv1[1] = (t3 * (unsigned)LD + (unsigned)gC[1]) * 2u; }
                else { nv0[0] = cv0[0]; nv0[1] = cv0[1]; nv1[0] = cv1[0]; nv1[1] = cv1[1]; } } }
            if constexpr (SP2) {
            PG8_LDB(B0, 0, 0); PG8_LDB(B1, 0, 1); PG8_SCHED; PG8_LDA(At, 0, 0); PG8_STA1(PG8_SA(1, 1), a1, false);
            PG8_WAIT_V(8); PG8_WAIT_L(0); PG8_BAR; PG8_MMA(0, 0, At, B0); PG8_MMA(0, 1, At, B1); PG8_BAR; PG8_SCHED;
            PG8_LDA(At, 0, 1); PG8_STAGE(PG8_SB(0, 0), b2, voffB); PG8_STAGE(PG8_SB(0, 1), b2 + hstepB, voffB); PG8_STA0(PG8_SA(0, 0), a2, last);
            PG8_WAIT_V(8); PG8_WAIT_L(0); PG8_BAR; PG8_MMA(1, 0, At, B0); PG8_MMA(1, 1, At, B1); PG8_BAR; PG8_SCHED;
            PG8_LDB(B0, 1, 0); PG8_LDB(B1, 1, 1); PG8_SCHED; PG8_LDA(At, 1, 0); PG8_STA1(PG8_SA(0, 1), a2, last);
            PG8_WAIT_V(8); PG8_WAIT_L(0); PG8_BAR; PG8_MMA(0, 0, At, B0); PG8_MMA(0, 1, At, B1); PG8_BAR; PG8_SCHED;
            PG8_LDA(At, 1, 1); PG8_STAGE(PG8_SB(1, 0), b3, voffB); PG8_STAGE(PG8_SB(1, 1), b3 + hstepB, voffB); PG8_STA0(PG8_SA(1, 0), a3, last);
            PG8_WAIT_V(8); PG8_WAIT_L(0); PG8_BAR; PG8_MMA(1, 0, At, B0); PG8_MMA(1, 1, At, B1); PG8_BAR; PG8_SCHED;
            } else {
            PG8_LDB(B0, 0, 0); PG8_SCHED; PG8_LDA(At, 0, 0); PG8_STAGE(PG8_SA(1, 1), a1 + hstep, voffA);
            PG8_WAIT_L(8); PG8_BAR; PG8_WAIT_L(0); PG8_MMA(0, 0, At, B0); PG8_BAR; PG8_SCHED;
            PG8_LDB(B1, 0, 1); PG8_STAGE(PG8_SB(0, 0), b2, voffB);
            PG8_BAR; PG8_WAIT_L(0); PG8_MMA(0, 1, At, B1); PG8_BAR;
            PG8_LDA(At, 0, 1); PG8_STAGE(PG8_SA(0, 0), a2, voffA);
            PG8_BAR; PG8_WAIT_L(0); PG8_MMA(1, 0, At, B0); PG8_BAR; PG8_SCHED;
            PG8_STAGE(PG8_SB(0, 1), b2 + hstepB, voffB);
            PG8_WAIT_V(6); PG8_BAR; PG8_MMA(1, 1, At, B1); PG8_BAR;
            PG8_LDB(B0, 1, 0); PG8_SCHED; PG8_LDA(At, 1, 0); PG8_STAGE(PG8_SA(0, 1), a2 + hstep, voffA);
            PG8_WAIT_L(8); PG8_BAR; PG8_WAIT_L(0); PG8_MMA(0, 0, At, B0); PG8_BAR; PG8_SCHED;
            PG8_LDB(B1, 1, 1); PG8_STAGE(PG8_SB(1, 0), b3, voffB);
            PG8_BAR; PG8_WAIT_L(0); PG8_MMA(0, 1, At, B1); PG8_BAR;
            PG8_LDA(At, 1, 1); PG8_STAGE(PG8_SA(1, 0), a3, voffA);
            PG8_BAR; PG8_WAIT_L(0); PG8_MMA(1, 0, At, B0); PG8_BAR; PG8_SCHED;
            PG8_STAGE(PG8_SB(1, 1), b3 + hstepB, voffB);
            PG8_WAIT_V(6); PG8_BAR; PG8_MMA(1, 1, At, B1); PG8_BAR;
            }
        }
        if constexpr (ALIGN_EPI) { if (wr == 0) PG8_BAR; }
        if constexpr (!Epi::AFTER_DRAIN) { E(acc, cur, wr, wc, fr, fq); S.done(cur); }
        if (!has_next) break;
#pragma unroll
        for (int a = 0; a < 2; ++a)
#pragma unroll
            for (int b = 0; b < 2; ++b)
#pragma unroll
                for (int m = 0; m < 4; ++m)
#pragma unroll
                    for (int n = 0; n < 2; ++n) acc[a][b][m][n] = (f32x4){0.f, 0.f, 0.f, 0.f};
        cur = nxt; cA = nA; cB = nB; ++ui;
        if constexpr (GA) { cv0[0] = nv0[0]; cv0[1] = nv0[1]; cv1[0] = nv1[0]; cv1[1] = nv1[1]; }
        if constexpr (ALIGN_EPI) { if (wr == 1) PG8_BAR; }
    }
    PG8_WAIT_V(0);
    if constexpr (!ALIGN_EPI) { if (wr == 0) PG8_BAR; }
    PG8_BAR;
    if constexpr (Epi::AFTER_DRAIN) { E.fused(acc, cur, wr, wc, fr, fq, lds, wid, lane); S.done(cur); }
#undef PG8_SA
#undef PG8_SB
#undef PG8_STAGE
#undef PG8_LDA
#undef PG8_STA0
#undef PG8_STA1
#undef PG8_LDB
#undef PG8_MMA
#undef PG8_WAIT_V
#undef PG8_WAIT_L
#undef PG8_BAR
#undef PG8_SCHED
}
}

struct Frame {
    LAS unsigned char* lds;
    int tid, lane, wave, vcu, G;
    const float *x, *c, *ctx, *c_ctx, *ada_w, *ada_b, *norm_attn_g, *norm_ffn_g, *ev_w_in, *ev_w_out, *na_rpb, *conv_w, *conv_b, *dt_bias, *a_log, *ssm_d, *ssm_norm_g,
        *ffn_w1, *ffn_w3, *ffn_w2, *od_w_in, *od_w_out, *swa_sink, *ret_log_decay, *ret_gn_g, *ret_gn_b, *moe_router, *moe_w1, *moe_w3, *moe_w2, *final_g;
    float* out;
    float *MOD, *GATE, *ROPE; bf16* X;
    bf16 *WIN0, *WOUT0, *WF13, *WF2, *WIN1, *WOUT1, *WM13, *WM2, *H, *P, *YA0, *YA1, *XBC, *YF0, *YB0, *YF1, *YB1, *Gh, *MG, *HP;
    unsigned* ctl;
    int *TOPK, *SLOT, *CNT, *TILEE, *MMETA, *ROWIDX; bf16* PART; bf16* Y2T;
};

__device__ __forceinline__ void tr_item(const float* W, int K, int N, bf16* WT, int ilv, LAS float* scr, int item, int lane, int ldk = 0) {
    if (ldk == 0) ldk = K;
    const int nblk = N / 32, kb = item / nblk, nb = item % nblk, k0 = 64 * kb, n0 = 32 * nb;
#pragma unroll 8
    for (int i = 0; i < 32; ++i) { const int kk = 2 * i + (lane >> 5); scr[kk * 33 + (lane & 31)] = __builtin_nontemporal_load(W + (size_t)(k0 + kk) * N + n0 + (lane & 31)); }
    LDS_WAIT(); asm volatile("" ::: "memory");
    const int c = lane & 7;
#pragma unroll
    for (int j = 0; j < 4; ++j) { const int n = (lane >> 3) + 8 * j; const LAS float* s = scr + (8 * c) * 33 + n;
        v4u o; o.x = pk2(s[0 * 33], s[1 * 33]); o.y = pk2(s[2 * 33], s[3 * 33]); o.z = pk2(s[4 * 33], s[5 * 33]); o.w = pk2(s[6 * 33], s[7 * 33]);
        const int nn = n0 + n; int row = nn;
        if (ilv == 1 || ilv == 2) row = (nn >> 5) * 64 + (ilv == 2 ? 32 : 0) + (nn & 31);
        if (ilv == 3 && (nn < 640 || (nn >= 768 && nn < 1792))) row = (nn & ~63) + 8 * ((nn & 31) >> 2) + 4 * ((nn >> 5) & 1) + (nn & 3);
        __builtin_nontemporal_store(o, (v4u*)(WT + (size_t)row * ldk + k0 + 8 * c)); }
    LDS_WAIT(); asm volatile("" ::: "memory");
}

__device__ __forceinline__ void tr_item64(const float* W, int K, int N, bf16* WT, int ilv, LAS float* scr, int item, int lane, int ldk = 0) {
    if (ldk == 0) ldk = K;
    const int nblk = N / 64, kb = item / nblk, nb = item % nblk, k0 = 64 * kb, n0 = 64 * nb, c4 = (lane & 15) * 4, rq = lane >> 4;
    LAS unsigned* su = (LAS unsigned*)scr;
    f32x4 v0[8], v1[8];
#pragma unroll
    for (int i = 0; i < 8; ++i) { const float* p = W + (size_t)(k0 + 8 * i + 2 * rq) * N + n0 + c4; v0[i] = NTL((const f32x4*)p); v1[i] = NTL((const f32x4*)(p + N)); }
#pragma unroll
    for (int i = 0; i < 8; ++i) { LAS unsigned* d = su + (4 * i + rq) * 65 + c4; d[0] = pk2(v0[i].x, v1[i].x); d[1] = pk2(v0[i].y, v1[i].y); d[2] = pk2(v0[i].z, v1[i].z); d[3] = pk2(v0[i].w, v1[i].w); }
    LDS_WAIT(); asm volatile("" ::: "memory");
    const int c = lane & 7;
#pragma unroll
    for (int j = 0; j < 8; ++j) { const int n = (lane >> 3) + 8 * j; const LAS unsigned* s = su + (4 * c) * 65 + n;
        v4u o; o.x = s[0 * 65]; o.y = s[1 * 65]; o.z = s[2 * 65]; o.w = s[3 * 65];
        const int nn = n0 + n; int row = nn;
        if (ilv == 1 || ilv == 2) row = (nn >> 5) * 64 + (ilv == 2 ? 32 : 0) + (nn & 31);
        if (ilv == 3 && (nn < 640 || (nn >= 768 && nn < 1792))) row = (nn & ~63) + 8 * ((nn & 31) >> 2) + 4 * ((nn >> 5) & 1) + (nn & 3);
        NTS(o, (v4u*)(WT + (size_t)row * ldk + k0 + 8 * c)); }
    LDS_WAIT(); asm volatile("" ::: "memory");
}

__device__ __forceinline__ void ph_cvt(const Frame& F, bool fill) {
    LAS float* scr = (LAS float*)(F.lds + F.wave * 16640);
    const int gw = F.vcu * NWAVES + F.wave, NGW = F.G * NWAVES;
    constexpr int I_IN0 = 16 * 129, I_OUT = 24 * 16, I_F1 = 16 * 44, I_F2 = 44 * 16, I_IN1 = 16 * 60;
    constexpr int NITEMS = I_IN0 + I_OUT + 2 * I_F1 + I_F2 + I_IN1 + I_OUT;
    for (int it = gw; it < (fill ? I_IN0 : NITEMS); it += NGW) {
        int r = it;
        if (r < I_IN0) { tr_item(F.ev_w_in, 1024, 4128, F.WIN0, 0, scr, r, F.lane); continue; } r -= I_IN0;
        if (r < I_OUT) { tr_item64(F.ev_w_out, 1536, 1024, F.WOUT0, 0, scr, r, F.lane); continue; } r -= I_OUT;
        if (r < I_F1) { tr_item64(F.ffn_w1, 1024, DFF, F.WF13, 1, scr, r, F.lane); continue; } r -= I_F1;
        if (r < I_F1) { tr_item64(F.ffn_w3, 1024, DFF, F.WF13, 2, scr, r, F.lane); continue; } r -= I_F1;
        if (r < I_F2) { tr_item64(F.ffn_w2, DFF, 1024, F.WF2, 0, scr, r, F.lane); continue; } r -= I_F2;
        if (r < I_IN1) { tr_item64(F.od_w_in, 1024, LDP1, F.WIN1, 3, scr, r, F.lane); continue; } r -= I_IN1;
        tr_item64(F.od_w_out, 1536, 1024, F.WOUT1, 0, scr, r, F.lane, LDYA1);
    }
    { const int gt = F.vcu * 512 + F.tid, NGT = F.G * 512; v4u* z = (v4u*)(F.WIN0 + (size_t)4128 * 1024);
      for (int i = gt; i < 224 * 1024 / 8; i += NGT) z[i] = (v4u){0u, 0u, 0u, 0u}; }
    { const int gt = F.vcu * 512 + F.tid, NGT = F.G * 512;
      for (int i = gt; i < 2048 * 32; i += NGT) { const int t = i >> 5, f = i & 31; const float inv = powf(10000.f, -(float)(f & 15) / 16.f);
          const float ang = (float)((f < 16) ? (t >> 6) : (t & 63)) * inv; float sn, cs; sincosf(ang, &sn, &cs); F.ROPE[2 * i] = cs; F.ROPE[2 * i + 1] = sn; } }
    __syncthreads();
    LAS float* sv = (LAS float*)F.lds;
    LAS float* part = (LAS float*)(F.lds + 36864);
    for (int it = F.vcu; it < 192; it += F.G) {
        const int l = it / 96, n0 = (it % 96) * 64;
        for (int i = F.tid; i < 9 * 1024; i += 512) { const int r = i >> 10, k = i & 1023; const float v = (r < 8) ? F.c[r * 1024 + k] : F.c_ctx[k]; sv[i] = silu_f(v); }
        __syncthreads();
        float acc[9];
#pragma unroll
        for (int r = 0; r < 9; ++r) acc[r] = 0.f;
        const float* wp = F.ada_w + (size_t)l * 1024 * 6144 + n0 + F.lane;
        for (int kq = F.wave * 128; kq < F.wave * 128 + 128; kq += 64) {
            float w[64];
#pragma unroll
            for (int i = 0; i < 64; ++i) w[i] = NTL(wp + (size_t)(kq + i) * 6144);
#pragma unroll
            for (int i = 0; i < 64; ++i)
#pragma unroll
                for (int r = 0; r < 9; ++r) acc[r] += sv[r * 1024 + kq + i] * w[i]; }
#pragma unroll
        for (int r = 0; r < 9; ++r) part[(F.wave * 9 + r) * 64 + F.lane] = acc[r];
        __syncthreads();
        for (int i = F.tid; i < 9 * 64; i += 512) { const int r = i >> 6, n = i & 63; float s = 0.f;
#pragma unroll
            for (int w = 0; w < 8; ++w) s += part[(w * 9 + r) * 64 + n];
            F.MOD[(size_t)(l * 9 + r) * 6144 + n0 + n] = s + F.ada_b[l * 6144 + n0 + n]; }
        __syncthreads();
    }
}

__device__ __forceinline__ int cvt_claim(const Frame& F, int word, int n) {
    int it = 0;
    if (F.lane == 0) it = (int)__hip_atomic_fetch_add(F.ctl + word, (unsigned)n, __ATOMIC_RELAXED, __HIP_MEMORY_SCOPE_AGENT);
    return __builtin_amdgcn_readfirstlane(it);
}
__device__ __forceinline__ void cvt_item2(const Frame& F, LAS float* scr, int it) { constexpr int I_2 = 56 * 16; const int e = it / I_2, r = it % I_2;
    tr_item64(F.moe_w2 + (size_t)e * DFE * 1024, DFE, 1024, F.WM2 + (size_t)e * 1024 * DFE, 0, scr, r, F.lane); }
__device__ __forceinline__ void cvt_item13(const Frame& F, LAS float* scr, int it) { constexpr int I_1 = 16 * 56; const int e = it / (2 * I_1), r = it % (2 * I_1); const bool up = r >= I_1;
    tr_item64((up ? F.moe_w3 : F.moe_w1) + (size_t)e * 1024 * DFE, 1024, DFE, F.WM13 + (size_t)e * 7168 * LDHP, up ? 2 : 1, scr, up ? r - I_1 : r, F.lane, LDHP); }
constexpr int CVT_N2 = NEXP * 56 * 16, CVT_N13 = NEXP * 2 * 16 * 56;
__device__ __forceinline__ bool cvt_pull(const Frame& F, int budget, bool allow13) {
    LAS float* scr = (LAS float*)(F.lds + F.wave * 16640);
    if (!allow13) return false;
    const int b = cvt_claim(F, CW_Q13, budget);
    if (b >= CVT_N13) return false;
    for (int it = b; it < b + budget && it < CVT_N13; ++it) cvt_item13(F, scr, it);
    return true;
}
__device__ __forceinline__ void cvt_drain(const Frame& F) {
    LAS float* scr = (LAS float*)(F.lds + F.wave * 16640);
    for (;;) { const int b = cvt_claim(F, CW_Q2, 2); if (b >= CVT_N2) break; for (int it = b; it < b + 2 && it < CVT_N2; ++it) cvt_item2(F, scr, it); }
    for (;;) { const int b = cvt_claim(F, CW_Q13, 2); if (b >= CVT_N13) break; for (int it = b; it < b + 2 && it < CVT_N13; ++it) cvt_item13(F, scr, it); }
}
__device__ __forceinline__ int cvt_nt(const Frame& F) { const int rem = (72 * 22) % F.G; return rem ? (F.G - rem) * NWAVES * QB_F13 : 0; }
__device__ __forceinline__ void cvt_tail_f13(const Frame& F) {
    const int rem = (72 * 22) % F.G; if (rem == 0 || (int)blockIdx.x < rem || QB_F13 == 0) return;
    LAS float* scr = (LAS float*)(F.lds + F.wave * 16640);
    const int w = ((int)blockIdx.x - rem) * NWAVES + F.wave, nw = (F.G - rem) * NWAVES;
    for (int k = 0; k < QB_F13; ++k) { const int it = k * nw + w; if (it < CVT_N13) cvt_item13(F, scr, it); }
}
__device__ __forceinline__ void ph_cvt_moe(const Frame& F) {
    LAS float* scr = (LAS float*)(F.lds + F.wave * 16640);
    const int gw = F.vcu * NWAVES + F.wave, NGW = F.G * NWAVES;
    const int nt = min(cvt_nt(F), CVT_N13), n13 = CVT_N13 - nt;
    for (int it = gw; it < CVT_N2 + n13; it += NGW) { if (it < CVT_N2) cvt_item2(F, scr, it); else cvt_item13(F, scr, nt + (it - CVT_N2)); }
}
__device__ __forceinline__ bool short_round(const Frame& F, int units) { const int rem = units % F.G; return rem != 0 && (int)blockIdx.x >= rem; }

template <int MODE, int CTXSUM, int NR>
__device__ __forceinline__ void norm_rows(const Frame& F, const float* g, int layer, int which, int row0) {
    const int bidx = row0 < TL ? (row0 >> 11) : 8;
    const float* mod = F.MOD + (size_t)(layer * 9 + bidx) * 6144 + (which ? 3 : 0) * 1024;
    f32x4 v[NR][4];
#pragma unroll
    for (int r = 0; r < NR; ++r) { const int row = row0 + r;
        if (MODE == 0) { const float* src = row < TL ? F.x + (size_t)row * 1024 : F.ctx + (size_t)(row - TL) * 1024;
#pragma unroll
            for (int j = 0; j < 4; ++j) v[r][j] = __builtin_nontemporal_load((const f32x4*)src + F.lane + 64 * j); }
        else { const v2u* src = (const v2u*)(F.X + (size_t)row * 1024);
#pragma unroll
            for (int j = 0; j < 4; ++j) v[r][j] = bf4(NTL(src + F.lane + 64 * j)); } }
    if (CTXSUM != 0) {
#pragma unroll
        for (int r = 0; r < NR; ++r) { const int row = row0 + r;
#pragma unroll
            for (int j = 0; j < 4; ++j) { if (CTXSUM == 1) v[r][j] = ((const f32x4*)(F.ctx + (size_t)(row - TL) * 1024))[F.lane + 64 * j];
                f32x4 sum = (f32x4){0.f, 0.f, 0.f, 0.f};
#pragma unroll
                for (int sl = 0; sl < 6; ++sl) sum += bf4(((const v2u*)(F.PART + ((size_t)sl * TC + (row - TL)) * 1024))[F.lane + 64 * j]);
                const f32x4 gq = ((const f32x4*)(F.MOD + (size_t)8 * 6144 + (CTXSUM == 1 ? 2 : 5) * 1024))[F.lane + 64 * j];
                v[r][j] = v[r][j] + gq * sum; ((v2u*)(F.X + (size_t)row * 1024))[F.lane + 64 * j] = pk4(v[r][j]); v[r][j] = bf4(pk4(v[r][j])); } } }
    f32x4 gg[4], sh[4], sc[4];
#pragma unroll
    for (int j = 0; j < 4; ++j) { gg[j] = ((const f32x4*)g)[F.lane + 64 * j]; sh[j] = ((const f32x4*)mod)[F.lane + 64 * j]; sc[j] = ((const f32x4*)(mod + 1024))[F.lane + 64 * j] + 1.0f; gg[j] = gg[j] * sc[j]; }
    float ss[NR];
#pragma unroll
    for (int r = 0; r < NR; ++r) { float s = 0.f;
#pragma unroll
        for (int j = 0; j < 4; ++j) s += (v[r][j].x * v[r][j].x + v[r][j].y * v[r][j].y) + (v[r][j].z * v[r][j].z + v[r][j].w * v[r][j].w);
        ss[r] = s; }
#pragma unroll
    for (int o = 1; o < 64; o <<= 1) {
#pragma unroll
        for (int r = 0; r < NR; ++r) ss[r] += __shfl_xor(ss[r], o); }
#pragma unroll
    for (int r = 0; r < NR; ++r) { const float rstd = 1.0f / sqrtf(ss[r] * (1.f / 1024.f) + EPS);
        unsigned long long* o8 = (unsigned long long*)(F.H + (size_t)(row0 + r) * 1024) + F.lane;
#pragma unroll
        for (int j = 0; j < 4; ++j) { const f32x4 hv = (v[r][j] * rstd) * gg[j] + sh[j];
            *(o8 + 64 * j) = (unsigned long long)pk2(hv.x, hv.y) | ((unsigned long long)pk2(hv.z, hv.w) << 32); } }
}
template <int MODE, bool ROUTER, int CTXSUM = 0>
__device__ __forceinline__ void ph_norm(const Frame& F, int layer, int which, int nrows) {
    const int gw = F.vcu * NWAVES + F.wave, NGW = F.G * NWAVES;
    const float* g = (which ? F.norm_ffn_g : F.norm_attn_g) + layer * 1024;
    for (int row = TL + gw; row < nrows; row += NGW) norm_rows<MODE, CTXSUM, 1>(F, g, layer, which, row);
    for (int row0 = gw * 8; row0 < TL; row0 += NGW * 8) norm_rows<MODE, 0, 8>(F, g, layer, which, row0);
}

template <class Epi>
__device__ __forceinline__ void gemm_simple(const Frame& F, const bf16* A, const bf16* Bt, int M, int N, int K, const Epi& E) {
    const int nN = N / 128, nU = (M / 256) * nN;
    const int wr = F.wave >> 1, wc = F.wave & 1, fr = F.lane & 15, fq = F.lane >> 4;
    for (int u = F.vcu; u < nU; u += F.G) {
        const int pm = u / nN, pn = u % nN, row0 = pm * 256 + wr * 64, col0 = pn * 128 + wc * 64;
        f32x4 acc[4][4];
#pragma unroll
        for (int i = 0; i < 4; ++i)
#pragma unroll
            for (int j = 0; j < 4; ++j) acc[i][j] = (f32x4){0.f, 0.f, 0.f, 0.f};
        const bf16* ap = A + (size_t)(row0 + fr) * K + fq * 8;
        const bf16* bp0 = Bt + (size_t)(col0 + perm32(fr)) * K + fq * 8;
        const bf16* bp1 = Bt + (size_t)(col0 + perm32(16 + fr)) * K + fq * 8;
#pragma unroll 2
        for (int k0 = 0; k0 < K; k0 += 32) {
            bf16x8 a[4], b[4];
#pragma unroll
            for (int i = 0; i < 4; ++i) a[i] = *(const bf16x8*)(ap + (size_t)(16 * i) * K + k0);
            b[0] = *(const bf16x8*)(bp0 + k0); b[1] = *(const bf16x8*)(bp1 + k0);
            b[2] = *(const bf16x8*)(bp0 + (size_t)32 * K + k0); b[3] = *(const bf16x8*)(bp1 + (size_t)32 * K + k0);
#pragma unroll
            for (int i = 0; i < 4; ++i)
#pragma unroll
                for (int j = 0; j < 4; ++j) acc[i][j] = __builtin_amdgcn_mfma_f32_16x16x32_bf16(b[j], a[i], acc[i][j], 0, 0, 0);
        }
#pragma unroll
        for (int i = 0; i < 4; ++i)
#pragma unroll
            for (int q = 0; q < 2; ++q) E(row0 + 16 * i + fr, col0 + 32 * q + 8 * fq, acc[i][2 * q], acc[i][2 * q + 1]);
    }
}

struct EpiStore {
    bf16* O; int ldc;
    __device__ __forceinline__ void operator()(int row, int col, f32x4 lo, f32x4 hi, int part = 0) const {
        v4u w; w.x = pk2(lo.x, lo.y); w.y = pk2(lo.z, lo.w); w.z = pk2(hi.x, hi.y); w.w = pk2(hi.z, hi.w);
        *(v4u*)(O + (size_t)row * ldc + col) = w; }
};
struct EpiSwiglu {
    bf16* O; int ldc;
    __device__ __forceinline__ void operator()(int row, int col, f32x4 alo, f32x4 ahi, f32x4 blo, f32x4 bhi) const {
        v4u w; w.x = pk2(silu_f(alo.x) * blo.x, silu_f(alo.y) * blo.y); w.y = pk2(silu_f(alo.z) * blo.z, silu_f(alo.w) * blo.w);
        w.z = pk2(silu_f(ahi.x) * bhi.x, silu_f(ahi.y) * bhi.y); w.w = pk2(silu_f(ahi.z) * bhi.z, silu_f(ahi.w) * bhi.w);
        *(v4u*)(O + (size_t)row * ldc + col) = w; }
};
template <bool BASEF32>
struct EpiResidT {
    const float* bl; const float* bc; bf16* X; const float* gate  ; const float* rs; int rs_ld, rs_off;
    __device__ __forceinline__ void operator()(int row, int col, f32x4 lo, f32x4 hi, int part = 0) const {
        const int bidx = row < TL ? (row >> 11) : 8;
        const float* gp = gate + (size_t)bidx * 6144 + col;
        float sc = 1.f; if (rs) sc = rs[(size_t)row * rs_ld + rs_off];
        const f32x4 g0 = ((const f32x4*)gp)[0] * sc, g1 = ((const f32x4*)gp)[1] * sc;
        bf16* o = X + (size_t)row * 1024 + col;
        f32x4 b0, b1;
        if (BASEF32) { const float* b = row < TL ? bl + (size_t)row * 1024 + col : bc + (size_t)(row - TL) * 1024 + col; b0 = ((const f32x4*)b)[0]; b1 = ((const f32x4*)b)[1]; }
        else { const v4u w = *(const v4u*)o; b0 = (f32x4){bflo(w.x), bfhi(w.x), bflo(w.y), bfhi(w.y)}; b1 = (f32x4){bflo(w.z), bfhi(w.z), bflo(w.w), bfhi(w.w)}; }
        const f32x4 r0 = b0 + g0 * lo, r1 = b1 + g1 * hi;
        v4u w; w.x = pk2(r0.x, r0.y); w.y = pk2(r0.z, r0.w); w.z = pk2(r1.x, r1.y); w.w = pk2(r1.z, r1.w);
        *(v4u*)o = w; }
};
typedef EpiResidT<false> EpiResid;

struct EpiRope {
    bf16* O; const LAS float* tab;
    __device__ __forceinline__ void operator()(int row, int col, f32x4 lo, f32x4 hi, int part = 0) const {
        if (row < TL && (col < 640 || (col >= 768 && col < 1792))) {
            const int d0 = (col & 63) >> 1;
            const int t = row & 2047, pos = (d0 < 16) ? (t >> 6) : 32 + (t & 63); const LAS float* tp = tab + (pos * 16 + (d0 & 15)) * 2;
            const f32x4 c01 = ((const LAS f32x4*)tp)[0], c23 = ((const LAS f32x4*)tp)[1];
            const f32x4 a = (f32x4){lo.x * c01.x - hi.x * c01.y, lo.y * c01.z - hi.y * c01.w, lo.z * c23.x - hi.z * c23.y, lo.w * c23.z - hi.w * c23.w};
            const f32x4 b = (f32x4){hi.x * c01.x + lo.x * c01.y, hi.y * c01.z + lo.y * c01.w, hi.z * c23.x + lo.z * c23.y, hi.w * c23.z + lo.w * c23.w};
            lo = a; hi = b; }
        v4u w; w.x = pk2(lo.x, lo.y); w.y = pk2(lo.z, lo.w); w.z = pk2(hi.x, hi.y); w.w = pk2(hi.z, hi.w); *(v4u*)(O + (size_t)row * LDP1 + col) = w;
    }
};
struct In1Order {
    static constexpr bool GATHER = false;
    int G, c;
    __device__ __forceinline__ bool next(int i, pg8::Unit& u) const {
        const int L0 = i * G + c; if (L0 >= 1016) return false;
        const int L = (L0 & 7) * 127 + (L0 >> 3);
        if (L < 960) { const int grp = L / 120, rem = L % 120; u.pm = grp * 8 + (rem & 7); u.pn = rem >> 3; }
        else { const int q = L - 960, j = q >> 3; u.pm = 64 + (q & 7); u.pn = (j == 0) ? 2 : 4 + j; }
        u.k0 = 0; u.nk = 0; return true; }
    __device__ __forceinline__ void a_ready(const pg8::Unit&) const {}
    __device__ __forceinline__ void done(const pg8::Unit&) const {}
};
struct EpiNull {
    __device__ __forceinline__ void operator()(int row, int col, f32x4 lo, f32x4 hi, int part = 0) const { asm volatile("" :: "v"(lo), "v"(hi), "v"(row), "v"(col)); }
};
template <class F8> struct EpiAdapt {
    static constexpr bool PERM = true, AFTER_DRAIN = false;
    F8 f;
    __device__ __forceinline__ void operator()(const pg8::f32x4 (&acc)[2][2][4][2], const pg8::Unit& u, int wr, int wc, int fr, int fq) const {
#pragma unroll
        for (int ai = 0; ai < 2; ++ai)
#pragma unroll
            for (int m = 0; m < 4; ++m) { const int row = u.pm * 256 + ai * 128 + wr * 64 + m * 16 + fr;
#pragma unroll
                for (int bj = 0; bj < 2; ++bj) f(row, u.pn * 256 + wc * 64 + bj * 32 + 8 * fq, acc[ai][bj][m][0], acc[ai][bj][m][1], u.nk != 0 ? 1 + u.k0 : 0);
                if (m & 1) asm volatile("" ::: "memory"); }
    }
};
template <class F8> struct EpiAdaptPair {
    static constexpr bool PERM = true, AFTER_DRAIN = false;
    F8 f;
    __device__ __forceinline__ void operator()(const pg8::f32x4 (&acc)[2][2][4][2], const pg8::Unit& u, int wr, int wc, int fr, int fq) const {
#pragma unroll
        for (int ai = 0; ai < 2; ++ai)
#pragma unroll
            for (int m = 0; m < 4; ++m) f(u.pm * 256 + ai * 128 + wr * 64 + m * 16 + fr, u.pn * 128 + wc * 32 + 8 * fq, acc[ai][0][m][0], acc[ai][0][m][1], acc[ai][1][m][0], acc[ai][1][m][1]);
    }
};
#ifndef USE_SIMPLE_GEMM
#define USE_SIMPLE_GEMM 0
#endif
template <class F8>
__device__ __forceinline__ void gemm_pg8(const Frame& F, const bf16* A, const bf16* Bt, int M, int N, int K, const F8& f, int ld = 0) {
#if USE_SIMPLE_GEMM
    gemm_simple(F, A, Bt, M, N, K, f);
#else
    pg8::Gemm g{A, Bt, M, N, K, ld}; pg8::StaticOrder S; S.init(M, N, F.G, (int)blockIdx.x);
    EpiAdapt<F8> E{f};
    pg8::gemm_phase<EpiAdapt<F8>, pg8::StaticOrder, true, true>(F.lds, g, S, E);
#endif
}
template <class F8>
__device__ __forceinline__ void gemm_pg8_pair(const Frame& F, const bf16* A, const bf16* Bt, int M, int N, int K, const F8& f) {
    pg8::Gemm g{A, Bt, M, N, K, 0}; pg8::StaticOrder S; S.init(M, N, F.G, (int)blockIdx.x);
    EpiAdaptPair<F8> E{f};
    pg8::gemm_phase<EpiAdaptPair<F8>, pg8::StaticOrder, true, true>(F.lds, g, S, E);
}

template <class RT>
struct EpiResidTail {
    RT R; bf16* part; int kslice;
    __device__ __forceinline__ void operator()(int row, int col, f32x4 lo, f32x4 hi, int p = 0) const {
        if (p == 0) { R(row, col, lo, hi, 0); return; }
        bf16* o = part + ((size_t)((p - 1) / kslice) * TC + (row - TL)) * 1024 + col; v4u q; q.x = pk2(lo.x, lo.y); q.y = pk2(lo.z, lo.w); q.z = pk2(hi.x, hi.y); q.w = pk2(hi.z, hi.w); *(v4u*)o = q; }
};
struct TailOrder {
    static constexpr bool GATHER = false;
    pg8::StaticOrder S0; int G, c, K;
    __device__ __forceinline__ void init(int G_, int c_, int K_) { S0.init(TL, 1024, G_, c_); G = G_; c = c_; K = K_; }
    __device__ __forceinline__ bool next(int i, pg8::Unit& u) const {
        const int r0 = (256 + G - 1) / G;
        if (i < r0) return S0.next(i, u);
        const int q = (i - r0) * G + c; if (q >= 32 * 6) return false;
        const int bu = q & 31, sl = q >> 5; u.pm = 64 + (bu >> 2); u.pn = bu & 3;
        if (K == 1536) { u.k0 = sl * 256; u.nk = 4; } else { u.k0 = sl * 512; u.nk = (sl == 5) ? 4 : 8; }
        return true; }
    __device__ __forceinline__ void a_ready(const pg8::Unit&) const {}
    __device__ __forceinline__ void done(const pg8::Unit&) const {}
};
template <class F8>
__device__ __forceinline__ void gemm_tail(const Frame& F, const bf16* A, const bf16* Bt, int K, const F8& f) {
    pg8::Gemm g{A, Bt, TT, 1024, K, 0}; TailOrder S; S.init(F.G, (int)blockIdx.x, K);
    EpiAdapt<F8> E{f};
    pg8::gemm_phase<EpiAdapt<F8>, TailOrder, true, true>(F.lds, g, S, E);
}

#define DOT64(s, q, kp) do { s = 0.f; _Pragma("unroll") for (int _c = 0; _c < 8; ++_c) { const v4u _w = ((const v4u*)(kp))[_c]; \
    s += q[8*_c+0] * bflo(_w.x) + q[8*_c+1] * bfhi(_w.x) + q[8*_c+2] * bflo(_w.y) + q[8*_c+3] * bfhi(_w.y) + q[8*_c+4] * bflo(_w.z) + q[8*_c+5] * bfhi(_w.z) + q[8*_c+6] * bflo(_w.w) + q[8*_c+7] * bfhi(_w.w); } } while (0)
#define ONLINE_UPD(s, m, l, o, vp) do { if (s > m) { const float _cr = __expf(m - s); l *= _cr; _Pragma("unroll") for (int _d = 0; _d < 64; ++_d) o[_d] *= _cr; m = s; } \
    const float _p = __expf(s - m); l += _p; _Pragma("unroll") for (int _c = 0; _c < 8; ++_c) { const v4u _w = ((const v4u*)(vp))[_c]; \
    o[8*_c+0] += _p * bflo(_w.x); o[8*_c+1] += _p * bfhi(_w.x); o[8*_c+2] += _p * bflo(_w.y); o[8*_c+3] += _p * bfhi(_w.y); o[8*_c+4] += _p * bflo(_w.z); o[8*_c+5] += _p * bfhi(_w.z); o[8*_c+6] += _p * bflo(_w.w); o[8*_c+7] += _p * bfhi(_w.w); } } while (0)
#define LOADQ64(q, qp, scale) do { _Pragma("unroll") for (int _c = 0; _c < 8; ++_c) { const v4u _w = ((const v4u*)(qp))[_c]; \
    q[8*_c+0] = scale * bflo(_w.x); q[8*_c+1] = scale * bfhi(_w.x); q[8*_c+2] = scale * bflo(_w.y); q[8*_c+3] = scale * bfhi(_w.y); q[8*_c+4] = scale * bflo(_w.z); q[8*_c+5] = scale * bfhi(_w.z); q[8*_c+6] = scale * bflo(_w.w); q[8*_c+7] = scale * bfhi(_w.w); } } while (0)
#define STORE_O64(op, o, inv) do { _Pragma("unroll") for (int _c = 0; _c < 8; ++_c) { v4u _w; _w.x = pk2(o[8*_c+0] * inv, o[8*_c+1] * inv); _w.y = pk2(o[8*_c+2] * inv, o[8*_c+3] * inv); \
    _w.z = pk2(o[8*_c+4] * inv, o[8*_c+5] * inv); _w.w = pk2(o[8*_c+6] * inv, o[8*_c+7] * inv); ((v4u*)(op))[_c] = _w; } } while (0)

__device__ __forceinline__ void ph_conv(const Frame& F) {
    constexpr int NIT = (TT / 16) * 192;
    int per = (NIT + F.G - 1) / F.G, base = F.vcu * per;
    if (F.G == 256) {
        static_assert(NIT == 256 * 864, "conv deal");
        if (F.vcu < 128) { per = 739; base = F.vcu * 739; } else { per = 989; base = 128 * 739 + (F.vcu - 128) * 989; } }
    const int lim = min(base + per, NIT);
    for (int idx = base + F.tid; idx < lim; idx += 512) {
        const int rb = idx / 192, ch = (idx % 192) * 8, row0 = rb * 16;
        int t0, len; if (row0 < TL) { t0 = row0 & 2047; len = 2048; } else { t0 = (row0 - TL) & 255; len = 256; }
        const bf16* src = F.P + (size_t)row0 * LDP0 + 2560 + ch;
        const v4u zero = (v4u){0u, 0u, 0u, 0u};
        v4u win[20];
#pragma unroll
        for (int k = 0; k < 20; ++k) { const int t = t0 - 2 + k; win[k] = (t >= 0 && t < len) ? NTL((const v4u*)(src + (ptrdiff_t)(k - 2) * LDP0)) : zero; }
        float wgt[5][8], bias[8];
#pragma unroll
        for (int k = 0; k < 5; ++k) { const f32x4 a = *(const f32x4*)(F.conv_w + k * 1536 + ch), b = *(const f32x4*)(F.conv_w + k * 1536 + ch + 4);
            wgt[k][0] = a.x; wgt[k][1] = a.y; wgt[k][2] = a.z; wgt[k][3] = a.w; wgt[k][4] = b.x; wgt[k][5] = b.y; wgt[k][6] = b.z; wgt[k][7] = b.w; }
        { const f32x4 a = *(const f32x4*)(F.conv_b + ch), b = *(const f32x4*)(F.conv_b + ch + 4); bias[0] = a.x; bias[1] = a.y; bias[2] = a.z; bias[3] = a.w; bias[4] = b.x; bias[5] = b.y; bias[6] = b.z; bias[7] = b.w; }
#pragma unroll
        for (int i = 0; i < 16; ++i) {
            float acc[8];
#pragma unroll
            for (int j = 0; j < 8; ++j) acc[j] = bias[j];
#pragma unroll
            for (int k = 0; k < 5; ++k) { const v4u wv = win[i + k];
                acc[0] += wgt[k][0] * bflo(wv.x); acc[1] += wgt[k][1] * bfhi(wv.x); acc[2] += wgt[k][2] * bflo(wv.y); acc[3] += wgt[k][3] * bfhi(wv.y);
                acc[4] += wgt[k][4] * bflo(wv.z); acc[5] += wgt[k][5] * bfhi(wv.z); acc[6] += wgt[k][6] * bflo(wv.w); acc[7] += wgt[k][7] * bfhi(wv.w); }
            v4u o; o.x = pk2(silu_f(acc[0]), silu_f(acc[1])); o.y = pk2(silu_f(acc[2]), silu_f(acc[3])); o.z = pk2(silu_f(acc[4]), silu_f(acc[5])); o.w = pk2(silu_f(acc[6]), silu_f(acc[7]));
            *((v4u*)(F.XBC + (size_t)(row0 + i) * 1536 + ch)) = o;
        }
    }
}

__device__ __forceinline__ int scan_row(int b, int d, int s) {
    if (s < 256) return TL + b * 256 + (d ? 255 - s : s);
    const int t = s - 256; return b * 2048 + (d ? 2047 - t : t);
}

typedef short s16x4 __attribute__((ext_vector_type(4)));
__device__ __forceinline__ s16x4 lds_tr(const LAS unsigned char* p) { return __builtin_bit_cast(s16x4, __builtin_amdgcn_ds_read_tr16_b64_v4i16((LAS s16x4*)p)); }
__device__ __forceinline__ bf16x8 cat8(s16x4 a, s16x4 b) { return __builtin_shufflevector(a, b, 0, 1, 2, 3, 4, 5, 6, 7); }
template <int NST, bool RET>
__device__ __forceinline__ void chunk_scan(const Frame& F) {
    constexpr int SC = NST * 2 + 16, SX = 64 * 2 + 16, SH = NST * 2 + 16, NKS = NST / 32, NHT = NST / 32, NP = NST / 32  , PPR = NST / 8  ;
    LAS unsigned char* Cs = F.lds;
    LAS unsigned char* Bs = Cs + 128 * SC;
    LAS unsigned char* Xs = Bs + 128 * SC;
    LAS unsigned char* Xw = Xs + 128 * SX;
    LAS unsigned char* Hs = Xw + 128 * SX;
    LAS float* acs = (LAS float*)(Hs + 64 * SH);
    LAS float* dts = acs + 128;
    const int w = F.wave, lane = F.lane, l15 = lane & 15, g = lane >> 4, q4 = l15 >> 2, p4 = lane & 3;
    for (int u = F.vcu; u < 256; u += F.G) {
        int d, h, b, grp = 0, ph = 0;
        if (RET) { ph = u & 1; d = (u >> 1) & 1; h = (u >> 2) & 7; b = u >> 5; } else { d = u & 1; h = (u >> 1) & 15; b = u >> 5; grp = h >> 3; }
        float dtb = 0.f, Acoef = 0.f, lgam = 0.f;
        if (RET) lgam = log1pf(-expf(F.ret_log_decay[d * 8 + h])); else { dtb = F.dt_bias[d * 16 + h]; Acoef = -expf(F.a_log[d * 16 + h]); }
        const int nt = RET ? (w & 3) : w, pt0 = RET ? 2 * (w >> 2) : 0;
        const int ycol = RET ? h * 128 + ph * 64 : h * 64;
        bf16* Y = RET ? (d ? F.YB1 : F.YF1) : (d ? F.YB0 : F.YF0);
        f32x4 Hacc[NHT];
#pragma unroll
        for (int k = 0; k < NHT; ++k) Hacc[k] = (f32x4){0.f, 0.f, 0.f, 0.f};
        __syncthreads();
        for (int idx = F.tid; idx < 64 * SH / 16; idx += 512) ((LAS v4u*)Hs)[idx] = (v4u){0u, 0u, 0u, 0u};
        v4u rc[NP], rb[NP], rx[2]; unsigned short rdt0 = 0, rdt1 = 0;
#define SCAN_ISSUE(ck_) do { \
            _Pragma("unroll") for (int k = 0; k < NP; ++k) { const int idx = F.tid + 512 * k, i = idx / PPR, c = idx % PPR; const size_t row = scan_row(b, d, (ck_) * 128 + i); \
                if (RET) { const bf16* pr = F.P + row * LDP1 + h * 64 + c * 8; rc[k] = *(const v4u*)(pr + 768); rb[k] = *(const v4u*)(pr + 1280); } \
                else { const bf16* pr = F.XBC + row * 1536 + grp * 128 + c * 8; rc[k] = *(const v4u*)(pr + 1280); rb[k] = *(const v4u*)(pr + 1024); } } \
            _Pragma("unroll") for (int k = 0; k < 2; ++k) { const int idx = F.tid + 512 * k, i = idx >> 3, c = idx & 7; const size_t row = scan_row(b, d, (ck_) * 128 + i); \
                rx[k] = RET ? *(const v4u*)(F.P + row * LDP1 + 1792 + h * 128 + ph * 64 + c * 8) : *(const v4u*)(F.XBC + row * 1536 + h * 64 + c * 8); } \
            if (!RET) { rdt0 = F.P[(size_t)scan_row(b, d, (ck_) * 128 + lane) * LDP0 + 4096 + d * 16 + h]; rdt1 = F.P[(size_t)scan_row(b, d, (ck_) * 128 + 64 + lane) * LDP0 + 4096 + d * 16 + h]; } \
        } while (0)
        SCAN_ISSUE(0);
        for (int ck = 0; ck < 18; ++ck) {
            float atot;
            { float dt0 = 1.f, dt1 = 1.f, a0 = lgam, a1 = lgam;
              if (!RET) { const float x0 = bf2f(rdt0) + dtb, x1 = bf2f(rdt1) + dtb;
                  dt0 = x0 > 20.f ? x0 : log1pf(__expf(x0)); dt1 = x1 > 20.f ? x1 : log1pf(__expf(x1)); a0 = dt0 * Acoef; a1 = dt1 * Acoef; }
              float v0 = a0, v1 = a1;
#pragma unroll
              for (int o = 1; o < 64; o <<= 1) { const float n0 = __shfl_up(v0, o), n1 = __shfl_up(v1, o); if (lane >= o) { v0 += n0; v1 += n1; } }
              v1 += __shfl(v0, 63); atot = __shfl(v1, 63);
              acs[lane] = v0; acs[64 + lane] = v1; dts[lane] = dt0; dts[64 + lane] = dt1; }
            LDS_WAIT(); asm volatile("" ::: "memory");
#pragma unroll
            for (int k = 0; k < NP; ++k) { const int idx = F.tid + 512 * k, i = idx / PPR, c = idx % PPR;
                v4u kv = rb[k];
                if (RET) { kv.x = pk2(0.125f * bflo(kv.x), 0.125f * bfhi(kv.x)); kv.y = pk2(0.125f * bflo(kv.y), 0.125f * bfhi(kv.y)); kv.z = pk2(0.125f * bflo(kv.z), 0.125f * bfhi(kv.z)); kv.w = pk2(0.125f * bflo(kv.w), 0.125f * bfhi(kv.w)); }
                *(LAS v4u*)(Cs + i * SC + c * 16) = rc[k]; *(LAS v4u*)(Bs + i * SC + c * 16) = kv; }
#pragma unroll
            for (int k = 0; k < 2; ++k) { const int idx = F.tid + 512 * k, i = idx >> 3, c = idx & 7; const v4u xv = rx[k];
                const float dtj = dts[i], wj = dtj * __expf(atot - acs[i]);
                v4u a, bq; a.x = pk2(dtj * bflo(xv.x), dtj * bfhi(xv.x)); a.y = pk2(dtj * bflo(xv.y), dtj * bfhi(xv.y)); a.z = pk2(dtj * bflo(xv.z), dtj * bfhi(xv.z)); a.w = pk2(dtj * bflo(xv.w), dtj * bfhi(xv.w));
                bq.x = pk2(wj * bflo(xv.x), wj * bfhi(xv.x)); bq.y = pk2(wj * bflo(xv.y), wj * bfhi(xv.y)); bq.z = pk2(wj * bflo(xv.z), wj * bfhi(xv.z)); bq.w = pk2(wj * bflo(xv.w), wj * bfhi(xv.w));
                *(LAS v4u*)(Xs + i * SX + c * 16) = a; *(LAS v4u*)(Xw + i * SX + c * 16) = bq; }
            if (ck + 1 < 18) SCAN_ISSUE(ck + 1);
            __syncthreads();
            if (!RET || ck >= 2) {
                const float aci = acs[16 * w + l15];
                bf16x8 Cf[NKS];
#pragma unroll
                for (int s = 0; s < NKS; ++s) Cf[s] = *(const LAS bf16x8*)(Cs + (16 * w + l15) * SC + (32 * s + 8 * g) * 2);
                f32x4 Yacc[4];
                const float eaci = __expf(aci);
#pragma unroll
                for (int pt = 0; pt < 4; ++pt) { f32x4 acc = (f32x4){0.f, 0.f, 0.f, 0.f};
#pragma unroll
                    for (int s = 0; s < NKS; ++s) { const bf16x8 hf = *(const LAS bf16x8*)(Hs + (16 * pt + l15) * SH + (32 * s + 8 * g) * 2); acc = __builtin_amdgcn_mfma_f32_16x16x32_bf16(hf, Cf[s], acc, 0, 0, 0); }
                    Yacc[pt] = acc * eaci; }
#pragma unroll
                for (int sp = 0; sp < 4; ++sp) {
                    if (2 * sp <= w) {
                        v2u Lh[2];
#pragma unroll
                        for (int hh = 0; hh < 2; ++hh) { const int jt = 2 * sp + hh;
                            if (jt <= w) { f32x4 cb = (f32x4){0.f, 0.f, 0.f, 0.f};
#pragma unroll
                                for (int s = 0; s < NKS; ++s) { const bf16x8 bf = *(const LAS bf16x8*)(Bs + (16 * jt + l15) * SC + (32 * s + 8 * g) * 2); cb = __builtin_amdgcn_mfma_f32_16x16x32_bf16(bf, Cf[s], cb, 0, 0, 0); }
                                const f32x4 acj = *(const LAS f32x4*)(acs + 16 * jt + 4 * g);
                                float val[4];
#pragma unroll
                                for (int r = 0; r < 4; ++r) { const float arg = fminf(aci - acj[r], 0.f); val[r] = cb[r] * __expf(arg); if (jt == w && (4 * g + r) > l15) val[r] = 0.f; }
                                Lh[hh].x = pk2(val[0], val[1]); Lh[hh].y = pk2(val[2], val[3]); }
                            else { Lh[hh].x = 0u; Lh[hh].y = 0u; } }
                        v4u lw; lw.x = Lh[0].x; lw.y = Lh[0].y; lw.z = Lh[1].x; lw.w = Lh[1].y;
                        const bf16x8 Lf = __builtin_bit_cast(bf16x8, lw);
#pragma unroll
                        for (int pt = 0; pt < 4; ++pt) { const s16x4 x0 = lds_tr(Xs + (32 * sp + 4 * g + q4) * SX + (16 * pt + 4 * p4) * 2), x1 = lds_tr(Xs + (32 * sp + 16 + 4 * g + q4) * SX + (16 * pt + 4 * p4) * 2);
                            Yacc[pt] = __builtin_amdgcn_mfma_f32_16x16x32_bf16(cat8(x0, x1), Lf, Yacc[pt], 0, 0, 0); }
                    }
                }
                const size_t row = scan_row(b, d, ck * 128 + 16 * w + l15);
#pragma unroll
                for (int pt = 0; pt < 4; ++pt) { v2u o; o.x = pk2(Yacc[pt].x, Yacc[pt].y); o.y = pk2(Yacc[pt].z, Yacc[pt].w); *((v2u*)(Y + row * 1024 + ycol + 16 * pt + 4 * g)) = o; }
            }
            if (ck < 17) {
                const float eat = __expf(atot);
#pragma unroll
                for (int k = 0; k < NHT; ++k) Hacc[k] = Hacc[k] * eat;
#pragma unroll
                for (int s = 0; s < 4; ++s) {
                    const s16x4 b0 = lds_tr(Bs + (32 * s + 8 * g + q4) * SC + (16 * nt + 4 * p4) * 2), b1 = lds_tr(Bs + (32 * s + 8 * g + 4 + q4) * SC + (16 * nt + 4 * p4) * 2);
                    const bf16x8 Bf = cat8(b0, b1);
#pragma unroll
                    for (int k = 0; k < NHT; ++k) { const int pt = pt0 + k;
                        const s16x4 x0 = lds_tr(Xw + (32 * s + 8 * g + q4) * SX + (16 * pt + 4 * p4) * 2), x1 = lds_tr(Xw + (32 * s + 8 * g + 4 + q4) * SX + (16 * pt + 4 * p4) * 2);
                        Hacc[k] = __builtin_amdgcn_mfma_f32_16x16x32_bf16(cat8(x0, x1), Bf, Hacc[k], 0, 0, 0); }
                }
            }
            __syncthreads();
            if (ck < 17) {
#pragma unroll
                for (int k = 0; k < NHT; ++k)
#pragma unroll
                    for (int r = 0; r < 4; ++r) *(LAS bf16*)(Hs + (16 * (pt0 + k) + 4 * g + r) * SH + (16 * nt + l15) * 2) = (bf16)f2bf(Hacc[k][r]);
            }
        }
#undef SCAN_ISSUE
    }
}

template <int MODE>
__device__ __forceinline__ void attn16(const Frame& F, int u) {
    constexpr int PITCH = MODE == 2 ? LDP1 : LDP0;
    constexpr int SV = 144, VBUF = 4608;
    LAS unsigned char* vb = F.lds + F.wave * 10240;
    LAS float* btab = (LAS float*)(vb + 2 * VBUF);
    const int lane = F.lane, l15 = lane & 15, g = lane >> 4, q4 = l15 >> 2, p4 = lane & 3;
    int b, h, nloc; size_t qrow0, locbase, ctxbase; int kcol, vcol;
    int r = 0, r0 = 0, jq = 0, kstart = 0, t0 = 0, jb_lo = 0;
    if (MODE == 0) { jq = u & 3; h = (u >> 2) & 7; r = (u >> 5) & 31; b = u >> 10; r0 = min(max(r - 4, 0), 24); kstart = min(max(16 * jq - 8, 0), 32);
        qrow0 = (size_t)b * 2048 + r * 64 + 16 * jq; locbase = (size_t)b * 2048 + r0 * 64 + kstart; nloc = 8; kcol = 512 + h * 64; vcol = 1024 + h * 64; }
    else if (MODE == 1) { const int qt = u & 15; h = (u >> 4) & 7; b = u >> 7; qrow0 = (size_t)TL + b * 256 + qt * 16; locbase = 0; nloc = 0; kcol = 512 + h * 64; vcol = 1024 + h * 64; }
    else { const int hq = u & 3, qt = (u >> 2) & 127, kvh = (u >> 9) & 1; b = u >> 10; h = kvh * 4 + hq; t0 = qt * 16; qrow0 = (size_t)b * 2048 + t0;
        jb_lo = max(t0 - 128, 0) >> 5; const int jb_hi = min(t0 + 15 + 128, 2047) >> 5; nloc = jb_hi - jb_lo + 1; locbase = (size_t)b * 2048 + jb_lo * 32; kcol = 512 + kvh * 64; vcol = 640 + kvh * 64; }
    ctxbase = (size_t)TL + b * 256;
    const int nblk = nloc + 8, nit = (nblk + 1) >> 1;
    const bf16* P = F.P;
    if (MODE == 0) {
#pragma unroll
        for (int k = 0; k < 4; ++k) { const int i = lane + 64 * k, kb = i >> 5, c = i & 31; btab[i] = (c < 31) ? F.na_rpb[(h * 15 + (r0 - r + 7 + kb)) * 31 + c] : 0.f; } }
    bf16x8 qf[2];
#pragma unroll
    for (int s = 0; s < 2; ++s) { const v4u w = *(const v4u*)(P + (qrow0 + l15) * PITCH + h * 64 + 32 * s + 8 * g); v4u o;
        o.x = pk2(0.125f * bflo(w.x), 0.125f * bfhi(w.x)); o.y = pk2(0.125f * bflo(w.y), 0.125f * bfhi(w.y)); o.z = pk2(0.125f * bflo(w.z), 0.125f * bfhi(w.z)); o.w = pk2(0.125f * bflo(w.w), 0.125f * bfhi(w.w));
        qf[s] = __builtin_bit_cast(bf16x8, o); }
    int dc[2][4]; bool okc[2][4];
    if (MODE == 0) { const int qc = 16 * jq + l15, c0 = min(max(qc - 8, 0), 48);
#pragma unroll
        for (int t = 0; t < 2; ++t)
#pragma unroll
            for (int rr = 0; rr < 4; ++rr) { const int kc = kstart + 16 * t + 4 * g + rr; okc[t][rr] = (kc >= c0) && (kc < c0 + 16); dc[t][rr] = min(max(kc - qc + 15, 0), 30); } }
    f32x4 oacc[4];
#pragma unroll
    for (int dt = 0; dt < 4; ++dt) oacc[dt] = (f32x4){0.f, 0.f, 0.f, 0.f};
    float m = -INFINITY, lsum = 0.f;
    bf16x8 kf[2][2][2]; v4u vr[2][4];
#define ATT_LOAD(it_) do { _Pragma("unroll") for (int bb = 0; bb < 2; ++bb) { int kb_ = 2 * (it_) + bb; kb_ = kb_ < nblk ? kb_ : nblk - 1; \
        const size_t rb_ = (kb_ < nloc) ? locbase + (MODE == 0 ? kb_ * 64 : kb_ * 32) : ctxbase + (kb_ - nloc) * 32; \
        _Pragma("unroll") for (int t = 0; t < 2; ++t) _Pragma("unroll") for (int s = 0; s < 2; ++s) kf[bb][t][s] = *(const bf16x8*)(P + (rb_ + 16 * t + l15) * PITCH + kcol + 32 * s + 8 * g); \
        _Pragma("unroll") for (int k = 0; k < 4; ++k) { const int idx = lane + 64 * k; vr[bb][k] = *(const v4u*)(P + (rb_ + (idx >> 3)) * PITCH + vcol + (idx & 7) * 8); } } } while (0)
    ATT_LOAD(0);
    for (int it = 0; it < nit; ++it) {
        f32x4 st[2][2];
#pragma unroll
        for (int bb = 0; bb < 2; ++bb)
#pragma unroll
            for (int t = 0; t < 2; ++t) { f32x4 a = (f32x4){0.f, 0.f, 0.f, 0.f}; a = __builtin_amdgcn_mfma_f32_16x16x32_bf16(kf[bb][t][0], qf[0], a, 0, 0, 0); st[bb][t] = __builtin_amdgcn_mfma_f32_16x16x32_bf16(kf[bb][t][1], qf[1], a, 0, 0, 0); }
#pragma unroll
        for (int bb = 0; bb < 2; ++bb)
#pragma unroll
            for (int k = 0; k < 4; ++k) { const int idx = lane + 64 * k; *(LAS v4u*)(vb + bb * VBUF + (idx >> 3) * SV + (idx & 7) * 16) = vr[bb][k]; }
        asm volatile("" ::: "memory");
        if (it + 1 < nit) ATT_LOAD(it + 1);
#pragma unroll
        for (int bb = 0; bb < 2; ++bb) { const int kb = 2 * it + bb;
            if (kb >= nblk) {
#pragma unroll
                for (int t = 0; t < 2; ++t) st[bb][t] = (f32x4){-INFINITY, -INFINITY, -INFINITY, -INFINITY}; }
            else if (kb < nloc) {
                if (MODE == 0) {
#pragma unroll
                    for (int t = 0; t < 2; ++t)
#pragma unroll
                        for (int rr = 0; rr < 4; ++rr) st[bb][t][rr] = okc[t][rr] ? st[bb][t][rr] + btab[kb * 32 + dc[t][rr]] : -INFINITY; }
                if (MODE == 2) { const int tq = t0 + l15;
#pragma unroll
                    for (int t = 0; t < 2; ++t)
#pragma unroll
                        for (int rr = 0; rr < 4; ++rr) { const int dj = tq - ((jb_lo + kb) * 32 + 16 * t + 4 * g + rr); if (dj > 128 || dj < -128) st[bb][t][rr] = -INFINITY; } }
            } }
        float mx = -INFINITY;
#pragma unroll
        for (int bb = 0; bb < 2; ++bb)
#pragma unroll
            for (int t = 0; t < 2; ++t) mx = fmaxf(mx, fmaxf(fmaxf(st[bb][t][0], st[bb][t][1]), fmaxf(st[bb][t][2], st[bb][t][3])));
        mx = fmaxf(mx, __shfl_xor(mx, 16)); mx = fmaxf(mx, __shfl_xor(mx, 32));
        const float mn = fmaxf(m, mx), mu = (mn == -INFINITY) ? 0.f : mn;
        const float corr = __expf(m - mu);
        m = mn;
        float ps = 0.f; bf16x8 pf[2];
#pragma unroll
        for (int bb = 0; bb < 2; ++bb) { float p[8];
#pragma unroll
            for (int t = 0; t < 2; ++t)
#pragma unroll
                for (int rr = 0; rr < 4; ++rr) { p[4 * t + rr] = __expf(st[bb][t][rr] - mu); ps += p[4 * t + rr]; }
            v4u pw; pw.x = pk2(p[0], p[1]); pw.y = pk2(p[2], p[3]); pw.z = pk2(p[4], p[5]); pw.w = pk2(p[6], p[7]); pf[bb] = __builtin_bit_cast(bf16x8, pw); }
        lsum = lsum * corr + ps;
#pragma unroll
        for (int dt = 0; dt < 4; ++dt) { oacc[dt] = oacc[dt] * corr;
#pragma unroll
            for (int bb = 0; bb < 2; ++bb) {
                const s16x4 v0 = lds_tr(vb + bb * VBUF + (4 * g + q4) * SV + (16 * dt + 4 * p4) * 2), v1 = lds_tr(vb + bb * VBUF + (16 + 4 * g + q4) * SV + (16 * dt + 4 * p4) * 2);
                oacc[dt] = __builtin_amdgcn_mfma_f32_16x16x32_bf16(cat8(v0, v1), pf[bb], oacc[dt], 0, 0, 0); } }
        asm volatile("" ::: "memory");
    }
#undef ATT_LOAD
    lsum += __shfl_xor(lsum, 16); lsum += __shfl_xor(lsum, 32);
    if (MODE == 2) { const float sk = F.swa_sink[h]; const float mn = fmaxf(m, sk); const float corr = __expf(m - mn); lsum = lsum * corr + __expf(sk - mn);
#pragma unroll
        for (int dt = 0; dt < 4; ++dt) oacc[dt] = oacc[dt] * corr; }
    const float inv = 1.f / lsum;
    bf16* orow = (MODE == 2 ? F.YA1 + (qrow0 + l15) * LDYA1 : F.YA0 + (qrow0 + l15) * 1536) + h * 64;
#pragma unroll
    for (int dt = 0; dt < 4; ++dt) { v2u o; o.x = pk2(oacc[dt].x * inv, oacc[dt].y * inv); o.y = pk2(oacc[dt].z * inv, oacc[dt].w * inv); *((v2u*)(orow + 16 * dt + 4 * g)) = o; }
}
template <int NST, bool RET>
__device__ __forceinline__ void chunk_scan2(const Frame& F) {
    constexpr int SB = NST * 2 + 16, SX = 64 * 2 + 16, SH = NST * 2 + 16, NKS = NST / 32, NHT = NST / 32, NP = NST / 32, PPR = NST / 8;
    constexpr int BSZ = 128 * SB, XSZ = 128 * SX, HSZ = 64 * SH;
    LAS unsigned char* Bs0 = F.lds;
    LAS unsigned char* Xs0 = Bs0 + 2 * BSZ;
    LAS unsigned char* Hs0 = Xs0 + 2 * XSZ;
    LAS float* acs0 = (LAS float*)(Hs0 + 2 * HSZ);
    LAS float* wsc0 = acs0 + 256;
    LAS float* dts0 = wsc0 + 256;
    static_assert(2 * BSZ + 2 * XSZ + 2 * HSZ + 3072 <= LDSCTL_OFF, "chunk_scan2 LDS");
    const int w = F.wave, lane = F.lane, l15 = lane & 15, g = lane >> 4, q4 = l15 >> 2, p4 = lane & 3;
    for (int u = F.vcu; u < 256; u += F.G) {
        int d, h, b, grp = 0, ph = 0;
        if (RET) { ph = u & 1; d = (u >> 1) & 1; h = (u >> 2) & 7; b = u >> 5; } else { d = u & 1; h = (u >> 1) & 15; b = u >> 5; grp = h >> 3; }
        float dtb = 0.f, Acoef = 0.f, lgam = 0.f;
        if (RET) lgam = log1pf(-expf(F.ret_log_decay[d * 8 + h])); else { dtb = F.dt_bias[d * 16 + h]; Acoef = -expf(F.a_log[d * 16 + h]); }
        const int nt = RET ? (w & 3) : w, pt0 = RET ? 2 * (w >> 2) : 0;
        const int ycol = RET ? h * 128 + ph * 64 : h * 64;
        bf16* Y = RET ? (d ? F.YB1 : F.YF1) : (d ? F.YB0 : F.YF0);
        f32x4 Hacc[NHT];
#pragma unroll
        for (int k = 0; k < NHT; ++k) Hacc[k] = (f32x4){0.f, 0.f, 0.f, 0.f};
        __syncthreads();
        for (int idx = F.tid; idx < HSZ / 16; idx += 512) ((LAS v4u*)Hs0)[idx] = (v4u){0u, 0u, 0u, 0u};
        if (RET && F.tid < 256) { const int i = F.tid & 127, bb = F.tid >> 7;
            acs0[bb * 128 + i] = (float)(i + 1) * lgam * 1.4426950408889634f; wsc0[bb * 128 + i] = __expf((float)(127 - i) * lgam); dts0[bb * 128 + i] = 1.f; }
        v4u rb[NP], rx[2]; bf16x8 rc[NKS], cf[NKS]; unsigned short rdt0 = 0, rdt1 = 0;
#define SC2_ISSUE_BX(ck_) do { \
            _Pragma("unroll") for (int k = 0; k < NP; ++k) { const int idx = F.tid + 512 * k, i = idx / PPR, c = idx % PPR; const size_t row = scan_row(b, d, (ck_) * 128 + i); \
                rb[k] = RET ? *(const v4u*)(F.P + row * LDP1 + 1280 + h * 64 + c * 8) : *(const v4u*)(F.XBC + row * 1536 + 1024 + grp * 128 + c * 8); } \
            _Pragma("unroll") for (int k = 0; k < 2; ++k) { const int idx = F.tid + 512 * k, i = idx >> 3, c = idx & 7; const size_t row = scan_row(b, d, (ck_) * 128 + i); \
                rx[k] = RET ? *(const v4u*)(F.P + row * LDP1 + 1792 + h * 128 + ph * 64 + c * 8) : *(const v4u*)(F.XBC + row * 1536 + h * 64 + c * 8); } \
            if (!RET && w == 0) { rdt0 = F.P[(size_t)scan_row(b, d, (ck_) * 128 + lane) * LDP0 + 4096 + d * 16 + h]; rdt1 = F.P[(size_t)scan_row(b, d, (ck_) * 128 + 64 + lane) * LDP0 + 4096 + d * 16 + h]; } \
        } while (0)
#define SC2_ISSUE_C(ck_) do { const size_t row = scan_row(b, d, (ck_) * 128 + 16 * w + l15); \
            _Pragma("unroll") for (int s = 0; s < NKS; ++s) rc[s] = RET ? *(const bf16x8*)(F.P + row * LDP1 + 768 + h * 64 + 32 * s + 8 * g) : *(const bf16x8*)(F.XBC + row * 1536 + 1280 + grp * 128 + 32 * s + 8 * g); } while (0)
#define SC2_STAGE(bi_) do { LAS unsigned char* Bs = Bs0 + (bi_) * BSZ; LAS unsigned char* Xs = Xs0 + (bi_) * XSZ; \
            if (!RET && w == 0) { LAS float* acs = acs0 + (bi_) * 128; LAS float* wsc = wsc0 + (bi_) * 128; LAS float* dts = dts0 + (bi_) * 128; \
                const float x0 = bf2f(rdt0) + dtb, x1 = bf2f(rdt1) + dtb; const float dt0 = x0 > 20.f ? x0 : log1pf(__expf(x0)), dt1 = x1 > 20.f ? x1 : log1pf(__expf(x1)); \
                float v0 = dt0 * Acoef, v1 = dt1 * Acoef; \
                _Pragma("unroll") for (int o = 1; o < 64; o <<= 1) { const float n0 = __shfl_up(v0, o), n1 = __shfl_up(v1, o); if (lane >= o) { v0 += n0; v1 += n1; } } \
                v1 += __shfl(v0, 63); const float atot_ = __shfl(v1, 63); \
                acs[lane] = v0 * 1.4426950408889634f; acs[64 + lane] = v1 * 1.4426950408889634f; wsc[lane] = dt0 * __expf(atot_ - v0); wsc[64 + lane] = dt1 * __expf(atot_ - v1); dts[lane] = dt0; dts[64 + lane] = dt1; } \
            _Pragma("unroll") for (int k = 0; k < NP; ++k) { const int idx = F.tid + 512 * k, i = idx / PPR, c = idx % PPR; v4u kv = rb[k]; \
                if (RET) { kv.x = pk2(0.125f * bflo(kv.x), 0.125f * bfhi(kv.x)); kv.y = pk2(0.125f * bflo(kv.y), 0.125f * bfhi(kv.y)); kv.z = pk2(0.125f * bflo(kv.z), 0.125f * bfhi(kv.z)); kv.w = pk2(0.125f * bflo(kv.w), 0.125f * bfhi(kv.w)); } \
                *(LAS v4u*)(Bs + i * SB + c * 16) = kv; } \
            _Pragma("unroll") for (int k = 0; k < 2; ++k) { const int idx = F.tid + 512 * k, i = idx >> 3, c = idx & 7; *(LAS v4u*)(Xs + i * SX + c * 16) = rx[k]; } \
        } while (0)
        SC2_ISSUE_BX(0); SC2_ISSUE_C(0);
        SC2_STAGE(0);
#pragma unroll
        for (int s = 0; s < NKS; ++s) cf[s] = rc[s];
        SC2_ISSUE_BX(1); SC2_ISSUE_C(1);
        __syncthreads();
        for (int ck = 0; ck < 18; ++ck) {
            const int bi = ck & 1;
            if (ck + 1 < 18) { SC2_STAGE(bi ^ 1); if (ck + 2 < 18) SC2_ISSUE_BX(ck + 2); }
            const LAS unsigned char* Bs = Bs0 + bi * BSZ; const LAS unsigned char* Xs = Xs0 + bi * XSZ; const LAS unsigned char* Hs = Hs0 + bi * HSZ;
            const LAS float* acs = acs0 + bi * 128; const LAS float* wsc = wsc0 + bi * 128; const LAS float* dts = dts0 + bi * 128;
            const bool do_y = !RET || ck >= 2, do_h = ck < 17;
            const float aci = acs[16 * w + l15];
            f32x4 Yacc[4];
            if (do_y) { const float eaci = __builtin_amdgcn_exp2f(aci);
#pragma unroll
                for (int pt = 0; pt < 4; ++pt) { f32x4 acc = (f32x4){0.f, 0.f, 0.f, 0.f};
#pragma unroll
                    for (int s = 0; s < NKS; ++s) { const bf16x8 hf = *(const LAS bf16x8*)(Hs + (16 * pt + l15) * SH + (32 * s + 8 * g) * 2); acc = __builtin_amdgcn_mfma_f32_16x16x32_bf16(hf, cf[s], acc, 0, 0, 0); }
                    Yacc[pt] = acc * eaci; } }
            if (do_h) { const float eat = __builtin_amdgcn_exp2f(acs[127]);
#pragma unroll
                for (int k = 0; k < NHT; ++k) Hacc[k] = Hacc[k] * eat; }
#pragma unroll
            for (int sp = 0; sp < 4; ++sp) {
                s16x4 xa[4], xb[4];
#pragma unroll
                for (int pt = 0; pt < 4; ++pt) { xa[pt] = lds_tr(Xs + (32 * sp + 4 * g + q4) * SX + (16 * pt + 4 * p4) * 2); xb[pt] = lds_tr(Xs + (32 * sp + 16 + 4 * g + q4) * SX + (16 * pt + 4 * p4) * 2); }
                if (do_y && 2 * sp <= w) {
                    v2u Lh[2]; f32x4 cb[2] = {(f32x4){0.f, 0.f, 0.f, 0.f}, (f32x4){0.f, 0.f, 0.f, 0.f}};
#pragma unroll
                    for (int s = 0; s < NKS; ++s)
#pragma unroll
                        for (int hh = 0; hh < 2; ++hh) { const bf16x8 bf = *(const LAS bf16x8*)(Bs + (16 * (2 * sp + hh) + l15) * SB + (32 * s + 8 * g) * 2); cb[hh] = __builtin_amdgcn_mfma_f32_16x16x32_bf16(bf, cf[s], cb[hh], 0, 0, 0); }
#pragma unroll
                    for (int hh = 0; hh < 2; ++hh) { const int jt = 2 * sp + hh;
                        const f32x4 acj = *(const LAS f32x4*)(acs + 16 * jt + 4 * g);
                        f32x4 dj = (f32x4){1.f, 1.f, 1.f, 1.f}; if (!RET) dj = *(const LAS f32x4*)(dts + 16 * jt + 4 * g);
                        float val[4];
#pragma unroll
                        for (int r = 0; r < 4; ++r) { val[r] = cb[hh][r] * __builtin_amdgcn_exp2f(aci - acj[r]) * dj[r]; if (jt > w || (jt == w && (4 * g + r) > l15)) val[r] = 0.f; }
                        Lh[hh].x = pk2(val[0], val[1]); Lh[hh].y = pk2(val[2], val[3]); }
                    v4u lw; lw.x = Lh[0].x; lw.y = Lh[0].y; lw.z = Lh[1].x; lw.w = Lh[1].y;
                    const bf16x8 Lf = __builtin_bit_cast(bf16x8, lw);
#pragma unroll
                    for (int pt = 0; pt < 4; ++pt) Yacc[pt] = __builtin_amdgcn_mfma_f32_16x16x32_bf16(cat8(xa[pt], xb[pt]), Lf, Yacc[pt], 0, 0, 0);
                }
                if (do_h) {
                    const v2u b0 = __builtin_bit_cast(v2u, lds_tr(Bs + (32 * sp + 4 * g + q4) * SB + (16 * nt + 4 * p4) * 2)), b1 = __builtin_bit_cast(v2u, lds_tr(Bs + (32 * sp + 16 + 4 * g + q4) * SB + (16 * nt + 4 * p4) * 2));
                    const f32x4 w0 = *(const LAS f32x4*)(wsc + 32 * sp + 4 * g), w1 = *(const LAS f32x4*)(wsc + 32 * sp + 16 + 4 * g);
                    v4u bw; bw.x = pk2(w0.x * bflo(b0.x), w0.y * bfhi(b0.x)); bw.y = pk2(w0.z * bflo(b0.y), w0.w * bfhi(b0.y)); bw.z = pk2(w1.x * bflo(b1.x), w1.y * bfhi(b1.x)); bw.w = pk2(w1.z * bflo(b1.y), w1.w * bfhi(b1.y));
                    const bf16x8 Bf = __builtin_bit_cast(bf16x8, bw);
#pragma unroll
                    for (int k = 0; k < NHT; ++k) { const bf16x8 xf = RET ? (pt0 == 0 ? cat8(xa[k], xb[k]) : cat8(xa[2 + (k & 1)], xb[2 + (k & 1)])) : cat8(xa[k & 3], xb[k & 3]);
                        Hacc[k] = __builtin_amdgcn_mfma_f32_16x16x32_bf16(xf, Bf, Hacc[k], 0, 0, 0); }
                }
            }
            if (do_y) { const size_t row = scan_row(b, d, ck * 128 + 16 * w + l15);
#pragma unroll
                for (int pt = 0; pt < 4; ++pt) { v2u o; o.x = pk2(Yacc[pt].x, Yacc[pt].y); o.y = pk2(Yacc[pt].z, Yacc[pt].w); *(v2u*)(Y + row * 1024 + ycol + 16 * pt + 4 * g) = o; } }
            if (do_h) { LAS unsigned char* Hn = Hs0 + (bi ^ 1) * HSZ;
#pragma unroll
                for (int k = 0; k < NHT; ++k)
#pragma unroll
                    for (int r = 0; r < 4; ++r) *(LAS bf16*)(Hn + (16 * (pt0 + k) + 4 * g + r) * SH + (16 * nt + l15) * 2) = (bf16)f2bf(Hacc[k][r]); }
#pragma unroll
            for (int s = 0; s < NKS; ++s) cf[s] = rc[s];
            if (ck + 2 < 18) SC2_ISSUE_C(ck + 2);
            __syncthreads();
        }
#undef SC2_ISSUE_BX
#undef SC2_ISSUE_C
#undef SC2_STAGE
    }
}

__device__ __forceinline__ float xrow16_max(float x) {
    auto s = __builtin_amdgcn_permlane16_swap(__float_as_uint(x), __float_as_uint(x), false, false);
    x = fmaxf(__uint_as_float(s[0]), __uint_as_float(s[1]));
    auto t = __builtin_amdgcn_permlane32_swap(__float_as_uint(x), __float_as_uint(x), false, false);
    return fmaxf(__uint_as_float(t[0]), __uint_as_float(t[1]));
}
__device__ __forceinline__ float xrow16_sum(float x) {
    auto s = __builtin_amdgcn_permlane16_swap(__float_as_uint(x), __float_as_uint(x), false, false);
    x = __uint_as_float(s[0]) + __uint_as_float(s[1]);
    auto t = __builtin_amdgcn_permlane32_swap(__float_as_uint(x), __float_as_uint(x), false, false);
    return __uint_as_float(t[0]) + __uint_as_float(t[1]);
}
template <int N> struct IntC { static constexpr int value = N; };
template <int MODE>
__device__ __forceinline__ void attn_wg(const Frame& F, int item) {
    constexpr int PITCH = MODE == 2 ? LDP1 : LDP0;
    constexpr int SK = 144, TILE = 64 * SK, BUFB = 4 * TILE, NPC = 4;
    LAS unsigned char* lds = F.lds;
    LAS float* btab = (LAS float*)(F.lds + 2 * BUFB) + F.wave * 256;
    const int w = F.wave, lane = F.lane, l15 = lane & 15, g = lane >> 4, q4 = l15 >> 2, p4 = lane & 3;
    int b, h, nloc, kcol0, vcol0; size_t qrow0;
    int r = 0, r0w = 0, jq = 0, kstart = 0, ku0 = 0, t0w = 0, jb_lo = 0;
    if (MODE == 0) { const int rp = item & 15; h = (item >> 4) & 7; b = item >> 7; jq = w & 3; r = 2 * rp + (w >> 2); r0w = min(max(r - 4, 0), 24); kstart = min(max(16 * jq - 8, 0), 32);
        ku0 = min(max(2 * rp - 4, 0), 24); const int ku1 = min(max(2 * rp + 1 - 4, 0), 24) + 7; nloc = (ku1 - ku0 + 2) >> 1;
        qrow0 = (size_t)b * 2048 + r * 64 + 16 * jq; kcol0 = 512 + h * 64; vcol0 = 1024 + h * 64; }
    else if (MODE == 1) { const int qg = item & 1; h = (item >> 1) & 7; b = item >> 4; qrow0 = (size_t)TL + b * 256 + qg * 128 + w * 16; nloc = 0; kcol0 = 512 + h * 64; vcol0 = 1024 + h * 64; }
    else { const int qg = item & 63, kvh = (item >> 6) & 1; b = item >> 7; h = kvh * 4 + (w & 3); const int t0 = qg * 32; t0w = t0 + 16 * (w >> 2); qrow0 = (size_t)b * 2048 + t0w;
        jb_lo = max(t0 - 128, 0) >> 7; const int jb_hi = min(t0 + 31 + 128, 2047) >> 7; nloc = jb_hi - jb_lo + 1; kcol0 = 512 + kvh * 64; vcol0 = 640 + kvh * 64; }
    const int nst = nloc + 2;
    const bf16* P = F.P;
    __syncthreads();
    if (MODE == 0) {
#pragma unroll
        for (int k = 0; k < 4; ++k) { const int i = lane + 64 * k, kb = i >> 5, c = i & 31; btab[i] = (c < 31) ? F.na_rpb[(h * 15 + (r0w - r + 7 + kb)) * 31 + c] * 1.4426950408889634f : 0.f; } }
    constexpr float QS = 0.125f * 1.4426950408889634f;
    bf16x8 qf[2];
#pragma unroll
    for (int s = 0; s < 2; ++s) { const v4u wv = *(const v4u*)(P + (qrow0 + l15) * PITCH + h * 64 + 32 * s + 8 * g); v4u o;
        o.x = pk2(QS * bflo(wv.x), QS * bfhi(wv.x)); o.y = pk2(QS * bflo(wv.y), QS * bfhi(wv.y)); o.z = pk2(QS * bflo(wv.z), QS * bfhi(wv.z)); o.w = pk2(QS * bflo(wv.w), QS * bfhi(wv.w));
        qf[s] = __builtin_bit_cast(bf16x8, o); }
    int dc[2][4]; bool okc[2][4];
    if (MODE == 0) { const int qc = 16 * jq + l15, c0 = min(max(qc - 8, 0), 48);
#pragma unroll
        for (int t = 0; t < 2; ++t)
#pragma unroll
            for (int rr = 0; rr < 4; ++rr) { const int kc = kstart + 16 * t + 4 * g + rr; okc[t][rr] = (kc >= c0) && (kc < c0 + 16); dc[t][rr] = min(max(kc - qc + 15, 0), 30); } }
    f32x4 oacc[4];
#pragma unroll
    for (int dt = 0; dt < 4; ++dt) oacc[dt] = (f32x4){0.f, 0.f, 0.f, 0.f};
    float m = -INFINITY, lsum = 0.f;
    v4u pre[NPC];
#define AWG_LOAD(dst_, st_) do { _Pragma("unroll") for (int k = 0; k < NPC; ++k) { const int idx = F.tid + 512 * k, which = idx >> 10, tile = (idx >> 9) & 1, key = (idx & 511) >> 3, c = idx & 7; size_t row_; \
            if ((st_) < nloc) row_ = (MODE == 0) ? (size_t)b * 2048 + min(ku0 + 2 * (st_) + tile, 31) * 64 + key : (size_t)b * 2048 + (jb_lo + (st_)) * 128 + tile * 64 + key; \
            else row_ = (size_t)TL + b * 256 + ((st_) - nloc) * 128 + tile * 64 + key; \
            dst_[k] = *(const v4u*)(P + row_ * PITCH + (which ? vcol0 : kcol0) + c * 8); } } while (0)
#define AWG_STORE(buf_) do { _Pragma("unroll") for (int k = 0; k < NPC; ++k) { const int idx = F.tid + 512 * k, which = idx >> 10, tile = (idx >> 9) & 1, key = (idx & 511) >> 3, c = idx & 7; \
            *(LAS v4u*)(lds + (buf_) * BUFB + (which * 2 + tile) * TILE + key * SK + c * 16) = pre[k]; } } while (0)
    AWG_LOAD(pre, 0); AWG_STORE(0);
    __syncthreads();
    for (int st = 0; st < nst; ++st) {
        if (st + 1 < nst) AWG_LOAD(pre, st + 1);
        const LAS unsigned char* Kb = lds + (st & 1) * BUFB;
        const LAS unsigned char* Vb = Kb + 2 * TILE;
        const bool loc = st < nloc;
        auto body = [&](auto LOCc, const int hf) __attribute__((always_inline)) {
            constexpr bool LOC = decltype(LOCc)::value != 0;
            f32x4 sc[2][2]; bool bval[2]; int kbv[2];
#pragma unroll
            for (int bb = 0; bb < 2; ++bb) { int kb = 0; bool valid = true;
                if (MODE == 0 && LOC) { const int krow = ku0 + 2 * st + bb; kb = krow - r0w; valid = (kb >= 0) && (kb < 8); }
                if (MODE == 2 && LOC) { const int j0 = (jb_lo + st) * 128 + 64 * hf + 32 * bb; valid = (j0 + 31 >= t0w - 128) && (j0 <= t0w + 15 + 128); }
                bval[bb] = valid; kbv[bb] = kb; }
            auto sblk = [&](const int bb) __attribute__((always_inline)) {
                const int tile = (MODE == 0 && LOC) ? bb : hf, koff = (MODE == 0 && LOC) ? kstart : 32 * bb;
                float bv[2][4];
                if (MODE == 0 && LOC) {
#pragma unroll
                    for (int t = 0; t < 2; ++t)
#pragma unroll
                        for (int rr = 0; rr < 4; ++rr) bv[t][rr] = btab[kbv[bb] * 32 + dc[t][rr]];
                    asm volatile("" : "+v"(bv[0][0]), "+v"(bv[0][1]), "+v"(bv[0][2]), "+v"(bv[0][3]), "+v"(bv[1][0]), "+v"(bv[1][1]), "+v"(bv[1][2]), "+v"(bv[1][3])); }
#pragma unroll
                for (int t = 0; t < 2; ++t) { const LAS unsigned char* kp = Kb + tile * TILE + (koff + 16 * t + l15) * SK + 8 * g * 2;
                    f32x4 a = (f32x4){0.f, 0.f, 0.f, 0.f}; a = __builtin_amdgcn_mfma_f32_16x16x32_bf16(*(const LAS bf16x8*)kp, qf[0], a, 0, 0, 0); sc[bb][t] = __builtin_amdgcn_mfma_f32_16x16x32_bf16(*(const LAS bf16x8*)(kp + 64), qf[1], a, 0, 0, 0); }
                if (MODE == 0 && LOC) {
#pragma unroll
                    for (int t = 0; t < 2; ++t)
#pragma unroll
                        for (int rr = 0; rr < 4; ++rr) sc[bb][t][rr] = okc[t][rr] ? sc[bb][t][rr] + bv[t][rr] : -INFINITY; }
                if (MODE == 2 && LOC) { const int tq = t0w + l15;
#pragma unroll
                    for (int t = 0; t < 2; ++t)
#pragma unroll
                        for (int rr = 0; rr < 4; ++rr) { const int dj = tq - ((jb_lo + st) * 128 + 64 * hf + 32 * bb + 16 * t + 4 * g + rr); if (dj > 128 || dj < -128) sc[bb][t][rr] = -INFINITY; } }
            };
            if (!LOC || (bval[0] && bval[1])) { sblk(0); sblk(1); }
            else {
#pragma unroll
                for (int bb = 0; bb < 2; ++bb) {
                    if (bval[bb]) sblk(bb);
                    else {
#pragma unroll
                        for (int t = 0; t < 2; ++t) sc[bb][t] = (f32x4){-INFINITY, -INFINITY, -INFINITY, -INFINITY}; } } }
            float mx = -INFINITY;
#pragma unroll
            for (int bb = 0; bb < 2; ++bb)
#pragma unroll
                for (int t = 0; t < 2; ++t) mx = fmaxf(mx, fmaxf(fmaxf(sc[bb][t][0], sc[bb][t][1]), fmaxf(sc[bb][t][2], sc[bb][t][3])));
            mx = xrow16_max(mx);
            const float mn = fmaxf(m, mx), mu = (mn == -INFINITY) ? 0.f : mn;
            const float corr = __builtin_amdgcn_exp2f(m - mu);
            m = mn;
            float ps = 0.f; bf16x8 pf[2];
#pragma unroll
            for (int bb = 0; bb < 2; ++bb) { float p[8];
#pragma unroll
                for (int t = 0; t < 2; ++t)
#pragma unroll
                    for (int rr = 0; rr < 4; ++rr) { p[4 * t + rr] = __builtin_amdgcn_exp2f(sc[bb][t][rr] - mu); ps += p[4 * t + rr]; }
                v4u pw; pw.x = pk2(p[0], p[1]); pw.y = pk2(p[2], p[3]); pw.z = pk2(p[4], p[5]); pw.w = pk2(p[6], p[7]); pf[bb] = __builtin_bit_cast(bf16x8, pw); }
            lsum = lsum * corr + ps;
#pragma unroll
            for (int dt = 0; dt < 4; ++dt) oacc[dt] = oacc[dt] * corr;
#pragma unroll
            for (int bb = 0; bb < 2; ++bb) {
                if (bval[bb]) { const int tile = (MODE == 0 && LOC) ? bb : hf, koff = (MODE == 0 && LOC) ? kstart : 32 * bb;
#pragma unroll
                    for (int dt = 0; dt < 4; ++dt) { const LAS unsigned char* vp = Vb + tile * TILE + koff * SK + (16 * dt + 4 * p4) * 2;
                        const s16x4 v0 = lds_tr(vp + (4 * g + q4) * SK), v1 = lds_tr(vp + (16 + 4 * g + q4) * SK);
                        oacc[dt] = __builtin_amdgcn_mfma_f32_16x16x32_bf16(cat8(v0, v1), pf[bb], oacc[dt], 0, 0, 0); } } }
        };
        if (MODE == 0) { if (loc) body(IntC<1>{}, 0); else { body(IntC<0>{}, 0); body(IntC<0>{}, 1); } }
        else { if (loc) { body(IntC<1>{}, 0); body(IntC<1>{}, 1); } else { body(IntC<0>{}, 0); body(IntC<0>{}, 1); } }
        if (st + 1 < nst) AWG_STORE((st + 1) & 1);
        __syncthreads();
    }
#undef AWG_LOAD
#undef AWG_STORE
    lsum = xrow16_sum(lsum);
    if (MODE == 2) { const float sk = F.swa_sink[h] * 1.4426950408889634f; const float mn = fmaxf(m, sk); const float corr = __builtin_amdgcn_exp2f(m - mn); lsum = lsum * corr + __builtin_amdgcn_exp2f(sk - mn);
#pragma unroll
        for (int dt = 0; dt < 4; ++dt) oacc[dt] = oacc[dt] * corr; }
    const float inv = 1.f / lsum;
    bf16* orow = (MODE == 2 ? F.YA1 + (qrow0 + l15) * LDYA1 : F.YA0 + (qrow0 + l15) * 1536) + h * 64;
#pragma unroll
    for (int dt = 0; dt < 4; ++dt) { v2u o; o.x = pk2(oacc[dt].x * inv, oacc[dt].y * inv); o.y = pk2(oacc[dt].z * inv, oacc[dt].w * inv); *(v2u*)(orow + 16 * dt + 4 * g) = o; }
}
__device__ __forceinline__ void ph_attn0_mfma(const Frame& F) {
    for (int it = F.vcu; it < 1024; it += F.G) attn_wg<0>(F, it);
    for (int it = F.vcu; it < 128; it += F.G) attn_wg<1>(F, it);
}
__device__ __forceinline__ void ph_swa_mfma(const Frame& F) {
    for (int it = F.vcu; it < 1024; it += F.G) attn_wg<2>(F, it);
}

__device__ __forceinline__ void ph_ssmout(const Frame& F) {
    const int gw = F.vcu * NWAVES + F.wave, NGW = F.G * NWAVES;
    f32x4 gn[2][2]; float dsk[2];
#pragma unroll
    for (int grp = 0; grp < 2; ++grp) { const int ch = grp * 512 + F.lane * 8; gn[grp][0] = *(const f32x4*)(F.ssm_norm_g + ch); gn[grp][1] = *(const f32x4*)(F.ssm_norm_g + ch + 4); dsk[grp] = F.ssm_d[ch >> 6]; }
    for (int row0 = gw * 3; row0 < TT; row0 += NGW * 3) {
        v4u yf[3][2], yb[3][2], xv[3][2], zv[3][2];
#pragma unroll
        for (int r = 0; r < 3; ++r)
#pragma unroll
            for (int grp = 0; grp < 2; ++grp) { const int ch = grp * 512 + F.lane * 8; const size_t row = row0 + r;
                yf[r][grp] = NTL((const v4u*)(F.YF0 + row * 1024 + ch)); yb[r][grp] = NTL((const v4u*)(F.YB0 + row * 1024 + ch));
                xv[r][grp] = NTL((const v4u*)(F.XBC + row * 1536 + ch)); zv[r][grp] = NTL((const v4u*)(F.P + row * LDP0 + 1536 + ch)); }
#pragma unroll
        for (int r = 0; r < 3; ++r)
#pragma unroll
            for (int grp = 0; grp < 2; ++grp) { const int ch = grp * 512 + F.lane * 8;
                const unsigned yfw[4] = {yf[r][grp].x, yf[r][grp].y, yf[r][grp].z, yf[r][grp].w}, ybw[4] = {yb[r][grp].x, yb[r][grp].y, yb[r][grp].z, yb[r][grp].w};
                const unsigned xw[4] = {xv[r][grp].x, xv[r][grp].y, xv[r][grp].z, xv[r][grp].w}, zw[4] = {zv[r][grp].x, zv[r][grp].y, zv[r][grp].z, zv[r][grp].w};
                float yz[8]; float ss = 0.f;
#pragma unroll
                for (int j = 0; j < 4; ++j) {
                    const float y0 = bflo(yfw[j]) + bflo(ybw[j]) + bflo(xw[j]) * dsk[grp], y1 = bfhi(yfw[j]) + bfhi(ybw[j]) + bfhi(xw[j]) * dsk[grp];
                    yz[2 * j] = y0 * silu_f(bflo(zw[j])); yz[2 * j + 1] = y1 * silu_f(bfhi(zw[j]));
                    ss += yz[2 * j] * yz[2 * j] + yz[2 * j + 1] * yz[2 * j + 1]; }
                const float rstd = 1.0f / sqrtf(wave_sum(ss) * (1.f / 512.f) + EPS);
                const f32x4 g0 = gn[grp][0], g1 = gn[grp][1];
                v4u o; o.x = pk2(yz[0] * rstd * g0.x, yz[1] * rstd * g0.y); o.y = pk2(yz[2] * rstd * g0.z, yz[3] * rstd * g0.w);
                o.z = pk2(yz[4] * rstd * g1.x, yz[5] * rstd * g1.y); o.w = pk2(yz[6] * rstd * g1.z, yz[7] * rstd * g1.w);
                *((v4u*)(F.YA0 + (size_t)(row0 + r) * 1536 + 512 + ch)) = o; }
    }
}

__device__ __forceinline__ void ph_retout(const Frame& F) {
    const int gw = F.vcu * NWAVES + F.wave, NGW = F.G * NWAVES;
    f32x4 gg[2][2], gb[2][2];
#pragma unroll
    for (int half = 0; half < 2; ++half) { const int ch = half * 512 + F.lane * 8; gg[half][0] = *(const f32x4*)(F.ret_gn_g + ch); gg[half][1] = *(const f32x4*)(F.ret_gn_g + ch + 4); gb[half][0] = *(const f32x4*)(F.ret_gn_b + ch); gb[half][1] = *(const f32x4*)(F.ret_gn_b + ch + 4); }
    for (int row0 = gw * 2; row0 < TL; row0 += NGW * 2) {
        v4u yf[2][2], yb[2][2], gv[2][2];
#pragma unroll
        for (int r = 0; r < 2; ++r)
#pragma unroll
            for (int half = 0; half < 2; ++half) { const int ch = half * 512 + F.lane * 8; const size_t row = row0 + r;
                yf[r][half] = NTL((const v4u*)(F.YF1 + row * 1024 + ch)); yb[r][half] = NTL((const v4u*)(F.YB1 + row * 1024 + ch)); gv[r][half] = NTL((const v4u*)(F.P + row * LDP1 + 2816 + ch)); }
#pragma unroll
        for (int r = 0; r < 2; ++r)
#pragma unroll
            for (int half = 0; half < 2; ++half) { const int ch = half * 512 + F.lane * 8;
                const unsigned yfw[4] = {yf[r][half].x, yf[r][half].y, yf[r][half].z, yf[r][half].w}, ybw[4] = {yb[r][half].x, yb[r][half].y, yb[r][half].z, yb[r][half].w}, gw4[4] = {gv[r][half].x, gv[r][half].y, gv[r][half].z, gv[r][half].w};
                float y[8]; float s = 0.f;
#pragma unroll
                for (int j = 0; j < 4; ++j) { y[2 * j] = bflo(yfw[j]) + bflo(ybw[j]); y[2 * j + 1] = bfhi(yfw[j]) + bfhi(ybw[j]); s += y[2 * j] + y[2 * j + 1]; }
                s += __shfl_xor(s, 1); s += __shfl_xor(s, 2); s += __shfl_xor(s, 4); s += __shfl_xor(s, 8);
                const float mu = s * (1.f / 128.f); float q = 0.f;
#pragma unroll
                for (int j = 0; j < 8; ++j) { y[j] -= mu; q += y[j] * y[j]; }
                q += __shfl_xor(q, 1); q += __shfl_xor(q, 2); q += __shfl_xor(q, 4); q += __shfl_xor(q, 8);
                const float rstd = 1.0f / sqrtf(q * (1.f / 128.f) + EPS);
                float ov[8];
#pragma unroll
                for (int j = 0; j < 8; ++j) { const float gt = (j & 1) ? bfhi(gw4[j >> 1]) : bflo(gw4[j >> 1]); ov[j] = silu_f(gt) * (y[j] * rstd * gg[half][j >> 2][j & 3] + gb[half][j >> 2][j & 3]); }
                v4u o; o.x = pk2(ov[0], ov[1]); o.y = pk2(ov[2], ov[3]); o.z = pk2(ov[4], ov[5]); o.w = pk2(ov[6], ov[7]);
                *((v4u*)(F.YA1 + (size_t)(row0 + r) * LDYA1 + 512 + ch)) = o; }
    }
}

#define SEL8(arr, idx) (((idx) == 0 ? arr[0] : 0) + ((idx) == 1 ? arr[1] : 0) + ((idx) == 2 ? arr[2] : 0) + ((idx) == 3 ? arr[3] : 0) + ((idx) == 4 ? arr[4] : 0) + ((idx) == 5 ? arr[5] : 0) + ((idx) == 6 ? arr[6] : 0) + ((idx) == 7 ? arr[7] : 0))
__device__ __forceinline__ void ph_norm3_route(const Frame& F) {
    LAS float* rt = (LAS float*)F.lds;
    for (int i = F.tid; i < 1024 * 8 / 4; i += 512) ((LAS f32x4*)rt)[i] = ((const f32x4*)F.moe_router)[i];
    __syncthreads();
    const int gw = F.vcu * NWAVES + F.wave, NGW = F.G * NWAVES;
    const float* g = F.norm_ffn_g + 1024;
    for (int ch = gw; ch < 2048; ch += NGW) {
        int cnt[8];
#pragma unroll
        for (int e = 0; e < 8; ++e) cnt[e] = 0;
        const int bidx = (ch * 8) >> 11;
        const float* mod = F.MOD + (size_t)(9 + bidx) * 6144 + 3 * 1024;
        f32x4 gg[4], sh[4];
#pragma unroll
        for (int j = 0; j < 4; ++j) { gg[j] = ((const f32x4*)g)[F.lane + 64 * j] * (((const f32x4*)(mod + 1024))[F.lane + 64 * j] + 1.0f); sh[j] = ((const f32x4*)mod)[F.lane + 64 * j]; }
        for (int i2 = 0; i2 < 8; i2 += 2) {
            f32x4 v[2][4]; float ss[2];
#pragma unroll
            for (int r = 0; r < 2; ++r) { const v2u* xr = (const v2u*)(F.X + (size_t)(ch * 8 + i2 + r) * 1024) + F.lane;
#pragma unroll
                for (int j = 0; j < 4; ++j) v[r][j] = bf4(NTL(xr + 64 * j)); }
#pragma unroll
            for (int r = 0; r < 2; ++r) { float s = 0.f;
#pragma unroll
                for (int j = 0; j < 4; ++j) s += (v[r][j].x * v[r][j].x + v[r][j].y * v[r][j].y) + (v[r][j].z * v[r][j].z + v[r][j].w * v[r][j].w);
                ss[r] = s; }
#pragma unroll
            for (int o = 1; o < 64; o <<= 1) { ss[0] += __shfl_xor(ss[0], o); ss[1] += __shfl_xor(ss[1], o); }
#pragma unroll
            for (int r = 0; r < 2; ++r) { const float rstd = 1.0f / sqrtf(ss[r] * (1.f / 1024.f) + EPS);
                unsigned long long* o8 = (unsigned long long*)(F.H + (size_t)(ch * 8 + i2 + r) * 1024) + F.lane;
#pragma unroll
                for (int j = 0; j < 4; ++j) { v[r][j] = (v[r][j] * rstd) * gg[j] + sh[j]; *(o8 + 64 * j) = (unsigned long long)pk2(v[r][j].x, v[r][j].y) | ((unsigned long long)pk2(v[r][j].z, v[r][j].w) << 32); } }
#pragma unroll
            for (int r = 0; r < 2; ++r) { const int row = ch * 8 + i2 + r;
                float lg[8];
#pragma unroll
                for (int e = 0; e < 8; ++e) lg[e] = 0.f;
#pragma unroll
                for (int j = 0; j < 4; ++j)
#pragma unroll
                    for (int q = 0; q < 4; ++q) { const int k = 4 * (F.lane + 64 * j) + q; const f32x4 r0 = ((const LAS f32x4*)(rt + k * 8))[0], r1 = ((const LAS f32x4*)(rt + k * 8))[1];
                        const float hv = v[r][j][q];
                        lg[0] += hv * r0.x; lg[1] += hv * r0.y; lg[2] += hv * r0.z; lg[3] += hv * r0.w; lg[4] += hv * r1.x; lg[5] += hv * r1.y; lg[6] += hv * r1.z; lg[7] += hv * r1.w; }
#pragma unroll
                for (int o = 1; o < 64; o <<= 1) {
#pragma unroll
                    for (int e = 0; e < 8; ++e) lg[e] += __shfl_xor(lg[e], o); }
                int i0 = 0; float v0 = lg[0];
#pragma unroll
                for (int e = 1; e < 8; ++e) if (lg[e] > v0) { v0 = lg[e]; i0 = e; }
                int i1 = -1; float v1 = -3.0e38f;
#pragma unroll
                for (int e = 0; e < 8; ++e) if (e != i0 && lg[e] > v1) { v1 = lg[e]; i1 = e; }
                const float e1 = __expf(v1 - v0), g0 = 1.f / (1.f + e1), g1 = e1 / (1.f + e1);
                const int r0 = SEL8(cnt, i0);
#pragma unroll
                for (int e = 0; e < 8; ++e) cnt[e] += (e == i0) ? 1 : 0;
                const int r1 = SEL8(cnt, i1);
#pragma unroll
                for (int e = 0; e < 8; ++e) cnt[e] += (e == i1) ? 1 : 0;
                if (F.lane == 0) { F.TOPK[row] = i0 | (i1 << 4) | (r0 << 8) | (r1 << 16); F.GATE[row * 2] = g0; F.GATE[row * 2 + 1] = g1; } }
        }
        if (F.lane < 8) F.CNT[ch * 8 + F.lane] = SEL8(cnt, F.lane);
    }
}

__device__ __forceinline__ void ph_norm3_route_mfma(const Frame& F) {
    constexpr int RS = 1056;
    LAS bf16* wt = (LAS bf16*)F.lds;
    LAS float* tiles = (LAS float*)(F.lds + 2 * 8 * RS * 2);
    for (int i = F.tid; i < 1024 * 8; i += 512) { const int kk = i >> 3, e = i & 7; const float w = F.moe_router[i]; const unsigned hi = f2bf(w); const float rem = w - bf2f((bf16)hi);
        wt[e * RS + kk] = (bf16)hi; wt[8 * RS + e * RS + kk] = (bf16)f2bf(rem); }
    const float* gptr = F.norm_ffn_g + 1024;
    const int lane = F.lane, l15 = lane & 15, g = lane >> 4;
    for (int base = F.vcu * 64; base < TL; base += F.G * 64) {
        norm_rows<1, 0, 8>(F, gptr, 1, 1, base + F.wave * 8);
        asm volatile("s_waitcnt vmcnt(0)" ::: "memory");
        __syncthreads();
        if (F.wave < 4) {
            const int rb = base + 16 * F.wave;
            const bf16* hp = F.H + (size_t)(rb + l15) * 1024 + 8 * g;
            const LAS bf16* wh = wt + (l15 & 7) * RS + 8 * g; const LAS bf16* wl = wh + 8 * RS;
            f32x4 ah[2] = {(f32x4){0.f, 0.f, 0.f, 0.f}, (f32x4){0.f, 0.f, 0.f, 0.f}}, al[2] = {(f32x4){0.f, 0.f, 0.f, 0.f}, (f32x4){0.f, 0.f, 0.f, 0.f}};
            const bf16x8 zero8 = {0, 0, 0, 0, 0, 0, 0, 0};
#pragma unroll
            for (int half = 0; half < 2; ++half) {
                bf16x8 af[16];
#pragma unroll
                for (int s = 0; s < 16; ++s) af[s] = *(const bf16x8*)(hp + 32 * (16 * half + s));
#pragma unroll
                for (int s = 0; s < 16; ++s) { const int ss = 16 * half + s;
                    bf16x8 bh = *(const LAS bf16x8*)(wh + 32 * ss), bl = *(const LAS bf16x8*)(wl + 32 * ss);
                    if (l15 >= 8) { bh = zero8; bl = zero8; }
                    ah[s & 1] = __builtin_amdgcn_mfma_f32_16x16x32_bf16(af[s], bh, ah[s & 1], 0, 0, 0);
                    al[s & 1] = __builtin_amdgcn_mfma_f32_16x16x32_bf16(af[s], bl, al[s & 1], 0, 0, 0); } }
            const f32x4 lgv = (ah[0] + ah[1]) + (al[0] + al[1]);
            LAS float* tile = tiles + F.wave * 128;
            if (l15 < 8) {
#pragma unroll
                for (int r = 0; r < 4; ++r) tile[(4 * g + r) * 8 + l15] = lgv[r]; }
            LDS_WAIT(); asm volatile("" ::: "memory");
            int i0 = 15, i1 = 15; float g0 = 0.f, g1 = 0.f;
            if (lane < 16) { const f32x4 q0 = *(const LAS f32x4*)(tile + lane * 8), q1 = *(const LAS f32x4*)(tile + lane * 8 + 4);
                const float lg[8] = {q0.x, q0.y, q0.z, q0.w, q1.x, q1.y, q1.z, q1.w};
                i0 = 0; float v0 = lg[0];
#pragma unroll
                for (int e = 1; e < 8; ++e) if (lg[e] > v0) { v0 = lg[e]; i0 = e; }
                i1 = -1; float v1 = -3.0e38f;
#pragma unroll
                for (int e = 0; e < 8; ++e) if (e != i0 && lg[e] > v1) { v1 = lg[e]; i1 = e; }
                const float e1 = __expf(v1 - v0); g0 = 1.f / (1.f + e1); g1 = e1 / (1.f + e1); }
            const unsigned long long chunkbits = (lane < 8) ? 0xFFull : 0xFF00ull, below = chunkbits & ((1ull << (lane & 15)) - 1ull);
            int r0 = 0, r1 = 0, cn = 0;
#pragma unroll
            for (int e = 0; e < 8; ++e) { const unsigned long long mk = __ballot((i0 == e) || (i1 == e)) & 0xFFFFull;
                const int nb = __popcll(mk & below);
                r0 = (i0 == e) ? nb : r0; r1 = (i1 == e) ? nb : r1;
                cn = ((lane & 7) == e) ? __popcll(mk & chunkbits) : cn; }
            if (lane < 16) { const int row = rb + lane;
                F.TOPK[row] = i0 | (i1 << 4) | (r0 << 8) | (r1 << 16); F.GATE[row * 2] = g0; F.GATE[row * 2 + 1] = g1;
                F.CNT[rb + lane] = cn; }
        }
        __syncthreads();
    }
}

__device__ __forceinline__ void ph_route2(const Frame& F) {
    LAS int* coff = (LAS int*)F.lds;
    LAS int* wtot = coff + 2048 * 8;
    LAS int* meta = wtot + 64;
    const int t = F.tid;
    int loc[4][8], tot[8], incl[8];
#pragma unroll
    for (int i = 0; i < 4; ++i) { const int4 a = ((const int4*)(F.CNT + (4 * t + i) * 8))[0], b = ((const int4*)(F.CNT + (4 * t + i) * 8))[1];
        loc[i][0] = a.x; loc[i][1] = a.y; loc[i][2] = a.z; loc[i][3] = a.w; loc[i][4] = b.x; loc[i][5] = b.y; loc[i][6] = b.z; loc[i][7] = b.w; }
#pragma unroll
    for (int e = 0; e < 8; ++e) { int run = 0;
#pragma unroll
        for (int i = 0; i < 4; ++i) { const int tmp = loc[i][e]; loc[i][e] = run; run += tmp; }
        tot[e] = run; int v = run;
#pragma unroll
        for (int o = 1; o < 64; o <<= 1) { const int n = __shfl_up(v, o); if (F.lane >= o) v += n; }
        incl[e] = v;
        if (F.lane == 63) wtot[F.wave * 8 + e] = v; }
    __syncthreads();
#pragma unroll
    for (int e = 0; e < 8; ++e) { int woff = 0;
        for (int w = 0; w < F.wave; ++w) woff += wtot[w * 8 + e];
        const int excl = woff + incl[e] - tot[e];
#pragma unroll
        for (int i = 0; i < 4; ++i) coff[(4 * t + i) * 8 + e] = excl + loc[i][e]; }
    if (t < 8) { int s = 0; for (int w = 0; w < 8; ++w) s += wtot[w * 8 + t]; meta[8 + t] = s; }
    __syncthreads();
    if (t == 0) { int base = 0; for (int e = 0; e < 8; ++e) { meta[e] = base; base += (meta[8 + e] + 255) & ~255; } meta[16] = base >> 8; }
    __syncthreads();
    if (F.vcu == 0 && t < 144) { int e = 0;
#pragma unroll
        for (int q = 1; q < 8; ++q) if (t * 256 >= meta[q]) e = q;
        F.TILEE[t] = e; if (t == 0) F.MMETA[0] = meta[16]; }
    const int gt = F.vcu * 512 + t, NGT = F.G * 512;
    for (int row = gt; row < TL; row += NGT) {
        const int tk = F.TOPK[row], ch = row >> 3, e0 = tk & 15, e1 = (tk >> 4) & 15, r0 = (tk >> 8) & 255, r1 = (tk >> 16) & 255;
        const int s0 = meta[e0] + coff[ch * 8 + e0] + r0, s1 = meta[e1] + coff[ch * 8 + e1] + r1;
        F.SLOT[row * 2] = s0; F.SLOT[row * 2 + 1] = s1; F.ROWIDX[s0] = row; F.ROWIDX[s1] = row;
    }
    for (int it = gt; it < 2048; it += NGT) { const int e = it >> 8, r = it & 255, slot = meta[e] + meta[8 + e] + r;
        if (slot < meta[e] + ((meta[8 + e] + 255) & ~255)) F.ROWIDX[slot] = 0; }
}

template <bool GATHER_>
struct MoeOrderT {
    static constexpr bool GATHER = GATHER_; const int* rowidx;
    const int* tile_e; int t0, t1, nN, G, c;
    __device__ __forceinline__ bool next(int i, pg8::Unit& u) const {
        const int ntiles = t1 - t0; u.k0 = 0; u.nk = 0;
        if ((G & 7) != 0) { const int L = i * G + c; if (L >= ntiles * nN) return false; const int pm = t0 + L / nN; u.pm = pm; u.pn = tile_e[pm] * nN + (L % nN); return true; }
        const int x = c & 7, wpx = G >> 3, s = i * wpx + (c >> 3), nblk = ntiles >> 3, rem = ntiles & 7;
        const int nbx = (nblk > x) ? ((nblk - x + 7) >> 3) : 0, full = nbx * 8 * nN;
        int pm, pl;
        if (s < full) { const int blk = x + 8 * (s / (8 * nN)), w = s % (8 * nN); pm = t0 + 8 * blk + (w & 7); pl = w >> 3; }
        else { const int q = (s - full) * 8 + x; if (rem == 0 || q >= rem * nN) return false; pm = t0 + 8 * nblk + (q % rem); pl = q / rem; }
        u.pm = pm; u.pn = tile_e[pm] * nN + pl; return true; }
    __device__ __forceinline__ void a_ready(const pg8::Unit&) const {}
    __device__ __forceinline__ void done(const pg8::Unit&) const {}
};
using MoeOrder = MoeOrderT<false>;
struct Moe2BOrder {
    static constexpr bool GATHER = false;
    const int* tile_e; int MT, G, c;
    __device__ __forceinline__ bool next(int i, pg8::Unit& u) const {
        const int t1 = MT < 128 ? MT : 128, nfull = (t1 - 64) * 4, L = i * G + c;
        if (L < nfull) { const int pm = 64 + (L >> 2); u.pm = pm; u.pn = tile_e[pm] * 4 + (L & 3); u.k0 = 0; u.nk = 0; return true; }
        const int nb = (MT - t1) * 4; if (nb <= 0) return false;
        const int r0 = (nfull + G - 1) / G; if (i < r0) return false;
        const int NS = 7, q = (i - r0) * G + c; if (q >= nb * NS) return false;
        const int bu = q % nb, sl = q / nb, pm = t1 + (bu >> 2); u.pm = pm; u.pn = tile_e[pm] * 4 + (bu & 3); u.k0 = sl * (DFE / NS); u.nk = DFE / NS / 64; return true; }
    __device__ __forceinline__ void a_ready(const pg8::Unit&) const {}
    __device__ __forceinline__ void done(const pg8::Unit&) const {}
};
struct EpiSwigluMoe {
    bf16* O; int row0;
    __device__ __forceinline__ void operator()(int row, int col, f32x4 alo, f32x4 ahi, f32x4 blo, f32x4 bhi) const {
        v4u w; w.x = pk2(silu_f(alo.x) * blo.x, silu_f(alo.y) * blo.y); w.y = pk2(silu_f(alo.z) * blo.z, silu_f(alo.w) * blo.w);
        w.z = pk2(silu_f(ahi.x) * bhi.x, silu_f(ahi.y) * bhi.y); w.w = pk2(silu_f(ahi.z) * bhi.z, silu_f(ahi.w) * bhi.w);
        *(v4u*)(O + (size_t)(row - row0) * DFE + (col % DFE)) = w; }
};
struct EpiStoreMoe {
    bf16* O; bf16* T;
    __device__ __forceinline__ void operator()(int row, int col, f32x4 lo, f32x4 hi, int part = 0) const {
        if (part) { bf16* o = T + ((size_t)((part - 1) / 512) * 2048 + (row - 128 * 256)) * 1024 + (col & 1023); v4u q; q.x = pk2(lo.x, lo.y); q.y = pk2(lo.z, lo.w); q.z = pk2(hi.x, hi.y); q.w = pk2(hi.z, hi.w); *(v4u*)o = q; return; }
        v4u w; w.x = pk2(lo.x, lo.y); w.y = pk2(lo.z, lo.w); w.z = pk2(hi.x, hi.y); w.w = pk2(hi.z, hi.w);
        *(v4u*)(O + (size_t)row * LDHP + (col & 1023)) = w; }
};
template <class F8>
__device__ __forceinline__ void gemm_moe_pair(const Frame& F, const bf16* A, const bf16* Bt, int K, int nN, int t0, int t1, const F8& f, int ld = 0) {
    pg8::Gemm g{A, Bt, 0, 0, K, ld}; MoeOrderT<true> S{F.ROWIDX, F.TILEE, t0, t1, nN, F.G, (int)blockIdx.x};
    EpiAdaptPair<F8> E{f};
    pg8::gemm_phase<EpiAdaptPair<F8>, MoeOrderT<true>, true, true>(F.lds, g, S, E);
}
template <class F8>
__device__ __forceinline__ void gemm_moe(const Frame& F, const bf16* A, const bf16* Bt, int K, int nN, int t0, int t1, const F8& f, int ld = 0) {
    pg8::Gemm g{A, Bt, 0, 0, K, ld}; MoeOrder S{nullptr, F.TILEE, t0, t1, nN, F.G, (int)blockIdx.x};
    EpiAdapt<F8> E{f};
    pg8::gemm_phase<EpiAdapt<F8>, MoeOrder, true, true>(F.lds, g, S, E);
}

__device__ __forceinline__ void ph_final(const Frame& F) {
    const int gw = F.vcu * NWAVES + F.wave, NGW = F.G * NWAVES;
    for (int row0 = gw * 8; row0 < TL; row0 += NGW * 8) {
        const int slv = (F.lane < 16) ? F.SLOT[row0 * 2 + F.lane] : 0; const float gtv = (F.lane < 16) ? F.GATE[row0 * 2 + F.lane] : 0.f;
        const float* g2 = F.MOD + (size_t)(9 + (row0 >> 11)) * 6144 + 5 * 1024;
        v2u xall[8][4];
#pragma unroll
        for (int r = 0; r < 8; ++r)
#pragma unroll
            for (int j = 0; j < 4; ++j) xall[r][j] = NTL((const v2u*)(F.X + (size_t)(row0 + r) * 1024) + F.lane + 64 * j);
#pragma unroll
        for (int h4 = 0; h4 < 8; h4 += 4) {
            v2u xr[4][4], yr[4][2][4]; float gt[4][2];
#pragma unroll
            for (int r = 0; r < 4; ++r) {
#pragma unroll
                for (int j = 0; j < 4; ++j) xr[r][j] = xall[h4 + r][j];
#pragma unroll
                for (int k = 0; k < 2; ++k) { const int s = __builtin_amdgcn_readfirstlane(__shfl(slv, (h4 + r) * 2 + k)); gt[r][k] = __uint_as_float(__builtin_amdgcn_readfirstlane(__float_as_uint(__shfl(gtv, (h4 + r) * 2 + k))));
                    if (s >= 32768) { const v2u* tp = (const v2u*)(F.Y2T + (size_t)(s - 32768) * 1024) + F.lane;
#pragma unroll
                        for (int j = 0; j < 4; ++j) { f32x4 a = bf4(tp[64 * j]);
#pragma unroll
                            for (int q = 1; q < 7; ++q) a += bf4(tp[64 * j + (size_t)q * 2048 * 256]);
                            yr[r][k][j] = pk4(a); } }
                    else { const v2u* yp = (const v2u*)(F.HP + (size_t)s * LDHP) + F.lane;
#pragma unroll
                        for (int j = 0; j < 4; ++j) yr[r][k][j] = NTL(yp + 64 * j); } } }
            f32x4 gg[4];
#pragma unroll
            for (int j = 0; j < 4; ++j) gg[j] = ((const f32x4*)g2)[F.lane + 64 * j];
            f32x4 xv[4][4]; float ss[4];
#pragma unroll
            for (int r = 0; r < 4; ++r) { float s = 0.f;
#pragma unroll
                for (int j = 0; j < 4; ++j) { const f32x4 y = bf4(yr[r][0][j]) * gt[r][0] + bf4(yr[r][1][j]) * gt[r][1];
                    xv[r][j] = bf4(xr[r][j]) + gg[j] * y; s += (xv[r][j].x * xv[r][j].x + xv[r][j].y * xv[r][j].y) + (xv[r][j].z * xv[r][j].z + xv[r][j].w * xv[r][j].w); }
                ss[r] = s; }
#pragma unroll
            for (int o = 1; o < 64; o <<= 1) {
#pragma unroll
                for (int r = 0; r < 4; ++r) ss[r] += __shfl_xor(ss[r], o); }
            f32x4 fg[4];
#pragma unroll
            for (int j = 0; j < 4; ++j) fg[j] = ((const f32x4*)F.final_g)[F.lane + 64 * j];
#pragma unroll
            for (int r = 0; r < 4; ++r) { const float rstd = 1.0f / sqrtf(ss[r] * (1.f / 1024.f) + EPS);
                f32x4* o = (f32x4*)(F.out + (size_t)(row0 + h4 + r) * 1024) + F.lane;
#pragma unroll
                for (int j = 0; j < 4; ++j) o[64 * j] = xv[r][j] * rstd * fg[j]; }
        }
    }
}

constexpr int IN0_Q = 3, IN0_X = (256 - (72 * 17) % 256) * NWAVES * IN0_Q;
__device__ __forceinline__ void cvt_tail_in0(const Frame& F) {
    const int rem = (72 * 17) % 256; if ((int)blockIdx.x < rem) return;
    LAS float* scr = (LAS float*)(F.lds + F.wave * 16640);
    const int w = ((int)blockIdx.x - rem) * NWAVES + F.wave, nw = (256 - rem) * NWAVES;
    for (int k = 0; k < IN0_Q; ++k) cvt_item2(F, scr, CVT_N2 - IN0_X + k * nw + w);
}
constexpr int TAIL_OUT0 = 64 * NWAVES, TAIL_F2 = 64 * NWAVES, TAIL_IN1 = 8 * NWAVES * 3, TAILX = TAIL_OUT0 + TAIL_F2 + TAIL_IN1, W2T_BASE = CVT_N2 - IN0_X - TAILX;
__device__ __forceinline__ void cvt_tail_w2(const Frame& F, int first_idle, int base, int q) {
    if ((int)blockIdx.x < first_idle) return;
    LAS float* scr = (LAS float*)(F.lds + F.wave * 16640);
    const int w = ((int)blockIdx.x - first_idle) * NWAVES + F.wave, nw = (256 - first_idle) * NWAVES;
    for (int k = 0; k < q; ++k) cvt_item2(F, scr, base + k * nw + w);
}
constexpr int FW = 5, SEAM_C = FW * 256, NT256 = (256 - (72 * 22) % 256) * NWAVES * QB_F13, SEAM_N13 = CVT_N13 - NT256, SEAM_E13 = 7680 + SEAM_N13;
static_assert(NT256 <= CVT_N13 && SEAM_E13 + (CVT_N2 - 3840 - IN0_X - TAILX) <= 16 * SEAM_C && IN0_X + TAILX <= CVT_N2 - 3840 && 7680 == 6 * SEAM_C && SEAM_E13 <= 16 * SEAM_C, "seam filler schedule");
template <int K>
__device__ __forceinline__ void seam_fill(const Frame& F) {
    constexpr int lo = K * SEAM_C, hi = lo + SEAM_C;
    if constexpr (lo >= SEAM_E13 + (CVT_N2 - 3840 - IN0_X - TAILX)) return;
    LAS float* scr = (LAS float*)(F.lds + F.wave * 16640);
    const int g = lo + F.vcu * FW + (F.wave - 1);
    if (g >= hi) return;
#define SEAM_RANGE(a_, b_) if constexpr (hi > (a_) && lo < (b_)) if (g >= (a_) && g < (b_))
    SEAM_RANGE(0, 384) { tr_item64(F.ev_w_out, 1536, 1024, F.WOUT0, 0, scr, g, F.lane); return; }
    SEAM_RANGE(384, 1792) { const int r = g - 384; const bool up = r >= 704; tr_item64(up ? F.ffn_w3 : F.ffn_w1, 1024, DFF, F.WF13, up ? 2 : 1, scr, up ? r - 704 : r, F.lane); return; }
    SEAM_RANGE(1792, 2496) { tr_item64(F.ffn_w2, DFF, 1024, F.WF2, 0, scr, g - 1792, F.lane); return; }
    SEAM_RANGE(2496, 3456) { tr_item64(F.od_w_in, 1024, LDP1, F.WIN1, 3, scr, g - 2496, F.lane); return; }
    SEAM_RANGE(3456, 3840) { tr_item64(F.od_w_out, 1536, 1024, F.WOUT1, 0, scr, g - 3456, F.lane, LDYA1); return; }
    SEAM_RANGE(3840, 7680) { cvt_item2(F, scr, g - 3840); return; }
    SEAM_RANGE(7680, SEAM_E13) { cvt_item13(F, scr, NT256 + (g - 7680)); return; }
    SEAM_RANGE(SEAM_E13, SEAM_E13 + (CVT_N2 - 3840 - IN0_X - TAILX)) { cvt_item2(F, scr, 3840 + (g - SEAM_E13)); return; }
#undef SEAM_RANGE
}
template <int K>
__device__ __forceinline__ void xcd_barrier_fill(const XcdBarrier& b, const Frame& F, bool fill) {
    asm volatile("s_waitcnt vmcnt(0)" ::: "memory");
    __syncthreads();
    if (F.wave == 0) xcd_barrier_thread0(b);
    else if (fill && F.wave <= FW) seam_fill<K>(F);
    __syncthreads();
}

__device__ __forceinline__ void frame_ws(Frame& F, unsigned char* ws) {
    F.MOD = (float*)(ws + WS_MOD); F.GATE = (float*)(ws + WS_GATE); F.ROPE = (float*)(ws + WS_ROPE); F.X = (bf16*)(ws + WS_X);
    F.WIN0 = (bf16*)(ws + WS_WIN0); F.WOUT0 = (bf16*)(ws + WS_WOUT0); F.WF13 = (bf16*)(ws + WS_WF13); F.WF2 = (bf16*)(ws + WS_WF2); F.WIN1 = (bf16*)(ws + WS_WIN1); F.WOUT1 = (bf16*)(ws + WS_WOUT1);
    F.WM13 = (bf16*)(ws + WS_WM13); F.H = (bf16*)(ws + WS_H); F.P = (bf16*)(ws + WS_P); F.YA0 = (bf16*)(ws + WS_YA0); F.YA1 = (bf16*)(ws + WS_YA1); F.XBC = (bf16*)(ws + WS_XBC);
    F.YF0 = (bf16*)(ws + WS_YF0); F.YB0 = (bf16*)(ws + WS_YB0); F.YF1 = (bf16*)(ws + WS_YF1); F.YB1 = (bf16*)(ws + WS_YB1); F.Gh = (bf16*)(ws + WS_G); F.MG = (bf16*)(ws + WS_MG); F.HP = (bf16*)(ws + WS_HP);
    F.ctl = (unsigned*)(ws + WS_CTL); F.Y2T = (bf16*)(ws + WS_Y2T); F.PART = (bf16*)(ws + WS_PART);
    F.TOPK = (int*)(ws + WS_TOPK); F.SLOT = (int*)(ws + WS_SLOT); F.CNT = (int*)(ws + WS_CNT); F.TILEE = (int*)(ws + WS_TILEE); F.MMETA = (int*)(ws + WS_MMETA); F.ROWIDX = (int*)(ws + WS_ROWIDX);
}

__device__ __forceinline__ void frame_in(Frame& F) {
    using CFP = const float*; typedef __attribute__((address_space(4))) const CFP* KP;
    unsigned long long k_ = (unsigned long long)__builtin_amdgcn_kernarg_segment_ptr(); asm volatile("" : "+s"(k_)); const KP kp = (KP)k_;
    F.x = kp[0]; F.c = kp[1]; F.ctx = kp[2]; F.c_ctx = kp[3]; F.ada_w = kp[4]; F.ada_b = kp[5]; F.norm_attn_g = kp[6]; F.norm_ffn_g = kp[7];
    F.ev_w_in = kp[8]; F.ev_w_out = kp[9]; F.na_rpb = kp[10]; F.conv_w = kp[11]; F.conv_b = kp[12]; F.dt_bias = kp[13]; F.a_log = kp[14]; F.ssm_d = kp[15];
    F.ssm_norm_g = kp[16]; F.ffn_w1 = kp[17]; F.ffn_w3 = kp[18]; F.ffn_w2 = kp[19]; F.od_w_in = kp[20]; F.od_w_out = kp[21]; F.swa_sink = kp[22];
    F.ret_log_decay = kp[23]; F.ret_gn_g = kp[24]; F.ret_gn_b = kp[25]; F.moe_router = kp[26]; F.moe_w1 = kp[27]; F.moe_w3 = kp[28]; F.moe_w2 = kp[29]; F.final_g = kp[30];
    F.out = (float*)kp[31]; F.WM2 = (bf16*)F.out;
    frame_ws(F, (unsigned char*)kp[32]);
}
__device__ __forceinline__ bool frame_phase(Frame& F) { frame_in(F);
    int t_ = threadIdx.x; asm volatile("" : "+v"(t_)); t_ &= 511; F.tid = t_; F.lane = t_ & 63; F.wave = __builtin_amdgcn_readfirstlane(t_ >> 6);
    return true; }

enum { PH_CVT = 0, PH_NORM0, PH_IN0, PH_MIX0, PH_SCAN0, PH_SSMOUT, PH_OUT0, PH_NORM1, PH_F13, PH_F2, PH_NORM2, PH_IN1, PH_MIX1, PH_RETOUT, PH_OUT1, PH_NORM3, PH_ROUTE2, PH_MG1A, PH_MG2A, PH_MG1B, PH_MG2B, PH_FINAL, NPHASES };

struct Args { const float* in[31]; float* out; unsigned char* ws; int ph_lo, ph_hi; };

__global__ void __launch_bounds__(NWAVES * 64, 2) fwd(Args args) {
    extern __shared__ __attribute__((aligned(16))) unsigned char lds_raw[];
    Frame F;
    F.lds = (LAS unsigned char*)lds_raw;
    F.tid = threadIdx.x; F.lane = F.tid & 63; F.wave = __builtin_amdgcn_readfirstlane(F.tid >> 6);
    F.G = gridDim.x; { const int bx = blockIdx.x; F.vcu = (F.G % 8 == 0) ? (bx % 8) * (F.G / 8) + bx / 8 : bx; }
    frame_in(F);
    unsigned char* ws = args.ws;

    for (int u = F.tid; u < (LDS_BYTES - LDSCTL_OFF) / 4; u += NWAVES * 64) ((LAS unsigned*)(F.lds + LDSCTL_OFF))[u] = 0u;
    __syncthreads();
    volatile LAS unsigned* MISC = (volatile LAS unsigned*)(F.lds + MISC_OFF);
    XcdBarrier bar; bar.bar = (unsigned*)(ws + WS_CTL) + CW_BAR; bar.x = 0; bar.st = nullptr;
    const int lo = args.ph_lo, hi = args.ph_hi;
    const bool fill = (F.G == 256) && (hi - lo == NPHASES);
    if (hi - lo > 1) bar = xcd_barrier_post((unsigned*)(ws + WS_CTL) + CW_BAR, MISC + 8);
#ifndef PROBE_PH
#define PROBE_PH -1
#endif
#ifndef PROBE_TAG
#define PROBE_TAG 0
#endif
#define TREP(tag) for (int _tr = 0; _tr < ((tag) == PROBE_TAG ? 2 : 1); ++_tr)
#define REPS(k) for (int _rep = 0; _rep < ((k) == PROBE_PH ? 2 : 1); ++_rep)
#define IN(k) (lo <= (k) && (k) < hi && frame_phase(F))
#define SEAM(k) do { if (IN(k) && IN((k) + 1)) { unsigned long long wsb_ = (unsigned long long)args.ws; asm volatile("" : "+s"(wsb_)); \
        XcdBarrier bb_; bb_.bar = (unsigned*)(wsb_ + WS_CTL) + CW_BAR; bb_.x = xb_xcc_id(); bb_.st = (volatile LAS unsigned*)(F.lds + MISC_OFF) + 8; xcd_barrier_fill<(k)>(bb_, F, fill); } else __syncthreads(); } while (0)

    if (IN(PH_CVT)) { REPS(PH_CVT) { ph_cvt(F, fill); __syncthreads(); } SEAM(PH_CVT); }
    if (IN(PH_NORM0)) { REPS(PH_NORM0) ph_norm<0, false>(F, 0, 0, TT); SEAM(PH_NORM0); }
    if (IN(PH_IN0)) { REPS(PH_IN0) { EpiStore E{F.P, LDP0}; gemm_pg8(F, F.H, F.WIN0, TT, LDP0, 1024, E); } TREP(8) { if (_tr == 1) { EpiNull E0; gemm_pg8(F, F.H, F.WIN0, TT, LDP0, 512, E0, 1024); } } TREP(11) { if (_tr == 1) { EpiNull E0; gemm_pg8(F, F.H, F.WIN0, TT, LDP0, 1024, E0, 1024); } } if (fill) cvt_tail_in0(F); SEAM(PH_IN0); }
    if (IN(PH_MIX0)) { REPS(PH_MIX0) { TREP(1) ph_attn0_mfma(F); TREP(2) ph_conv(F); } SEAM(PH_MIX0); }
    if (IN(PH_SCAN0)) { REPS(PH_SCAN0) chunk_scan2<128, false>(F); SEAM(PH_SCAN0); }
    if (IN(PH_SSMOUT)) { REPS(PH_SSMOUT) ph_ssmout(F); SEAM(PH_SSMOUT); }
    if (IN(PH_OUT0)) REPS(PH_OUT0) { EpiResidTail<EpiResidT<true>> E{EpiResidT<true>{F.x, F.ctx, F.X, F.MOD + 2 * 1024, nullptr, 0, 0}, F.PART, 256}; gemm_tail(F, F.YA0, F.WOUT0, 1536, E); if (fill) cvt_tail_w2(F, 192, W2T_BASE, 1); SEAM(PH_OUT0); }
    if (IN(PH_NORM1)) { ph_norm<1, false, 1>(F, 0, 1, TT); SEAM(PH_NORM1); }
    if (IN(PH_F13)) { REPS(PH_F13) { EpiSwiglu E{F.Gh, DFF}; gemm_pg8_pair(F, F.H, F.WF13, TT, 2 * DFF, 1024, E); } cvt_tail_f13(F); SEAM(PH_F13); }
    if (IN(PH_F2)) { EpiResidTail<EpiResid> E{EpiResid{nullptr, nullptr, F.X, F.MOD + 5 * 1024, nullptr, 0, 0}, F.PART, 512}; gemm_tail(F, F.Gh, F.WF2, DFF, E); TREP(9) { if (_tr == 1) { EpiNull E0; gemm_tail(F, F.Gh, F.WF2, DFF, E0); } } if (fill) cvt_tail_w2(F, 192, W2T_BASE + TAIL_OUT0, 1); SEAM(PH_F2); }
    if (IN(PH_NORM2)) { ph_norm<1, false, 2>(F, 1, 0, TT); SEAM(PH_NORM2); }
    if (IN(PH_IN1)) { LAS float* rtab = (LAS float*)(F.lds + RING_BYTES + 1024);
        for (int i = F.tid; i < 96 * 16; i += 512) { const int pos = i >> 4, f = i & 15; const float* sp = F.ROPE + ((size_t)(pos < 32 ? pos * 64 : (pos - 32)) * 32 + (pos < 32 ? f : 16 + f)) * 2; rtab[2 * i] = sp[0]; rtab[2 * i + 1] = sp[1]; }
        __syncthreads();
        REPS(PH_IN1) { pg8::Gemm g{F.H, F.WIN1, TT, LDP1, 1024, 0}; In1Order S{F.G, (int)blockIdx.x}; EpiAdapt<EpiRope> E{EpiRope{F.P, rtab}};
            pg8::gemm_phase<EpiAdapt<EpiRope>, In1Order, true, true>(F.lds, g, S, E); } if (fill) cvt_tail_w2(F, 248, W2T_BASE + TAIL_OUT0 + TAIL_F2, 3); SEAM(PH_IN1); }
    if (IN(PH_MIX1)) { REPS(PH_MIX1) { TREP(4) { chunk_scan2<64, true>(F); __syncthreads(); } TREP(5) { ph_swa_mfma(F); __syncthreads(); } } SEAM(PH_MIX1); }
    if (IN(PH_RETOUT)) { REPS(PH_RETOUT) { ph_retout(F); } SEAM(PH_RETOUT); }
    if (IN(PH_OUT1)) { EpiResid E{nullptr, nullptr, F.X, F.MOD + 9 * 6144 + 2 * 1024, nullptr, 0, 0}; gemm_pg8(F, F.YA1, F.WOUT1, TL, 1024, 1536, E, LDYA1); TREP(10) { if (_tr == 1) { EpiNull E0; gemm_pg8(F, F.YA1, F.WOUT1, TL, 1024, 1536, E0, LDYA1); } } SEAM(PH_OUT1); }
    if (IN(PH_NORM3)) { REPS(PH_NORM3) { TREP(6) ph_norm3_route_mfma(F); __syncthreads(); if (!fill) ph_cvt_moe(F); } SEAM(PH_NORM3); }
    if (IN(PH_ROUTE2)) { REPS(PH_ROUTE2) { ph_route2(F); __syncthreads(); } SEAM(PH_ROUTE2); }
    {
        int MT = 0; if (IN(PH_MG1A) || IN(PH_MG2A) || IN(PH_MG1B) || IN(PH_MG2B)) MT = __builtin_amdgcn_readfirstlane(F.MMETA[0]);
        const int ta = MT < 64 ? MT : 64;
        if (IN(PH_MG1A)) { REPS(PH_MG1A) { EpiSwigluMoe E{F.MG, 0}; gemm_moe_pair(F, F.H, F.WM13, 1024, 28, 0, ta, E, 1024); } SEAM(PH_MG1A); }
        if (IN(PH_MG2A)) { EpiStoreMoe E{F.HP, F.Y2T}; gemm_moe(F, F.MG, F.WM2, DFE, 4, 0, ta, E); SEAM(PH_MG2A); }
        if (IN(PH_MG1B)) { REPS(PH_MG1B) { EpiSwigluMoe E{F.MG, 64 * 256}; gemm_moe_pair(F, F.H, F.WM13, 1024, 28, 64, MT, E, 1024); } SEAM(PH_MG1B); }
        if (IN(PH_MG2B)) REPS(PH_MG2B) { EpiStoreMoe Ef{F.HP, F.Y2T}; pg8::Gemm g{F.MG - (size_t)64 * 256 * DFE, F.WM2, 0, 0, DFE, 0}; Moe2BOrder S{F.TILEE, MT, F.G, (int)blockIdx.x}; EpiAdapt<EpiStoreMoe> E{Ef};
            pg8::gemm_phase<EpiAdapt<EpiStoreMoe>, Moe2BOrder, true, true>(F.lds, g, S, E); SEAM(PH_MG2B); }
    }
    if (IN(PH_FINAL)) { REPS(PH_FINAL) ph_final(F); }
#undef IN
#undef SEAM
}

extern "C" void kernel_launch(void* const* d_in, const int* in_sizes, int n_in, void* d_out, int out_size, void* d_ws, size_t ws_size, hipStream_t stream) {
    static int grid = 0;
    if (grid == 0) {
        if (n_in != 31 || out_size != TL * DM || ws_size < WS_END) { fprintf(stderr, "kernel_launch: unexpected shapes (n_in %d out %d ws %zu need %zu)\n", n_in, out_size, ws_size, (size_t)WS_END); grid = -1; return; }
        int dev = 0, cus = 0, per_cu = 0;
        if (hipGetDevice(&dev) != hipSuccess || hipDeviceGetAttribute(&cus, hipDeviceAttributeMultiprocessorCount, dev) != hipSuccess) { grid = -1; return; }
        if (hipFuncSetAttribute((const void*)fwd, hipFuncAttributeMaxDynamicSharedMemorySize, LDS_BYTES) != hipSuccess) { grid = -1; return; }
        if (hipOccupancyMaxActiveBlocksPerMultiprocessor(&per_cu, (const void*)fwd, NWAVES * 64, LDS_BYTES) != hipSuccess || per_cu < 1) fprintf(stderr, "kernel_launch: occupancy query reports %d\n", per_cu);
        (void)hipGetLastError();
        grid = cus;
    }
    if (grid < 0) return;
    if (hipMemsetAsync((char*)d_ws + WS_CTL, 0, CTL_ZERO_BYTES, stream) != hipSuccess) return;
    Args a{};
    for (int i = 0; i < 31; ++i) a.in[i] = (const float*)d_in[i];
    a.out = (float*)d_out; a.ws = (unsigned char*)d_ws;
#if MK_ONE_LAUNCH
    a.ph_lo = 0; a.ph_hi = NPHASES;
    hipLaunchKernelGGL(fwd, dim3(grid), dim3(NWAVES * 64), LDS_BYTES, stream, a);
#else
    for (int ph = 0; ph < NPHASES; ++ph) { a.ph_lo = ph; a.ph_hi = ph + 1; hipLaunchKernelGGL(fwd, dim3(grid), dim3(NWAVES * 64), LDS_BYTES, stream, a); }
#endif
}
```
